# Optimizing an MI355X kernel written in HIP

```python
import math
import jax
import jax.numpy as jnp
from jax import lax
import numpy as np

D_MODEL = 1024
BATCH = 8
SEQ = 4096
DEPTH = 2

GRID_W = 64
CTX_LEN = 256
RMS_EPS = 1e-6
N_ADA = 6
DIFF_HEADS = 8
DIFF_HEAD_DIM = 64
DIFF_V_DIM = 2 * DIFF_HEAD_DIM
DIFF_QK_W = DIFF_HEADS * 2 * DIFF_HEAD_DIM
DIFF_V_W = DIFF_HEADS * DIFF_V_DIM
Q_BLOCK = 128
ROPE_BASE = 10000.0
ROT_AXIS_DIM = DIFF_HEAD_DIM // 2
CONV_W = D_MODEL // 2
CONV_K = 3
GLA_HEADS = 4
GLA_DK = 64
GLA_DV = 128
GLA_K_W = GLA_HEADS * GLA_DK
GLA_V_W = GLA_HEADS * GLA_DV
GLA_RANK = 16
GLA_TAU = 16.0
GLA_CHUNK = 64
N_BRANCH = 3
N_EXPERTS = 32
TOP_K = 4
D_EXPERT = D_MODEL
SWIGLU_LIMIT = 7.0
SWIGLU_ALPHA = 1.702
MOE_BLOCK = 128
SPLITS = (DIFF_QK_W, DIFF_QK_W, DIFF_V_W,
          CONV_W, CONV_W, CONV_W,
          GLA_K_W, GLA_K_W, GLA_V_W, GLA_V_W,
          2 * GLA_RANK,
          N_BRANCH * D_MODEL)
W_IN_COLS = int(sum(SPLITS))
SPLIT_POINTS = tuple(int(p) for p in np.cumsum(SPLITS)[:-1])

kernel_name = 'hybrid_diffattn_conv_gla_moe_dit'


def rms_norm(x, g):
    xf = x.astype(jnp.float32)
    y = xf * lax.rsqrt(jnp.mean(xf * xf, axis=-1, keepdims=True) + RMS_EPS)
    return (y * g.astype(jnp.float32)).astype(x.dtype)


def modulate(h, shift, scale):
    return h * (1.0 + scale) + shift


def rope_2d(x, row, col):
    inv_freq = ROPE_BASE ** (-jnp.arange(0, ROT_AXIS_DIM, 2, dtype=jnp.float32) / ROT_AXIS_DIM)

    def rotate(xp, pos):
        ang = pos.astype(jnp.float32)[:, None] * inv_freq[None, :]
        ang = jnp.concatenate([ang, ang], axis=-1)[:, None, None, :]
        cos = jnp.cos(ang).astype(xp.dtype)
        sin = jnp.sin(ang).astype(xp.dtype)
        x1, x2 = jnp.split(xp, 2, axis=-1)
        return xp * cos + jnp.concatenate([-x2, x1], axis=-1) * sin

    x_row, x_col = jnp.split(x, 2, axis=-1)
    return jnp.concatenate([rotate(x_row, row), rotate(x_col, col)], axis=-1)


def diff_attend(q, k, v, lam):
    s = jnp.einsum('bqhid,bkhid->bhiqk', q, k).astype(jnp.float32) * (DIFF_HEAD_DIM ** -0.5)
    p = jax.nn.softmax(s, axis=-1)
    a = p[:, :, 0] - lam * p[:, :, 1]
    return jnp.einsum('bhqk,bkhe->bqhe', a.astype(v.dtype), v)


def short_conv(u, w):
    up = jnp.pad(u, ((0, 0), (1, 1), (0, 0)))
    return up[:, :-2] * w[0] + up[:, 1:-1] * w[1] + up[:, 2:] * w[2]


def gla_chunked(q, k, v, g, s0):
    b, h, t, dk = q.shape
    dv = v.shape[-1]
    n = t // GLA_CHUNK
    q, k, g = (a.reshape(b, h, n, GLA_CHUNK, dk) for a in (q, k, g))
    v = v.reshape(b, h, n, GLA_CHUNK, dv)
    g_cum = jnp.cumsum(g, axis=3)
    g_tot = g_cum[:, :, :, -1]
    q_dec = q * jnp.exp(g_cum)
    k_inv = k * jnp.exp(-g_cum)
    k_end = k * jnp.exp(g_tot[:, :, :, None] - g_cum)
    lower_tri = jnp.tril(jnp.ones((GLA_CHUNK, GLA_CHUNK), dtype=bool))
    a = jnp.where(lower_tri, jnp.einsum('bhnld,bhnmd->bhnlm', q_dec, k_inv), 0.0)
    o_intra = jnp.einsum('bhnlm,bhnme->bhnle', a, v)
    s_local = jnp.einsum('bhnld,bhnle->bhnde', k_end, v)

    def step(s, inp):
        dec, s_loc = inp
        return jnp.exp(dec)[..., None] * s + s_loc, s

    s_fin, s_prev = lax.scan(step, s0, (jnp.moveaxis(g_tot, 2, 0), jnp.moveaxis(s_local, 2, 0)))
    o_inter = jnp.einsum('bhnld,bhnde->bhnle', q_dec, jnp.moveaxis(s_prev, 0, 2))
    return (o_intra + o_inter).reshape(b, h, t, dv), s_fin


def gla_bidir(q, k, v, g_f, g_b, s_f0, s_b0):
    o_f, s_f = gla_chunked(q, k, v, g_f, s_f0)
    flip = lambda a: jnp.flip(a, axis=2)
    o_b, s_b = gla_chunked(flip(q), flip(k), flip(v), flip(g_b), s_b0)
    return o_f + flip(o_b), s_f, s_b


def clamped_swiglu(hh):
    x_glu, x_lin = hh[..., ::2], hh[..., 1::2]
    x_glu = jnp.minimum(x_glu, SWIGLU_LIMIT)
    x_lin = jnp.clip(x_lin, -SWIGLU_LIMIT, SWIGLU_LIMIT)
    return x_glu * jax.nn.sigmoid(SWIGLU_ALPHA * x_glu) * (x_lin + 1.0)


def moe_ffn(h, router_w, router_b, w1, b1, w2, b2):
    t, d = h.shape
    logits = (h @ router_w + router_b).astype(jnp.float32)
    top_val, top_idx = lax.top_k(logits, TOP_K)
    gate = jax.nn.softmax(top_val, axis=-1)
    e_flat = top_idx.reshape(-1)
    g_flat = gate.reshape(-1)
    tk = t * TOP_K
    order = jnp.argsort(e_flat)
    e_sorted = e_flat[order]
    counts = jnp.bincount(e_flat, length=N_EXPERTS)
    padded = (counts + MOE_BLOCK - 1) // MOE_BLOCK * MOE_BLOCK
    pad_end = jnp.cumsum(padded)
    pad_start = pad_end - padded
    start = jnp.cumsum(counts) - counts
    dest = pad_start[e_sorted] + (jnp.arange(tk) - start[e_sorted])
    n_blocks = -(-tk // MOE_BLOCK) + N_EXPERTS
    n_rows = n_blocks * MOE_BLOCK
    row_tok = jnp.full((n_rows,), t, dtype=jnp.int32).at[dest].set((order // TOP_K).astype(jnp.int32))
    row_gate = jnp.zeros((n_rows,), jnp.float32).at[dest].set(g_flat[order])
    block_exp = jnp.minimum(jnp.searchsorted(pad_end, jnp.arange(n_blocks) * MOE_BLOCK, side='right'),
                            N_EXPERTS - 1)
    h_pad = jnp.concatenate([h, jnp.zeros((1, d), h.dtype)], axis=0)
    xs = h_pad[row_tok].reshape(n_blocks, MOE_BLOCK, d)

    def expert_block(args):
        xb, e = args
        return clamped_swiglu(xb @ w1[e] + b1[e]) @ w2[e] + b2[e]

    ys = lax.map(expert_block, (xs, block_exp)).reshape(n_rows, d)
    out = jnp.zeros((t + 1, d), ys.dtype).at[row_tok].add(ys * row_gate[:, None].astype(ys.dtype))
    return out[:t]


def token_mixer(h, hc, row, col, w_in, diff_lambda, lam_init, diff_subln_g, diff_w_out,
                conv_w, conv_w_out, gla_w_a2, gla_b_a, gla_norm_g, gla_w_out, w_o, ctx_out):
    b, s, _ = h.shape
    (d_q, d_k, d_v, cv_b, cv_c, cv_x, gl_q, gl_k, gl_v, gl_r, gl_a, gates) = jnp.split(
        h @ w_in, SPLIT_POINTS, axis=-1)
    (d_q_c, d_k_c, d_v_c, cv_b_c, cv_c_c, cv_x_c, gl_q_c, gl_k_c, gl_v_c, gl_r_c, gl_a_c, gates_c) = jnp.split(
        hc @ w_in, SPLIT_POINTS, axis=-1)

    lam_v = diff_lambda.astype(jnp.float32)
    lam = jnp.exp(jnp.sum(lam_v[0] * lam_v[1])) - jnp.exp(jnp.sum(lam_v[2] * lam_v[3])) + lam_init
    qk_heads = lambda a: a.reshape(a.shape[0], a.shape[1], DIFF_HEADS, 2, DIFF_HEAD_DIM)
    v_heads = lambda a: a.reshape(a.shape[0], a.shape[1], DIFF_HEADS, DIFF_V_DIM)
    q_lat = rope_2d(qk_heads(d_q), row, col)
    k_all = jnp.concatenate([rope_2d(qk_heads(d_k), row, col), qk_heads(d_k_c)], axis=1)
    v_all = jnp.concatenate([v_heads(d_v), v_heads(d_v_c)], axis=1)
    n_qb = s // Q_BLOCK
    q_blocks = jnp.moveaxis(q_lat.reshape(b, n_qb, Q_BLOCK, DIFF_HEADS, 2, DIFF_HEAD_DIM), 1, 0)
    o_blocks = lax.map(lambda qi: diff_attend(qi, k_all, v_all, lam), q_blocks)
    o_lat = jnp.moveaxis(o_blocks, 0, 1).reshape(b, s, DIFF_HEADS, DIFF_V_DIM)

    def diff_out(o_heads):
        o_heads = rms_norm(o_heads, diff_subln_g) * (1.0 - lam_init)
        return o_heads.reshape(o_heads.shape[0], o_heads.shape[1], DIFF_V_W) @ diff_w_out

    def conv_out(gb, gc, u):
        return (gb * short_conv(gc * u, conv_w)) @ conv_w_out

    def gla_inputs(gq, gk, gv, ga):
        t = gq.shape[1]
        heads = lambda a, dh: jnp.moveaxis(a.reshape(b, t, GLA_HEADS, dh), 2, 1).astype(jnp.float32)
        a_f, a_b = jnp.split(ga, 2, axis=-1)
        g_f = jax.nn.log_sigmoid((a_f @ gla_w_a2[0] + gla_b_a[0]).astype(jnp.float32)) / GLA_TAU
        g_b = jax.nn.log_sigmoid((a_b @ gla_w_a2[1] + gla_b_a[1]).astype(jnp.float32)) / GLA_TAU
        return (heads(gq, GLA_DK) * (GLA_DK ** -0.5), heads(gk, GLA_DK), heads(gv, GLA_DV),
                heads(g_f, GLA_DK), heads(g_b, GLA_DK))

    s0 = jnp.zeros((b, GLA_HEADS, GLA_DK, GLA_DV), jnp.float32)
    qc_, kc_, vc_, gfc_, gbc_ = gla_inputs(gl_q_c, gl_k_c, gl_v_c, gl_a_c)
    o_gla_c, s_f, s_b = gla_bidir(qc_, kc_, vc_, gfc_, gbc_, s0, s0)
    q_, k_, v_, gf_, gb_ = gla_inputs(gl_q, gl_k, gl_v, gl_a)
    o_gla, _, _ = gla_bidir(q_, k_, v_, gf_, gb_, s_f, s_b)

    def gla_out(o_heads, r):
        o_heads = rms_norm(jnp.moveaxis(o_heads, 1, 2), gla_norm_g).astype(r.dtype)
        return (o_heads.reshape(r.shape[0], r.shape[1], GLA_V_W) * jax.nn.silu(r)) @ gla_w_out

    def merge(gt, y_diff, y_conv, y_gla):
        g = jax.nn.sigmoid(gt).reshape(gt.shape[0], gt.shape[1], N_BRANCH, D_MODEL)
        return (g[:, :, 0] * y_diff + g[:, :, 1] * y_conv + g[:, :, 2] * y_gla) @ w_o

    m = merge(gates, diff_out(o_lat), conv_out(cv_b, cv_c, cv_x), gla_out(o_gla, gl_r))
    if not ctx_out:
        return m, None
    o_ctx = diff_attend(qk_heads(d_q_c), qk_heads(d_k_c), v_heads(d_v_c), lam)
    mc = merge(gates_c, diff_out(o_ctx), conv_out(cv_b_c, cv_c_c, cv_x_c), gla_out(o_gla_c, gl_r_c))
    return m, mc


def setup_inputs(seed: int = 0) -> dict:
    key = jax.random.key(seed)
    ks = jax.random.split(key, 32)
    L = DEPTH

    def nrm(k, shape, scale):
        return jax.random.normal(k, shape, jnp.float32) * scale

    return {
        'x': nrm(ks[0], (BATCH, SEQ, D_MODEL), 1.0),
        'c': nrm(ks[1], (BATCH, D_MODEL), 1.0),
        'ctx': nrm(ks[2], (BATCH, CTX_LEN, D_MODEL), 1.0),
        'c_ctx': nrm(ks[3], (D_MODEL,), 1.0),
        'ada_w': nrm(ks[4], (L, D_MODEL, N_ADA * D_MODEL), 0.5 * D_MODEL ** -0.5),
        'ada_b': nrm(ks[5], (L, N_ADA * D_MODEL), 0.01),
        'norm1_g': 1.0 + nrm(ks[6], (L, D_MODEL), 0.05),
        'norm2_g': 1.0 + nrm(ks[7], (L, D_MODEL), 0.05),
        'w_in': nrm(ks[8], (L, D_MODEL, W_IN_COLS), D_MODEL ** -0.5),
        'diff_lambda': nrm(ks[9], (L, 4, DIFF_HEAD_DIM), 0.1),
        'diff_subln_g': 1.0 + nrm(ks[10], (L, DIFF_V_DIM), 0.05),
        'diff_w_out': nrm(ks[11], (L, DIFF_V_W, D_MODEL), DIFF_V_W ** -0.5),
        'conv_w': nrm(ks[12], (L, CONV_K, CONV_W), CONV_K ** -0.5),
        'conv_w_out': nrm(ks[13], (L, CONV_W, D_MODEL), CONV_W ** -0.5),
        'gla_w_a2': nrm(ks[14], (L, 2, GLA_RANK, GLA_K_W), GLA_RANK ** -0.5),
        'gla_b_a': nrm(ks[15], (L, 2, GLA_K_W), 0.1),
        'gla_norm_g': 1.0 + nrm(ks[16], (L, GLA_DV), 0.05),
        'gla_w_out': nrm(ks[17], (L, GLA_V_W, D_MODEL), GLA_V_W ** -0.5),
        'w_o': nrm(ks[18], (L, D_MODEL, D_MODEL), D_MODEL ** -0.5),
        'router_w': nrm(ks[19], (L, D_MODEL, N_EXPERTS), D_MODEL ** -0.5),
        'router_b': nrm(ks[20], (L, N_EXPERTS), 0.01),
        'moe_w1': nrm(ks[21], (L, N_EXPERTS, D_MODEL, 2 * D_EXPERT), D_MODEL ** -0.5),
        'moe_b1': nrm(ks[22], (L, N_EXPERTS, 2 * D_EXPERT), 0.01),
        'moe_w2': nrm(ks[23], (L, N_EXPERTS, D_EXPERT, D_MODEL), D_EXPERT ** -0.5),
        'moe_b2': nrm(ks[24], (L, N_EXPERTS, D_MODEL), 0.01),
        'final_norm_g': 1.0 + nrm(ks[25], (D_MODEL,), 0.05),
    }


def reference(x, c, ctx, c_ctx, ada_w, ada_b, norm1_g, norm2_g, w_in, diff_lambda, diff_subln_g,
              diff_w_out, conv_w, conv_w_out, gla_w_a2, gla_b_a, gla_norm_g, gla_w_out, w_o,
              router_w, router_b, moe_w1, moe_b1, moe_w2, moe_b2, final_norm_g):
    b, s, d = x.shape
    rows = s // GRID_W
    row = jnp.repeat(jnp.arange(rows, dtype=jnp.int32), GRID_W)
    col = jnp.tile(jnp.arange(GRID_W, dtype=jnp.int32), rows)
    c_act = jax.nn.silu(c)
    c_ctx_act = jax.nn.silu(c_ctx)
    for layer in range(DEPTH):
        last = layer == DEPTH - 1
        lam_init = 0.8 - 0.6 * math.exp(-0.3 * layer)
        mod = c_act @ ada_w[layer] + ada_b[layer]
        mod_c = c_ctx_act @ ada_w[layer] + ada_b[layer]
        sh1, sc1, g1, sh2, sc2, g2 = jnp.split(mod[:, None, :], N_ADA, axis=-1)
        sh1c, sc1c, g1c, sh2c, sc2c, g2c = jnp.split(mod_c, N_ADA, axis=-1)
        h = modulate(rms_norm(x, norm1_g[layer]), sh1, sc1)
        hc = modulate(rms_norm(ctx, norm1_g[layer]), sh1c, sc1c)
        m, mc = token_mixer(h, hc, row, col, w_in[layer], diff_lambda[layer], lam_init,
                            diff_subln_g[layer], diff_w_out[layer], conv_w[layer], conv_w_out[layer],
                            gla_w_a2[layer], gla_b_a[layer], gla_norm_g[layer], gla_w_out[layer],
                            w_o[layer], not last)
        x = x + g1 * m
        h2 = modulate(rms_norm(x, norm2_g[layer]), sh2, sc2)
        moe_args = (router_w[layer], router_b[layer], moe_w1[layer], moe_b1[layer],
                    moe_w2[layer], moe_b2[layer])
        if last:
            f = moe_ffn(h2.reshape(b * s, d), *moe_args)
            x = x + g2 * f.reshape(b, s, d)
        else:
            ctx = ctx + g1c * mc
            h2c = modulate(rms_norm(ctx, norm2_g[layer]), sh2c, sc2c)
            tokens = jnp.concatenate([h2.reshape(b * s, d), h2c.reshape(-1, d)], axis=0)
            f = moe_ffn(tokens, *moe_args)
            x = x + g2 * f[:b * s].reshape(b, s, d)
            ctx = ctx + g2c * f[b * s:].reshape(ctx.shape)
    return rms_norm(x, final_norm_g)
```

```cpp
#include <hip/hip_runtime.h>
#include <cstdio>
#include <cstdint>
#define N_LAUNCH_MODE 0
namespace pg8 {
#define PG8_LAS __attribute__((address_space(3)))
typedef unsigned short bf16_t;
typedef short bf16x8 __attribute__((ext_vector_type(8)));
typedef float f32x4 __attribute__((ext_vector_type(4)));
typedef float f32x2 __attribute__((ext_vector_type(2)));
typedef unsigned u32x4 __attribute__((ext_vector_type(4)));
typedef unsigned u32x2 __attribute__((ext_vector_type(2)));
constexpr int BM = 256, BK = 64, HALF = 128, HTB = HALF * BK * 2  , STAGE_BYTES = 8 * HTB, NXCD = 8, WGM = 8;

__host__ __device__ __forceinline__ int lds_byte(int r, int c) { const int st = (r >> 4) * 2 + (c >> 5), rr = r & 15, cc = c & 31, ob = rr * 64 + cc * 2; return st * 1024 + (ob ^ (((ob >> 9) & 1) << 5)); }
__host__ __device__ __forceinline__ void stage_rc(int b, int& R, int& C) { const int st = b / 1024, sb = b % 1024, swz = sb ^ (((sb >> 9) & 1) << 5); R = (st >> 1) * 16 + swz / 64; C = (st & 1) * 32 + (swz % 64) / 2; }
__host__ __device__ __forceinline__ int perm32(int rho) { const int n = rho >> 4, i = rho & 15; return 8 * (i >> 2) + 4 * n + (i & 3); }

struct Unit { int pm, pn, pb; };
struct Gemm { const bf16_t* A; const bf16_t* Bt; int K, lda, ldb; };

struct StaticOrder {
    int nM, nN, nwg, G, c;
    __host__ __device__ void init(int M, int N, int G_, int c_) { nM = M / BM; nN = N / BM; nwg = nM * nN; G = G_; c = c_; }
    __host__ __device__ bool next(int i, Unit& u) const {
        const long L = (long)i * G + c; if (L >= nwg) return false;
        int wgid = (int)L; { const int q = nwg / NXCD, r = nwg % NXCD, xcd = wgid % NXCD, off = wgid / NXCD; wgid = (xcd < r ? xcd * (q + 1) : r * (q + 1) + (xcd - r) * q) + off; }
        const int nig = WGM * nN, gid = wgid / nig, fm = gid * WGM, gsz = (nM - fm) < WGM ? (nM - fm) : WGM;
        u.pm = fm + ((wgid % nig) % gsz); u.pn = (wgid % nig) / gsz; u.pb = u.pn; return true;
    }
    __device__ __forceinline__ void a_ready(const Unit&) const {}
    __device__ __forceinline__ void done(const Unit&) const {}
};

__device__ __forceinline__ unsigned cvt_pk_bf16(float lo, float hi) { unsigned r; asm volatile("v_cvt_pk_bf16_f32 %0, %1, %2" : "=v"(r) : "v"(lo), "v"(hi)); return r; }

template <class Epi, class Sched, bool ALIGN_EPI = false, bool SP2 = false>
__device__ __forceinline__ void gemm_phase(PG8_LAS unsigned char* lds, const Gemm g, const Sched& S, const Epi& E) {
    int tid_ = threadIdx.x; asm volatile("" : "+v"(tid_));
    const int tid = tid_, wid = __builtin_amdgcn_readfirstlane(tid >> 6), lane = tid & 63, wr = wid >> 2, wc = wid & 3, fr = lane & 15, fq = lane >> 4;
    const int K = g.K, nt = K / BK;
    unsigned voffA[2], voffB[2];
#pragma unroll
    for (int i = 0; i < 2; ++i) { int R, C; stage_rc(tid * 16 + i * 8192, R, C); const int Rb = Epi::PERM ? ((R & ~31) + perm32(R & 31)) : R;
        voffA[i] = (unsigned)(R * g.lda + C) * 2u; voffB[i] = (unsigned)(Rb * g.ldb + C) * 2u; }
    const size_t kstep = (size_t)(BK * 2);
    const size_t hstepA = (size_t)HALF * g.lda * 2, hstepB = (size_t)HALF * g.ldb * 2;
    const size_t tstepA = 2 * hstepA, tstepB = 2 * hstepB;
    const unsigned ldsw = (unsigned)wid * 1024u;
    const int aoff = lds_byte(wr * 64 + fr, fq * 8), boff = lds_byte(wc * 32 + fr, fq * 8);
#define PG8_SA(b, h) (((b) * 2 + (h)) * HTB)
#define PG8_SB(b, h) ((4 + (b) * 2 + (h)) * HTB)
#define PG8_STAGE(bufoff, gbase, voff) do { _Pragma("unroll") for (int _i = 0; _i < 2; ++_i) \
        __builtin_amdgcn_global_load_lds((const unsigned*)((const char*)(gbase) + (voff)[_i]), (PG8_LAS unsigned*)(lds + (bufoff) + ldsw + _i * 8192), 16, 0, 0); } while (0)
#define PG8_LDA(dst, b, h) do { _Pragma("unroll") for (int m = 0; m < 4; ++m) _Pragma("unroll") for (int k = 0; k < 2; ++k) dst[m][k] = *(const PG8_LAS bf16x8*)(lds + PG8_SA(b, h) + aoff + m * 2048 + k * 1024); } while (0)
#define PG8_LDB(dst, b, h) do { _Pragma("unroll") for (int n = 0; n < 2; ++n) _Pragma("unroll") for (int k = 0; k < 2; ++k) dst[n][k] = *(const PG8_LAS bf16x8*)(lds + PG8_SB(b, h) + boff + n * 2048 + k * 1024); } while (0)
#define PG8_MMA(ai, bj, At, Bt) do { __builtin_amdgcn_s_setprio(1); _Pragma("unroll") for (int m = 0; m < 4; ++m) _Pragma("unroll") for (int n = 0; n < 2; ++n) _Pragma("unroll") for (int k = 0; k < 2; ++k) \
        acc[ai][bj][m][n] = __builtin_amdgcn_mfma_f32_16x16x32_bf16(Bt[n][k], At[m][k], acc[ai][bj][m][n], 0, 0, 0); __builtin_amdgcn_s_setprio(0); } while (0)
#define PG8_WAIT_V(n) asm volatile("s_waitcnt vmcnt(" #n ")" ::: "memory")
#define PG8_WAIT_L(n) asm volatile("s_waitcnt lgkmcnt(" #n ")" ::: "memory")
#define PG8_BAR __builtin_amdgcn_s_barrier()
#define PG8_SCHED __builtin_amdgcn_sched_barrier(0)
    Unit cur, nxt; int ui = 0;
    if (!S.next(0, cur)) return;
    f32x4 acc[2][2][4][2];
#pragma unroll
    for (int a = 0; a < 2; ++a)
#pragma unroll
        for (int b = 0; b < 2; ++b)
#pragma unroll
            for (int m = 0; m < 4; ++m)
#pragma unroll
                for (int n = 0; n < 2; ++n) acc[a][b][m][n] = (f32x4){0.f, 0.f, 0.f, 0.f};
    bf16x8 At[4][2], B0[2][2], B1[2][2];
    const char* cA = (const char*)g.A + (size_t)cur.pm * tstepA; const char* cB = (const char*)g.Bt + (size_t)cur.pb * tstepB;
    S.a_ready(cur);
    if constexpr (SP2) {
        PG8_STAGE(PG8_SB(0, 0), cB, voffB); PG8_STAGE(PG8_SB(0, 1), cB + hstepB, voffB); PG8_STAGE(PG8_SA(0, 0), cA, voffA); PG8_STAGE(PG8_SA(0, 1), cA + hstepA, voffA);
        if (wr == 1) PG8_BAR;
        PG8_WAIT_V(2); PG8_BAR;
        PG8_STAGE(PG8_SB(1, 0), cB + kstep, voffB); PG8_STAGE(PG8_SA(1, 0), cA + kstep, voffA); PG8_STAGE(PG8_SB(1, 1), cB + hstepB + kstep, voffB);
        PG8_WAIT_V(6); PG8_BAR;
    } else {
        PG8_STAGE(PG8_SB(0, 0), cB, voffB); PG8_STAGE(PG8_SA(0, 0), cA, voffA); PG8_STAGE(PG8_SB(0, 1), cB + hstepB, voffB); PG8_STAGE(PG8_SA(0, 1), cA + hstepA, voffA);
        if (wr == 1) PG8_BAR;
        PG8_WAIT_V(4); PG8_BAR;
        PG8_STAGE(PG8_SB(1, 0), cB + kstep, voffB); PG8_STAGE(PG8_SA(1, 0), cA + kstep, voffA); PG8_STAGE(PG8_SB(1, 1), cB + hstepB + kstep, voffB);
        PG8_WAIT_V(6); PG8_BAR;
    }
    for (;;) {
        const bool has_next = S.next(ui + 1, nxt);
        const char* nA = has_next ? (const char*)g.A + (size_t)nxt.pm * tstepA : cA; const char* nB = has_next ? (const char*)g.Bt + (size_t)nxt.pb * tstepB : cB;
        for (int t = 0; t < nt; t += 2) {
            const bool last = (t == nt - 2);
            const char* a1 = cA + (size_t)(t + 1) * kstep;
            const char* a2 = last ? nA : cA + (size_t)(t + 2) * kstep; const char* b2 = last ? nB : cB + (size_t)(t + 2) * kstep;
            const char* a3 = a2 + kstep; const char* b3 = b2 + kstep;
            if (last && has_next) S.a_ready(nxt);
            if constexpr (SP2) {
            PG8_LDB(B0, 0, 0); PG8_LDB(B1, 0, 1); PG8_SCHED; PG8_LDA(At, 0, 0); PG8_STAGE(PG8_SA(1, 1), a1 + hstepA, voffA);
            PG8_WAIT_V(8); PG8_WAIT_L(0); PG8_BAR; PG8_MMA(0, 0, At, B0); PG8_MMA(0, 1, At, B1); PG8_BAR; PG8_SCHED;
            PG8_LDA(At, 0, 1); PG8_STAGE(PG8_SB(0, 0), b2, voffB); PG8_STAGE(PG8_SB(0, 1), b2 + hstepB, voffB); PG8_STAGE(PG8_SA(0, 0), a2, voffA);
            PG8_WAIT_V(8); PG8_WAIT_L(0); PG8_BAR; PG8_MMA(1, 0, At, B0); PG8_MMA(1, 1, At, B1); PG8_BAR; PG8_SCHED;
            PG8_LDB(B0, 1, 0); PG8_LDB(B1, 1, 1); PG8_SCHED; PG8_LDA(At, 1, 0); PG8_STAGE(PG8_SA(0, 1), a2 + hstepA, voffA);
            PG8_WAIT_V(8); PG8_WAIT_L(0); PG8_BAR; PG8_MMA(0, 0, At, B0); PG8_MMA(0, 1, At, B1); PG8_BAR; PG8_SCHED;
            PG8_LDA(At, 1, 1); PG8_STAGE(PG8_SB(1, 0), b3, voffB); PG8_STAGE(PG8_SB(1, 1), b3 + hstepB, voffB); PG8_STAGE(PG8_SA(1, 0), a3, voffA);
            PG8_WAIT_V(8); PG8_WAIT_L(0); PG8_BAR; PG8_MMA(1, 0, At, B0); PG8_MMA(1, 1, At, B1); PG8_BAR; PG8_SCHED;
            } else {
            PG8_LDB(B0, 0, 0); PG8_SCHED; PG8_LDA(At, 0, 0); PG8_STAGE(PG8_SA(1, 1), a1 + hstepA, voffA);
            PG8_WAIT_L(8); PG8_BAR; PG8_WAIT_L(0); PG8_MMA(0, 0, At, B0); PG8_BAR; PG8_SCHED;
            PG8_LDB(B1, 0, 1); PG8_STAGE(PG8_SB(0, 0), b2, voffB);
            PG8_BAR; PG8_WAIT_L(0); PG8_MMA(0, 1, At, B1); PG8_BAR;
            PG8_LDA(At, 0, 1); PG8_STAGE(PG8_SA(0, 0), a2, voffA);
            PG8_BAR; PG8_WAIT_L(0); PG8_MMA(1, 0, At, B0); PG8_BAR; PG8_SCHED;
            PG8_STAGE(PG8_SB(0, 1), b2 + hstepB, voffB);
            PG8_WAIT_V(6); PG8_BAR; PG8_MMA(1, 1, At, B1); PG8_BAR;
            PG8_LDB(B0, 1, 0); PG8_SCHED; PG8_LDA(At, 1, 0); PG8_STAGE(PG8_SA(0, 1), a2 + hstepA, voffA);
            PG8_WAIT_L(8); PG8_BAR; PG8_WAIT_L(0); PG8_MMA(0, 0, At, B0); PG8_BAR; PG8_SCHED;
            PG8_LDB(B1, 1, 1); PG8_STAGE(PG8_SB(1, 0), b3, voffB);
            PG8_BAR; PG8_WAIT_L(0); PG8_MMA(0, 1, At, B1); PG8_BAR;
            PG8_LDA(At, 1, 1); PG8_STAGE(PG8_SA(1, 0), a3, voffA);
            PG8_BAR; PG8_WAIT_L(0); PG8_MMA(1, 0, At, B0); PG8_BAR; PG8_SCHED;
            PG8_STAGE(PG8_SB(1, 1), b3 + hstepB, voffB);
            PG8_WAIT_V(6); PG8_BAR; PG8_MMA(1, 1, At, B1); PG8_BAR;
            }
        }
        if constexpr (ALIGN_EPI) { if (wr == 0) PG8_BAR; }
        E(acc, cur, wr, wc, fr, fq); S.done(cur);
        if (!has_next) break;
#pragma unroll
        for (int a = 0; a < 2; ++a)
#pragma unroll
            for (int b = 0; b < 2; ++b)
#pragma unroll
                for (int m = 0; m < 4; ++m)
#pragma unroll
                    for (int n = 0; n < 2; ++n) acc[a][b][m][n] = (f32x4){0.f, 0.f, 0.f, 0.f};
        cur = nxt; cA = nA; cB = nB; ++ui;
        if constexpr (ALIGN_EPI) { if (wr == 1) PG8_BAR; }
    }
    PG8_WAIT_V(0);
    if constexpr (!ALIGN_EPI) { if (wr == 0) PG8_BAR; }
    PG8_BAR;
#undef PG8_SA
#undef PG8_SB
#undef PG8_STAGE
#undef PG8_LDA
#undef PG8_LDB
#undef PG8_MMA
#undef PG8_WAIT_V
#undef PG8_WAIT_L
#undef PG8_BAR
#undef PG8_SCHED
}
}
constexpr int NB = 8, SEQ = 4096, DM = 1024, CTXL = 256;
constexpr int TL = NB * SEQ, TC = NB * CTXL, TT = TL + TC;
constexpr int NIN = 9472, PW = 9216;
constexpr int OQ = 0, OKK = 1024, OV = 2048, OCB = 3072, OCC = 3584, OCX = 4096, OGQ = 4608, OGK = 4864, OGV = 5120, OGR = 5632, OGATE = 6144;
constexpr int NEXP = 32, NRMAX = 147456;
constexpr float RMS_EPS = 1e-6f;
constexpr float QSCALE = 0.125f * 1.4426950408889634f;
constexpr int NWAVES = 8, NTHR = 512;
#ifndef N_LAUNCH_MODE
#define N_LAUNCH_MODE 0
#endif
constexpr int NPHASE = 25;

constexpr size_t MiB = 1u << 20;
constexpr size_t WS_CTL = 0, CTL_ZERO_BYTES = 1 * MiB;
constexpr size_t WS_MOD = 1 * MiB;
constexpr size_t WS_ROPE = WS_MOD + 512 * 1024;
constexpr size_t WS_LAM = WS_ROPE + 16 * 1024;
constexpr size_t WS_ROUTE = 2 * MiB, ROUTE_STRIDE = 8 * MiB;
constexpr size_t R_TOPI = 0, R_TOPG = 1 * MiB, R_POSOF = 2 * MiB, R_ROWTOK = 3 * MiB, R_CNT = 4 * MiB, R_TILEEXP = 4 * MiB + 64 * 1024, R_NT = 4 * MiB + 128 * 1024;
constexpr size_t WS_GA = 18 * MiB;
constexpr size_t WS_WIN = 24 * MiB, WIN_STRIDE = (size_t)NIN * DM * 2;
constexpr size_t WS_WD = 61 * MiB, WS_WCG = 65 * MiB, WS_WO = 69 * MiB, W1K_STRIDE = 2 * MiB;
constexpr size_t WS_W1 = 73 * MiB, W1_STRIDE = 128 * MiB;
constexpr size_t WS_W2 = 329 * MiB, W2_STRIDE = 64 * MiB;
constexpr size_t WS_H = 457 * MiB, WS_AD = 525 * MiB, WS_ACG = 593 * MiB, WS_MERGED = 661 * MiB;
constexpr size_t WS_OG = 729 * MiB;
constexpr size_t WS_XW = 865 * MiB;
constexpr size_t WS_ASCR = 1001 * MiB;
constexpr size_t WS_P = 1033 * MiB;
constexpr size_t WS_XS = WS_P, WS_HH = WS_P + 288 * MiB;
constexpr size_t WS_END = 1645 * MiB;
static_assert(WS_P + (size_t)TT * PW * 2 <= WS_END && WS_HH + (size_t)NRMAX * DM * 2 <= WS_END, "ws map");

constexpr int LDS_BYTES = 147456;
constexpr int MISC_OFF = 147456 - 1024;

#define GAS __attribute__((address_space(1)))
#define LAS __attribute__((address_space(3)))
typedef unsigned short bf16_t;
typedef float f32x4 __attribute__((ext_vector_type(4)));
typedef float f32x2 __attribute__((ext_vector_type(2)));
typedef unsigned u32x4 __attribute__((ext_vector_type(4)));
typedef unsigned u32x2 __attribute__((ext_vector_type(2)));
#define LDS_WAIT() asm volatile("s_waitcnt lgkmcnt(0)" ::: "memory")
#define VM_WAIT() asm volatile("s_waitcnt vmcnt(0)" ::: "memory")
__device__ __forceinline__ unsigned f2bf(float f) { unsigned u = __builtin_bit_cast(unsigned, f); return (u + 0x7fffu + ((u >> 16) & 1u)) >> 16; }
__device__ __forceinline__ unsigned pk2(float lo, float hi) { return f2bf(lo) | (f2bf(hi) << 16); }
__device__ __forceinline__ float bflo(unsigned w) { return __builtin_bit_cast(float, w << 16); }
__device__ __forceinline__ float bfhi(unsigned w) { return __builtin_bit_cast(float, w & 0xffff0000u); }
__device__ __forceinline__ float bf2f(bf16_t b) { return __builtin_bit_cast(float, ((unsigned)b) << 16); }
__device__ __forceinline__ float wave_sum(float v) {
#pragma unroll
    for (int o = 1; o < 64; o <<= 1) v += __shfl_xor(v, o);
    return v;
}
__device__ __forceinline__ float sigmoidf_(float x) { return 1.f / (1.f + __expf(-x)); }

#define XB_TMO      128
#define XB_XCNT(j)  (256  + 64 * (j))
#define XB_XSUB(j)  (1280 + 64 * (j))
#define XB_XGEN(j)  (2304 + 64 * (j))
#define XB_TOP      3328
#define XB_TOPGEN   3392
#define XCD_BAR_WORDS 3456
#define XB_SPIN_CAP (1u << 18)
__device__ __forceinline__ unsigned xb_ld(unsigned* p)              { return __hip_atomic_load(p, __ATOMIC_RELAXED, __HIP_MEMORY_SCOPE_AGENT); }
__device__ __forceinline__ unsigned xb_add(unsigned* p, unsigned v) { return __hip_atomic_fetch_add(p, v, __ATOMIC_RELAXED, __HIP_MEMORY_SCOPE_AGENT); }
__device__ __forceinline__ unsigned xb_xcc_id() { return (unsigned)__builtin_amdgcn_s_getreg((3 << 11) | 20) & 0xFu; }
#define XB_SPIN(cond, bar) do { unsigned _sp = 0; while (cond) { __builtin_amdgcn_s_sleep(1); \
    if ((++_sp & 255u) == 0u) { if (xb_ld(&(bar)[XB_TMO])) break; if (_sp > XB_SPIN_CAP) { atomicAdd(&(bar)[XB_TMO], 1u); break; } } } } while (0)
struct XcdBarrier { unsigned* bar; unsigned x; volatile LAS unsigned* st; };
__device__ __forceinline__ XcdBarrier xcd_barrier_post(unsigned* bar, volatile LAS unsigned* st) {
    XcdBarrier b; b.bar = bar; b.x = xb_xcc_id(); b.st = st;
    if (threadIdx.x == 0) (void)xb_add(&bar[XB_XCNT(b.x)], 1u);
    return b;
}
__device__ __forceinline__ void xcd_barrier_complete(unsigned* bar, unsigned x, unsigned& nloc, unsigned& nx) {
    const unsigned G = gridDim.x * gridDim.y * gridDim.z;
    unsigned sum, cnt, mine, sp = 0u;
    for (;;) {
        sum = 0u; cnt = 0u; mine = 0u;
#pragma unroll
        for (unsigned j = 0; j < 16; ++j) { const unsigned c = xb_ld(&bar[XB_XCNT(j)]); sum += c; cnt += (c > 0u) ? 1u : 0u; mine = (j == x) ? c : mine; }
        if (sum == G) break;
        __builtin_amdgcn_s_sleep(1);
        if ((++sp & 255u) == 0u) { if (xb_ld(&bar[XB_TMO])) break; if (sp > XB_SPIN_CAP) { atomicAdd(&bar[XB_TMO], 1u); break; } }
    }
    nloc = mine > 0u ? mine : 1u; nx = cnt > 0u ? cnt : 1u;
}
__device__ __forceinline__ void xcd_barrier(const XcdBarrier& b) {
    asm volatile("s_waitcnt vmcnt(0)" ::: "memory");
    __syncthreads();
    if (threadIdx.x == 0) {
        unsigned* bar = b.bar;
        __builtin_amdgcn_s_waitcnt(0);
        unsigned nloc = b.st[0], nx = b.st[1];
        if (nloc == 0u) { xcd_barrier_complete(bar, b.x, nloc, nx); b.st[0] = nloc; b.st[1] = nx; }
        const unsigned old = xb_add(&bar[XB_XSUB(b.x)], 1u);
        const unsigned gen = old / nloc;
        if (old + 1u == (gen + 1u) * nloc) {
            __builtin_amdgcn_fence(__ATOMIC_RELEASE, "agent");
            asm volatile("s_waitcnt vmcnt(0)" ::: "memory");
            const unsigned og = xb_add(&bar[XB_TOP], 1u);
            const unsigned tg = og / nx;
            if (og + 1u == (tg + 1u) * nx) xb_add(&bar[XB_TOPGEN], 1u);
            else XB_SPIN(xb_ld(&bar[XB_TOPGEN]) == tg, bar);
            __builtin_amdgcn_fence(__ATOMIC_ACQUIRE, "agent");
            xb_add(&bar[XB_XGEN(b.x)], 1u);
            asm volatile("s_waitcnt vmcnt(0)" ::: "memory");
        } else {
            XB_SPIN(xb_ld(&bar[XB_XGEN(b.x)]) == gen, bar);
            __builtin_amdgcn_fence(__ATOMIC_ACQUIRE, "agent");
            asm volatile("s_waitcnt vmcnt(0)" ::: "memory");
        }
    }
    __syncthreads();
}

using pg8::Unit;
struct EpiIn {
    static constexpr bool PERM = false;
    bf16_t* P; float* GA; const float* cosT; const float* sinT;
    __device__ __forceinline__ void operator()(const f32x4 (&acc)[2][2][4][2], const Unit& u, int wr, int wc, int fr, int fq) const {
        const int row0 = u.pm * 256 + wr * 64 + fr; const int pn = u.pn;
        if (pn == 36) {
            if (wc == 0) {
#pragma unroll
                for (int ai = 0; ai < 2; ++ai)
#pragma unroll
                    for (int m = 0; m < 4; ++m) { const size_t row = (size_t)(row0 + ai * 128 + m * 16);
#pragma unroll
                        for (int n = 0; n < 2; ++n) *(f32x4*)(GA + row * 32 + 16 * n + 4 * fq) = acc[ai][0][m][n]; }
            }
            return;
        }
        const int colbase = pn * 256 + wc * 32 + 4 * fq;
        if (pn < 8) {
            const bool lat = u.pm < 128; const float qs = pn < 4 ? QSCALE : 1.f; const int axis = wc & 1;
#pragma unroll
            for (int ai = 0; ai < 2; ++ai)
#pragma unroll
                for (int m = 0; m < 4; ++m) { const int row = row0 + ai * 128 + m * 16; const int s = row & 4095; const int pos = axis ? (s & 63) : (s >> 6);
                    f32x4 c4 = (f32x4){1.f, 1.f, 1.f, 1.f}, s4 = (f32x4){0.f, 0.f, 0.f, 0.f};
                    if (lat) { c4 = *(const f32x4*)(cosT + pos * 16 + 4 * fq); s4 = *(const f32x4*)(sinT + pos * 16 + 4 * fq); }
                    bf16_t* rowp = P + (size_t)row * PW + colbase;
#pragma unroll
                    for (int bj = 0; bj < 2; ++bj) { const f32x4 x1 = acc[ai][bj][m][0], x2 = acc[ai][bj][m][1];
                        const f32x4 o1 = (x1 * c4 - x2 * s4) * qs, o2 = (x2 * c4 + x1 * s4) * qs;
                        u32x2 w1, w2; w1.x = pk2(o1[0], o1[1]); w1.y = pk2(o1[2], o1[3]); w2.x = pk2(o2[0], o2[1]); w2.y = pk2(o2[2], o2[3]);
                        *(u32x2*)(rowp + bj * 128) = w1; *(u32x2*)(rowp + bj * 128 + 16) = w2; } }
        } else {
            const bool sg = pn >= 24;
#pragma unroll
            for (int ai = 0; ai < 2; ++ai)
#pragma unroll
                for (int m = 0; m < 4; ++m) { const int row = row0 + ai * 128 + m * 16; bf16_t* rowp = P + (size_t)row * PW + colbase;
#pragma unroll
                    for (int bj = 0; bj < 2; ++bj)
#pragma unroll
                        for (int n = 0; n < 2; ++n) { f32x4 v = acc[ai][bj][m][n];
                            if (sg) { v[0] = sigmoidf_(v[0]); v[1] = sigmoidf_(v[1]); v[2] = sigmoidf_(v[2]); v[3] = sigmoidf_(v[3]); }
                            u32x2 w; w.x = pk2(v[0], v[1]); w.y = pk2(v[2], v[3]); *(u32x2*)(rowp + bj * 128 + 16 * n) = w; } }
        }
    }
};
template <int MODE> struct EpiGate {
    static constexpr bool PERM = false;
    const bf16_t* P; float* M32; bf16_t* MG;
    __device__ __forceinline__ void operator()(const f32x4 (&acc)[2][2][4][2], const Unit& u, int wr, int wc, int fr, int fq) const {
        const int row0 = u.pm * 256 + wr * 64 + fr, col0 = u.pn * 256 + wc * 32 + 4 * fq;
#pragma unroll
        for (int ai = 0; ai < 2; ++ai)
#pragma unroll
            for (int m = 0; m < 4; ++m) { const size_t row = (size_t)(row0 + ai * 128 + m * 16);
#pragma unroll
                for (int bj = 0; bj < 2; ++bj)
#pragma unroll
                    for (int n = 0; n < 2; ++n) { const int col = col0 + bj * 128 + 16 * n;
                        const u32x2 gw = *(const u32x2*)(P + row * PW + OGATE + MODE * 1024 + col);
                        const f32x4 s = (f32x4){bflo(gw.x), bfhi(gw.x), bflo(gw.y), bfhi(gw.y)};
                        f32x4 v = s * acc[ai][bj][m][n];
                        float* mp = M32 + row * 1024 + col;
                        if (MODE >= 1) v = v + __builtin_nontemporal_load((const f32x4*)mp);
                        if (MODE <= 1) *(f32x4*)mp = v;
                        else { u32x2 w; w.x = pk2(v[0], v[1]); w.y = pk2(v[2], v[3]); *(u32x2*)(MG + row * 1024 + col) = w; } } }
    }
};
struct EpiRes {
    static constexpr bool PERM = false;
    const float* xlat; const float* xctx; float* XW; const float* mod;
    __device__ __forceinline__ void operator()(const f32x4 (&acc)[2][2][4][2], const Unit& u, int wr, int wc, int fr, int fq) const {
        const int row0 = u.pm * 256 + wr * 64 + fr, col0 = u.pn * 256 + wc * 32 + 4 * fq;
        const int mr = u.pm < 128 ? (u.pm >> 4) : 8; const float* xin = u.pm < 128 ? xlat : xctx;
        const float* g1 = mod + (size_t)mr * 6144 + 2048;
        f32x4 gv[2][2];
#pragma unroll
        for (int bj = 0; bj < 2; ++bj)
#pragma unroll
            for (int n = 0; n < 2; ++n) gv[bj][n] = *(const f32x4*)(g1 + col0 + bj * 128 + 16 * n);
#pragma unroll
        for (int ai = 0; ai < 2; ++ai)
#pragma unroll
            for (int m = 0; m < 4; ++m) { const size_t off = (size_t)(row0 + ai * 128 + m * 16) * 1024 + col0;
#pragma unroll
                for (int bj = 0; bj < 2; ++bj)
#pragma unroll
                    for (int n = 0; n < 2; ++n) { const f32x4 xi = *(const f32x4*)(xin + off + bj * 128 + 16 * n);
                        *(f32x4*)(XW + off + bj * 128 + 16 * n) = xi + gv[bj][n] * acc[ai][bj][m][n]; } }
    }
};
struct EpiSwiglu {
    static constexpr bool PERM = true;
    bf16_t* HH; const float* b1;
    __device__ __forceinline__ void operator()(const f32x4 (&acc)[2][2][4][2], const Unit& u, int wr, int wc, int fr, int fq) const {
        const int row0 = u.pm * 256 + wr * 64 + fr, c0 = u.pn * 256 + wc * 32 + 8 * fq; const int e = u.pb >> 3;
        const float* bp = b1 + (size_t)e * 2048 + c0;
        f32x4 bv[2][2];
#pragma unroll
        for (int bj = 0; bj < 2; ++bj)
#pragma unroll
            for (int n = 0; n < 2; ++n) bv[bj][n] = *(const f32x4*)(bp + bj * 128 + 4 * n);
#pragma unroll
        for (int ai = 0; ai < 2; ++ai)
#pragma unroll
            for (int m = 0; m < 4; ++m) { bf16_t* rowp = HH + (size_t)(row0 + ai * 128 + m * 16) * 1024 + (c0 >> 1);
#pragma unroll
                for (int bj = 0; bj < 2; ++bj) { const f32x4 v0 = acc[ai][bj][m][0] + bv[bj][0], v1 = acc[ai][bj][m][1] + bv[bj][1];
                    float o[4];
#pragma unroll
                    for (int p = 0; p < 4; ++p) { float gl = p < 2 ? v0[2 * p] : v1[2 * p - 4], ln = p < 2 ? v0[2 * p + 1] : v1[2 * p - 3];
                        gl = fminf(gl, 7.f); ln = fminf(fmaxf(ln, -7.f), 7.f); o[p] = gl * sigmoidf_(1.702f * gl) * (ln + 1.f); }
                    u32x2 w; w.x = pk2(o[0], o[1]); w.y = pk2(o[2], o[3]); *(u32x2*)(rowp + bj * 64) = w; } }
    }
};
struct EpiY {
    static constexpr bool PERM = true;
    bf16_t* YY; const float* b2;
    __device__ __forceinline__ void operator()(const f32x4 (&acc)[2][2][4][2], const Unit& u, int wr, int wc, int fr, int fq) const {
        const int row0 = u.pm * 256 + wr * 64 + fr, c0 = u.pn * 256 + wc * 32 + 8 * fq; const int e = u.pb >> 2;
        const float* bp = b2 + (size_t)e * 1024 + c0;
        f32x4 bv[2][2];
#pragma unroll
        for (int bj = 0; bj < 2; ++bj)
#pragma unroll
            for (int n = 0; n < 2; ++n) bv[bj][n] = *(const f32x4*)(bp + bj * 128 + 4 * n);
#pragma unroll
        for (int ai = 0; ai < 2; ++ai)
#pragma unroll
            for (int m = 0; m < 4; ++m) { bf16_t* rowp = YY + (size_t)(row0 + ai * 128 + m * 16) * 1024 + c0;
#pragma unroll
                for (int bj = 0; bj < 2; ++bj) { const f32x4 v0 = acc[ai][bj][m][0] + bv[bj][0], v1 = acc[ai][bj][m][1] + bv[bj][1];
                    u32x4 w; w.x = pk2(v0[0], v0[1]); w.y = pk2(v0[2], v0[3]); w.z = pk2(v1[0], v1[1]); w.w = pk2(v1[2], v1[3]);
                    *(u32x4*)(rowp + bj * 128) = w; } }
    }
};
struct MoeOrder {
    int ntiles, nN, G, c; const int* tile_exp;
    __device__ __forceinline__ bool next(int i, Unit& u) const {
        const long L = (long)i * G + c; if (L >= (long)ntiles * nN) return false;
        const int tile = (int)(L / nN), pn = (int)(L % nN);
        u.pm = tile; u.pn = pn; u.pb = __builtin_amdgcn_readfirstlane(__builtin_nontemporal_load(tile_exp + tile)) * nN + pn; return true;
    }
    __device__ __forceinline__ void a_ready(const Unit&) const {}
    __device__ __forceinline__ void done(const Unit&) const {}
};
struct Args { const float* in[26]; float* out; unsigned char* ws; int ph_lo, ph_hi; };
struct Frame {
    LAS unsigned char* lds; unsigned char* ws; int tid, lane, wave, G, gw, NGW;
};
constexpr int PTR_OFF = 147456 - 1024 + 256;
__device__ __forceinline__ const float* in_ptr(const Frame& F, int i) {
    const unsigned long long v = ((volatile LAS unsigned long long*)(F.lds + PTR_OFF))[i];
    const unsigned lo = __builtin_amdgcn_readfirstlane((unsigned)v), hi = __builtin_amdgcn_readfirstlane((unsigned)(v >> 32));
    return (const float*)(((unsigned long long)hi << 32) | lo);
}
__device__ __forceinline__ float* out_ptr(const Frame& F) { return (float*)in_ptr(F, 26); }
__device__ __forceinline__ Frame relaunder(const Frame& F0) {
    Frame F = F0; int t = threadIdx.x; asm volatile("" : "+v"(t));
    F.tid = t; F.lane = t & 63; F.wave = __builtin_amdgcn_readfirstlane(t >> 6); F.gw = blockIdx.x * NWAVES + F.wave; return F;
}

__device__ __forceinline__ void transpose_item(const float* W, int srcN, bf16_t* WT, int dstK, int k0, int n0, int drow0, int dk0, LAS float* scr, int lane) {
#pragma unroll 8
    for (int i = 0; i < 32; ++i) { const int kk = 2 * i + (lane >> 5); scr[kk * 33 + (lane & 31)] = W[(size_t)(k0 + kk) * srcN + n0 + (lane & 31)]; }
    LDS_WAIT(); asm volatile("" ::: "memory");
    const int c = lane & 7;
#pragma unroll
    for (int j = 0; j < 4; ++j) { const int n = (lane >> 3) + 8 * j; const LAS float* s = scr + (8 * c) * 33 + n;
        u32x4 o; o.x = pk2(s[0 * 33], s[1 * 33]); o.y = pk2(s[2 * 33], s[3 * 33]); o.z = pk2(s[4 * 33], s[5 * 33]); o.w = pk2(s[6 * 33], s[7 * 33]);
        *(u32x4*)(WT + (size_t)(drow0 + n0 + n) * dstK + dk0 + 8 * c) = o; }
    LDS_WAIT(); asm volatile("" ::: "memory");
}

__device__ __forceinline__ void p0_prologue(const Frame& F0) {
    const Frame F = relaunder(F0);
    unsigned char* ws = F.ws;
    {
        LAS float* sc = (LAS float*)F.lds;
        LAS float* red = sc + 9 * 1024;
        for (int i = F.tid; i < 9 * 1024; i += NTHR) { const float c = i < 8192 ? in_ptr(F, 1)[i] : in_ptr(F, 3)[i - 8192]; sc[i] = c / (1.f + __expf(-c)); }
        __syncthreads();
        float* MOD = (float*)(ws + WS_MOD);
        for (int job = blockIdx.x; job < 192; job += F.G) {
            const int l = job / 96, blk = job % 96, ks = F.tid >> 6, n = F.tid & 63, col = blk * 64 + n;
            const float* w = in_ptr(F, 4) + (size_t)l * 1024 * 6144 + col;
            float a[9];
#pragma unroll
            for (int r = 0; r < 9; ++r) a[r] = 0.f;
            for (int k = ks * 128; k < ks * 128 + 128; ++k) { const float wv = w[(size_t)k * 6144];
#pragma unroll
                for (int r = 0; r < 9; ++r) a[r] += sc[r * 1024 + k] * wv; }
#pragma unroll
            for (int r = 0; r < 9; ++r) red[(ks * 9 + r) * 64 + n] = a[r];
            __syncthreads();
            for (int o = F.tid; o < 576; o += NTHR) { const int r = o >> 6, nn = o & 63; float s = 0.f;
#pragma unroll
                for (int k8 = 0; k8 < 8; ++k8) s += red[(k8 * 9 + r) * 64 + nn];
                MOD[((size_t)l * 9 + r) * 6144 + blk * 64 + nn] = s + in_ptr(F, 5)[(size_t)l * 6144 + blk * 64 + nn]; }
            __syncthreads();
        }
    }
    if (blockIdx.x == 0) {
        float* cosT = (float*)(ws + WS_ROPE); float* sinT = cosT + 1024;
        for (int i = F.tid; i < 1024; i += NTHR) { const int pos = i >> 4, f = i & 15; const float inv = powf(10000.f, -(float)(2 * f) / 32.f); const float ang = (float)pos * inv; cosT[i] = cosf(ang); sinT[i] = sinf(ang); }
        if (F.wave < 2) { const int l = F.wave; const float* dl = in_ptr(F, 9) + (size_t)l * 256;
            const float s1 = wave_sum(dl[F.lane] * dl[64 + F.lane]), s2 = wave_sum(dl[128 + F.lane] * dl[192 + F.lane]);
            const float lam_init = 0.8f - 0.6f * expf(-0.3f * (float)l);
            if (F.lane == 0) ((float*)(ws + WS_LAM))[l] = expf(s1) - expf(s2) + lam_init; }
    }
    __syncthreads();
    LAS float* scr = (LAS float*)(F.lds + F.wave * 16384);
    constexpr int I_IN = 16 * 289, I_D = 512, I_C = 256, I_G = 256, I_O = 512, I_1 = 32 * 1024, I_2 = 32 * 512;
    constexpr int PER_L = I_IN + I_D + I_C + I_G + I_O + I_1 + I_2;
    for (int it = F.gw; it < 2 * PER_L; it += F.NGW) {
        const int l = it / PER_L; int r = it % PER_L;
        if (r < I_IN) { const int kb = r / 289, nb = r % 289, n0 = nb * 32; const int d0 = n0 < 6144 ? n0 : (n0 < 6176 ? 9216 + (n0 - 6144) : n0 - 32);
            transpose_item(in_ptr(F, 8) + (size_t)l * 1024 * 9248, 9248, (bf16_t*)(ws + WS_WIN + l * WIN_STRIDE), 1024, kb * 64, n0, d0 - n0, kb * 64, scr, F.lane); continue; } r -= I_IN;
        if (r < I_D) { const int kb = r / 32, nb = r % 32; transpose_item(in_ptr(F, 11) + (size_t)l * 1024 * 1024, 1024, (bf16_t*)(ws + WS_WD + l * W1K_STRIDE), 1024, kb * 64, nb * 32, 0, kb * 64, scr, F.lane); continue; } r -= I_D;
        if (r < I_C) { const int kb = r / 32, nb = r % 32; transpose_item(in_ptr(F, 13) + (size_t)l * 512 * 1024, 1024, (bf16_t*)(ws + WS_WCG + l * W1K_STRIDE), 1024, kb * 64, nb * 32, 0, kb * 64, scr, F.lane); continue; } r -= I_C;
        if (r < I_G) { const int kb = r / 32, nb = r % 32; transpose_item(in_ptr(F, 17) + (size_t)l * 512 * 1024, 1024, (bf16_t*)(ws + WS_WCG + l * W1K_STRIDE), 1024, kb * 64, nb * 32, 0, 512 + kb * 64, scr, F.lane); continue; } r -= I_G;
        if (r < I_O) { const int kb = r / 32, nb = r % 32; transpose_item(in_ptr(F, 18) + (size_t)l * 1024 * 1024, 1024, (bf16_t*)(ws + WS_WO + l * W1K_STRIDE), 1024, kb * 64, nb * 32, 0, kb * 64, scr, F.lane); continue; } r -= I_O;
        if (r < I_1) { const int e = r / 1024, q = r % 1024, kb = q / 64, nb = q % 64;
            transpose_item(in_ptr(F, 21) + ((size_t)l * 32 + e) * 1024 * 2048, 2048, (bf16_t*)(ws + WS_W1 + l * W1_STRIDE) + (size_t)e * 2048 * 1024, 1024, kb * 64, nb * 32, 0, kb * 64, scr, F.lane); continue; } r -= I_1;
        { const int e = r / 512, q = r % 512, kb = q / 32, nb = q % 32;
            transpose_item(in_ptr(F, 23) + ((size_t)l * 32 + e) * 1024 * 1024, 1024, (bf16_t*)(ws + WS_W2 + l * W2_STRIDE) + (size_t)e * 1024 * 1024, 1024, kb * 64, nb * 32, 0, kb * 64, scr, F.lane); }
    }
    for (int i = F.gw * 64 + F.lane; i < 2 * 224 * 128; i += F.NGW * 64) { const int l = i / (224 * 128), q = i % (224 * 128);
        *(u32x4*)(ws + WS_WIN + l * WIN_STRIDE + (size_t)9248 * 2048 + (size_t)q * 16) = (u32x4){0u, 0u, 0u, 0u}; }
}

__device__ __forceinline__ void load_row(const float* p, int lane, f32x4 (&v)[4]) {
#pragma unroll
    for (int j = 0; j < 4; ++j) v[j] = *(const f32x4*)(p + 256 * j + 4 * lane);
}
__device__ __forceinline__ float row_rstd(const f32x4 (&v)[4]) {
    float s = 0.f;
#pragma unroll
    for (int j = 0; j < 4; ++j) s += (v[j][0] * v[j][0] + v[j][1] * v[j][1]) + (v[j][2] * v[j][2] + v[j][3] * v[j][3]);
    return 1.0f / sqrtf(wave_sum(s) * (1.f / 1024.f) + RMS_EPS);
}
__device__ __forceinline__ void norm_mod(f32x4 (&v)[4], const float* g, const float* shift, const float* scale, int lane) {
    const float rstd = row_rstd(v);
#pragma unroll
    for (int j = 0; j < 4; ++j) { const f32x4 gv = *(const f32x4*)(g + 256 * j + 4 * lane), sh = *(const f32x4*)(shift + 256 * j + 4 * lane), sc = *(const f32x4*)(scale + 256 * j + 4 * lane);
        v[j] = (v[j] * rstd * gv) * (sc + 1.f) + sh; }
}
__device__ __forceinline__ void store_row_bf16(bf16_t* p, int lane, const f32x4 (&v)[4]) {
#pragma unroll
    for (int j = 0; j < 4; ++j) { u32x2 w; w.x = pk2(v[j][0], v[j][1]); w.y = pk2(v[j][2], v[j][3]); *(u32x2*)(p + 256 * j + 4 * lane) = w; }
}

__device__ __forceinline__ void p_norm1_l0(const Frame& F0) {
    const Frame F = relaunder(F0);
    const float* MOD = (const float*)(F.ws + WS_MOD); bf16_t* H = (bf16_t*)(F.ws + WS_H);
    for (int row = F.gw; row < TT; row += F.NGW) {
        const float* xin = row < TL ? in_ptr(F, 0) + (size_t)row * 1024 : in_ptr(F, 2) + (size_t)(row - TL) * 1024;
        const int mr = row < TL ? (row >> 12) : 8;
        f32x4 v[4]; load_row(xin, F.lane, v);
        norm_mod(v, in_ptr(F, 6), MOD + (size_t)mr * 6144, MOD + (size_t)mr * 6144 + 1024, F.lane);
        store_row_bf16(H + (size_t)row * 1024, F.lane, v);
    }
}

__device__ __forceinline__ void p_conv(const Frame& F0, const float* cw  ) {
    const Frame F = relaunder(F0);
    const bf16_t* P = (const bf16_t*)(F.ws + WS_P); bf16_t* ACG = (bf16_t*)(F.ws + WS_ACG);
    const int gt = F.gw * 64 + F.lane, NGT = F.NGW * 64;
    for (int it = gt; it < TT * 64; it += NGT) {
        const int row = it >> 6, c0 = (it & 63) * 8;
        bool hp, hn;
        if (row < TL) { const int s = row & 4095; hp = s > 0; hn = s < 4095; } else { const int s = (row - TL) & 255; hp = s > 0; hn = s < 255; }
        const bf16_t* pr = P + (size_t)row * PW;
        const u32x4 gb = *(const u32x4*)(pr + OCB + c0);
        const u32x4 c1 = *(const u32x4*)(pr + OCC + c0), x1 = *(const u32x4*)(pr + OCX + c0);
        u32x4 c0v = (u32x4){0u, 0u, 0u, 0u}, x0v = c0v, c2v = c0v, x2v = c0v;
        if (hp) { c0v = *(const u32x4*)(pr - PW + OCC + c0); x0v = *(const u32x4*)(pr - PW + OCX + c0); }
        if (hn) { c2v = *(const u32x4*)(pr + PW + OCC + c0); x2v = *(const u32x4*)(pr + PW + OCX + c0); }
        float o[8];
#pragma unroll
        for (int q = 0; q < 4; ++q) {
#pragma unroll
            for (int hh = 0; hh < 2; ++hh) { const int ch = c0 + 2 * q + hh;
                const float b = hh ? bfhi(gb[q]) : bflo(gb[q]);
                const float u0 = (hh ? bfhi(c0v[q]) : bflo(c0v[q])) * (hh ? bfhi(x0v[q]) : bflo(x0v[q]));
                const float u1 = (hh ? bfhi(c1[q]) : bflo(c1[q])) * (hh ? bfhi(x1[q]) : bflo(x1[q]));
                const float u2 = (hh ? bfhi(c2v[q]) : bflo(c2v[q])) * (hh ? bfhi(x2v[q]) : bflo(x2v[q]));
                o[2 * q + hh] = b * (cw[ch] * u0 + cw[512 + ch] * u1 + cw[1024 + ch] * u2); } }
        u32x4 w; w.x = pk2(o[0], o[1]); w.y = pk2(o[2], o[3]); w.z = pk2(o[4], o[5]); w.w = pk2(o[6], o[7]);
        *(u32x4*)(ACG + (size_t)row * 1024 + c0) = w;
    }
}
__device__ __forceinline__ int gla_row(int step, int b, int dir) {
    if (dir == 0) return step < 256 ? TL + b * 256 + step : b * 4096 + (step - 256);
    return step < 256 ? TL + b * 256 + (255 - step) : b * 4096 + (4095 - (step - 256));
}
__device__ __forceinline__ void p_gla_chain(const Frame& F0, const float* wa2  , const float* ba  , int chain) {
    const Frame F = relaunder(F0);
    const bf16_t* P = (const bf16_t*)(F.ws + WS_P); const float* GA = (const float*)(F.ws + WS_GA); float* OG = (float*)(F.ws + WS_OG);
    const int b = chain >> 3, h = (chain >> 1) & 3, dir = chain & 1;
    LAS float* Wa = (LAS float*)F.lds;
    LAS float* bav = Wa + 1024;
    LAS float* qs = bav + 64;
    LAS float* ks = qs + 1024;
    LAS float* egs = ks + 1024;
    LAS float* vs = egs + 1024;
    LAS float* po = vs + 2048;
    const int tid = F.tid, dkg = tid >> 7, dv = tid & 127;
    __syncthreads();
    for (int i = tid; i < 1024; i += NTHR) { const int r = i >> 6, dk = i & 63; Wa[i] = wa2[(size_t)(dir * 16 + r) * 256 + h * 64 + dk]; }
    if (tid < 64) bav[tid] = ba[dir * 256 + h * 64 + tid];
    float S[16];
#pragma unroll
    for (int i = 0; i < 16; ++i) S[i] = 0.f;
    for (int blk = 0; blk < 272; ++blk) {
        __syncthreads();
        for (int e = tid; e < 1024; e += NTHR) { const int tk = e >> 6, dk = e & 63; const int row = gla_row(blk * 16 + tk, b, dir);
            qs[e] = bf2f(P[(size_t)row * PW + OGQ + h * 64 + dk]);
            ks[e] = bf2f(P[(size_t)row * PW + OGK + h * 64 + dk]);
            float z = bav[dk]; const float* ga = GA + (size_t)row * 32 + dir * 16;
#pragma unroll
            for (int r = 0; r < 16; ++r) z += ga[r] * Wa[r * 64 + dk];
            const float ls = fminf(z, 0.f) - log1pf(__expf(-fabsf(z)));
            egs[e] = __expf(ls * (1.f / 16.f)); }
        for (int e = tid; e < 2048; e += NTHR) { const int tk = e >> 7, d = e & 127; const int row = gla_row(blk * 16 + tk, b, dir);
            vs[e] = bf2f(P[(size_t)row * PW + OGV + h * 128 + d]); }
        __syncthreads();
#pragma unroll 1
        for (int tk = 0; tk < 16; ++tk) {
            const float vv = vs[tk * 128 + dv]; float pacc = 0.f;
#pragma unroll
            for (int i = 0; i < 16; ++i) { const int dk = dkg * 16 + i; S[i] = egs[tk * 64 + dk] * S[i] + ks[tk * 64 + dk] * vv; pacc += qs[tk * 64 + dk] * S[i]; }
            po[(tk * 4 + dkg) * 128 + dv] = pacc;
        }
        __syncthreads();
        for (int e = tid; e < 2048; e += NTHR) { const int tk = e >> 7, d = e & 127; const int row = gla_row(blk * 16 + tk, b, dir);
            const float o = (po[(tk * 4 + 0) * 128 + d] + po[(tk * 4 + 1) * 128 + d]) + (po[(tk * 4 + 2) * 128 + d] + po[(tk * 4 + 3) * 128 + d]);
            OG[((size_t)dir * TT + row) * 512 + h * 128 + d] = o * 0.125f; }
    }
    __syncthreads();
}

__device__ __forceinline__ void p_attn_naive(const Frame& F0, int layer, const float* subg  ) {
    const Frame F = relaunder(F0);
    const bf16_t* P = (const bf16_t*)(F.ws + WS_P); bf16_t* AD = (bf16_t*)(F.ws + WS_AD);
    float* scr = (float*)(F.ws + WS_ASCR) + (size_t)blockIdx.x * 64 * 512;
    const float lam = __builtin_nontemporal_load((const float*)(F.ws + WS_LAM) + layer);
    const float lam_init = 0.8f - 0.6f * expf(-0.3f * (float)layer);
    LAS float* Ks = (LAS float*)F.lds;
    LAS float* Vs = Ks + 4096;
    LAS float* red = Vs + 8192;
    const int tid = F.tid, qr = tid & 255, half = tid >> 8;
    const int nunits = layer == 0 ? 1024 + 64 : 1024;
    for (int u = blockIdx.x; u < nunits; u += F.G) {
        const bool lat = u < 1024;
        int b, h, qrow0, ntiles;
        if (lat) { b = u >> 7; h = (u >> 4) & 7; qrow0 = b * 4096 + (u & 15) * 256; ntiles = 68; }
        else { const int v = u - 1024; b = v >> 3; h = v & 7; qrow0 = TL + b * 256; ntiles = 4; }
        const int qrow = qrow0 + qr;
        float O[64];
#pragma unroll 1
        for (int map = 1; map >= 0; --map) {
            float q[64];
            { const bf16_t* qp = P + (size_t)qrow * PW + OQ + h * 128 + map * 64;
#pragma unroll
              for (int c = 0; c < 8; ++c) { const u32x4 w = *(const u32x4*)(qp + 8 * c);
#pragma unroll
                  for (int e = 0; e < 4; ++e) { q[8 * c + 2 * e] = bflo(w[e]); q[8 * c + 2 * e + 1] = bfhi(w[e]); } asm volatile("" ::: "memory"); } }
            float mx = -1e30f, l = 0.f;
#pragma unroll
            for (int i = 0; i < 64; ++i) O[i] = 0.f;
#pragma unroll 1
            for (int t = 0; t < ntiles; ++t) {
                const int krow0 = (lat && t < 64) ? b * 4096 + t * 64 : TL + b * 256 + (t - (lat ? 64 : 0)) * 64;
                __syncthreads();
                { const int key = tid >> 3, ch = tid & 7; const u32x4 w = *(const u32x4*)(P + (size_t)(krow0 + key) * PW + OKK + h * 128 + map * 64 + ch * 8);
                  *(LAS f32x4*)(Ks + key * 64 + ch * 8) = (f32x4){bflo(w.x), bfhi(w.x), bflo(w.y), bfhi(w.y)};
                  *(LAS f32x4*)(Ks + key * 64 + ch * 8 + 4) = (f32x4){bflo(w.z), bfhi(w.z), bflo(w.w), bfhi(w.w)}; }
#pragma unroll
                for (int i2 = 0; i2 < 2; ++i2) { const int e = tid + i2 * 512, key = e >> 4, ch = e & 15; const u32x4 w = *(const u32x4*)(P + (size_t)(krow0 + key) * PW + OV + h * 128 + ch * 8);
                  *(LAS f32x4*)(Vs + key * 128 + ch * 8) = (f32x4){bflo(w.x), bfhi(w.x), bflo(w.y), bfhi(w.y)};
                  *(LAS f32x4*)(Vs + key * 128 + ch * 8 + 4) = (f32x4){bflo(w.z), bfhi(w.z), bflo(w.w), bfhi(w.w)}; }
                __syncthreads();
#pragma unroll 1
                for (int key = 0; key < 64; ++key) {
                    float s = 0.f;
#pragma unroll
                    for (int c = 0; c < 16; ++c) { const f32x4 kv = *(const LAS f32x4*)(Ks + key * 64 + 4 * c); s += (q[4 * c] * kv[0] + q[4 * c + 1] * kv[1]) + (q[4 * c + 2] * kv[2] + q[4 * c + 3] * kv[3]);
                        if ((c & 3) == 3) asm volatile("" ::: "memory"); }
                    const float mn = fmaxf(mx, s); const float alpha = __builtin_amdgcn_exp2f(mx - mn), p = __builtin_amdgcn_exp2f(s - mn);
                    l = l * alpha + p; mx = mn;
#pragma unroll
                    for (int c = 0; c < 16; ++c) { const f32x4 vv = *(const LAS f32x4*)(Vs + key * 128 + half * 64 + 4 * c);
                        O[4 * c] = O[4 * c] * alpha + p * vv[0]; O[4 * c + 1] = O[4 * c + 1] * alpha + p * vv[1]; O[4 * c + 2] = O[4 * c + 2] * alpha + p * vv[2]; O[4 * c + 3] = O[4 * c + 3] * alpha + p * vv[3];
                        if ((c & 3) == 3) asm volatile("" ::: "memory"); }
                }
            }
            const float inv = 1.f / l;
            if (map == 1) {
#pragma unroll
                for (int i = 0; i < 16; ++i) { *(f32x4*)(scr + tid * 64 + 4 * i) = (f32x4){O[4 * i] * inv, O[4 * i + 1] * inv, O[4 * i + 2] * inv, O[4 * i + 3] * inv}; if ((i & 3) == 3) asm volatile("" ::: "memory"); }
            } else {
#pragma unroll
                for (int i = 0; i < 16; ++i) { const f32x4 t = __builtin_nontemporal_load((const f32x4*)(scr + tid * 64 + 4 * i));
                    O[4 * i] = O[4 * i] * inv - lam * t[0]; O[4 * i + 1] = O[4 * i + 1] * inv - lam * t[1]; O[4 * i + 2] = O[4 * i + 2] * inv - lam * t[2]; O[4 * i + 3] = O[4 * i + 3] * inv - lam * t[3];
                    if ((i & 3) == 3) asm volatile("" ::: "memory"); }
            }
        }
        float ss = 0.f;
#pragma unroll
        for (int i = 0; i < 64; ++i) ss += O[i] * O[i];
        __syncthreads();
        red[tid] = ss;
        __syncthreads();
        const float tot = red[qr] + red[qr + 256];
        const float r = (1.f - lam_init) / sqrtf(tot * (1.f / 128.f) + RMS_EPS);
        bf16_t* op = AD + (size_t)qrow * 1024 + h * 128 + half * 64;
#pragma unroll
        for (int c = 0; c < 8; ++c) { u32x4 w;
            w.x = pk2(O[8 * c] * r * subg[half * 64 + 8 * c], O[8 * c + 1] * r * subg[half * 64 + 8 * c + 1]);
            w.y = pk2(O[8 * c + 2] * r * subg[half * 64 + 8 * c + 2], O[8 * c + 3] * r * subg[half * 64 + 8 * c + 3]);
            w.z = pk2(O[8 * c + 4] * r * subg[half * 64 + 8 * c + 4], O[8 * c + 5] * r * subg[half * 64 + 8 * c + 5]);
            w.w = pk2(O[8 * c + 6] * r * subg[half * 64 + 8 * c + 6], O[8 * c + 7] * r * subg[half * 64 + 8 * c + 7]);
            *(u32x4*)(op + 8 * c) = w; asm volatile("" ::: "memory"); }
    }
    __syncthreads();
}

__device__ __forceinline__ void p_gla_tail(const Frame& F0, const float* gng  , int nrows) {
    const Frame F = relaunder(F0);
    const bf16_t* P = (const bf16_t*)(F.ws + WS_P); const float* OG = (const float*)(F.ws + WS_OG); bf16_t* ACG = (bf16_t*)(F.ws + WS_ACG);
    for (int row = F.gw; row < nrows; row += F.NGW) {
        const int c0 = F.lane * 8;
        const float* o0 = OG + (size_t)row * 512 + c0; const float* o1 = OG + ((size_t)TT + row) * 512 + c0;
        f32x4 a = *(const f32x4*)o0 + *(const f32x4*)o1, b = *(const f32x4*)(o0 + 4) + *(const f32x4*)(o1 + 4);
        float ss = (a[0] * a[0] + a[1] * a[1]) + (a[2] * a[2] + a[3] * a[3]) + (b[0] * b[0] + b[1] * b[1]) + (b[2] * b[2] + b[3] * b[3]);
        ss += __shfl_xor(ss, 1); ss += __shfl_xor(ss, 2); ss += __shfl_xor(ss, 4); ss += __shfl_xor(ss, 8);
        const float rstd = 1.f / sqrtf(ss * (1.f / 128.f) + RMS_EPS);
        const f32x4 g0 = *(const f32x4*)(gng + (c0 & 127)), g1 = *(const f32x4*)(gng + (c0 & 127) + 4);
        const u32x4 rw = *(const u32x4*)(P + (size_t)row * PW + OGR + c0);
        float rr[8] = {bflo(rw.x), bfhi(rw.x), bflo(rw.y), bfhi(rw.y), bflo(rw.z), bfhi(rw.z), bflo(rw.w), bfhi(rw.w)};
        float o[8];
#pragma unroll
        for (int i = 0; i < 4; ++i) { const float y0 = a[i] * rstd * g0[i], y1 = b[i] * rstd * g1[i];
            o[i] = y0 * (rr[i] * sigmoidf_(rr[i])); o[4 + i] = y1 * (rr[4 + i] * sigmoidf_(rr[4 + i])); }
        u32x4 w; w.x = pk2(o[0], o[1]); w.y = pk2(o[2], o[3]); w.z = pk2(o[4], o[5]); w.w = pk2(o[6], o[7]);
        *(u32x4*)(ACG + (size_t)row * 1024 + 512 + c0) = w;
    }
}

__device__ __forceinline__ void p_norm2_router(const Frame& F0, int layer, int Tm) {
    const Frame F = relaunder(F0);
    const float* MOD = (const float*)(F.ws + WS_MOD) + (size_t)layer * 9 * 6144; bf16_t* H = (bf16_t*)(F.ws + WS_H); const float* XW = (const float*)(F.ws + WS_XW);
    unsigned char* rt = F.ws + WS_ROUTE + layer * ROUTE_STRIDE;
    int* TOPI = (int*)(rt + R_TOPI); float* TOPG = (float*)(rt + R_TOPG); int* CNT = (int*)(rt + R_CNT);
    const float* rw = in_ptr(F, 19) + (size_t)layer * 1024 * 32; const float* rb = in_ptr(F, 20) + layer * 32; const float* g2n = in_ptr(F, 7) + layer * 1024;
    LAS float* WT = (LAS float*)F.lds;
    LAS float* lg = (LAS float*)(F.lds + 132096) + F.wave * 32;
    LAS float* selv = (LAS float*)(F.lds + 132096 + 1024) + F.wave * 8;
    LAS int* hist = (LAS int*)(F.lds + 132096 + 2048);
    __syncthreads();
    for (int i = F.tid; i < 32768; i += NTHR) { const int k = i >> 5, e = i & 31; WT[e * 1028 + k] = rw[i]; }
    if (F.tid < 32) hist[F.tid] = 0;
    __syncthreads();
    const int RPW = Tm / F.G;
    for (int ri = F.wave; ri < RPW; ri += NWAVES) {
        const int row = blockIdx.x * RPW + ri; const int mr = row < TL ? (row >> 12) : 8;
        f32x4 v[4]; load_row(XW + (size_t)row * 1024, F.lane, v);
        norm_mod(v, g2n, MOD + (size_t)mr * 6144 + 3072, MOD + (size_t)mr * 6144 + 4096, F.lane);
        store_row_bf16(H + (size_t)row * 1024, F.lane, v);
        float p[32];
#pragma unroll
        for (int e = 0; e < 32; ++e) { float s = 0.f;
#pragma unroll
            for (int j = 0; j < 4; ++j) { const f32x4 w = *(const LAS f32x4*)(WT + e * 1028 + 256 * j + 4 * F.lane); s += (v[j][0] * w[0] + v[j][1] * w[1]) + (v[j][2] * w[2] + v[j][3] * w[3]); }
            p[e] = s; }
#pragma unroll
        for (int i = 0; i < 16; ++i) { const bool up = (F.lane & 32) != 0; const float send = up ? p[i] : p[i + 16], keep = up ? p[i + 16] : p[i]; p[i] = keep + __shfl_xor(send, 32); }
#pragma unroll
        for (int i = 0; i < 8; ++i) { const bool up = (F.lane & 16) != 0; const float send = up ? p[i] : p[i + 8], keep = up ? p[i + 8] : p[i]; p[i] = keep + __shfl_xor(send, 16); }
#pragma unroll
        for (int i = 0; i < 4; ++i) { const bool up = (F.lane & 8) != 0; const float send = up ? p[i] : p[i + 4], keep = up ? p[i + 4] : p[i]; p[i] = keep + __shfl_xor(send, 8); }
#pragma unroll
        for (int i = 0; i < 2; ++i) { const bool up = (F.lane & 4) != 0; const float send = up ? p[i] : p[i + 2], keep = up ? p[i + 2] : p[i]; p[i] = keep + __shfl_xor(send, 4); }
        { const bool up = (F.lane & 2) != 0; const float send = up ? p[0] : p[1], keep = up ? p[1] : p[0]; p[0] = keep + __shfl_xor(send, 2); }
        const int ex = F.lane >> 1;
        const float logit = p[0] + __shfl_xor(p[0], 1) + rb[ex];
        if ((F.lane & 1) == 0) lg[ex] = logit;
        LDS_WAIT(); asm volatile("" ::: "memory");
        int rank = 0;
#pragma unroll
        for (int e = 0; e < 32; ++e) { const float o = lg[e]; rank += (o > logit || (o == logit && e < ex)) ? 1 : 0; }
        if ((F.lane & 1) == 0 && rank < 4) { selv[rank * 2] = logit; selv[rank * 2 + 1] = __builtin_bit_cast(float, ex); }
        LDS_WAIT(); asm volatile("" ::: "memory");
        const float v0 = selv[0], v1 = selv[2], v2 = selv[4], v3 = selv[6];
        const float e0 = 1.f, e1 = __expf(v1 - v0), e2 = __expf(v2 - v0), e3 = __expf(v3 - v0); const float inv = 1.f / (e0 + e1 + e2 + e3);
        if (F.lane < 4) { const int ej = __builtin_bit_cast(int, selv[F.lane * 2 + 1]); const float gj = (F.lane == 0 ? e0 : F.lane == 1 ? e1 : F.lane == 2 ? e2 : e3) * inv;
            TOPI[(size_t)row * 4 + F.lane] = ej; TOPG[(size_t)row * 4 + F.lane] = gj; __hip_atomic_fetch_add(hist + ej, 1, __ATOMIC_RELAXED, __HIP_MEMORY_SCOPE_WORKGROUP); }
        LDS_WAIT(); asm volatile("" ::: "memory");
    }
    __syncthreads();
    if (F.tid < 32) CNT[blockIdx.x * 32 + F.tid] = hist[F.tid];
}

__device__ __forceinline__ void p_route_gather(const Frame& F0, int layer, int Tm) {
    const Frame F = relaunder(F0);
    unsigned char* rt = F.ws + WS_ROUTE + layer * ROUTE_STRIDE;
    const int* TOPI = (const int*)(rt + R_TOPI); int* POSOF = (int*)(rt + R_POSOF); int* ROWTOK = (int*)(rt + R_ROWTOK); const int* CNT = (const int*)(rt + R_CNT);
    int* TILEEXP = (int*)(rt + R_TILEEXP); int* NT = (int*)(rt + R_NT);
    const bf16_t* H = (const bf16_t*)(F.ws + WS_H); bf16_t* XS = (bf16_t*)(F.ws + WS_XS);
    LAS int* tot = (LAS int*)F.lds;
    LAS int* mine = tot + 32;
    LAS int* pst = mine + 32;
    LAS int* es = pst + 64;
    LAS int* ps = es + 1024;
    const int RPW = Tm / F.G, NP = RPW * 4;
    __syncthreads();
    if (F.tid < 32) { int t = 0, m = 0; for (int w = 0; w < F.G; ++w) { const int c = __builtin_nontemporal_load(CNT + w * 32 + F.tid); t += c; if (w < (int)blockIdx.x) m += c; } tot[F.tid] = t; mine[F.tid] = m; }
    for (int i = F.tid; i < NP; i += NTHR) es[i] = __builtin_nontemporal_load(TOPI + (size_t)blockIdx.x * NP + i);
    __syncthreads();
    if (F.tid == 0) { int s = 0; for (int e = 0; e < 32; ++e) { pst[e] = s; s += (tot[e] + 255) & ~255; } pst[32] = s; }
    __syncthreads();
    for (int i = F.tid; i < NP; i += NTHR) { const int e = es[i]; int r = 0; for (int j = 0; j < i; ++j) r += (es[j] == e) ? 1 : 0;
        const int pos = pst[e] + mine[e] + r; ps[i] = pos; const int tok = blockIdx.x * RPW + (i >> 2);
        ROWTOK[pos] = tok; POSOF[(size_t)tok * 4 + (i & 3)] = pos; }
    const int ntiles = pst[32] >> 8;
    if (blockIdx.x == 0) { for (int t = F.tid; t < ntiles; t += NTHR) { int e = 0; for (int q = 0; q < 32; ++q) if (pst[q] <= t * 256) e = q; TILEEXP[t] = e; }
        if (F.tid == 0) NT[0] = ntiles; }
    __syncthreads();
    for (int i = F.wave; i < NP; i += NWAVES) { const int tok = blockIdx.x * RPW + (i >> 2); const int pos = ps[i];
        const u32x4* src = (const u32x4*)(H + (size_t)tok * 1024); u32x4* dst = (u32x4*)(XS + (size_t)pos * 1024);
        dst[F.lane] = src[F.lane]; dst[64 + F.lane] = src[64 + F.lane]; }
    if (blockIdx.x < 32) { const int e = blockIdx.x; const int r0 = pst[e] + tot[e], r1 = pst[e + 1];
        for (int r = r0 + F.wave; r < r1; r += NWAVES) { u32x4* dst = (u32x4*)(XS + (size_t)r * 1024); dst[F.lane] = (u32x4){0u, 0u, 0u, 0u}; dst[64 + F.lane] = (u32x4){0u, 0u, 0u, 0u}; if (F.lane == 0) ROWTOK[r] = 0; } }
}

__device__ __forceinline__ void p_combine(const Frame& F0, int layer, int Tm) {
    const Frame F = relaunder(F0);
    const float* MODL = (const float*)(F.ws + WS_MOD) + (size_t)layer * 9 * 6144;
    const float* MODN = (const float*)(F.ws + WS_MOD) + (size_t)(layer + 1) * 9 * 6144;
    unsigned char* rt = F.ws + WS_ROUTE + layer * ROUTE_STRIDE;
    const int* POSOF = (const int*)(rt + R_POSOF); const float* TOPG = (const float*)(rt + R_TOPG);
    const bf16_t* YY = (const bf16_t*)(F.ws + WS_XS); float* XW = (float*)(F.ws + WS_XW); bf16_t* H = (bf16_t*)(F.ws + WS_H);
    const bool last = layer == 1;
    for (int row = F.gw; row < Tm; row += F.NGW) {
        const int mr = row < TL ? (row >> 12) : 8;
        f32x4 v[4]; load_row(XW + (size_t)row * 1024, F.lane, v);
        f32x4 y[4];
#pragma unroll
        for (int j = 0; j < 4; ++j) y[j] = (f32x4){0.f, 0.f, 0.f, 0.f};
#pragma unroll
        for (int s = 0; s < 4; ++s) { const int pos = __builtin_nontemporal_load(POSOF + (size_t)row * 4 + s); const float gt = __builtin_nontemporal_load(TOPG + (size_t)row * 4 + s);
            const bf16_t* yp = YY + (size_t)pos * 1024;
#pragma unroll
            for (int j = 0; j < 4; ++j) { const u32x2 w = *(const u32x2*)(yp + 256 * j + 4 * F.lane); y[j] = y[j] + gt * (f32x4){bflo(w.x), bfhi(w.x), bflo(w.y), bfhi(w.y)}; } }
        const float* g2 = MODL + (size_t)mr * 6144 + 5120;
#pragma unroll
        for (int j = 0; j < 4; ++j) v[j] = v[j] + *(const f32x4*)(g2 + 256 * j + 4 * F.lane) * y[j];
        if (!last) {
#pragma unroll
            for (int j = 0; j < 4; ++j) *(f32x4*)(XW + (size_t)row * 1024 + 256 * j + 4 * F.lane) = v[j];
            norm_mod(v, in_ptr(F, 6) + 1024, MODN + (size_t)mr * 6144, MODN + (size_t)mr * 6144 + 1024, F.lane);
            store_row_bf16(H + (size_t)row * 1024, F.lane, v);
        } else {
            const float rstd = row_rstd(v);
#pragma unroll
            for (int j = 0; j < 4; ++j) *(f32x4*)(out_ptr(F) + (size_t)row * 1024 + 256 * j + 4 * F.lane) = v[j] * rstd * *(const f32x4*)(in_ptr(F, 25) + 256 * j + 4 * F.lane);
        }
    }
}
__global__ void __launch_bounds__(NTHR, 2) fwd(Args args) {
    extern __shared__ __attribute__((aligned(16))) unsigned char lds_raw[];
    Frame F;
    F.lds = (LAS unsigned char*)lds_raw; F.ws = args.ws;
    F.tid = threadIdx.x; F.lane = F.tid & 63; F.wave = __builtin_amdgcn_readfirstlane(F.tid >> 6);
    F.G = gridDim.x; F.gw = blockIdx.x * NWAVES + F.wave; F.NGW = F.G * NWAVES;
    volatile LAS unsigned* MISC = (volatile LAS unsigned*)(F.lds + MISC_OFF);
    if (F.tid < 64) MISC[F.tid] = 0u;
    if (F.tid < 27) ((volatile LAS unsigned long long*)(F.lds + PTR_OFF))[F.tid] = (unsigned long long)(F.tid < 26 ? (const void*)args.in[F.tid] : (const void*)args.out);
    __syncthreads();
    XcdBarrier bar; bar.bar = (unsigned*)(args.ws + WS_CTL) + 4096; bar.x = 0; bar.st = nullptr;
    if (N_LAUNCH_MODE == 1) bar = xcd_barrier_post((unsigned*)(args.ws + WS_CTL) + 4096, MISC + 8);
    const int lo = args.ph_lo, hi = args.ph_hi;
#ifndef DISABLE_MASK
#define DISABLE_MASK 0
#endif
#define EN(k) (!((DISABLE_MASK >> (k)) & 1))
#define IN(k) (lo <= (k) && (k) < hi)
#define SEAM(k) do { if (IN(k) && IN((k) + 1)) xcd_barrier(bar); } while (0)
    unsigned char* ws = args.ws;

    if (EN(12) && IN(0)) { p0_prologue(F); } SEAM(0);

#pragma unroll
    for (int L = 0; L < 2; ++L) {
        const int pb = 1 + 12 * L; const bool lastL = (L == 1);
        const int Tm = lastL ? TL : TT;
        const float* MODL = (const float*)(ws + WS_MOD) + (size_t)L * 9 * 6144;
        if (EN(0) && IN(pb + 0)) { if (L == 0) p_norm1_l0(F); } SEAM(pb + 0);
        if (EN(1) && IN(pb + 1)) {
            pg8::Gemm g{(const bf16_t*)(ws + WS_H), (const bf16_t*)(ws + WS_WIN + L * WIN_STRIDE), 1024, 1024, 1024};
            pg8::StaticOrder S; S.init(TT, NIN, F.G, (int)blockIdx.x);
            EpiIn E{(bf16_t*)(ws + WS_P), (float*)(ws + WS_GA), (const float*)(ws + WS_ROPE), (const float*)(ws + WS_ROPE) + 1024};
            pg8::gemm_phase<EpiIn, pg8::StaticOrder, true, true>(F.lds, g, S, E);
        } SEAM(pb + 1);
        if (EN(2) && IN(pb + 2)) {
            p_conv(F, in_ptr(F, 12) + (size_t)L * 3 * 512);
            if (blockIdx.x < 64) p_gla_chain(F, in_ptr(F, 14) + (size_t)L * 2 * 16 * 256, in_ptr(F, 15) + (size_t)L * 2 * 256, (int)blockIdx.x);
        } SEAM(pb + 2);
        if (EN(3) && IN(pb + 3)) { p_attn_naive(F, L, in_ptr(F, 10) + (size_t)L * 128); } SEAM(pb + 3);
        if (EN(4) && IN(pb + 4)) { p_gla_tail(F, in_ptr(F, 16) + (size_t)L * 128, Tm); } SEAM(pb + 4);
        if (EN(5) && IN(pb + 5)) {
            pg8::StaticOrder S; S.init(Tm, 1024, F.G, (int)blockIdx.x);
            const bf16_t* P = (const bf16_t*)(ws + WS_P); float* M32 = (float*)(ws + WS_OG); bf16_t* MG = (bf16_t*)(ws + WS_MERGED);
            { pg8::Gemm g{(const bf16_t*)(ws + WS_AD), (const bf16_t*)(ws + WS_WD + L * W1K_STRIDE), 1024, 1024, 1024};
              EpiGate<0> E{P, M32, MG}; pg8::gemm_phase<EpiGate<0>, pg8::StaticOrder, true, true>(F.lds, g, S, E); }
            { pg8::Gemm g{(const bf16_t*)(ws + WS_ACG), (const bf16_t*)(ws + WS_WCG + L * W1K_STRIDE), 512, 1024, 1024};
              EpiGate<1> E{P, M32, MG}; pg8::gemm_phase<EpiGate<1>, pg8::StaticOrder, true, true>(F.lds, g, S, E); }
            { pg8::Gemm g{(const bf16_t*)(ws + WS_ACG) + 512, (const bf16_t*)(ws + WS_WCG + L * W1K_STRIDE) + 512, 512, 1024, 1024};
              EpiGate<2> E{P, M32, MG}; pg8::gemm_phase<EpiGate<2>, pg8::StaticOrder, true, true>(F.lds, g, S, E); }
        } SEAM(pb + 5);
        if (EN(6) && IN(pb + 6)) {
            pg8::Gemm g{(const bf16_t*)(ws + WS_MERGED), (const bf16_t*)(ws + WS_WO + L * W1K_STRIDE), 1024, 1024, 1024};
            pg8::StaticOrder S; S.init(Tm, 1024, F.G, (int)blockIdx.x);
            const float* xl = L == 0 ? in_ptr(F, 0) : (const float*)(ws + WS_XW);
            const float* xc = L == 0 ? in_ptr(F, 2) - (size_t)TL * 1024 : (const float*)(ws + WS_XW);
            EpiRes E{xl, xc, (float*)(ws + WS_XW), MODL};
            pg8::gemm_phase<EpiRes, pg8::StaticOrder, true, true>(F.lds, g, S, E);
        } SEAM(pb + 6);
        if (EN(7) && IN(pb + 7)) { p_norm2_router(F, L, Tm); } SEAM(pb + 7);
        if (EN(8) && IN(pb + 8)) { p_route_gather(F, L, Tm); } SEAM(pb + 8);
        unsigned char* rt = ws + WS_ROUTE + L * ROUTE_STRIDE;
        if (EN(9) && IN(pb + 9)) {
            const int nt = __builtin_amdgcn_readfirstlane(__builtin_nontemporal_load((const int*)(rt + R_NT)));
            pg8::Gemm g{(const bf16_t*)(ws + WS_XS), (const bf16_t*)(ws + WS_W1 + L * W1_STRIDE), 1024, 1024, 1024};
            MoeOrder S{nt, 8, F.G, (int)blockIdx.x, (const int*)(rt + R_TILEEXP)};
            EpiSwiglu E{(bf16_t*)(ws + WS_HH), in_ptr(F, 22) + (size_t)L * 32 * 2048};
            pg8::gemm_phase<EpiSwiglu, MoeOrder, true, true>(F.lds, g, S, E);
        } SEAM(pb + 9);
        if (EN(10) && IN(pb + 10)) {
            const int nt = __builtin_amdgcn_readfirstlane(__builtin_nontemporal_load((const int*)(rt + R_NT)));
            pg8::Gemm g{(const bf16_t*)(ws + WS_HH), (const bf16_t*)(ws + WS_W2 + L * W2_STRIDE), 1024, 1024, 1024};
            MoeOrder S{nt, 4, F.G, (int)blockIdx.x, (const int*)(rt + R_TILEEXP)};
            EpiY E{(bf16_t*)(ws + WS_XS), in_ptr(F, 24) + (size_t)L * 32 * 1024};
            pg8::gemm_phase<EpiY, MoeOrder, true, true>(F.lds, g, S, E);
        } SEAM(pb + 10);
        if (EN(11) && IN(pb + 11)) { p_combine(F, L, Tm); } SEAM(pb + 11);
    }
#undef IN
#undef SEAM
#ifdef DBG_STOP
    if (lo == 100) {
        float* out = out_ptr(F); const int gt = F.gw * 64 + F.lane, NGT = F.NGW * 64;
#if DBG_KIND == 2
        unsigned* cnt = (unsigned*)(ws + WS_XW + 130 * MiB);
        unsigned c = 0; if (blockIdx.x == 0 && F.tid == 0) { c = cnt[0]; cnt[0] = c + 1; }
        for (size_t i = gt; i < (size_t)TL * 1024; i += NGT) out[i] = 1.0f;
        if (blockIdx.x == 0 && F.tid == 0) out[0] = (float)(c & 1023u);
#elif DBG_KIND == 0
        const float* src = (const float*)(ws + WS_XW); for (size_t i = gt; i < (size_t)TL * 1024; i += NGT) out[i] = src[i];
#elif DBG_KIND == 1
        const bf16_t* src = (const bf16_t*)(ws + DBG_OFF); for (size_t i = gt; i < (size_t)TL * 1024; i += NGT) out[i] = bf2f(src[i * DBG_STRIDE]);
#endif
    }
#endif
}

extern "C" void kernel_launch(void* const* d_in, const int* in_sizes, int n_in, void* d_out, int out_size, void* d_ws, size_t ws_size, hipStream_t stream) {
    static int grid = 0;
    if (grid == 0) {
        if (n_in != 26 || out_size != TL * DM || ws_size < WS_END) { fprintf(stderr, "kernel_launch: unexpected problem (n_in %d out %d ws %zu)\n", n_in, out_size, ws_size); grid = -1; return; }
        int dev = 0, cus = 0, per_cu = 0;
        if (hipGetDevice(&dev) != hipSuccess || hipDeviceGetAttribute(&cus, hipDeviceAttributeMultiprocessorCount, dev) != hipSuccess) { grid = -1; return; }
        if (hipFuncSetAttribute((const void*)fwd, hipFuncAttributeMaxDynamicSharedMemorySize, LDS_BYTES) != hipSuccess) { fprintf(stderr, "kernel_launch: hipFuncSetAttribute failed\n"); grid = -1; return; }
        if (hipOccupancyMaxActiveBlocksPerMultiprocessor(&per_cu, (const void*)fwd, NTHR, LDS_BYTES) != hipSuccess || per_cu < 1) fprintf(stderr, "kernel_launch: occupancy query reports %d\n", per_cu);
        (void)hipGetLastError();
        grid = cus;
        if (grid > 256) grid = 256;
    }
    if (grid < 0) return;
    (void)hipMemsetAsync((char*)d_ws + WS_CTL, 0, CTL_ZERO_BYTES, stream);
    Args a{};
    for (int i = 0; i < 26; ++i) a.in[i] = (const float*)d_in[i];
    a.out = (float*)d_out; a.ws = (unsigned char*)d_ws;
    if (N_LAUNCH_MODE == 1) { a.ph_lo = 0; a.ph_hi = NPHASE; hipLaunchKernelGGL(fwd, dim3(grid), dim3(NTHR), LDS_BYTES, stream, a); }
#ifdef DBG_STOP
    else { for (int p = 0; p <= DBG_STOP; ++p) { if (p == 13) continue; a.ph_lo = p; a.ph_hi = p + 1; hipLaunchKernelGGL(fwd, dim3(grid), dim3(NTHR), LDS_BYTES, stream, a); }
        a.ph_lo = 100; a.ph_hi = 101; hipLaunchKernelGGL(fwd, dim3(grid), dim3(NTHR), LDS_BYTES, stream, a); }
#else
    else for (int p = 0; p < NPHASE; ++p) { if (p == 13) continue; a.ph_lo = p; a.ph_hi = p + 1; hipLaunchKernelGGL(fwd, dim3(grid), dim3(NTHR), LDS_BYTES, stream, a); }
#endif
}
```

```cpp
#include <hip/hip_runtime.h>
#include <cstdio>
#include <cstdint>
#define N_LAUNCH_MODE 1
namespace pg8 {
#define PG8_LAS __attribute__((address_space(3)))
typedef unsigned short bf16_t;
typedef short bf16x8 __attribute__((ext_vector_type(8)));
typedef float f32x4 __attribute__((ext_vector_type(4)));
typedef float f32x2 __attribute__((ext_vector_type(2)));
typedef unsigned u32x4 __attribute__((ext_vector_type(4)));
typedef unsigned u32x2 __attribute__((ext_vector_type(2)));
constexpr int BM = 256, BK = 64, HALF = 128, HTB = HALF * BK * 2  , STAGE_BYTES = 8 * HTB, NXCD = 8, WGM = 8;

__host__ __device__ __forceinline__ int lds_byte(int r, int c) { const int st = (r >> 4) * 2 + (c >> 5), rr = r & 15, cc = c & 31, ob = rr * 64 + cc * 2; return st * 1024 + (ob ^ (((ob >> 9) & 1) << 5)); }
__host__ __device__ __forceinline__ void stage_rc(int b, int& R, int& C) { const int st = b / 1024, sb = b % 1024, swz = sb ^ (((sb >> 9) & 1) << 5); R = (st >> 1) * 16 + swz / 64; C = (st & 1) * 32 + (swz % 64) / 2; }
__host__ __device__ __forceinline__ int perm32(int rho) { const int n = rho >> 4, i = rho & 15; return 8 * (i >> 2) + 4 * n + (i & 3); }

struct Unit { int pm, pn, pb; };
struct Gemm { const bf16_t* A; const bf16_t* Bt; int K, lda, ldb; };

struct StaticOrder {
    int nM, nN, nwg, G, c;
    __host__ __device__ void init(int M, int N, int G_, int c_) { nM = M / BM; nN = N / BM; nwg = nM * nN; G = G_; c = c_; }
    __host__ __device__ bool next(int i, Unit& u) const {
        const long L = (long)i * G + c; if (L >= nwg) return false;
        int wgid = (int)L; { const int q = nwg / NXCD, r = nwg % NXCD, xcd = wgid % NXCD, off = wgid / NXCD; wgid = (xcd < r ? xcd * (q + 1) : r * (q + 1) + (xcd - r) * q) + off; }
        const int nig = WGM * nN, gid = wgid / nig, fm = gid * WGM, gsz = (nM - fm) < WGM ? (nM - fm) : WGM;
        u.pm = fm + ((wgid % nig) % gsz); u.pn = (wgid % nig) / gsz; u.pb = u.pn; return true;
    }
    __device__ __forceinline__ void a_ready(const Unit&) const {}
    __device__ __forceinline__ void done(const Unit&) const {}
};

__device__ __forceinline__ unsigned cvt_pk_bf16(float lo, float hi) { unsigned r; asm volatile("v_cvt_pk_bf16_f32 %0, %1, %2" : "=v"(r) : "v"(lo), "v"(hi)); return r; }

template <class Epi, class Sched, bool ALIGN_EPI = false, bool SP2 = false>
__device__ __forceinline__ void gemm_phase(PG8_LAS unsigned char* lds, const Gemm g, const Sched& S, const Epi& E) {
    int tid_ = threadIdx.x; asm volatile("" : "+v"(tid_));
    const int tid = tid_, wid = __builtin_amdgcn_readfirstlane(tid >> 6), lane = tid & 63, wr = wid >> 2, wc = wid & 3, fr = lane & 15, fq = lane >> 4;
    const int K = g.K, nt = K / BK;
    unsigned voffA[2], voffB[2];
#pragma unroll
    for (int i = 0; i < 2; ++i) { int R, C; stage_rc(tid * 16 + i * 8192, R, C); const int Rb = Epi::PERM ? ((R & ~31) + perm32(R & 31)) : R;
        voffA[i] = (unsigned)(R * g.lda + C) * 2u; voffB[i] = (unsigned)(Rb * g.ldb + C) * 2u; }
    const size_t kstep = (size_t)(BK * 2);
    const size_t hstepA = (size_t)HALF * g.lda * 2, hstepB = (size_t)HALF * g.ldb * 2;
    const size_t tstepA = 2 * hstepA, tstepB = 2 * hstepB;
    const unsigned ldsw = (unsigned)wid * 1024u;
    const int aoff = lds_byte(wr * 64 + fr, fq * 8), boff = lds_byte(wc * 32 + fr, fq * 8);
#define PG8_SA(b, h) (((b) * 2 + (h)) * HTB)
#define PG8_SB(b, h) ((4 + (b) * 2 + (h)) * HTB)
#define PG8_STAGE(bufoff, gbase, voff) do { _Pragma("unroll") for (int _i = 0; _i < 2; ++_i) \
        __builtin_amdgcn_global_load_lds((const unsigned*)((const char*)(gbase) + (voff)[_i]), (PG8_LAS unsigned*)(lds + (bufoff) + ldsw + _i * 8192), 16, 0, 0); } while (0)
#define PG8_LDA(dst, b, h) do { _Pragma("unroll") for (int m = 0; m < 4; ++m) _Pragma("unroll") for (int k = 0; k < 2; ++k) dst[m][k] = *(const PG8_LAS bf16x8*)(lds + PG8_SA(b, h) + aoff + m * 2048 + k * 1024); } while (0)
#define PG8_LDB(dst, b, h) do { _Pragma("unroll") for (int n = 0; n < 2; ++n) _Pragma("unroll") for (int k = 0; k < 2; ++k) dst[n][k] = *(const PG8_LAS bf16x8*)(lds + PG8_SB(b, h) + boff + n * 2048 + k * 1024); } while (0)
#define PG8_MMA(ai, bj, At, Bt) do { __builtin_amdgcn_s_setprio(1); _Pragma("unroll") for (int m = 0; m < 4; ++m) _Pragma("unroll") for (int n = 0; n < 2; ++n) _Pragma("unroll") for (int k = 0; k < 2; ++k) \
        acc[ai][bj][m][n] = __builtin_amdgcn_mfma_f32_16x16x32_bf16(Bt[n][k], At[m][k], acc[ai][bj][m][n], 0, 0, 0); __builtin_amdgcn_s_setprio(0); } while (0)
#define PG8_WAIT_V(n) asm volatile("s_waitcnt vmcnt(" #n ")" ::: "memory")
#define PG8_WAIT_L(n) asm volatile("s_waitcnt lgkmcnt(" #n ")" ::: "memory")
#define PG8_BAR __builtin_amdgcn_s_barrier()
#define PG8_SCHED __builtin_amdgcn_sched_barrier(0)
    Unit cur, nxt; int ui = 0;
    if (!S.next(0, cur)) return;
    f32x4 acc[2][2][4][2];
#pragma unroll
    for (int a = 0; a < 2; ++a)
#pragma unroll
        for (int b = 0; b < 2; ++b)
#pragma unroll
            for (int m = 0; m < 4; ++m)
#pragma unroll
                for (int n = 0; n < 2; ++n) acc[a][b][m][n] = (f32x4){0.f, 0.f, 0.f, 0.f};
    bf16x8 At[4][2], B0[2][2], B1[2][2];
    const char* cA = (const char*)g.A + (size_t)cur.pm * tstepA; const char* cB = (const char*)g.Bt + (size_t)cur.pb * tstepB;
    S.a_ready(cur);
    if constexpr (SP2) {
        PG8_STAGE(PG8_SB(0, 0), cB, voffB); PG8_STAGE(PG8_SB(0, 1), cB + hstepB, voffB); PG8_STAGE(PG8_SA(0, 0), cA, voffA); PG8_STAGE(PG8_SA(0, 1), cA + hstepA, voffA);
        if (wr == 1) PG8_BAR;
        PG8_WAIT_V(2); PG8_BAR;
        PG8_STAGE(PG8_SB(1, 0), cB + kstep, voffB); PG8_STAGE(PG8_SA(1, 0), cA + kstep, voffA); PG8_STAGE(PG8_SB(1, 1), cB + hstepB + kstep, voffB);
        PG8_WAIT_V(6); PG8_BAR;
    } else {
        PG8_STAGE(PG8_SB(0, 0), cB, voffB); PG8_STAGE(PG8_SA(0, 0), cA, voffA); PG8_STAGE(PG8_SB(0, 1), cB + hstepB, voffB); PG8_STAGE(PG8_SA(0, 1), cA + hstepA, voffA);
        if (wr == 1) PG8_BAR;
        PG8_WAIT_V(4); PG8_BAR;
        PG8_STAGE(PG8_SB(1, 0), cB + kstep, voffB); PG8_STAGE(PG8_SA(1, 0), cA + kstep, voffA); PG8_STAGE(PG8_SB(1, 1), cB + hstepB + kstep, voffB);
        PG8_WAIT_V(6); PG8_BAR;
    }
    for (;;) {
        const bool has_next = S.next(ui + 1, nxt);
        const char* nA = has_next ? (const char*)g.A + (size_t)nxt.pm * tstepA : cA; const char* nB = has_next ? (const char*)g.Bt + (size_t)nxt.pb * tstepB : cB;
        for (int t = 0; t < nt; t += 2) {
            const bool last = (t == nt - 2);
            const char* a1 = cA + (size_t)(t + 1) * kstep;
            const char* a2 = last ? nA : cA + (size_t)(t + 2) * kstep; const char* b2 = last ? nB : cB + (size_t)(t + 2) * kstep;
            const char* a3 = a2 + kstep; const char* b3 = b2 + kstep;
            if (last && has_next) S.a_ready(nxt);
            if constexpr (SP2) {
            PG8_LDB(B0, 0, 0); PG8_LDB(B1, 0, 1); PG8_SCHED; PG8_LDA(At, 0, 0); PG8_STAGE(PG8_SA(1, 1), a1 + hstepA, voffA);
            PG8_WAIT_V(8); PG8_WAIT_L(0); PG8_BAR; PG8_MMA(0, 0, At, B0); PG8_MMA(0, 1, At, B1); PG8_BAR; PG8_SCHED;
            PG8_LDA(At, 0, 1); PG8_STAGE(PG8_SB(0, 0), b2, voffB); PG8_STAGE(PG8_SB(0, 1), b2 + hstepB, voffB); PG8_STAGE(PG8_SA(0, 0), a2, voffA);
            PG8_WAIT_V(8); PG8_WAIT_L(0); PG8_BAR; PG8_MMA(1, 0, At, B0); PG8_MMA(1, 1, At, B1); PG8_BAR; PG8_SCHED;
            PG8_LDB(B0, 1, 0); PG8_LDB(B1, 1, 1); PG8_SCHED; PG8_LDA(At, 1, 0); PG8_STAGE(PG8_SA(0, 1), a2 + hstepA, voffA);
            PG8_WAIT_V(8); PG8_WAIT_L(0); PG8_BAR; PG8_MMA(0, 0, At, B0); PG8_MMA(0, 1, At, B1); PG8_BAR; PG8_SCHED;
            PG8_LDA(At, 1, 1); PG8_STAGE(PG8_SB(1, 0), b3, voffB); PG8_STAGE(PG8_SB(1, 1), b3 + hstepB, voffB); PG8_STAGE(PG8_SA(1, 0), a3, voffA);
            PG8_WAIT_V(8); PG8_WAIT_L(0); PG8_BAR; PG8_MMA(1, 0, At, B0); PG8_MMA(1, 1, At, B1); PG8_BAR; PG8_SCHED;
            } else {
            PG8_LDB(B0, 0, 0); PG8_SCHED; PG8_LDA(At, 0, 0); PG8_STAGE(PG8_SA(1, 1), a1 + hstepA, voffA);
            PG8_WAIT_L(8); PG8_BAR; PG8_WAIT_L(0); PG8_MMA(0, 0, At, B0); PG8_BAR; PG8_SCHED;
            PG8_LDB(B1, 0, 1); PG8_STAGE(PG8_SB(0, 0), b2, voffB);
            PG8_BAR; PG8_WAIT_L(0); PG8_MMA(0, 1, At, B1); PG8_BAR;
            PG8_LDA(At, 0, 1); PG8_STAGE(PG8_SA(0, 0), a2, voffA);
            PG8_BAR; PG8_WAIT_L(0); PG8_MMA(1, 0, At, B0); PG8_BAR; PG8_SCHED;
            PG8_STAGE(PG8_SB(0, 1), b2 + hstepB, voffB);
            PG8_WAIT_V(6); PG8_BAR; PG8_MMA(1, 1, At, B1); PG8_BAR;
            PG8_LDB(B0, 1, 0); PG8_SCHED; PG8_LDA(At, 1, 0); PG8_STAGE(PG8_SA(0, 1), a2 + hstepA, voffA);
            PG8_WAIT_L(8); PG8_BAR; PG8_WAIT_L(0); PG8_MMA(0, 0, At, B0); PG8_BAR; PG8_SCHED;
            PG8_LDB(B1, 1, 1); PG8_STAGE(PG8_SB(1, 0), b3, voffB);
            PG8_BAR; PG8_WAIT_L(0); PG8_MMA(0, 1, At, B1); PG8_BAR;
            PG8_LDA(At, 1, 1); PG8_STAGE(PG8_SA(1, 0), a3, voffA);
            PG8_BAR; PG8_WAIT_L(0); PG8_MMA(1, 0, At, B0); PG8_BAR; PG8_SCHED;
            PG8_STAGE(PG8_SB(1, 1), b3 + hstepB, voffB);
            PG8_WAIT_V(6); PG8_BAR; PG8_MMA(1, 1, At, B1); PG8_BAR;
            }
        }
        if constexpr (ALIGN_EPI) { if (wr == 0) PG8_BAR; }
        E(acc, cur, wr, wc, fr, fq); S.done(cur);
        if (!has_next) break;
#pragma unroll
        for (int a = 0; a < 2; ++a)
#pragma unroll
            for (int b = 0; b < 2; ++b)
#pragma unroll
                for (int m = 0; m < 4; ++m)
#pragma unroll
                    for (int n = 0; n < 2; ++n) acc[a][b][m][n] = (f32x4){0.f, 0.f, 0.f, 0.f};
        cur = nxt; cA = nA; cB = nB; ++ui;
        if constexpr (ALIGN_EPI) { if (wr == 1) PG8_BAR; }
    }
    PG8_WAIT_V(0);
    if constexpr (!ALIGN_EPI) { if (wr == 0) PG8_BAR; }
    PG8_BAR;
#undef PG8_SA
#undef PG8_SB
#undef PG8_STAGE
#undef PG8_LDA
#undef PG8_LDB
#undef PG8_MMA
#undef PG8_WAIT_V
#undef PG8_WAIT_L
#undef PG8_BAR
#undef PG8_SCHED
}
}
constexpr int NB = 8, SEQ = 4096, DM = 1024, CTXL = 256;
constexpr int TL = NB * SEQ, TC = NB * CTXL, TT = TL + TC;
constexpr int NIN = 9472, PW = 9216;
constexpr int OQ = 0, OKK = 1024, OV = 2048, OCB = 3072, OCC = 3584, OCX = 4096, OGQ = 4608, OGK = 4864, OGV = 5120, OGR = 5632, OGATE = 6144;
constexpr int NEXP = 32, NRMAX = 147456;
constexpr float RMS_EPS = 1e-6f;
constexpr float QSCALE = 0.125f * 1.4426950408889634f;
constexpr int NWAVES = 8, NTHR = 512;
#ifndef N_LAUNCH_MODE
#define N_LAUNCH_MODE 0
#endif
constexpr int NPHASE = 25;

constexpr size_t MiB = 1u << 20;
constexpr size_t WS_CTL = 0, CTL_ZERO_BYTES = 1 * MiB;
constexpr size_t WS_MOD = 1 * MiB;
constexpr size_t WS_ROPE = WS_MOD + 512 * 1024;
constexpr size_t WS_LAM = WS_ROPE + 16 * 1024;
constexpr size_t WS_ROUTE = 2 * MiB, ROUTE_STRIDE = 8 * MiB;
constexpr size_t R_TOPI = 0, R_TOPG = 1 * MiB, R_POSOF = 2 * MiB, R_ROWTOK = 3 * MiB, R_CNT = 4 * MiB, R_TILEEXP = 4 * MiB + 64 * 1024, R_NT = 4 * MiB + 128 * 1024;
constexpr size_t WS_GA = 18 * MiB;
constexpr size_t WS_WIN = 24 * MiB, WIN_STRIDE = (size_t)NIN * DM * 2;
constexpr size_t WS_WD = 61 * MiB, WS_WCG = 65 * MiB, WS_WO = 69 * MiB, W1K_STRIDE = 2 * MiB;
constexpr size_t WS_W1 = 73 * MiB, W1_STRIDE = 128 * MiB;
constexpr size_t WS_W2 = 329 * MiB, W2_STRIDE = 64 * MiB;
constexpr size_t WS_H = 457 * MiB, WS_AD = 525 * MiB, WS_ACG = 593 * MiB, WS_MERGED = 661 * MiB;
constexpr size_t WS_OG = 729 * MiB;
constexpr size_t WS_XW = 865 * MiB;
constexpr size_t WS_ASCR = 1001 * MiB;
constexpr size_t WS_P = 1033 * MiB;
constexpr size_t WS_XS = WS_P, WS_HH = WS_P + 288 * MiB;
constexpr size_t WS_END = 1645 * MiB;
static_assert(WS_P + (size_t)TT * PW * 2 <= WS_END && WS_HH + (size_t)NRMAX * DM * 2 <= WS_END, "ws map");

constexpr int LDS_BYTES = 147456;
constexpr int MISC_OFF = 147456 - 1024;

#define GAS __attribute__((address_space(1)))
#define LAS __attribute__((address_space(3)))
typedef unsigned short bf16_t;
typedef float f32x4 __attribute__((ext_vector_type(4)));
typedef float f32x2 __attribute__((ext_vector_type(2)));
typedef unsigned u32x4 __attribute__((ext_vector_type(4)));
typedef unsigned u32x2 __attribute__((ext_vector_type(2)));
#define LDS_WAIT() asm volatile("s_waitcnt lgkmcnt(0)" ::: "memory")
#define VM_WAIT() asm volatile("s_waitcnt vmcnt(0)" ::: "memory")
__device__ __forceinline__ unsigned f2bf(float f) { unsigned u = __builtin_bit_cast(unsigned, f); return (u + 0x7fffu + ((u >> 16) & 1u)) >> 16; }
__device__ __forceinline__ unsigned pk2(float lo, float hi) { return f2bf(lo) | (f2bf(hi) << 16); }
__device__ __forceinline__ float bflo(unsigned w) { return __builtin_bit_cast(float, w << 16); }
__device__ __forceinline__ float bfhi(unsigned w) { return __builtin_bit_cast(float, w & 0xffff0000u); }
__device__ __forceinline__ float bf2f(bf16_t b) { return __builtin_bit_cast(float, ((unsigned)b) << 16); }
__device__ __forceinline__ float wave_sum(float v) {
#pragma unroll
    for (int o = 1; o < 64; o <<= 1) v += __shfl_xor(v, o);
    return v;
}
__device__ __forceinline__ float sigmoidf_(float x) { return 1.f / (1.f + __expf(-x)); }

#define XB_TMO      128
#define XB_XCNT(j)  (256  + 64 * (j))
#define XB_XSUB(j)  (1280 + 64 * (j))
#define XB_XGEN(j)  (2304 + 64 * (j))
#define XB_TOP      3328
#define XB_TOPGEN   3392
#define XCD_BAR_WORDS 3456
#define XB_SPIN_CAP (1u << 18)
__device__ __forceinline__ unsigned xb_ld(unsigned* p)              { return __hip_atomic_load(p, __ATOMIC_RELAXED, __HIP_MEMORY_SCOPE_AGENT); }
__device__ __forceinline__ unsigned xb_add(unsigned* p, unsigned v) { return __hip_atomic_fetch_add(p, v, __ATOMIC_RELAXED, __HIP_MEMORY_SCOPE_AGENT); }
__device__ __forceinline__ unsigned xb_xcc_id() { return (unsigned)__builtin_amdgcn_s_getreg((3 << 11) | 20) & 0xFu; }
#define XB_SPIN(cond, bar) do { unsigned _sp = 0; while (cond) { __builtin_amdgcn_s_sleep(1); \
    if ((++_sp & 255u) == 0u) { if (xb_ld(&(bar)[XB_TMO])) break; if (_sp > XB_SPIN_CAP) { atomicAdd(&(bar)[XB_TMO], 1u); break; } } } } while (0)
struct XcdBarrier { unsigned* bar; unsigned x; volatile LAS unsigned* st; };
__device__ __forceinline__ XcdBarrier xcd_barrier_post(unsigned* bar, volatile LAS unsigned* st) {
    XcdBarrier b; b.bar = bar; b.x = xb_xcc_id(); b.st = st;
    if (threadIdx.x == 0) (void)xb_add(&bar[XB_XCNT(b.x)], 1u);
    return b;
}
__device__ __forceinline__ void xcd_barrier_complete(unsigned* bar, unsigned x, unsigned& nloc, unsigned& nx) {
    const unsigned G = gridDim.x * gridDim.y * gridDim.z;
    unsigned sum, cnt, mine, sp = 0u;
    for (;;) {
        sum = 0u; cnt = 0u; mine = 0u;
#pragma unroll
        for (unsigned j = 0; j < 16; ++j) { const unsigned c = xb_ld(&bar[XB_XCNT(j)]); sum += c; cnt += (c > 0u) ? 1u : 0u; mine = (j == x) ? c : mine; }
        if (sum == G) break;
        __builtin_amdgcn_s_sleep(1);
        if ((++sp & 255u) == 0u) { if (xb_ld(&bar[XB_TMO])) break; if (sp > XB_SPIN_CAP) { atomicAdd(&bar[XB_TMO], 1u); break; } }
    }
    nloc = mine > 0u ? mine : 1u; nx = cnt > 0u ? cnt : 1u;
}
__device__ __forceinline__ void xcd_barrier(const XcdBarrier& b) {
    asm volatile("s_waitcnt vmcnt(0)" ::: "memory");
    __syncthreads();
    if (threadIdx.x == 0) {
        unsigned* bar = b.bar;
        __builtin_amdgcn_s_waitcnt(0);
        unsigned nloc = b.st[0], nx = b.st[1];
        if (nloc == 0u) { xcd_barrier_complete(bar, b.x, nloc, nx); b.st[0] = nloc; b.st[1] = nx; }
        const unsigned old = xb_add(&bar[XB_XSUB(b.x)], 1u);
        const unsigned gen = old / nloc;
        if (old + 1u == (gen + 1u) * nloc) {
            __builtin_amdgcn_fence(__ATOMIC_RELEASE, "agent");
            asm volatile("s_waitcnt vmcnt(0)" ::: "memory");
            const unsigned og = xb_add(&bar[XB_TOP], 1u);
            const unsigned tg = og / nx;
            if (og + 1u == (tg + 1u) * nx) xb_add(&bar[XB_TOPGEN], 1u);
            else XB_SPIN(xb_ld(&bar[XB_TOPGEN]) == tg, bar);
            __builtin_amdgcn_fence(__ATOMIC_ACQUIRE, "agent");
            xb_add(&bar[XB_XGEN(b.x)], 1u);
            asm volatile("s_waitcnt vmcnt(0)" ::: "memory");
        } else {
            XB_SPIN(xb_ld(&bar[XB_XGEN(b.x)]) == gen, bar);
            __builtin_amdgcn_fence(__ATOMIC_ACQUIRE, "agent");
            asm volatile("s_waitcnt vmcnt(0)" ::: "memory");
        }
    }
    __syncthreads();
}

using pg8::Unit;
struct EpiIn {
    static constexpr bool PERM = false;
    bf16_t* P; float* GA; const float* cosT; const float* sinT;
    __device__ __forceinline__ void operator()(const f32x4 (&acc)[2][2][4][2], const Unit& u, int wr, int wc, int fr, int fq) const {
        const int row0 = u.pm * 256 + wr * 64 + fr; const int pn = u.pn;
        if (pn == 36) {
            if (wc == 0) {
#pragma unroll
                for (int ai = 0; ai < 2; ++ai)
#pragma unroll
                    for (int m = 0; m < 4; ++m) { const size_t row = (size_t)(row0 + ai * 128 + m * 16);
#pragma unroll
                        for (int n = 0; n < 2; ++n) *(f32x4*)(GA + row * 32 + 16 * n + 4 * fq) = acc[ai][0][m][n]; }
            }
            return;
        }
        const int colbase = pn * 256 + wc * 32 + 4 * fq;
        if (pn < 8) {
            const bool lat = u.pm < 128; const float qs = pn < 4 ? QSCALE : 1.f; const int axis = wc & 1;
#pragma unroll
            for (int ai = 0; ai < 2; ++ai)
#pragma unroll
                for (int m = 0; m < 4; ++m) { const int row = row0 + ai * 128 + m * 16; const int s = row & 4095; const int pos = axis ? (s & 63) : (s >> 6);
                    f32x4 c4 = (f32x4){1.f, 1.f, 1.f, 1.f}, s4 = (f32x4){0.f, 0.f, 0.f, 0.f};
                    if (lat) { c4 = *(const f32x4*)(cosT + pos * 16 + 4 * fq); s4 = *(const f32x4*)(sinT + pos * 16 + 4 * fq); }
                    bf16_t* rowp = P + (size_t)row * PW + colbase;
#pragma unroll
                    for (int bj = 0; bj < 2; ++bj) { const f32x4 x1 = acc[ai][bj][m][0], x2 = acc[ai][bj][m][1];
                        const f32x4 o1 = (x1 * c4 - x2 * s4) * qs, o2 = (x2 * c4 + x1 * s4) * qs;
                        u32x2 w1, w2; w1.x = pk2(o1[0], o1[1]); w1.y = pk2(o1[2], o1[3]); w2.x = pk2(o2[0], o2[1]); w2.y = pk2(o2[2], o2[3]);
                        *(u32x2*)(rowp + bj * 128) = w1; *(u32x2*)(rowp + bj * 128 + 16) = w2; } }
        } else {
            const bool sg = pn >= 24;
#pragma unroll
            for (int ai = 0; ai < 2; ++ai)
#pragma unroll
                for (int m = 0; m < 4; ++m) { const int row = row0 + ai * 128 + m * 16; bf16_t* rowp = P + (size_t)row * PW + colbase;
#pragma unroll
                    for (int bj = 0; bj < 2; ++bj)
#pragma unroll
                        for (int n = 0; n < 2; ++n) { f32x4 v = acc[ai][bj][m][n];
                            if (sg) { v[0] = sigmoidf_(v[0]); v[1] = sigmoidf_(v[1]); v[2] = sigmoidf_(v[2]); v[3] = sigmoidf_(v[3]); }
                            u32x2 w; w.x = pk2(v[0], v[1]); w.y = pk2(v[2], v[3]); *(u32x2*)(rowp + bj * 128 + 16 * n) = w; } }
        }
    }
};
template <int MODE> struct EpiGate {
    static constexpr bool PERM = false;
    const bf16_t* P; float* M32; bf16_t* MG;
    __device__ __forceinline__ void operator()(const f32x4 (&acc)[2][2][4][2], const Unit& u, int wr, int wc, int fr, int fq) const {
        const int row0 = u.pm * 256 + wr * 64 + fr, col0 = u.pn * 256 + wc * 32 + 4 * fq;
#pragma unroll
        for (int ai = 0; ai < 2; ++ai)
#pragma unroll
            for (int m = 0; m < 4; ++m) { const size_t row = (size_t)(row0 + ai * 128 + m * 16);
#pragma unroll
                for (int bj = 0; bj < 2; ++bj)
#pragma unroll
                    for (int n = 0; n < 2; ++n) { const int col = col0 + bj * 128 + 16 * n;
                        const u32x2 gw = *(const u32x2*)(P + row * PW + OGATE + MODE * 1024 + col);
                        const f32x4 s = (f32x4){bflo(gw.x), bfhi(gw.x), bflo(gw.y), bfhi(gw.y)};
                        f32x4 v = s * acc[ai][bj][m][n];
                        float* mp = M32 + row * 1024 + col;
                        if (MODE >= 1) v = v + __builtin_nontemporal_load((const f32x4*)mp);
                        if (MODE <= 1) *(f32x4*)mp = v;
                        else { u32x2 w; w.x = pk2(v[0], v[1]); w.y = pk2(v[2], v[3]); *(u32x2*)(MG + row * 1024 + col) = w; } } }
    }
};
struct EpiRes {
    static constexpr bool PERM = false;
    const float* xlat; const float* xctx; float* XW; const float* mod;
    __device__ __forceinline__ void operator()(const f32x4 (&acc)[2][2][4][2], const Unit& u, int wr, int wc, int fr, int fq) const {
        const int row0 = u.pm * 256 + wr * 64 + fr, col0 = u.pn * 256 + wc * 32 + 4 * fq;
        const int mr = u.pm < 128 ? (u.pm >> 4) : 8; const float* xin = u.pm < 128 ? xlat : xctx;
        const float* g1 = mod + (size_t)mr * 6144 + 2048;
        f32x4 gv[2][2];
#pragma unroll
        for (int bj = 0; bj < 2; ++bj)
#pragma unroll
            for (int n = 0; n < 2; ++n) gv[bj][n] = *(const f32x4*)(g1 + col0 + bj * 128 + 16 * n);
#pragma unroll
        for (int ai = 0; ai < 2; ++ai)
#pragma unroll
            for (int m = 0; m < 4; ++m) { const size_t off = (size_t)(row0 + ai * 128 + m * 16) * 1024 + col0;
#pragma unroll
                for (int bj = 0; bj < 2; ++bj)
#pragma unroll
                    for (int n = 0; n < 2; ++n) { const f32x4 xi = *(const f32x4*)(xin + off + bj * 128 + 16 * n);
                        *(f32x4*)(XW + off + bj * 128 + 16 * n) = xi + gv[bj][n] * acc[ai][bj][m][n]; } }
    }
};
struct EpiSwiglu {
    static constexpr bool PERM = true;
    bf16_t* HH; const float* b1;
    __device__ __forceinline__ void operator()(const f32x4 (&acc)[2][2][4][2], const Unit& u, int wr, int wc, int fr, int fq) const {
        const int row0 = u.pm * 256 + wr * 64 + fr, c0 = u.pn * 256 + wc * 32 + 8 * fq; const int e = u.pb >> 3;
        const float* bp = b1 + (size_t)e * 2048 + c0;
        f32x4 bv[2][2];
#pragma unroll
        for (int bj = 0; bj < 2; ++bj)
#pragma unroll
            for (int n = 0; n < 2; ++n) bv[bj][n] = *(const f32x4*)(bp + bj * 128 + 4 * n);
#pragma unroll
        for (int ai = 0; ai < 2; ++ai)
#pragma unroll
            for (int m = 0; m < 4; ++m) { bf16_t* rowp = HH + (size_t)(row0 + ai * 128 + m * 16) * 1024 + (c0 >> 1);
#pragma unroll
                for (int bj = 0; bj < 2; ++bj) { const f32x4 v0 = acc[ai][bj][m][0] + bv[bj][0], v1 = acc[ai][bj][m][1] + bv[bj][1];
                    float o[4];
#pragma unroll
                    for (int p = 0; p < 4; ++p) { float gl = p < 2 ? v0[2 * p] : v1[2 * p - 4], ln = p < 2 ? v0[2 * p + 1] : v1[2 * p - 3];
                        gl = fminf(gl, 7.f); ln = fminf(fmaxf(ln, -7.f), 7.f); o[p] = gl * sigmoidf_(1.702f * gl) * (ln + 1.f); }
                    u32x2 w; w.x = pk2(o[0], o[1]); w.y = pk2(o[2], o[3]); *(u32x2*)(rowp + bj * 64) = w; } }
    }
};
struct EpiY {
    static constexpr bool PERM = true;
    bf16_t* YY; const float* b2;
    __device__ __forceinline__ void operator()(const f32x4 (&acc)[2][2][4][2], const Unit& u, int wr, int wc, int fr, int fq) const {
        const int row0 = u.pm * 256 + wr * 64 + fr, c0 = u.pn * 256 + wc * 32 + 8 * fq; const int e = u.pb >> 2;
        const float* bp = b2 + (size_t)e * 1024 + c0;
        f32x4 bv[2][2];
#pragma unroll
        for (int bj = 0; bj < 2; ++bj)
#pragma unroll
            for (int n = 0; n < 2; ++n) bv[bj][n] = *(const f32x4*)(bp + bj * 128 + 4 * n);
#pragma unroll
        for (int ai = 0; ai < 2; ++ai)
#pragma unroll
            for (int m = 0; m < 4; ++m) { bf16_t* rowp = YY + (size_t)(row0 + ai * 128 + m * 16) * 1024 + c0;
#pragma unroll
                for (int bj = 0; bj < 2; ++bj) { const f32x4 v0 = acc[ai][bj][m][0] + bv[bj][0], v1 = acc[ai][bj][m][1] + bv[bj][1];
                    u32x4 w; w.x = pk2(v0[0], v0[1]); w.y = pk2(v0[2], v0[3]); w.z = pk2(v1[0], v1[1]); w.w = pk2(v1[2], v1[3]);
                    *(u32x4*)(rowp + bj * 128) = w; } }
    }
};
struct MoeOrder {
    int ntiles, nN, G, c; const int* tile_exp;
    __device__ __forceinline__ bool next(int i, Unit& u) const {
        const long L = (long)i * G + c; if (L >= (long)ntiles * nN) return false;
        const int tile = (int)(L / nN), pn = (int)(L % nN);
        u.pm = tile; u.pn = pn; u.pb = __builtin_amdgcn_readfirstlane(__builtin_nontemporal_load(tile_exp + tile)) * nN + pn; return true;
    }
    __device__ __forceinline__ void a_ready(const Unit&) const {}
    __device__ __forceinline__ void done(const Unit&) const {}
};
struct Args { const float* in[26]; float* out; unsigned char* ws; int ph_lo, ph_hi; };
struct Frame {
    LAS unsigned char* lds; unsigned char* ws; int tid, lane, wave, G, gw, NGW;
};
constexpr int PTR_OFF = 147456 - 1024 + 256;
__device__ __forceinline__ const float* in_ptr(const Frame& F, int i) {
    const unsigned long long v = ((volatile LAS unsigned long long*)(F.lds + PTR_OFF))[i];
    const unsigned lo = __builtin_amdgcn_readfirstlane((unsigned)v), hi = __builtin_amdgcn_readfirstlane((unsigned)(v >> 32));
    return (const float*)(((unsigned long long)hi << 32) | lo);
}
__device__ __forceinline__ float* out_ptr(const Frame& F) { return (float*)in_ptr(F, 26); }
__device__ __forceinline__ Frame relaunder(const Frame& F0) {
    Frame F = F0; int t = threadIdx.x; asm volatile("" : "+v"(t));
    F.tid = t; F.lane = t & 63; F.wave = __builtin_amdgcn_readfirstlane(t >> 6); F.gw = blockIdx.x * NWAVES + F.wave; return F;
}

__device__ __forceinline__ void transpose_item(const float* W, int srcN, bf16_t* WT, int dstK, int k0, int n0, int drow0, int dk0, LAS float* scr, int lane) {
#pragma unroll 8
    for (int i = 0; i < 32; ++i) { const int kk = 2 * i + (lane >> 5); scr[kk * 33 + (lane & 31)] = W[(size_t)(k0 + kk) * srcN + n0 + (lane & 31)]; }
    LDS_WAIT(); asm volatile("" ::: "memory");
    const int c = lane & 7;
#pragma unroll
    for (int j = 0; j < 4; ++j) { const int n = (lane >> 3) + 8 * j; const LAS float* s = scr + (8 * c) * 33 + n;
        u32x4 o; o.x = pk2(s[0 * 33], s[1 * 33]); o.y = pk2(s[2 * 33], s[3 * 33]); o.z = pk2(s[4 * 33], s[5 * 33]); o.w = pk2(s[6 * 33], s[7 * 33]);
        *(u32x4*)(WT + (size_t)(drow0 + n0 + n) * dstK + dk0 + 8 * c) = o; }
    LDS_WAIT(); asm volatile("" ::: "memory");
}

__device__ __forceinline__ void p0_prologue(const Frame& F0) {
    const Frame F = relaunder(F0);
    unsigned char* ws = F.ws;
    {
        LAS float* sc = (LAS float*)F.lds;
        LAS float* red = sc + 9 * 1024;
        for (int i = F.tid; i < 9 * 1024; i += NTHR) { const float c = i < 8192 ? in_ptr(F, 1)[i] : in_ptr(F, 3)[i - 8192]; sc[i] = c / (1.f + __expf(-c)); }
        __syncthreads();
        float* MOD = (float*)(ws + WS_MOD);
        for (int job = blockIdx.x; job < 192; job += F.G) {
            const int l = job / 96, blk = job % 96, ks = F.tid >> 6, n = F.tid & 63, col = blk * 64 + n;
            const float* w = in_ptr(F, 4) + (size_t)l * 1024 * 6144 + col;
            float a[9];
#pragma unroll
            for (int r = 0; r < 9; ++r) a[r] = 0.f;
            for (int k = ks * 128; k < ks * 128 + 128; ++k) { const float wv = w[(size_t)k * 6144];
#pragma unroll
                for (int r = 0; r < 9; ++r) a[r] += sc[r * 1024 + k] * wv; }
#pragma unroll
            for (int r = 0; r < 9; ++r) red[(ks * 9 + r) * 64 + n] = a[r];
            __syncthreads();
            for (int o = F.tid; o < 576; o += NTHR) { const int r = o >> 6, nn = o & 63; float s = 0.f;
#pragma unroll
                for (int k8 = 0; k8 < 8; ++k8) s += red[(k8 * 9 + r) * 64 + nn];
                MOD[((size_t)l * 9 + r) * 6144 + blk * 64 + nn] = s + in_ptr(F, 5)[(size_t)l * 6144 + blk * 64 + nn]; }
            __syncthreads();
        }
    }
    if (blockIdx.x == 0) {
        float* cosT = (float*)(ws + WS_ROPE); float* sinT = cosT + 1024;
        for (int i = F.tid; i < 1024; i += NTHR) { const int pos = i >> 4, f = i & 15; const float inv = powf(10000.f, -(float)(2 * f) / 32.f); const float ang = (float)pos * inv; cosT[i] = cosf(ang); sinT[i] = sinf(ang); }
        if (F.wave < 2) { const int l = F.wave; const float* dl = in_ptr(F, 9) + (size_t)l * 256;
            const float s1 = wave_sum(dl[F.lane] * dl[64 + F.lane]), s2 = wave_sum(dl[128 + F.lane] * dl[192 + F.lane]);
            const float lam_init = 0.8f - 0.6f * expf(-0.3f * (float)l);
            if (F.lane == 0) ((float*)(ws + WS_LAM))[l] = expf(s1) - expf(s2) + lam_init; }
    }
    __syncthreads();
    LAS float* scr = (LAS float*)(F.lds + F.wave * 16384);
    constexpr int I_IN = 16 * 289, I_D = 512, I_C = 256, I_G = 256, I_O = 512, I_1 = 32 * 1024, I_2 = 32 * 512;
    constexpr int PER_L = I_IN + I_D + I_C + I_G + I_O + I_1 + I_2;
    for (int it = F.gw; it < 2 * PER_L; it += F.NGW) {
        const int l = it / PER_L; int r = it % PER_L;
        if (r < I_IN) { const int kb = r / 289, nb = r % 289, n0 = nb * 32; const int d0 = n0 < 6144 ? n0 : (n0 < 6176 ? 9216 + (n0 - 6144) : n0 - 32);
            transpose_item(in_ptr(F, 8) + (size_t)l * 1024 * 9248, 9248, (bf16_t*)(ws + WS_WIN + l * WIN_STRIDE), 1024, kb * 64, n0, d0 - n0, kb * 64, scr, F.lane); continue; } r -= I_IN;
        if (r < I_D) { const int kb = r / 32, nb = r % 32; transpose_item(in_ptr(F, 11) + (size_t)l * 1024 * 1024, 1024, (bf16_t*)(ws + WS_WD + l * W1K_STRIDE), 1024, kb * 64, nb * 32, 0, kb * 64, scr, F.lane); continue; } r -= I_D;
        if (r < I_C) { const int kb = r / 32, nb = r % 32; transpose_item(in_ptr(F, 13) + (size_t)l * 512 * 1024, 1024, (bf16_t*)(ws + WS_WCG + l * W1K_STRIDE), 1024, kb * 64, nb * 32, 0, kb * 64, scr, F.lane); continue; } r -= I_C;
        if (r < I_G) { const int kb = r / 32, nb = r % 32; transpose_item(in_ptr(F, 17) + (size_t)l * 512 * 1024, 1024, (bf16_t*)(ws + WS_WCG + l * W1K_STRIDE), 1024, kb * 64, nb * 32, 0, 512 + kb * 64, scr, F.lane); continue; } r -= I_G;
        if (r < I_O) { const int kb = r / 32, nb = r % 32; transpose_item(in_ptr(F, 18) + (size_t)l * 1024 * 1024, 1024, (bf16_t*)(ws + WS_WO + l * W1K_STRIDE), 1024, kb * 64, nb * 32, 0, kb * 64, scr, F.lane); continue; } r -= I_O;
        if (r < I_1) { const int e = r / 1024, q = r % 1024, kb = q / 64, nb = q % 64;
            transpose_item(in_ptr(F, 21) + ((size_t)l * 32 + e) * 1024 * 2048, 2048, (bf16_t*)(ws + WS_W1 + l * W1_STRIDE) + (size_t)e * 2048 * 1024, 1024, kb * 64, nb * 32, 0, kb * 64, scr, F.lane); continue; } r -= I_1;
        { const int e = r / 512, q = r % 512, kb = q / 32, nb = q % 32;
            transpose_item(in_ptr(F, 23) + ((size_t)l * 32 + e) * 1024 * 1024, 1024, (bf16_t*)(ws + WS_W2 + l * W2_STRIDE) + (size_t)e * 1024 * 1024, 1024, kb * 64, nb * 32, 0, kb * 64, scr, F.lane); }
    }
    for (int i = F.gw * 64 + F.lane; i < 2 * 224 * 128; i += F.NGW * 64) { const int l = i / (224 * 128), q = i % (224 * 128);
        *(u32x4*)(ws + WS_WIN + l * WIN_STRIDE + (size_t)9248 * 2048 + (size_t)q * 16) = (u32x4){0u, 0u, 0u, 0u}; }
}

__device__ __forceinline__ void load_row(const float* p, int lane, f32x4 (&v)[4]) {
#pragma unroll
    for (int j = 0; j < 4; ++j) v[j] = *(const f32x4*)(p + 256 * j + 4 * lane);
}
__device__ __forceinline__ float row_rstd(const f32x4 (&v)[4]) {
    float s = 0.f;
#pragma unroll
    for (int j = 0; j < 4; ++j) s += (v[j][0] * v[j][0] + v[j][1] * v[j][1]) + (v[j][2] * v[j][2] + v[j][3] * v[j][3]);
    return 1.0f / sqrtf(wave_sum(s) * (1.f / 1024.f) + RMS_EPS);
}
__device__ __forceinline__ void norm_mod(f32x4 (&v)[4], const float* g, const float* shift, const float* scale, int lane) {
    const float rstd = row_rstd(v);
#pragma unroll
    for (int j = 0; j < 4; ++j) { const f32x4 gv = *(const f32x4*)(g + 256 * j + 4 * lane), sh = *(const f32x4*)(shift + 256 * j + 4 * lane), sc = *(const f32x4*)(scale + 256 * j + 4 * lane);
        v[j] = (v[j] * rstd * gv) * (sc + 1.f) + sh; }
}
__device__ __forceinline__ void store_row_bf16(bf16_t* p, int lane, const f32x4 (&v)[4]) {
#pragma unroll
    for (int j = 0; j < 4; ++j) { u32x2 w; w.x = pk2(v[j][0], v[j][1]); w.y = pk2(v[j][2], v[j][3]); *(u32x2*)(p + 256 * j + 4 * lane) = w; }
}

__device__ __forceinline__ void p_norm1_l0(const Frame& F0) {
    const Frame F = relaunder(F0);
    const float* MOD = (const float*)(F.ws + WS_MOD); bf16_t* H = (bf16_t*)(F.ws + WS_H);
    for (int row = F.gw; row < TT; row += F.NGW) {
        const float* xin = row < TL ? in_ptr(F, 0) + (size_t)row * 1024 : in_ptr(F, 2) + (size_t)(row - TL) * 1024;
        const int mr = row < TL ? (row >> 12) : 8;
        f32x4 v[4]; load_row(xin, F.lane, v);
        norm_mod(v, in_ptr(F, 6), MOD + (size_t)mr * 6144, MOD + (size_t)mr * 6144 + 1024, F.lane);
        store_row_bf16(H + (size_t)row * 1024, F.lane, v);
    }
}

__device__ __forceinline__ void p_conv(const Frame& F0, const float* cw  ) {
    const Frame F = relaunder(F0);
    const bf16_t* P = (const bf16_t*)(F.ws + WS_P); bf16_t* ACG = (bf16_t*)(F.ws + WS_ACG);
    const int gt = F.gw * 64 + F.lane, NGT = F.NGW * 64;
    for (int it = gt; it < TT * 64; it += NGT) {
        const int row = it >> 6, c0 = (it & 63) * 8;
        bool hp, hn;
        if (row < TL) { const int s = row & 4095; hp = s > 0; hn = s < 4095; } else { const int s = (row - TL) & 255; hp = s > 0; hn = s < 255; }
        const bf16_t* pr = P + (size_t)row * PW;
        const u32x4 gb = *(const u32x4*)(pr + OCB + c0);
        const u32x4 c1 = *(const u32x4*)(pr + OCC + c0), x1 = *(const u32x4*)(pr + OCX + c0);
        u32x4 c0v = (u32x4){0u, 0u, 0u, 0u}, x0v = c0v, c2v = c0v, x2v = c0v;
        if (hp) { c0v = *(const u32x4*)(pr - PW + OCC + c0); x0v = *(const u32x4*)(pr - PW + OCX + c0); }
        if (hn) { c2v = *(const u32x4*)(pr + PW + OCC + c0); x2v = *(const u32x4*)(pr + PW + OCX + c0); }
        float o[8];
#pragma unroll
        for (int q = 0; q < 4; ++q) {
#pragma unroll
            for (int hh = 0; hh < 2; ++hh) { const int ch = c0 + 2 * q + hh;
                const float b = hh ? bfhi(gb[q]) : bflo(gb[q]);
                const float u0 = (hh ? bfhi(c0v[q]) : bflo(c0v[q])) * (hh ? bfhi(x0v[q]) : bflo(x0v[q]));
                const float u1 = (hh ? bfhi(c1[q]) : bflo(c1[q])) * (hh ? bfhi(x1[q]) : bflo(x1[q]));
                const float u2 = (hh ? bfhi(c2v[q]) : bflo(c2v[q])) * (hh ? bfhi(x2v[q]) : bflo(x2v[q]));
                o[2 * q + hh] = b * (cw[ch] * u0 + cw[512 + ch] * u1 + cw[1024 + ch] * u2); } }
        u32x4 w; w.x = pk2(o[0], o[1]); w.y = pk2(o[2], o[3]); w.z = pk2(o[4], o[5]); w.w = pk2(o[6], o[7]);
        *(u32x4*)(ACG + (size_t)row * 1024 + c0) = w;
    }
}
__device__ __forceinline__ int gla_row(int step, int b, int dir) {
    if (dir == 0) return step < 256 ? TL + b * 256 + step : b * 4096 + (step - 256);
    return step < 256 ? TL + b * 256 + (255 - step) : b * 4096 + (4095 - (step - 256));
}
__device__ __forceinline__ void p_gla_chain(const Frame& F0, const float* wa2  , const float* ba  , int chain) {
    const Frame F = relaunder(F0);
    const bf16_t* P = (const bf16_t*)(F.ws + WS_P); const float* GA = (const float*)(F.ws + WS_GA); float* OG = (float*)(F.ws + WS_OG);
    const int b = chain >> 3, h = (chain >> 1) & 3, dir = chain & 1;
    LAS float* Wa = (LAS float*)F.lds;
    LAS float* bav = Wa + 1024;
    LAS float* qs = bav + 64;
    LAS float* ks = qs + 1024;
    LAS float* egs = ks + 1024;
    LAS float* vs = egs + 1024;
    LAS float* po = vs + 2048;
    const int tid = F.tid, dkg = tid >> 7, dv = tid & 127;
    __syncthreads();
    for (int i = tid; i < 1024; i += NTHR) { const int r = i >> 6, dk = i & 63; Wa[i] = wa2[(size_t)(dir * 16 + r) * 256 + h * 64 + dk]; }
    if (tid < 64) bav[tid] = ba[dir * 256 + h * 64 + tid];
    float S[16];
#pragma unroll
    for (int i = 0; i < 16; ++i) S[i] = 0.f;
    for (int blk = 0; blk < 272; ++blk) {
        __syncthreads();
        for (int e = tid; e < 1024; e += NTHR) { const int tk = e >> 6, dk = e & 63; const int row = gla_row(blk * 16 + tk, b, dir);
            qs[e] = bf2f(P[(size_t)row * PW + OGQ + h * 64 + dk]);
            ks[e] = bf2f(P[(size_t)row * PW + OGK + h * 64 + dk]);
            float z = bav[dk]; const float* ga = GA + (size_t)row * 32 + dir * 16;
#pragma unroll
            for (int r = 0; r < 16; ++r) z += ga[r] * Wa[r * 64 + dk];
            const float ls = fminf(z, 0.f) - log1pf(__expf(-fabsf(z)));
            egs[e] = __expf(ls * (1.f / 16.f)); }
        for (int e = tid; e < 2048; e += NTHR) { const int tk = e >> 7, d = e & 127; const int row = gla_row(blk * 16 + tk, b, dir);
            vs[e] = bf2f(P[(size_t)row * PW + OGV + h * 128 + d]); }
        __syncthreads();
#pragma unroll 1
        for (int tk = 0; tk < 16; ++tk) {
            const float vv = vs[tk * 128 + dv]; float pacc = 0.f;
#pragma unroll
            for (int i = 0; i < 16; ++i) { const int dk = dkg * 16 + i; S[i] = egs[tk * 64 + dk] * S[i] + ks[tk * 64 + dk] * vv; pacc += qs[tk * 64 + dk] * S[i]; }
            po[(tk * 4 + dkg) * 128 + dv] = pacc;
        }
        __syncthreads();
        for (int e = tid; e < 2048; e += NTHR) { const int tk = e >> 7, d = e & 127; const int row = gla_row(blk * 16 + tk, b, dir);
            const float o = (po[(tk * 4 + 0) * 128 + d] + po[(tk * 4 + 1) * 128 + d]) + (po[(tk * 4 + 2) * 128 + d] + po[(tk * 4 + 3) * 128 + d]);
            OG[((size_t)dir * TT + row) * 512 + h * 128 + d] = o * 0.125f; }
    }
    __syncthreads();
}

__device__ __forceinline__ void p_attn_naive(const Frame& F0, int layer, const float* subg  ) {
    const Frame F = relaunder(F0);
    const bf16_t* P = (const bf16_t*)(F.ws + WS_P); bf16_t* AD = (bf16_t*)(F.ws + WS_AD);
    float* scr = (float*)(F.ws + WS_ASCR) + (size_t)blockIdx.x * 64 * 512;
    const float lam = __builtin_nontemporal_load((const float*)(F.ws + WS_LAM) + layer);
    const float lam_init = 0.8f - 0.6f * expf(-0.3f * (float)layer);
    LAS float* Ks = (LAS float*)F.lds;
    LAS float* Vs = Ks + 4096;
    LAS float* red = Vs + 8192;
    const int tid = F.tid, qr = tid & 255, half = tid >> 8;
    const int nunits = layer == 0 ? 1024 + 64 : 1024;
    for (int u = blockIdx.x; u < nunits; u += F.G) {
        const bool lat = u < 1024;
        int b, h, qrow0, ntiles;
        if (lat) { b = u >> 7; h = (u >> 4) & 7; qrow0 = b * 4096 + (u & 15) * 256; ntiles = 68; }
        else { const int v = u - 1024; b = v >> 3; h = v & 7; qrow0 = TL + b * 256; ntiles = 4; }
        const int qrow = qrow0 + qr;
        float O[64];
#pragma unroll 1
        for (int map = 1; map >= 0; --map) {
            float q[64];
            { const bf16_t* qp = P + (size_t)qrow * PW + OQ + h * 128 + map * 64;
#pragma unroll
              for (int c = 0; c < 8; ++c) { const u32x4 w = *(const u32x4*)(qp + 8 * c);
#pragma unroll
                  for (int e = 0; e < 4; ++e) { q[8 * c + 2 * e] = bflo(w[e]); q[8 * c + 2 * e + 1] = bfhi(w[e]); } asm volatile("" ::: "memory"); } }
            float mx = -1e30f, l = 0.f;
#pragma unroll
            for (int i = 0; i < 64; ++i) O[i] = 0.f;
#pragma unroll 1
            for (int t = 0; t < ntiles; ++t) {
                const int krow0 = (lat && t < 64) ? b * 4096 + t * 64 : TL + b * 256 + (t - (lat ? 64 : 0)) * 64;
                __syncthreads();
                { const int key = tid >> 3, ch = tid & 7; const u32x4 w = *(const u32x4*)(P + (size_t)(krow0 + key) * PW + OKK + h * 128 + map * 64 + ch * 8);
                  *(LAS f32x4*)(Ks + key * 64 + ch * 8) = (f32x4){bflo(w.x), bfhi(w.x), bflo(w.y), bfhi(w.y)};
                  *(LAS f32x4*)(Ks + key * 64 + ch * 8 + 4) = (f32x4){bflo(w.z), bfhi(w.z), bflo(w.w), bfhi(w.w)}; }
#pragma unroll
                for (int i2 = 0; i2 < 2; ++i2) { const int e = tid + i2 * 512, key = e >> 4, ch = e & 15; const u32x4 w = *(const u32x4*)(P + (size_t)(krow0 + key) * PW + OV + h * 128 + ch * 8);
                  *(LAS f32x4*)(Vs + key * 128 + ch * 8) = (f32x4){bflo(w.x), bfhi(w.x), bflo(w.y), bfhi(w.y)};
                  *(LAS f32x4*)(Vs + key * 128 + ch * 8 + 4) = (f32x4){bflo(w.z), bfhi(w.z), bflo(w.w), bfhi(w.w)}; }
                __syncthreads();
#pragma unroll 1
                for (int key = 0; key < 64; ++key) {
                    float s = 0.f;
#pragma unroll
                    for (int c = 0; c < 16; ++c) { const f32x4 kv = *(const LAS f32x4*)(Ks + key * 64 + 4 * c); s += (q[4 * c] * kv[0] + q[4 * c + 1] * kv[1]) + (q[4 * c + 2] * kv[2] + q[4 * c + 3] * kv[3]);
                        if ((c & 3) == 3) asm volatile("" ::: "memory"); }
                    const float mn = fmaxf(mx, s); const float alpha = __builtin_amdgcn_exp2f(mx - mn), p = __builtin_amdgcn_exp2f(s - mn);
                    l = l * alpha + p; mx = mn;
#pragma unroll
                    for (int c = 0; c < 16; ++c) { const f32x4 vv = *(const LAS f32x4*)(Vs + key * 128 + half * 64 + 4 * c);
                        O[4 * c] = O[4 * c] * alpha + p * vv[0]; O[4 * c + 1] = O[4 * c + 1] * alpha + p * vv[1]; O[4 * c + 2] = O[4 * c + 2] * alpha + p * vv[2]; O[4 * c + 3] = O[4 * c + 3] * alpha + p * vv[3];
                        if ((c & 3) == 3) asm volatile("" ::: "memory"); }
                }
            }
            const float inv = 1.f / l;
            if (map == 1) {
#pragma unroll
                for (int i = 0; i < 16; ++i) { *(f32x4*)(scr + tid * 64 + 4 * i) = (f32x4){O[4 * i] * inv, O[4 * i + 1] * inv, O[4 * i + 2] * inv, O[4 * i + 3] * inv}; if ((i & 3) == 3) asm volatile("" ::: "memory"); }
            } else {
#pragma unroll
                for (int i = 0; i < 16; ++i) { const f32x4 t = __builtin_nontemporal_load((const f32x4*)(scr + tid * 64 + 4 * i));
                    O[4 * i] = O[4 * i] * inv - lam * t[0]; O[4 * i + 1] = O[4 * i + 1] * inv - lam * t[1]; O[4 * i + 2] = O[4 * i + 2] * inv - lam * t[2]; O[4 * i + 3] = O[4 * i + 3] * inv - lam * t[3];
                    if ((i & 3) == 3) asm volatile("" ::: "memory"); }
            }
        }
        float ss = 0.f;
#pragma unroll
        for (int i = 0; i < 64; ++i) ss += O[i] * O[i];
        __syncthreads();
        red[tid] = ss;
        __syncthreads();
        const float tot = red[qr] + red[qr + 256];
        const float r = (1.f - lam_init) / sqrtf(tot * (1.f / 128.f) + RMS_EPS);
        bf16_t* op = AD + (size_t)qrow * 1024 + h * 128 + half * 64;
#pragma unroll
        for (int c = 0; c < 8; ++c) { u32x4 w;
            w.x = pk2(O[8 * c] * r * subg[half * 64 + 8 * c], O[8 * c + 1] * r * subg[half * 64 + 8 * c + 1]);
            w.y = pk2(O[8 * c + 2] * r * subg[half * 64 + 8 * c + 2], O[8 * c + 3] * r * subg[half * 64 + 8 * c + 3]);
            w.z = pk2(O[8 * c + 4] * r * subg[half * 64 + 8 * c + 4], O[8 * c + 5] * r * subg[half * 64 + 8 * c + 5]);
            w.w = pk2(O[8 * c + 6] * r * subg[half * 64 + 8 * c + 6], O[8 * c + 7] * r * subg[half * 64 + 8 * c + 7]);
            *(u32x4*)(op + 8 * c) = w; asm volatile("" ::: "memory"); }
    }
    __syncthreads();
}

__device__ __forceinline__ void p_gla_tail(const Frame& F0, const float* gng  , int nrows) {
    const Frame F = relaunder(F0);
    const bf16_t* P = (const bf16_t*)(F.ws + WS_P); const float* OG = (const float*)(F.ws + WS_OG); bf16_t* ACG = (bf16_t*)(F.ws + WS_ACG);
    for (int row = F.gw; row < nrows; row += F.NGW) {
        const int c0 = F.lane * 8;
        const float* o0 = OG + (size_t)row * 512 + c0; const float* o1 = OG + ((size_t)TT + row) * 512 + c0;
        f32x4 a = *(const f32x4*)o0 + *(const f32x4*)o1, b = *(const f32x4*)(o0 + 4) + *(const f32x4*)(o1 + 4);
        float ss = (a[0] * a[0] + a[1] * a[1]) + (a[2] * a[2] + a[3] * a[3]) + (b[0] * b[0] + b[1] * b[1]) + (b[2] * b[2] + b[3] * b[3]);
        ss += __shfl_xor(ss, 1); ss += __shfl_xor(ss, 2); ss += __shfl_xor(ss, 4); ss += __shfl_xor(ss, 8);
        const float rstd = 1.f / sqrtf(ss * (1.f / 128.f) + RMS_EPS);
        const f32x4 g0 = *(const f32x4*)(gng + (c0 & 127)), g1 = *(const f32x4*)(gng + (c0 & 127) + 4);
        const u32x4 rw = *(const u32x4*)(P + (size_t)row * PW + OGR + c0);
        float rr[8] = {bflo(rw.x), bfhi(rw.x), bflo(rw.y), bfhi(rw.y), bflo(rw.z), bfhi(rw.z), bflo(rw.w), bfhi(rw.w)};
        float o[8];
#pragma unroll
        for (int i = 0; i < 4; ++i) { const float y0 = a[i] * rstd * g0[i], y1 = b[i] * rstd * g1[i];
            o[i] = y0 * (rr[i] * sigmoidf_(rr[i])); o[4 + i] = y1 * (rr[4 + i] * sigmoidf_(rr[4 + i])); }
        u32x4 w; w.x = pk2(o[0], o[1]); w.y = pk2(o[2], o[3]); w.z = pk2(o[4], o[5]); w.w = pk2(o[6], o[7]);
        *(u32x4*)(ACG + (size_t)row * 1024 + 512 + c0) = w;
    }
}

__device__ __forceinline__ void p_norm2_router(const Frame& F0, int layer, int Tm) {
    const Frame F = relaunder(F0);
    const float* MOD = (const float*)(F.ws + WS_MOD) + (size_t)layer * 9 * 6144; bf16_t* H = (bf16_t*)(F.ws + WS_H); const float* XW = (const float*)(F.ws + WS_XW);
    unsigned char* rt = F.ws + WS_ROUTE + layer * ROUTE_STRIDE;
    int* TOPI = (int*)(rt + R_TOPI); float* TOPG = (float*)(rt + R_TOPG); int* CNT = (int*)(rt + R_CNT);
    const float* rw = in_ptr(F, 19) + (size_t)layer * 1024 * 32; const float* rb = in_ptr(F, 20) + layer * 32; const float* g2n = in_ptr(F, 7) + layer * 1024;
    LAS float* WT = (LAS float*)F.lds;
    LAS float* lg = (LAS float*)(F.lds + 132096) + F.wave * 32;
    LAS float* selv = (LAS float*)(F.lds + 132096 + 1024) + F.wave * 8;
    LAS int* hist = (LAS int*)(F.lds + 132096 + 2048);
    __syncthreads();
    for (int i = F.tid; i < 32768; i += NTHR) { const int k = i >> 5, e = i & 31; WT[e * 1028 + k] = rw[i]; }
    if (F.tid < 32) hist[F.tid] = 0;
    __syncthreads();
    const int RPW = Tm / F.G;
    for (int ri = F.wave; ri < RPW; ri += NWAVES) {
        const int row = blockIdx.x * RPW + ri; const int mr = row < TL ? (row >> 12) : 8;
        f32x4 v[4]; load_row(XW + (size_t)row * 1024, F.lane, v);
        norm_mod(v, g2n, MOD + (size_t)mr * 6144 + 3072, MOD + (size_t)mr * 6144 + 4096, F.lane);
        store_row_bf16(H + (size_t)row * 1024, F.lane, v);
        float p[32];
#pragma unroll
        for (int e = 0; e < 32; ++e) { float s = 0.f;
#pragma unroll
            for (int j = 0; j < 4; ++j) { const f32x4 w = *(const LAS f32x4*)(WT + e * 1028 + 256 * j + 4 * F.lane); s += (v[j][0] * w[0] + v[j][1] * w[1]) + (v[j][2] * w[2] + v[j][3] * w[3]); }
            p[e] = s; }
#pragma unroll
        for (int i = 0; i < 16; ++i) { const bool up = (F.lane & 32) != 0; const float send = up ? p[i] : p[i + 16], keep = up ? p[i + 16] : p[i]; p[i] = keep + __shfl_xor(send, 32); }
#pragma unroll
        for (int i = 0; i < 8; ++i) { const bool up = (F.lane & 16) != 0; const float send = up ? p[i] : p[i + 8], keep = up ? p[i + 8] : p[i]; p[i] = keep + __shfl_xor(send, 16); }
#pragma unroll
        for (int i = 0; i < 4; ++i) { const bool up = (F.lane & 8) != 0; const float send = up ? p[i] : p[i + 4], keep = up ? p[i + 4] : p[i]; p[i] = keep + __shfl_xor(send, 8); }
#pragma unroll
        for (int i = 0; i < 2; ++i) { const bool up = (F.lane & 4) != 0; const float send = up ? p[i] : p[i + 2], keep = up ? p[i + 2] : p[i]; p[i] = keep + __shfl_xor(send, 4); }
        { const bool up = (F.lane & 2) != 0; const float send = up ? p[0] : p[1], keep = up ? p[1] : p[0]; p[0] = keep + __shfl_xor(send, 2); }
        const int ex = F.lane >> 1;
        const float logit = p[0] + __shfl_xor(p[0], 1) + rb[ex];
        if ((F.lane & 1) == 0) lg[ex] = logit;
        LDS_WAIT(); asm volatile("" ::: "memory");
        int rank = 0;
#pragma unroll
        for (int e = 0; e < 32; ++e) { const float o = lg[e]; rank += (o > logit || (o == logit && e < ex)) ? 1 : 0; }
        if ((F.lane & 1) == 0 && rank < 4) { selv[rank * 2] = logit; selv[rank * 2 + 1] = __builtin_bit_cast(float, ex); }
        LDS_WAIT(); asm volatile("" ::: "memory");
        const float v0 = selv[0], v1 = selv[2], v2 = selv[4], v3 = selv[6];
        const float e0 = 1.f, e1 = __expf(v1 - v0), e2 = __expf(v2 - v0), e3 = __expf(v3 - v0); const float inv = 1.f / (e0 + e1 + e2 + e3);
        if (F.lane < 4) { const int ej = __builtin_bit_cast(int, selv[F.lane * 2 + 1]); const float gj = (F.lane == 0 ? e0 : F.lane == 1 ? e1 : F.lane == 2 ? e2 : e3) * inv;
            TOPI[(size_t)row * 4 + F.lane] = ej; TOPG[(size_t)row * 4 + F.lane] = gj; __hip_atomic_fetch_add(hist + ej, 1, __ATOMIC_RELAXED, __HIP_MEMORY_SCOPE_WORKGROUP); }
        LDS_WAIT(); asm volatile("" ::: "memory");
    }
    __syncthreads();
    if (F.tid < 32) CNT[blockIdx.x * 32 + F.tid] = hist[F.tid];
}

__device__ __forceinline__ void p_route_gather(const Frame& F0, int layer, int Tm) {
    const Frame F = relaunder(F0);
    unsigned char* rt = F.ws + WS_ROUTE + layer * ROUTE_STRIDE;
    const int* TOPI = (const int*)(rt + R_TOPI); int* POSOF = (int*)(rt + R_POSOF); int* ROWTOK = (int*)(rt + R_ROWTOK); const int* CNT = (const int*)(rt + R_CNT);
    int* TILEEXP = (int*)(rt + R_TILEEXP); int* NT = (int*)(rt + R_NT);
    const bf16_t* H = (const bf16_t*)(F.ws + WS_H); bf16_t* XS = (bf16_t*)(F.ws + WS_XS);
    LAS int* tot = (LAS int*)F.lds;
    LAS int* mine = tot + 32;
    LAS int* pst = mine + 32;
    LAS int* es = pst + 64;
    LAS int* ps = es + 1024;
    const int RPW = Tm / F.G, NP = RPW * 4;
    __syncthreads();
    if (F.tid < 32) { int t = 0, m = 0; for (int w = 0; w < F.G; ++w) { const int c = __builtin_nontemporal_load(CNT + w * 32 + F.tid); t += c; if (w < (int)blockIdx.x) m += c; } tot[F.tid] = t; mine[F.tid] = m; }
    for (int i = F.tid; i < NP; i += NTHR) es[i] = __builtin_nontemporal_load(TOPI + (size_t)blockIdx.x * NP + i);
    __syncthreads();
    if (F.tid == 0) { int s = 0; for (int e = 0; e < 32; ++e) { pst[e] = s; s += (tot[e] + 255) & ~255; } pst[32] = s; }
    __syncthreads();
    for (int i = F.tid; i < NP; i += NTHR) { const int e = es[i]; int r = 0; for (int j = 0; j < i; ++j) r += (es[j] == e) ? 1 : 0;
        const int pos = pst[e] + mine[e] + r; ps[i] = pos; const int tok = blockIdx.x * RPW + (i >> 2);
        ROWTOK[pos] = tok; POSOF[(size_t)tok * 4 + (i & 3)] = pos; }
    const int ntiles = pst[32] >> 8;
    if (blockIdx.x == 0) { for (int t = F.tid; t < ntiles; t += NTHR) { int e = 0; for (int q = 0; q < 32; ++q) if (pst[q] <= t * 256) e = q; TILEEXP[t] = e; }
        if (F.tid == 0) NT[0] = ntiles; }
    __syncthreads();
    for (int i = F.wave; i < NP; i += NWAVES) { const int tok = blockIdx.x * RPW + (i >> 2); const int pos = ps[i];
        const u32x4* src = (const u32x4*)(H + (size_t)tok * 1024); u32x4* dst = (u32x4*)(XS + (size_t)pos * 1024);
        dst[F.lane] = src[F.lane]; dst[64 + F.lane] = src[64 + F.lane]; }
    if (blockIdx.x < 32) { const int e = blockIdx.x; const int r0 = pst[e] + tot[e], r1 = pst[e + 1];
        for (int r = r0 + F.wave; r < r1; r += NWAVES) { u32x4* dst = (u32x4*)(XS + (size_t)r * 1024); dst[F.lane] = (u32x4){0u, 0u, 0u, 0u}; dst[64 + F.lane] = (u32x4){0u, 0u, 0u, 0u}; if (F.lane == 0) ROWTOK[r] = 0; } }
}

__device__ __forceinline__ void p_combine(const Frame& F0, int layer, int Tm) {
    const Frame F = relaunder(F0);
    const float* MODL = (const float*)(F.ws + WS_MOD) + (size_t)layer * 9 * 6144;
    const float* MODN = (const float*)(F.ws + WS_MOD) + (size_t)(layer + 1) * 9 * 6144;
    unsigned char* rt = F.ws + WS_ROUTE + layer * ROUTE_STRIDE;
    const int* POSOF = (const int*)(rt + R_POSOF); const float* TOPG = (const float*)(rt + R_TOPG);
    const bf16_t* YY = (const bf16_t*)(F.ws + WS_XS); float* XW = (float*)(F.ws + WS_XW); bf16_t* H = (bf16_t*)(F.ws + WS_H);
    const bool last = layer == 1;
    for (int row = F.gw; row < Tm; row += F.NGW) {
        const int mr = row < TL ? (row >> 12) : 8;
        f32x4 v[4]; load_row(XW + (size_t)row * 1024, F.lane, v);
        f32x4 y[4];
#pragma unroll
        for (int j = 0; j < 4; ++j) y[j] = (f32x4){0.f, 0.f, 0.f, 0.f};
#pragma unroll
        for (int s = 0; s < 4; ++s) { const int pos = __builtin_nontemporal_load(POSOF + (size_t)row * 4 + s); const float gt = __builtin_nontemporal_load(TOPG + (size_t)row * 4 + s);
            const bf16_t* yp = YY + (size_t)pos * 1024;
#pragma unroll
            for (int j = 0; j < 4; ++j) { const u32x2 w = *(const u32x2*)(yp + 256 * j + 4 * F.lane); y[j] = y[j] + gt * (f32x4){bflo(w.x), bfhi(w.x), bflo(w.y), bfhi(w.y)}; } }
        const float* g2 = MODL + (size_t)mr * 6144 + 5120;
#pragma unroll
        for (int j = 0; j < 4; ++j) v[j] = v[j] + *(const f32x4*)(g2 + 256 * j + 4 * F.lane) * y[j];
        if (!last) {
#pragma unroll
            for (int j = 0; j < 4; ++j) *(f32x4*)(XW + (size_t)row * 1024 + 256 * j + 4 * F.lane) = v[j];
            norm_mod(v, in_ptr(F, 6) + 1024, MODN + (size_t)mr * 6144, MODN + (size_t)mr * 6144 + 1024, F.lane);
            store_row_bf16(H + (size_t)row * 1024, F.lane, v);
        } else {
            const float rstd = row_rstd(v);
#pragma unroll
            for (int j = 0; j < 4; ++j) *(f32x4*)(out_ptr(F) + (size_t)row * 1024 + 256 * j + 4 * F.lane) = v[j] * rstd * *(const f32x4*)(in_ptr(F, 25) + 256 * j + 4 * F.lane);
        }
    }
}
__global__ void __launch_bounds__(NTHR, 2) fwd(Args args) {
    extern __shared__ __attribute__((aligned(16))) unsigned char lds_raw[];
    Frame F;
    F.lds = (LAS unsigned char*)lds_raw; F.ws = args.ws;
    F.tid = threadIdx.x; F.lane = F.tid & 63; F.wave = __builtin_amdgcn_readfirstlane(F.tid >> 6);
    F.G = gridDim.x; F.gw = blockIdx.x * NWAVES + F.wave; F.NGW = F.G * NWAVES;
    volatile LAS unsigned* MISC = (volatile LAS unsigned*)(F.lds + MISC_OFF);
    if (F.tid < 64) MISC[F.tid] = 0u;
    if (F.tid < 27) ((volatile LAS unsigned long long*)(F.lds + PTR_OFF))[F.tid] = (unsigned long long)(F.tid < 26 ? (const void*)args.in[F.tid] : (const void*)args.out);
    __syncthreads();
    XcdBarrier bar; bar.bar = (unsigned*)(args.ws + WS_CTL) + 4096; bar.x = 0; bar.st = nullptr;
    if (N_LAUNCH_MODE == 1) bar = xcd_barrier_post((unsigned*)(args.ws + WS_CTL) + 4096, MISC + 8);
    const int lo = args.ph_lo, hi = args.ph_hi;
#ifndef DISABLE_MASK
#define DISABLE_MASK 0
#endif
#define EN(k) (!((DISABLE_MASK >> (k)) & 1))
#define IN(k) (lo <= (k) && (k) < hi)
#define SEAM(k) do { if (IN(k) && IN((k) + 1)) xcd_barrier(bar); } while (0)
    unsigned char* ws = args.ws;

    if (EN(12) && IN(0)) { p0_prologue(F); } SEAM(0);

#pragma unroll
    for (int L = 0; L < 2; ++L) {
        const int pb = 1 + 12 * L; const bool lastL = (L == 1);
        const int Tm = lastL ? TL : TT;
        const float* MODL = (const float*)(ws + WS_MOD) + (size_t)L * 9 * 6144;
        if (EN(0) && IN(pb + 0)) { if (L == 0) p_norm1_l0(F); } SEAM(pb + 0);
        if (EN(1) && IN(pb + 1)) {
            pg8::Gemm g{(const bf16_t*)(ws + WS_H), (const bf16_t*)(ws + WS_WIN + L * WIN_STRIDE), 1024, 1024, 1024};
            pg8::StaticOrder S; S.init(TT, NIN, F.G, (int)blockIdx.x);
            EpiIn E{(bf16_t*)(ws + WS_P), (float*)(ws + WS_GA), (const float*)(ws + WS_ROPE), (const float*)(ws + WS_ROPE) + 1024};
            pg8::gemm_phase<EpiIn, pg8::StaticOrder, true, true>(F.lds, g, S, E);
        } SEAM(pb + 1);
        if (EN(2) && IN(pb + 2)) {
            p_conv(F, in_ptr(F, 12) + (size_t)L * 3 * 512);
            if (blockIdx.x < 64) p_gla_chain(F, in_ptr(F, 14) + (size_t)L * 2 * 16 * 256, in_ptr(F, 15) + (size_t)L * 2 * 256, (int)blockIdx.x);
        } SEAM(pb + 2);
        if (EN(3) && IN(pb + 3)) { p_attn_naive(F, L, in_ptr(F, 10) + (size_t)L * 128); } SEAM(pb + 3);
        if (EN(4) && IN(pb + 4)) { p_gla_tail(F, in_ptr(F, 16) + (size_t)L * 128, Tm); } SEAM(pb + 4);
        if (EN(5) && IN(pb + 5)) {
            pg8::StaticOrder S; S.init(Tm, 1024, F.G, (int)blockIdx.x);
            const bf16_t* P = (const bf16_t*)(ws + WS_P); float* M32 = (float*)(ws + WS_OG); bf16_t* MG = (bf16_t*)(ws + WS_MERGED);
            { pg8::Gemm g{(const bf16_t*)(ws + WS_AD), (const bf16_t*)(ws + WS_WD + L * W1K_STRIDE), 1024, 1024, 1024};
              EpiGate<0> E{P, M32, MG}; pg8::gemm_phase<EpiGate<0>, pg8::StaticOrder, true, true>(F.lds, g, S, E); }
            { pg8::Gemm g{(const bf16_t*)(ws + WS_ACG), (const bf16_t*)(ws + WS_WCG + L * W1K_STRIDE), 512, 1024, 1024};
              EpiGate<1> E{P, M32, MG}; pg8::gemm_phase<EpiGate<1>, pg8::StaticOrder, true, true>(F.lds, g, S, E); }
            { pg8::Gemm g{(const bf16_t*)(ws + WS_ACG) + 512, (const bf16_t*)(ws + WS_WCG + L * W1K_STRIDE) + 512, 512, 1024, 1024};
              EpiGate<2> E{P, M32, MG}; pg8::gemm_phase<EpiGate<2>, pg8::StaticOrder, true, true>(F.lds, g, S, E); }
        } SEAM(pb + 5);
        if (EN(6) && IN(pb + 6)) {
            pg8::Gemm g{(const bf16_t*)(ws + WS_MERGED), (const bf16_t*)(ws + WS_WO + L * W1K_STRIDE), 1024, 1024, 1024};
            pg8::StaticOrder S; S.init(Tm, 1024, F.G, (int)blockIdx.x);
            const float* xl = L == 0 ? in_ptr(F, 0) : (const float*)(ws + WS_XW);
            const float* xc = L == 0 ? in_ptr(F, 2) - (size_t)TL * 1024 : (const float*)(ws + WS_XW);
            EpiRes E{xl, xc, (float*)(ws + WS_XW), MODL};
            pg8::gemm_phase<EpiRes, pg8::StaticOrder, true, true>(F.lds, g, S, E);
        } SEAM(pb + 6);
        if (EN(7) && IN(pb + 7)) { p_norm2_router(F, L, Tm); } SEAM(pb + 7);
        if (EN(8) && IN(pb + 8)) { p_route_gather(F, L, Tm); } SEAM(pb + 8);
        unsigned char* rt = ws + WS_ROUTE + L * ROUTE_STRIDE;
        if (EN(9) && IN(pb + 9)) {
            const int nt = __builtin_amdgcn_readfirstlane(__builtin_nontemporal_load((const int*)(rt + R_NT)));
            pg8::Gemm g{(const bf16_t*)(ws + WS_XS), (const bf16_t*)(ws + WS_W1 + L * W1_STRIDE), 1024, 1024, 1024};
            MoeOrder S{nt, 8, F.G, (int)blockIdx.x, (const int*)(rt + R_TILEEXP)};
            EpiSwiglu E{(bf16_t*)(ws + WS_HH), in_ptr(F, 22) + (size_t)L * 32 * 2048};
            pg8::gemm_phase<EpiSwiglu, MoeOrder, true, true>(F.lds, g, S, E);
        } SEAM(pb + 9);
        if (EN(10) && IN(pb + 10)) {
            const int nt = __builtin_amdgcn_readfirstlane(__builtin_nontemporal_load((const int*)(rt + R_NT)));
            pg8::Gemm g{(const bf16_t*)(ws + WS_HH), (const bf16_t*)(ws + WS_W2 + L * W2_STRIDE), 1024, 1024, 1024};
            MoeOrder S{nt, 4, F.G, (int)blockIdx.x, (const int*)(rt + R_TILEEXP)};
            EpiY E{(bf16_t*)(ws + WS_XS), in_ptr(F, 24) + (size_t)L * 32 * 1024};
            pg8::gemm_phase<EpiY, MoeOrder, true, true>(F.lds, g, S, E);
        } SEAM(pb + 10);
        if (EN(11) && IN(pb + 11)) { p_combine(F, L, Tm); } SEAM(pb + 11);
    }
#undef IN
#undef SEAM
#ifdef DBG_STOP
    if (lo == 100) {
        float* out = out_ptr(F); const int gt = F.gw * 64 + F.lane, NGT = F.NGW * 64;
#if DBG_KIND == 2
        unsigned* cnt = (unsigned*)(ws + WS_XW + 130 * MiB);
        unsigned c = 0; if (blockIdx.x == 0 && F.tid == 0) { c = cnt[0]; cnt[0] = c + 1; }
        for (size_t i = gt; i < (size_t)TL * 1024; i += NGT) out[i] = 1.0f;
        if (blockIdx.x == 0 && F.tid == 0) out[0] = (float)(c & 1023u);
#elif DBG_KIND == 0
        const float* src = (const float*)(ws + WS_XW); for (size_t i = gt; i < (size_t)TL * 1024; i += NGT) out[i] = src[i];
#elif DBG_KIND == 1
        const bf16_t* src = (const bf16_t*)(ws + DBG_OFF); for (size_t i = gt; i < (size_t)TL * 1024; i += NGT) out[i] = bf2f(src[i * DBG_STRIDE]);
#endif
    }
#endif
}

extern "C" void kernel_launch(void* const* d_in, const int* in_sizes, int n_in, void* d_out, int out_size, void* d_ws, size_t ws_size, hipStream_t stream) {
    static int grid = 0;
    if (grid == 0) {
        if (n_in != 26 || out_size != TL * DM || ws_size < WS_END) { fprintf(stderr, "kernel_launch: unexpected problem (n_in %d out %d ws %zu)\n", n_in, out_size, ws_size); grid = -1; return; }
        int dev = 0, cus = 0, per_cu = 0;
        if (hipGetDevice(&dev) != hipSuccess || hipDeviceGetAttribute(&cus, hipDeviceAttributeMultiprocessorCount, dev) != hipSuccess) { grid = -1; return; }
        if (hipFuncSetAttribute((const void*)fwd, hipFuncAttributeMaxDynamicSharedMemorySize, LDS_BYTES) != hipSuccess) { fprintf(stderr, "kernel_launch: hipFuncSetAttribute failed\n"); grid = -1; return; }
        if (hipOccupancyMaxActiveBlocksPerMultiprocessor(&per_cu, (const void*)fwd, NTHR, LDS_BYTES) != hipSuccess || per_cu < 1) fprintf(stderr, "kernel_launch: occupancy query reports %d\n", per_cu);
        (void)hipGetLastError();
        grid = cus;
        if (grid > 256) grid = 256;
    }
    if (grid < 0) return;
    (void)hipMemsetAsync((char*)d_ws + WS_CTL, 0, CTL_ZERO_BYTES, stream);
    Args a{};
    for (int i = 0; i < 26; ++i) a.in[i] = (const float*)d_in[i];
    a.out = (float*)d_out; a.ws = (unsigned char*)d_ws;
    if (N_LAUNCH_MODE == 1) { a.ph_lo = 0; a.ph_hi = NPHASE; hipLaunchKernelGGL(fwd, dim3(grid), dim3(NTHR), LDS_BYTES, stream, a); }
#ifdef DBG_STOP
    else { for (int p = 0; p <= DBG_STOP; ++p) { if (p == 13) continue; a.ph_lo = p; a.ph_hi = p + 1; hipLaunchKernelGGL(fwd, dim3(grid), dim3(NTHR), LDS_BYTES, stream, a); }
        a.ph_lo = 100; a.ph_hi = 101; hipLaunchKernelGGL(fwd, dim3(grid), dim3(NTHR), LDS_BYTES, stream, a); }
#else
    else for (int p = 0; p < NPHASE; ++p) { if (p == 13) continue; a.ph_lo = p; a.ph_hi = p + 1; hipLaunchKernelGGL(fwd, dim3(grid), dim3(NTHR), LDS_BYTES, stream, a); }
#endif
}
```

```cpp
#include <hip/hip_runtime.h>
#include <cstdio>
#include <cstdint>
#define N_LAUNCH_MODE 1
#ifndef ATTN_IMPL
#define ATTN_IMPL 1
#endif
namespace pg8 {
#define PG8_LAS __attribute__((address_space(3)))
typedef unsigned short bf16_t;
typedef short bf16x8 __attribute__((ext_vector_type(8)));
typedef float f32x4 __attribute__((ext_vector_type(4)));
typedef float f32x2 __attribute__((ext_vector_type(2)));
typedef unsigned u32x4 __attribute__((ext_vector_type(4)));
typedef unsigned u32x2 __attribute__((ext_vector_type(2)));
constexpr int BM = 256, BK = 64, HALF = 128, HTB = HALF * BK * 2  , STAGE_BYTES = 8 * HTB, NXCD = 8, WGM = 8;

__host__ __device__ __forceinline__ int lds_byte(int r, int c) { const int st = (r >> 4) * 2 + (c >> 5), rr = r & 15, cc = c & 31, ob = rr * 64 + cc * 2; return st * 1024 + (ob ^ (((ob >> 9) & 1) << 5)); }
__host__ __device__ __forceinline__ void stage_rc(int b, int& R, int& C) { const int st = b / 1024, sb = b % 1024, swz = sb ^ (((sb >> 9) & 1) << 5); R = (st >> 1) * 16 + swz / 64; C = (st & 1) * 32 + (swz % 64) / 2; }
__host__ __device__ __forceinline__ int perm32(int rho) { const int n = rho >> 4, i = rho & 15; return 8 * (i >> 2) + 4 * n + (i & 3); }

struct Unit { int pm, pn, pb; };
struct Gemm { const bf16_t* A; const bf16_t* Bt; int K, lda, ldb; };

struct StaticOrder {
    int nM, nN, nwg, G, c;
    __host__ __device__ void init(int M, int N, int G_, int c_) { nM = M / BM; nN = N / BM; nwg = nM * nN; G = G_; c = c_; }
    __host__ __device__ bool next(int i, Unit& u) const {
        const long L = (long)i * G + c; if (L >= nwg) return false;
        int wgid = (int)L; { const int q = nwg / NXCD, r = nwg % NXCD, xcd = wgid % NXCD, off = wgid / NXCD; wgid = (xcd < r ? xcd * (q + 1) : r * (q + 1) + (xcd - r) * q) + off; }
        const int nig = WGM * nN, gid = wgid / nig, fm = gid * WGM, gsz = (nM - fm) < WGM ? (nM - fm) : WGM;
        u.pm = fm + ((wgid % nig) % gsz); u.pn = (wgid % nig) / gsz; u.pb = u.pn; return true;
    }
    __device__ __forceinline__ void a_ready(const Unit&) const {}
    __device__ __forceinline__ void done(const Unit&) const {}
};

__device__ __forceinline__ unsigned cvt_pk_bf16(float lo, float hi) { unsigned r; asm volatile("v_cvt_pk_bf16_f32 %0, %1, %2" : "=v"(r) : "v"(lo), "v"(hi)); return r; }

template <class Epi, class Sched, bool ALIGN_EPI = false, bool SP2 = false>
__device__ __forceinline__ void gemm_phase(PG8_LAS unsigned char* lds, const Gemm g, const Sched& S, const Epi& E) {
    int tid_ = threadIdx.x; asm volatile("" : "+v"(tid_));
    const int tid = tid_, wid = __builtin_amdgcn_readfirstlane(tid >> 6), lane = tid & 63, wr = wid >> 2, wc = wid & 3, fr = lane & 15, fq = lane >> 4;
    const int K = g.K, nt = K / BK;
    unsigned voffA[2], voffB[2];
#pragma unroll
    for (int i = 0; i < 2; ++i) { int R, C; stage_rc(tid * 16 + i * 8192, R, C); const int Rb = Epi::PERM ? ((R & ~31) + perm32(R & 31)) : R;
        voffA[i] = (unsigned)(R * g.lda + C) * 2u; voffB[i] = (unsigned)(Rb * g.ldb + C) * 2u; }
    const size_t kstep = (size_t)(BK * 2);
    const size_t hstepA = (size_t)HALF * g.lda * 2, hstepB = (size_t)HALF * g.ldb * 2;
    const size_t tstepA = 2 * hstepA, tstepB = 2 * hstepB;
    const unsigned ldsw = (unsigned)wid * 1024u;
    const int aoff = lds_byte(wr * 64 + fr, fq * 8), boff = lds_byte(wc * 32 + fr, fq * 8);
#define PG8_SA(b, h) (((b) * 2 + (h)) * HTB)
#define PG8_SB(b, h) ((4 + (b) * 2 + (h)) * HTB)
#define PG8_STAGE(bufoff, gbase, voff) do { _Pragma("unroll") for (int _i = 0; _i < 2; ++_i) \
        __builtin_amdgcn_global_load_lds((const unsigned*)((const char*)(gbase) + (voff)[_i]), (PG8_LAS unsigned*)(lds + (bufoff) + ldsw + _i * 8192), 16, 0, 0); } while (0)
#define PG8_LDA(dst, b, h) do { _Pragma("unroll") for (int m = 0; m < 4; ++m) _Pragma("unroll") for (int k = 0; k < 2; ++k) dst[m][k] = *(const PG8_LAS bf16x8*)(lds + PG8_SA(b, h) + aoff + m * 2048 + k * 1024); } while (0)
#define PG8_LDB(dst, b, h) do { _Pragma("unroll") for (int n = 0; n < 2; ++n) _Pragma("unroll") for (int k = 0; k < 2; ++k) dst[n][k] = *(const PG8_LAS bf16x8*)(lds + PG8_SB(b, h) + boff + n * 2048 + k * 1024); } while (0)
#define PG8_MMA(ai, bj, At, Bt) do { __builtin_amdgcn_s_setprio(1); _Pragma("unroll") for (int m = 0; m < 4; ++m) _Pragma("unroll") for (int n = 0; n < 2; ++n) _Pragma("unroll") for (int k = 0; k < 2; ++k) \
        acc[ai][bj][m][n] = __builtin_amdgcn_mfma_f32_16x16x32_bf16(Bt[n][k], At[m][k], acc[ai][bj][m][n], 0, 0, 0); __builtin_amdgcn_s_setprio(0); } while (0)
#define PG8_WAIT_V(n) asm volatile("s_waitcnt vmcnt(" #n ")" ::: "memory")
#define PG8_WAIT_L(n) asm volatile("s_waitcnt lgkmcnt(" #n ")" ::: "memory")
#define PG8_BAR __builtin_amdgcn_s_barrier()
#define PG8_SCHED __builtin_amdgcn_sched_barrier(0)
    Unit cur, nxt; int ui = 0;
    if (!S.next(0, cur)) return;
    f32x4 acc[2][2][4][2];
#pragma unroll
    for (int a = 0; a < 2; ++a)
#pragma unroll
        for (int b = 0; b < 2; ++b)
#pragma unroll
            for (int m = 0; m < 4; ++m)
#pragma unroll
                for (int n = 0; n < 2; ++n) acc[a][b][m][n] = (f32x4){0.f, 0.f, 0.f, 0.f};
    bf16x8 At[4][2], B0[2][2], B1[2][2];
    const char* cA = (const char*)g.A + (size_t)cur.pm * tstepA; const char* cB = (const char*)g.Bt + (size_t)cur.pb * tstepB;
    S.a_ready(cur);
    if constexpr (SP2) {
        PG8_STAGE(PG8_SB(0, 0), cB, voffB); PG8_STAGE(PG8_SB(0, 1), cB + hstepB, voffB); PG8_STAGE(PG8_SA(0, 0), cA, voffA); PG8_STAGE(PG8_SA(0, 1), cA + hstepA, voffA);
        if (wr == 1) PG8_BAR;
        PG8_WAIT_V(2); PG8_BAR;
        PG8_STAGE(PG8_SB(1, 0), cB + kstep, voffB); PG8_STAGE(PG8_SA(1, 0), cA + kstep, voffA); PG8_STAGE(PG8_SB(1, 1), cB + hstepB + kstep, voffB);
        PG8_WAIT_V(6); PG8_BAR;
    } else {
        PG8_STAGE(PG8_SB(0, 0), cB, voffB); PG8_STAGE(PG8_SA(0, 0), cA, voffA); PG8_STAGE(PG8_SB(0, 1), cB + hstepB, voffB); PG8_STAGE(PG8_SA(0, 1), cA + hstepA, voffA);
        if (wr == 1) PG8_BAR;
        PG8_WAIT_V(4); PG8_BAR;
        PG8_STAGE(PG8_SB(1, 0), cB + kstep, voffB); PG8_STAGE(PG8_SA(1, 0), cA + kstep, voffA); PG8_STAGE(PG8_SB(1, 1), cB + hstepB + kstep, voffB);
        PG8_WAIT_V(6); PG8_BAR;
    }
    for (;;) {
        const bool has_next = S.next(ui + 1, nxt);
        const char* nA = has_next ? (const char*)g.A + (size_t)nxt.pm * tstepA : cA; const char* nB = has_next ? (const char*)g.Bt + (size_t)nxt.pb * tstepB : cB;
        for (int t = 0; t < nt; t += 2) {
            const bool last = (t == nt - 2);
            const char* a1 = cA + (size_t)(t + 1) * kstep;
            const char* a2 = last ? nA : cA + (size_t)(t + 2) * kstep; const char* b2 = last ? nB : cB + (size_t)(t + 2) * kstep;
            const char* a3 = a2 + kstep; const char* b3 = b2 + kstep;
            if (last && has_next) S.a_ready(nxt);
            if constexpr (SP2) {
            PG8_LDB(B0, 0, 0); PG8_LDB(B1, 0, 1); PG8_SCHED; PG8_LDA(At, 0, 0); PG8_STAGE(PG8_SA(1, 1), a1 + hstepA, voffA);
            PG8_WAIT_V(8); PG8_WAIT_L(0); PG8_BAR; PG8_MMA(0, 0, At, B0); PG8_MMA(0, 1, At, B1); PG8_BAR; PG8_SCHED;
            PG8_LDA(At, 0, 1); PG8_STAGE(PG8_SB(0, 0), b2, voffB); PG8_STAGE(PG8_SB(0, 1), b2 + hstepB, voffB); PG8_STAGE(PG8_SA(0, 0), a2, voffA);
            PG8_WAIT_V(8); PG8_WAIT_L(0); PG8_BAR; PG8_MMA(1, 0, At, B0); PG8_MMA(1, 1, At, B1); PG8_BAR; PG8_SCHED;
            PG8_LDB(B0, 1, 0); PG8_LDB(B1, 1, 1); PG8_SCHED; PG8_LDA(At, 1, 0); PG8_STAGE(PG8_SA(0, 1), a2 + hstepA, voffA);
            PG8_WAIT_V(8); PG8_WAIT_L(0); PG8_BAR; PG8_MMA(0, 0, At, B0); PG8_MMA(0, 1, At, B1); PG8_BAR; PG8_SCHED;
            PG8_LDA(At, 1, 1); PG8_STAGE(PG8_SB(1, 0), b3, voffB); PG8_STAGE(PG8_SB(1, 1), b3 + hstepB, voffB); PG8_STAGE(PG8_SA(1, 0), a3, voffA);
            PG8_WAIT_V(8); PG8_WAIT_L(0); PG8_BAR; PG8_MMA(1, 0, At, B0); PG8_MMA(1, 1, At, B1); PG8_BAR; PG8_SCHED;
            } else {
            PG8_LDB(B0, 0, 0); PG8_SCHED; PG8_LDA(At, 0, 0); PG8_STAGE(PG8_SA(1, 1), a1 + hstepA, voffA);
            PG8_WAIT_L(8); PG8_BAR; PG8_WAIT_L(0); PG8_MMA(0, 0, At, B0); PG8_BAR; PG8_SCHED;
            PG8_LDB(B1, 0, 1); PG8_STAGE(PG8_SB(0, 0), b2, voffB);
            PG8_BAR; PG8_WAIT_L(0); PG8_MMA(0, 1, At, B1); PG8_BAR;
            PG8_LDA(At, 0, 1); PG8_STAGE(PG8_SA(0, 0), a2, voffA);
            PG8_BAR; PG8_WAIT_L(0); PG8_MMA(1, 0, At, B0); PG8_BAR; PG8_SCHED;
            PG8_STAGE(PG8_SB(0, 1), b2 + hstepB, voffB);
            PG8_WAIT_V(6); PG8_BAR; PG8_MMA(1, 1, At, B1); PG8_BAR;
            PG8_LDB(B0, 1, 0); PG8_SCHED; PG8_LDA(At, 1, 0); PG8_STAGE(PG8_SA(0, 1), a2 + hstepA, voffA);
            PG8_WAIT_L(8); PG8_BAR; PG8_WAIT_L(0); PG8_MMA(0, 0, At, B0); PG8_BAR; PG8_SCHED;
            PG8_LDB(B1, 1, 1); PG8_STAGE(PG8_SB(1, 0), b3, voffB);
            PG8_BAR; PG8_WAIT_L(0); PG8_MMA(0, 1, At, B1); PG8_BAR;
            PG8_LDA(At, 1, 1); PG8_STAGE(PG8_SA(1, 0), a3, voffA);
            PG8_BAR; PG8_WAIT_L(0); PG8_MMA(1, 0, At, B0); PG8_BAR; PG8_SCHED;
            PG8_STAGE(PG8_SB(1, 1), b3 + hstepB, voffB);
            PG8_WAIT_V(6); PG8_BAR; PG8_MMA(1, 1, At, B1); PG8_BAR;
            }
        }
        if constexpr (ALIGN_EPI) { if (wr == 0) PG8_BAR; }
        E(acc, cur, wr, wc, fr, fq); S.done(cur);
        if (!has_next) break;
#pragma unroll
        for (int a = 0; a < 2; ++a)
#pragma unroll
            for (int b = 0; b < 2; ++b)
#pragma unroll
                for (int m = 0; m < 4; ++m)
#pragma unroll
                    for (int n = 0; n < 2; ++n) acc[a][b][m][n] = (f32x4){0.f, 0.f, 0.f, 0.f};
        cur = nxt; cA = nA; cB = nB; ++ui;
        if constexpr (ALIGN_EPI) { if (wr == 1) PG8_BAR; }
    }
    PG8_WAIT_V(0);
    if constexpr (!ALIGN_EPI) { if (wr == 0) PG8_BAR; }
    PG8_BAR;
#undef PG8_SA
#undef PG8_SB
#undef PG8_STAGE
#undef PG8_LDA
#undef PG8_LDB
#undef PG8_MMA
#undef PG8_WAIT_V
#undef PG8_WAIT_L
#undef PG8_BAR
#undef PG8_SCHED
}
}
constexpr int NB = 8, SEQ = 4096, DM = 1024, CTXL = 256;
constexpr int TL = NB * SEQ, TC = NB * CTXL, TT = TL + TC;
constexpr int NIN = 9472, PW = 9216;
constexpr int OQ = 0, OKK = 1024, OV = 2048, OCB = 3072, OCC = 3584, OCX = 4096, OGQ = 4608, OGK = 4864, OGV = 5120, OGR = 5632, OGATE = 6144;
constexpr int NEXP = 32, NRMAX = 147456;
constexpr float RMS_EPS = 1e-6f;
constexpr float QSCALE = 0.125f * 1.4426950408889634f;
constexpr int NWAVES = 8, NTHR = 512;
#ifndef N_LAUNCH_MODE
#define N_LAUNCH_MODE 0
#endif
constexpr int NPHASE = 25;

constexpr size_t MiB = 1u << 20;
constexpr size_t WS_CTL = 0, CTL_ZERO_BYTES = 1 * MiB;
constexpr size_t WS_MOD = 1 * MiB;
constexpr size_t WS_ROPE = WS_MOD + 512 * 1024;
constexpr size_t WS_LAM = WS_ROPE + 16 * 1024;
constexpr size_t WS_ROUTE = 2 * MiB, ROUTE_STRIDE = 8 * MiB;
constexpr size_t R_TOPI = 0, R_TOPG = 1 * MiB, R_POSOF = 2 * MiB, R_ROWTOK = 3 * MiB, R_CNT = 4 * MiB, R_TILEEXP = 4 * MiB + 64 * 1024, R_NT = 4 * MiB + 128 * 1024;
constexpr size_t WS_GA = 18 * MiB;
constexpr size_t WS_WIN = 24 * MiB, WIN_STRIDE = (size_t)NIN * DM * 2;
constexpr size_t WS_WD = 61 * MiB, WS_WCG = 65 * MiB, WS_WO = 69 * MiB, W1K_STRIDE = 2 * MiB;
constexpr size_t WS_W1 = 73 * MiB, W1_STRIDE = 128 * MiB;
constexpr size_t WS_W2 = 329 * MiB, W2_STRIDE = 64 * MiB;
constexpr size_t WS_H = 457 * MiB, WS_AD = 525 * MiB, WS_ACG = 593 * MiB, WS_MERGED = 661 * MiB;
constexpr size_t WS_OG = 729 * MiB;
constexpr size_t WS_XW = 865 * MiB;
constexpr size_t WS_ASCR = 1001 * MiB;
constexpr size_t WS_P = 1033 * MiB;
constexpr size_t WS_XS = WS_P, WS_HH = WS_P + 288 * MiB;
constexpr size_t WS_VT = 1645 * MiB;
constexpr size_t WS_END = 1713 * MiB;
static_assert(WS_P + (size_t)TT * PW * 2 <= WS_END && WS_HH + (size_t)NRMAX * DM * 2 <= WS_END, "ws map");

constexpr int LDS_BYTES = 147456;
constexpr int MISC_OFF = 147456 - 1024;

#define GAS __attribute__((address_space(1)))
#define LAS __attribute__((address_space(3)))
typedef unsigned short bf16_t;
typedef float f32x4 __attribute__((ext_vector_type(4)));
typedef float f32x2 __attribute__((ext_vector_type(2)));
typedef unsigned u32x4 __attribute__((ext_vector_type(4)));
typedef unsigned u32x2 __attribute__((ext_vector_type(2)));
#define LDS_WAIT() asm volatile("s_waitcnt lgkmcnt(0)" ::: "memory")
#define VM_WAIT() asm volatile("s_waitcnt vmcnt(0)" ::: "memory")
__device__ __forceinline__ unsigned f2bf(float f) { unsigned u = __builtin_bit_cast(unsigned, f); return (u + 0x7fffu + ((u >> 16) & 1u)) >> 16; }
__device__ __forceinline__ unsigned pk2(float lo, float hi) { return f2bf(lo) | (f2bf(hi) << 16); }
__device__ __forceinline__ float bflo(unsigned w) { return __builtin_bit_cast(float, w << 16); }
__device__ __forceinline__ float bfhi(unsigned w) { return __builtin_bit_cast(float, w & 0xffff0000u); }
__device__ __forceinline__ float bf2f(bf16_t b) { return __builtin_bit_cast(float, ((unsigned)b) << 16); }
__device__ __forceinline__ float wave_sum(float v) {
#pragma unroll
    for (int o = 1; o < 64; o <<= 1) v += __shfl_xor(v, o);
    return v;
}
__device__ __forceinline__ float sigmoidf_(float x) { return 1.f / (1.f + __expf(-x)); }

#define XB_TMO      128
#define XB_XCNT(j)  (256  + 64 * (j))
#define XB_XSUB(j)  (1280 + 64 * (j))
#define XB_XGEN(j)  (2304 + 64 * (j))
#define XB_TOP      3328
#define XB_TOPGEN   3392
#define XCD_BAR_WORDS 3456
#define XB_SPIN_CAP (1u << 18)
__device__ __forceinline__ unsigned xb_ld(unsigned* p)              { return __hip_atomic_load(p, __ATOMIC_RELAXED, __HIP_MEMORY_SCOPE_AGENT); }
__device__ __forceinline__ unsigned xb_add(unsigned* p, unsigned v) { return __hip_atomic_fetch_add(p, v, __ATOMIC_RELAXED, __HIP_MEMORY_SCOPE_AGENT); }
__device__ __forceinline__ unsigned xb_xcc_id() { return (unsigned)__builtin_amdgcn_s_getreg((3 << 11) | 20) & 0xFu; }
#define XB_SPIN(cond, bar) do { unsigned _sp = 0; while (cond) { __builtin_amdgcn_s_sleep(1); \
    if ((++_sp & 255u) == 0u) { if (xb_ld(&(bar)[XB_TMO])) break; if (_sp > XB_SPIN_CAP) { atomicAdd(&(bar)[XB_TMO], 1u); break; } } } } while (0)
struct XcdBarrier { unsigned* bar; unsigned x; volatile LAS unsigned* st; };
__device__ __forceinline__ XcdBarrier xcd_barrier_post(unsigned* bar, volatile LAS unsigned* st) {
    XcdBarrier b; b.bar = bar; b.x = xb_xcc_id(); b.st = st;
    if (threadIdx.x == 0) (void)xb_add(&bar[XB_XCNT(b.x)], 1u);
    return b;
}
__device__ __forceinline__ void xcd_barrier_complete(unsigned* bar, unsigned x, unsigned& nloc, unsigned& nx) {
    const unsigned G = gridDim.x * gridDim.y * gridDim.z;
    unsigned sum, cnt, mine, sp = 0u;
    for (;;) {
        sum = 0u; cnt = 0u; mine = 0u;
#pragma unroll
        for (unsigned j = 0; j < 16; ++j) { const unsigned c = xb_ld(&bar[XB_XCNT(j)]); sum += c; cnt += (c > 0u) ? 1u : 0u; mine = (j == x) ? c : mine; }
        if (sum == G) break;
        __builtin_amdgcn_s_sleep(1);
        if ((++sp & 255u) == 0u) { if (xb_ld(&bar[XB_TMO])) break; if (sp > XB_SPIN_CAP) { atomicAdd(&bar[XB_TMO], 1u); break; } }
    }
    nloc = mine > 0u ? mine : 1u; nx = cnt > 0u ? cnt : 1u;
}
__device__ __forceinline__ void xcd_barrier(const XcdBarrier& b) {
    asm volatile("s_waitcnt vmcnt(0)" ::: "memory");
    __syncthreads();
    if (threadIdx.x == 0) {
        unsigned* bar = b.bar;
        __builtin_amdgcn_s_waitcnt(0);
        unsigned nloc = b.st[0], nx = b.st[1];
        if (nloc == 0u) { xcd_barrier_complete(bar, b.x, nloc, nx); b.st[0] = nloc; b.st[1] = nx; }
        const unsigned old = xb_add(&bar[XB_XSUB(b.x)], 1u);
        const unsigned gen = old / nloc;
        if (old + 1u == (gen + 1u) * nloc) {
            __builtin_amdgcn_fence(__ATOMIC_RELEASE, "agent");
            asm volatile("s_waitcnt vmcnt(0)" ::: "memory");
            const unsigned og = xb_add(&bar[XB_TOP], 1u);
            const unsigned tg = og / nx;
            if (og + 1u == (tg + 1u) * nx) xb_add(&bar[XB_TOPGEN], 1u);
            else XB_SPIN(xb_ld(&bar[XB_TOPGEN]) == tg, bar);
            __builtin_amdgcn_fence(__ATOMIC_ACQUIRE, "agent");
            xb_add(&bar[XB_XGEN(b.x)], 1u);
            asm volatile("s_waitcnt vmcnt(0)" ::: "memory");
        } else {
            XB_SPIN(xb_ld(&bar[XB_XGEN(b.x)]) == gen, bar);
            __builtin_amdgcn_fence(__ATOMIC_ACQUIRE, "agent");
            asm volatile("s_waitcnt vmcnt(0)" ::: "memory");
        }
    }
    __syncthreads();
}

using pg8::Unit;
struct EpiIn {
    static constexpr bool PERM = false;
    bf16_t* P; float* GA; const float* cosT; const float* sinT;
    __device__ __forceinline__ void operator()(const f32x4 (&acc)[2][2][4][2], const Unit& u, int wr, int wc, int fr, int fq) const {
        const int row0 = u.pm * 256 + wr * 64 + fr; const int pn = u.pn;
        if (pn == 36) {
            if (wc == 0) {
#pragma unroll
                for (int ai = 0; ai < 2; ++ai)
#pragma unroll
                    for (int m = 0; m < 4; ++m) { const size_t row = (size_t)(row0 + ai * 128 + m * 16);
#pragma unroll
                        for (int n = 0; n < 2; ++n) *(f32x4*)(GA + row * 32 + 16 * n + 4 * fq) = acc[ai][0][m][n]; }
            }
            return;
        }
        const int colbase = pn * 256 + wc * 32 + 4 * fq;
        if (pn < 8) {
            const bool lat = u.pm < 128; const float qs = pn < 4 ? QSCALE : 1.f; const int axis = wc & 1;
#pragma unroll
            for (int ai = 0; ai < 2; ++ai)
#pragma unroll
                for (int m = 0; m < 4; ++m) { const int row = row0 + ai * 128 + m * 16; const int s = row & 4095; const int pos = axis ? (s & 63) : (s >> 6);
                    f32x4 c4 = (f32x4){1.f, 1.f, 1.f, 1.f}, s4 = (f32x4){0.f, 0.f, 0.f, 0.f};
                    if (lat) { c4 = *(const f32x4*)(cosT + pos * 16 + 4 * fq); s4 = *(const f32x4*)(sinT + pos * 16 + 4 * fq); }
                    bf16_t* rowp = P + (size_t)row * PW + colbase;
#pragma unroll
                    for (int bj = 0; bj < 2; ++bj) { const f32x4 x1 = acc[ai][bj][m][0], x2 = acc[ai][bj][m][1];
                        const f32x4 o1 = (x1 * c4 - x2 * s4) * qs, o2 = (x2 * c4 + x1 * s4) * qs;
                        u32x2 w1, w2; w1.x = pk2(o1[0], o1[1]); w1.y = pk2(o1[2], o1[3]); w2.x = pk2(o2[0], o2[1]); w2.y = pk2(o2[2], o2[3]);
                        *(u32x2*)(rowp + bj * 128) = w1; *(u32x2*)(rowp + bj * 128 + 16) = w2; } }
        } else {
            const bool sg = pn >= 24;
#pragma unroll
            for (int ai = 0; ai < 2; ++ai)
#pragma unroll
                for (int m = 0; m < 4; ++m) { const int row = row0 + ai * 128 + m * 16; bf16_t* rowp = P + (size_t)row * PW + colbase;
#pragma unroll
                    for (int bj = 0; bj < 2; ++bj)
#pragma unroll
                        for (int n = 0; n < 2; ++n) { f32x4 v = acc[ai][bj][m][n];
                            if (sg) { v[0] = sigmoidf_(v[0]); v[1] = sigmoidf_(v[1]); v[2] = sigmoidf_(v[2]); v[3] = sigmoidf_(v[3]); }
                            u32x2 w; w.x = pk2(v[0], v[1]); w.y = pk2(v[2], v[3]); *(u32x2*)(rowp + bj * 128 + 16 * n) = w; } }
        }
    }
};
template <int MODE> struct EpiGate {
    static constexpr bool PERM = false;
    const bf16_t* P; float* M32; bf16_t* MG;
    __device__ __forceinline__ void operator()(const f32x4 (&acc)[2][2][4][2], const Unit& u, int wr, int wc, int fr, int fq) const {
        const int row0 = u.pm * 256 + wr * 64 + fr, col0 = u.pn * 256 + wc * 32 + 4 * fq;
#pragma unroll
        for (int ai = 0; ai < 2; ++ai)
#pragma unroll
            for (int m = 0; m < 4; ++m) { const size_t row = (size_t)(row0 + ai * 128 + m * 16);
#pragma unroll
                for (int bj = 0; bj < 2; ++bj)
#pragma unroll
                    for (int n = 0; n < 2; ++n) { const int col = col0 + bj * 128 + 16 * n;
                        const u32x2 gw = *(const u32x2*)(P + row * PW + OGATE + MODE * 1024 + col);
                        const f32x4 s = (f32x4){bflo(gw.x), bfhi(gw.x), bflo(gw.y), bfhi(gw.y)};
                        f32x4 v = s * acc[ai][bj][m][n];
                        float* mp = M32 + row * 1024 + col;
                        if (MODE >= 1) v = v + __builtin_nontemporal_load((const f32x4*)mp);
                        if (MODE <= 1) *(f32x4*)mp = v;
                        else { u32x2 w; w.x = pk2(v[0], v[1]); w.y = pk2(v[2], v[3]); *(u32x2*)(MG + row * 1024 + col) = w; } } }
    }
};
struct EpiRes {
    static constexpr bool PERM = false;
    const float* xlat; const float* xctx; float* XW; const float* mod;
    __device__ __forceinline__ void operator()(const f32x4 (&acc)[2][2][4][2], const Unit& u, int wr, int wc, int fr, int fq) const {
        const int row0 = u.pm * 256 + wr * 64 + fr, col0 = u.pn * 256 + wc * 32 + 4 * fq;
        const int mr = u.pm < 128 ? (u.pm >> 4) : 8; const float* xin = u.pm < 128 ? xlat : xctx;
        const float* g1 = mod + (size_t)mr * 6144 + 2048;
        f32x4 gv[2][2];
#pragma unroll
        for (int bj = 0; bj < 2; ++bj)
#pragma unroll
            for (int n = 0; n < 2; ++n) gv[bj][n] = *(const f32x4*)(g1 + col0 + bj * 128 + 16 * n);
#pragma unroll
        for (int ai = 0; ai < 2; ++ai)
#pragma unroll
            for (int m = 0; m < 4; ++m) { const size_t off = (size_t)(row0 + ai * 128 + m * 16) * 1024 + col0;
#pragma unroll
                for (int bj = 0; bj < 2; ++bj)
#pragma unroll
                    for (int n = 0; n < 2; ++n) { const f32x4 xi = *(const f32x4*)(xin + off + bj * 128 + 16 * n);
                        *(f32x4*)(XW + off + bj * 128 + 16 * n) = xi + gv[bj][n] * acc[ai][bj][m][n]; } }
    }
};
struct EpiSwiglu {
    static constexpr bool PERM = true;
    bf16_t* HH; const float* b1;
    __device__ __forceinline__ void operator()(const f32x4 (&acc)[2][2][4][2], const Unit& u, int wr, int wc, int fr, int fq) const {
        const int row0 = u.pm * 256 + wr * 64 + fr, c0 = u.pn * 256 + wc * 32 + 8 * fq; const int e = u.pb >> 3;
        const float* bp = b1 + (size_t)e * 2048 + c0;
        f32x4 bv[2][2];
#pragma unroll
        for (int bj = 0; bj < 2; ++bj)
#pragma unroll
            for (int n = 0; n < 2; ++n) bv[bj][n] = *(const f32x4*)(bp + bj * 128 + 4 * n);
#pragma unroll
        for (int ai = 0; ai < 2; ++ai)
#pragma unroll
            for (int m = 0; m < 4; ++m) { bf16_t* rowp = HH + (size_t)(row0 + ai * 128 + m * 16) * 1024 + (c0 >> 1);
#pragma unroll
                for (int bj = 0; bj < 2; ++bj) { const f32x4 v0 = acc[ai][bj][m][0] + bv[bj][0], v1 = acc[ai][bj][m][1] + bv[bj][1];
                    float o[4];
#pragma unroll
                    for (int p = 0; p < 4; ++p) { float gl = p < 2 ? v0[2 * p] : v1[2 * p - 4], ln = p < 2 ? v0[2 * p + 1] : v1[2 * p - 3];
                        gl = fminf(gl, 7.f); ln = fminf(fmaxf(ln, -7.f), 7.f); o[p] = gl * sigmoidf_(1.702f * gl) * (ln + 1.f); }
                    u32x2 w; w.x = pk2(o[0], o[1]); w.y = pk2(o[2], o[3]); *(u32x2*)(rowp + bj * 64) = w; } }
    }
};
struct EpiY {
    static constexpr bool PERM = true;
    bf16_t* YY; const float* b2;
    __device__ __forceinline__ void operator()(const f32x4 (&acc)[2][2][4][2], const Unit& u, int wr, int wc, int fr, int fq) const {
        const int row0 = u.pm * 256 + wr * 64 + fr, c0 = u.pn * 256 + wc * 32 + 8 * fq; const int e = u.pb >> 2;
        const float* bp = b2 + (size_t)e * 1024 + c0;
        f32x4 bv[2][2];
#pragma unroll
        for (int bj = 0; bj < 2; ++bj)
#pragma unroll
            for (int n = 0; n < 2; ++n) bv[bj][n] = *(const f32x4*)(bp + bj * 128 + 4 * n);
#pragma unroll
        for (int ai = 0; ai < 2; ++ai)
#pragma unroll
            for (int m = 0; m < 4; ++m) { bf16_t* rowp = YY + (size_t)(row0 + ai * 128 + m * 16) * 1024 + c0;
#pragma unroll
                for (int bj = 0; bj < 2; ++bj) { const f32x4 v0 = acc[ai][bj][m][0] + bv[bj][0], v1 = acc[ai][bj][m][1] + bv[bj][1];
                    u32x4 w; w.x = pk2(v0[0], v0[1]); w.y = pk2(v0[2], v0[3]); w.z = pk2(v1[0], v1[1]); w.w = pk2(v1[2], v1[3]);
                    *(u32x4*)(rowp + bj * 128) = w; } }
    }
};
struct MoeOrder {
    int ntiles, nN, G, c; const int* tile_exp;
    __device__ __forceinline__ bool next(int i, Unit& u) const {
        const long L = (long)i * G + c; if (L >= (long)ntiles * nN) return false;
        const int tile = (int)(L / nN), pn = (int)(L % nN);
        u.pm = tile; u.pn = pn; u.pb = __builtin_amdgcn_readfirstlane(__builtin_nontemporal_load(tile_exp + tile)) * nN + pn; return true;
    }
    __device__ __forceinline__ void a_ready(const Unit&) const {}
    __device__ __forceinline__ void done(const Unit&) const {}
};
struct Args { const float* in[26]; float* out; unsigned char* ws; int ph_lo, ph_hi; };
struct Frame {
    LAS unsigned char* lds; unsigned char* ws; int tid, lane, wave, G, gw, NGW;
};
constexpr int PTR_OFF = 147456 - 1024 + 256;
__device__ __forceinline__ const float* in_ptr(const Frame& F, int i) {
    const unsigned long long v = ((volatile LAS unsigned long long*)(F.lds + PTR_OFF))[i];
    const unsigned lo = __builtin_amdgcn_readfirstlane((unsigned)v), hi = __builtin_amdgcn_readfirstlane((unsigned)(v >> 32));
    return (const float*)(((unsigned long long)hi << 32) | lo);
}
__device__ __forceinline__ float* out_ptr(const Frame& F) { return (float*)in_ptr(F, 26); }
__device__ __forceinline__ Frame relaunder(const Frame& F0) {
    Frame F = F0; int t = threadIdx.x; asm volatile("" : "+v"(t));
    F.tid = t; F.lane = t & 63; F.wave = __builtin_amdgcn_readfirstlane(t >> 6); F.gw = blockIdx.x * NWAVES + F.wave; return F;
}

__device__ __forceinline__ void transpose_item(const float* W, int srcN, bf16_t* WT, int dstK, int k0, int n0, int drow0, int dk0, LAS float* scr, int lane) {
#pragma unroll 8
    for (int i = 0; i < 32; ++i) { const int kk = 2 * i + (lane >> 5); scr[kk * 33 + (lane & 31)] = W[(size_t)(k0 + kk) * srcN + n0 + (lane & 31)]; }
    LDS_WAIT(); asm volatile("" ::: "memory");
    const int c = lane & 7;
#pragma unroll
    for (int j = 0; j < 4; ++j) { const int n = (lane >> 3) + 8 * j; const LAS float* s = scr + (8 * c) * 33 + n;
        u32x4 o; o.x = pk2(s[0 * 33], s[1 * 33]); o.y = pk2(s[2 * 33], s[3 * 33]); o.z = pk2(s[4 * 33], s[5 * 33]); o.w = pk2(s[6 * 33], s[7 * 33]);
        *(u32x4*)(WT + (size_t)(drow0 + n0 + n) * dstK + dk0 + 8 * c) = o; }
    LDS_WAIT(); asm volatile("" ::: "memory");
}

__device__ __forceinline__ void p0_prologue(const Frame& F0) {
    const Frame F = relaunder(F0);
    unsigned char* ws = F.ws;
    {
        LAS float* sc = (LAS float*)F.lds;
        LAS float* red = sc + 9 * 1024;
        for (int i = F.tid; i < 9 * 1024; i += NTHR) { const float c = i < 8192 ? in_ptr(F, 1)[i] : in_ptr(F, 3)[i - 8192]; sc[i] = c / (1.f + __expf(-c)); }
        __syncthreads();
        float* MOD = (float*)(ws + WS_MOD);
        for (int job = blockIdx.x; job < 192; job += F.G) {
            const int l = job / 96, blk = job % 96, ks = F.tid >> 6, n = F.tid & 63, col = blk * 64 + n;
            const float* w = in_ptr(F, 4) + (size_t)l * 1024 * 6144 + col;
            float a[9];
#pragma unroll
            for (int r = 0; r < 9; ++r) a[r] = 0.f;
            for (int k = ks * 128; k < ks * 128 + 128; ++k) { const float wv = w[(size_t)k * 6144];
#pragma unroll
                for (int r = 0; r < 9; ++r) a[r] += sc[r * 1024 + k] * wv; }
#pragma unroll
            for (int r = 0; r < 9; ++r) red[(ks * 9 + r) * 64 + n] = a[r];
            __syncthreads();
            for (int o = F.tid; o < 576; o += NTHR) { const int r = o >> 6, nn = o & 63; float s = 0.f;
#pragma unroll
                for (int k8 = 0; k8 < 8; ++k8) s += red[(k8 * 9 + r) * 64 + nn];
                MOD[((size_t)l * 9 + r) * 6144 + blk * 64 + nn] = s + in_ptr(F, 5)[(size_t)l * 6144 + blk * 64 + nn]; }
            __syncthreads();
        }
    }
    if (blockIdx.x == 0) {
        float* cosT = (float*)(ws + WS_ROPE); float* sinT = cosT + 1024;
        for (int i = F.tid; i < 1024; i += NTHR) { const int pos = i >> 4, f = i & 15; const float inv = powf(10000.f, -(float)(2 * f) / 32.f); const float ang = (float)pos * inv; cosT[i] = cosf(ang); sinT[i] = sinf(ang); }
        if (F.wave < 2) { const int l = F.wave; const float* dl = in_ptr(F, 9) + (size_t)l * 256;
            const float s1 = wave_sum(dl[F.lane] * dl[64 + F.lane]), s2 = wave_sum(dl[128 + F.lane] * dl[192 + F.lane]);
            const float lam_init = 0.8f - 0.6f * expf(-0.3f * (float)l);
            if (F.lane == 0) ((float*)(ws + WS_LAM))[l] = expf(s1) - expf(s2) + lam_init; }
    }
    __syncthreads();
    LAS float* scr = (LAS float*)(F.lds + F.wave * 16384);
    constexpr int I_IN = 16 * 289, I_D = 512, I_C = 256, I_G = 256, I_O = 512, I_1 = 32 * 1024, I_2 = 32 * 512;
    constexpr int PER_L = I_IN + I_D + I_C + I_G + I_O + I_1 + I_2;
    for (int it = F.gw; it < 2 * PER_L; it += F.NGW) {
        const int l = it / PER_L; int r = it % PER_L;
        if (r < I_IN) { const int kb = r / 289, nb = r % 289, n0 = nb * 32; const int d0 = n0 < 6144 ? n0 : (n0 < 6176 ? 9216 + (n0 - 6144) : n0 - 32);
            transpose_item(in_ptr(F, 8) + (size_t)l * 1024 * 9248, 9248, (bf16_t*)(ws + WS_WIN + l * WIN_STRIDE), 1024, kb * 64, n0, d0 - n0, kb * 64, scr, F.lane); continue; } r -= I_IN;
        if (r < I_D) { const int kb = r / 32, nb = r % 32; transpose_item(in_ptr(F, 11) + (size_t)l * 1024 * 1024, 1024, (bf16_t*)(ws + WS_WD + l * W1K_STRIDE), 1024, kb * 64, nb * 32, 0, kb * 64, scr, F.lane); continue; } r -= I_D;
        if (r < I_C) { const int kb = r / 32, nb = r % 32; transpose_item(in_ptr(F, 13) + (size_t)l * 512 * 1024, 1024, (bf16_t*)(ws + WS_WCG + l * W1K_STRIDE), 1024, kb * 64, nb * 32, 0, kb * 64, scr, F.lane); continue; } r -= I_C;
        if (r < I_G) { const int kb = r / 32, nb = r % 32; transpose_item(in_ptr(F, 17) + (size_t)l * 512 * 1024, 1024, (bf16_t*)(ws + WS_WCG + l * W1K_STRIDE), 1024, kb * 64, nb * 32, 0, 512 + kb * 64, scr, F.lane); continue; } r -= I_G;
        if (r < I_O) { const int kb = r / 32, nb = r % 32; transpose_item(in_ptr(F, 18) + (size_t)l * 1024 * 1024, 1024, (bf16_t*)(ws + WS_WO + l * W1K_STRIDE), 1024, kb * 64, nb * 32, 0, kb * 64, scr, F.lane); continue; } r -= I_O;
        if (r < I_1) { const int e = r / 1024, q = r % 1024, kb = q / 64, nb = q % 64;
            transpose_item(in_ptr(F, 21) + ((size_t)l * 32 + e) * 1024 * 2048, 2048, (bf16_t*)(ws + WS_W1 + l * W1_STRIDE) + (size_t)e * 2048 * 1024, 1024, kb * 64, nb * 32, 0, kb * 64, scr, F.lane); continue; } r -= I_1;
        { const int e = r / 512, q = r % 512, kb = q / 32, nb = q % 32;
            transpose_item(in_ptr(F, 23) + ((size_t)l * 32 + e) * 1024 * 1024, 1024, (bf16_t*)(ws + WS_W2 + l * W2_STRIDE) + (size_t)e * 1024 * 1024, 1024, kb * 64, nb * 32, 0, kb * 64, scr, F.lane); }
    }
    for (int i = F.gw * 64 + F.lane; i < 2 * 224 * 128; i += F.NGW * 64) { const int l = i / (224 * 128), q = i % (224 * 128);
        *(u32x4*)(ws + WS_WIN + l * WIN_STRIDE + (size_t)9248 * 2048 + (size_t)q * 16) = (u32x4){0u, 0u, 0u, 0u}; }
}

__device__ __forceinline__ void load_row(const float* p, int lane, f32x4 (&v)[4]) {
#pragma unroll
    for (int j = 0; j < 4; ++j) v[j] = *(const f32x4*)(p + 256 * j + 4 * lane);
}
__device__ __forceinline__ float row_rstd(const f32x4 (&v)[4]) {
    float s = 0.f;
#pragma unroll
    for (int j = 0; j < 4; ++j) s += (v[j][0] * v[j][0] + v[j][1] * v[j][1]) + (v[j][2] * v[j][2] + v[j][3] * v[j][3]);
    return 1.0f / sqrtf(wave_sum(s) * (1.f / 1024.f) + RMS_EPS);
}
__device__ __forceinline__ void norm_mod(f32x4 (&v)[4], const float* g, const float* shift, const float* scale, int lane) {
    const float rstd = row_rstd(v);
#pragma unroll
    for (int j = 0; j < 4; ++j) { const f32x4 gv = *(const f32x4*)(g + 256 * j + 4 * lane), sh = *(const f32x4*)(shift + 256 * j + 4 * lane), sc = *(const f32x4*)(scale + 256 * j + 4 * lane);
        v[j] = (v[j] * rstd * gv) * (sc + 1.f) + sh; }
}
__device__ __forceinline__ void store_row_bf16(bf16_t* p, int lane, const f32x4 (&v)[4]) {
#pragma unroll
    for (int j = 0; j < 4; ++j) { u32x2 w; w.x = pk2(v[j][0], v[j][1]); w.y = pk2(v[j][2], v[j][3]); *(u32x2*)(p + 256 * j + 4 * lane) = w; }
}

__device__ __forceinline__ void p_norm1_l0(const Frame& F0) {
    const Frame F = relaunder(F0);
    const float* MOD = (const float*)(F.ws + WS_MOD); bf16_t* H = (bf16_t*)(F.ws + WS_H);
    for (int row = F.gw; row < TT; row += F.NGW) {
        const float* xin = row < TL ? in_ptr(F, 0) + (size_t)row * 1024 : in_ptr(F, 2) + (size_t)(row - TL) * 1024;
        const int mr = row < TL ? (row >> 12) : 8;
        f32x4 v[4]; load_row(xin, F.lane, v);
        norm_mod(v, in_ptr(F, 6), MOD + (size_t)mr * 6144, MOD + (size_t)mr * 6144 + 1024, F.lane);
        store_row_bf16(H + (size_t)row * 1024, F.lane, v);
    }
}

__device__ __forceinline__ void p_conv(const Frame& F0, const float* cw  ) {
    const Frame F = relaunder(F0);
    const bf16_t* P = (const bf16_t*)(F.ws + WS_P); bf16_t* ACG = (bf16_t*)(F.ws + WS_ACG);
    const int gt = F.gw * 64 + F.lane, NGT = F.NGW * 64;
    for (int it = gt; it < TT * 64; it += NGT) {
        const int row = it >> 6, c0 = (it & 63) * 8;
        bool hp, hn;
        if (row < TL) { const int s = row & 4095; hp = s > 0; hn = s < 4095; } else { const int s = (row - TL) & 255; hp = s > 0; hn = s < 255; }
        const bf16_t* pr = P + (size_t)row * PW;
        const u32x4 gb = *(const u32x4*)(pr + OCB + c0);
        const u32x4 c1 = *(const u32x4*)(pr + OCC + c0), x1 = *(const u32x4*)(pr + OCX + c0);
        u32x4 c0v = (u32x4){0u, 0u, 0u, 0u}, x0v = c0v, c2v = c0v, x2v = c0v;
        if (hp) { c0v = *(const u32x4*)(pr - PW + OCC + c0); x0v = *(const u32x4*)(pr - PW + OCX + c0); }
        if (hn) { c2v = *(const u32x4*)(pr + PW + OCC + c0); x2v = *(const u32x4*)(pr + PW + OCX + c0); }
        float o[8];
#pragma unroll
        for (int q = 0; q < 4; ++q) {
#pragma unroll
            for (int hh = 0; hh < 2; ++hh) { const int ch = c0 + 2 * q + hh;
                const float b = hh ? bfhi(gb[q]) : bflo(gb[q]);
                const float u0 = (hh ? bfhi(c0v[q]) : bflo(c0v[q])) * (hh ? bfhi(x0v[q]) : bflo(x0v[q]));
                const float u1 = (hh ? bfhi(c1[q]) : bflo(c1[q])) * (hh ? bfhi(x1[q]) : bflo(x1[q]));
                const float u2 = (hh ? bfhi(c2v[q]) : bflo(c2v[q])) * (hh ? bfhi(x2v[q]) : bflo(x2v[q]));
                o[2 * q + hh] = b * (cw[ch] * u0 + cw[512 + ch] * u1 + cw[1024 + ch] * u2); } }
        u32x4 w; w.x = pk2(o[0], o[1]); w.y = pk2(o[2], o[3]); w.z = pk2(o[4], o[5]); w.w = pk2(o[6], o[7]);
        *(u32x4*)(ACG + (size_t)row * 1024 + c0) = w;
    }
}
__device__ __forceinline__ int gla_row(int step, int b, int dir) {
    if (dir == 0) return step < 256 ? TL + b * 256 + step : b * 4096 + (step - 256);
    return step < 256 ? TL + b * 256 + (255 - step) : b * 4096 + (4095 - (step - 256));
}
__device__ __forceinline__ void p_gla_chain(const Frame& F0, const float* wa2  , const float* ba  , int chain) {
    const Frame F = relaunder(F0);
    const bf16_t* P = (const bf16_t*)(F.ws + WS_P); const float* GA = (const float*)(F.ws + WS_GA); float* OG = (float*)(F.ws + WS_OG);
    const int b = chain >> 3, h = (chain >> 1) & 3, dir = chain & 1;
    LAS float* Wa = (LAS float*)F.lds;
    LAS float* bav = Wa + 1024;
    LAS float* qs = bav + 64;
    LAS float* ks = qs + 1024;
    LAS float* egs = ks + 1024;
    LAS float* vs = egs + 1024;
    LAS float* po = vs + 2048;
    const int tid = F.tid, dkg = tid >> 7, dv = tid & 127;
    __syncthreads();
    for (int i = tid; i < 1024; i += NTHR) { const int r = i >> 6, dk = i & 63; Wa[i] = wa2[(size_t)(dir * 16 + r) * 256 + h * 64 + dk]; }
    if (tid < 64) bav[tid] = ba[dir * 256 + h * 64 + tid];
    float S[16];
#pragma unroll
    for (int i = 0; i < 16; ++i) S[i] = 0.f;
    for (int blk = 0; blk < 272; ++blk) {
        __syncthreads();
        for (int e = tid; e < 1024; e += NTHR) { const int tk = e >> 6, dk = e & 63; const int row = gla_row(blk * 16 + tk, b, dir);
            qs[e] = bf2f(P[(size_t)row * PW + OGQ + h * 64 + dk]);
            ks[e] = bf2f(P[(size_t)row * PW + OGK + h * 64 + dk]);
            float z = bav[dk]; const float* ga = GA + (size_t)row * 32 + dir * 16;
#pragma unroll
            for (int r = 0; r < 16; ++r) z += ga[r] * Wa[r * 64 + dk];
            const float ls = fminf(z, 0.f) - log1pf(__expf(-fabsf(z)));
            egs[e] = __expf(ls * (1.f / 16.f)); }
        for (int e = tid; e < 2048; e += NTHR) { const int tk = e >> 7, d = e & 127; const int row = gla_row(blk * 16 + tk, b, dir);
            vs[e] = bf2f(P[(size_t)row * PW + OGV + h * 128 + d]); }
        __syncthreads();
#pragma unroll 1
        for (int tk = 0; tk < 16; ++tk) {
            const float vv = vs[tk * 128 + dv]; float pacc = 0.f;
#pragma unroll
            for (int i = 0; i < 16; ++i) { const int dk = dkg * 16 + i; S[i] = egs[tk * 64 + dk] * S[i] + ks[tk * 64 + dk] * vv; pacc += qs[tk * 64 + dk] * S[i]; }
            po[(tk * 4 + dkg) * 128 + dv] = pacc;
        }
        __syncthreads();
        for (int e = tid; e < 2048; e += NTHR) { const int tk = e >> 7, d = e & 127; const int row = gla_row(blk * 16 + tk, b, dir);
            const float o = (po[(tk * 4 + 0) * 128 + d] + po[(tk * 4 + 1) * 128 + d]) + (po[(tk * 4 + 2) * 128 + d] + po[(tk * 4 + 3) * 128 + d]);
            OG[((size_t)dir * TT + row) * 512 + h * 128 + d] = o * 0.125f; }
    }
    __syncthreads();
}

__device__ __forceinline__ void p_attn_naive(const Frame& F0, int layer, const float* subg  ) {
    const Frame F = relaunder(F0);
    const bf16_t* P = (const bf16_t*)(F.ws + WS_P); bf16_t* AD = (bf16_t*)(F.ws + WS_AD);
    float* scr = (float*)(F.ws + WS_ASCR) + (size_t)blockIdx.x * 64 * 512;
    const float lam = __builtin_nontemporal_load((const float*)(F.ws + WS_LAM) + layer);
    const float lam_init = 0.8f - 0.6f * expf(-0.3f * (float)layer);
    LAS float* Ks = (LAS float*)F.lds;
    LAS float* Vs = Ks + 4096;
    LAS float* red = Vs + 8192;
    const int tid = F.tid, qr = tid & 255, half = tid >> 8;
    const int nunits = layer == 0 ? 1024 + 64 : 1024;
    for (int u = blockIdx.x; u < nunits; u += F.G) {
        const bool lat = u < 1024;
        int b, h, qrow0, ntiles;
        if (lat) { b = u >> 7; h = (u >> 4) & 7; qrow0 = b * 4096 + (u & 15) * 256; ntiles = 68; }
        else { const int v = u - 1024; b = v >> 3; h = v & 7; qrow0 = TL + b * 256; ntiles = 4; }
        const int qrow = qrow0 + qr;
        float O[64];
#pragma unroll 1
        for (int map = 1; map >= 0; --map) {
            float q[64];
            { const bf16_t* qp = P + (size_t)qrow * PW + OQ + h * 128 + map * 64;
#pragma unroll
              for (int c = 0; c < 8; ++c) { const u32x4 w = *(const u32x4*)(qp + 8 * c);
#pragma unroll
                  for (int e = 0; e < 4; ++e) { q[8 * c + 2 * e] = bflo(w[e]); q[8 * c + 2 * e + 1] = bfhi(w[e]); } asm volatile("" ::: "memory"); } }
            float mx = -1e30f, l = 0.f;
#pragma unroll
            for (int i = 0; i < 64; ++i) O[i] = 0.f;
#pragma unroll 1
            for (int t = 0; t < ntiles; ++t) {
                const int krow0 = (lat && t < 64) ? b * 4096 + t * 64 : TL + b * 256 + (t - (lat ? 64 : 0)) * 64;
                __syncthreads();
                { const int key = tid >> 3, ch = tid & 7; const u32x4 w = *(const u32x4*)(P + (size_t)(krow0 + key) * PW + OKK + h * 128 + map * 64 + ch * 8);
                  *(LAS f32x4*)(Ks + key * 64 + ch * 8) = (f32x4){bflo(w.x), bfhi(w.x), bflo(w.y), bfhi(w.y)};
                  *(LAS f32x4*)(Ks + key * 64 + ch * 8 + 4) = (f32x4){bflo(w.z), bfhi(w.z), bflo(w.w), bfhi(w.w)}; }
#pragma unroll
                for (int i2 = 0; i2 < 2; ++i2) { const int e = tid + i2 * 512, key = e >> 4, ch = e & 15; const u32x4 w = *(const u32x4*)(P + (size_t)(krow0 + key) * PW + OV + h * 128 + ch * 8);
                  *(LAS f32x4*)(Vs + key * 128 + ch * 8) = (f32x4){bflo(w.x), bfhi(w.x), bflo(w.y), bfhi(w.y)};
                  *(LAS f32x4*)(Vs + key * 128 + ch * 8 + 4) = (f32x4){bflo(w.z), bfhi(w.z), bflo(w.w), bfhi(w.w)}; }
                __syncthreads();
#pragma unroll 1
                for (int key = 0; key < 64; ++key) {
                    float s = 0.f;
#pragma unroll
                    for (int c = 0; c < 16; ++c) { const f32x4 kv = *(const LAS f32x4*)(Ks + key * 64 + 4 * c); s += (q[4 * c] * kv[0] + q[4 * c + 1] * kv[1]) + (q[4 * c + 2] * kv[2] + q[4 * c + 3] * kv[3]);
                        if ((c & 3) == 3) asm volatile("" ::: "memory"); }
                    const float mn = fmaxf(mx, s); const float alpha = __builtin_amdgcn_exp2f(mx - mn), p = __builtin_amdgcn_exp2f(s - mn);
                    l = l * alpha + p; mx = mn;
#pragma unroll
                    for (int c = 0; c < 16; ++c) { const f32x4 vv = *(const LAS f32x4*)(Vs + key * 128 + half * 64 + 4 * c);
                        O[4 * c] = O[4 * c] * alpha + p * vv[0]; O[4 * c + 1] = O[4 * c + 1] * alpha + p * vv[1]; O[4 * c + 2] = O[4 * c + 2] * alpha + p * vv[2]; O[4 * c + 3] = O[4 * c + 3] * alpha + p * vv[3];
                        if ((c & 3) == 3) asm volatile("" ::: "memory"); }
                }
            }
            const float inv = 1.f / l;
            if (map == 1) {
#pragma unroll
                for (int i = 0; i < 16; ++i) { *(f32x4*)(scr + tid * 64 + 4 * i) = (f32x4){O[4 * i] * inv, O[4 * i + 1] * inv, O[4 * i + 2] * inv, O[4 * i + 3] * inv}; if ((i & 3) == 3) asm volatile("" ::: "memory"); }
            } else {
#pragma unroll
                for (int i = 0; i < 16; ++i) { const f32x4 t = __builtin_nontemporal_load((const f32x4*)(scr + tid * 64 + 4 * i));
                    O[4 * i] = O[4 * i] * inv - lam * t[0]; O[4 * i + 1] = O[4 * i + 1] * inv - lam * t[1]; O[4 * i + 2] = O[4 * i + 2] * inv - lam * t[2]; O[4 * i + 3] = O[4 * i + 3] * inv - lam * t[3];
                    if ((i & 3) == 3) asm volatile("" ::: "memory"); }
            }
        }
        float ss = 0.f;
#pragma unroll
        for (int i = 0; i < 64; ++i) ss += O[i] * O[i];
        __syncthreads();
        red[tid] = ss;
        __syncthreads();
        const float tot = red[qr] + red[qr + 256];
        const float r = (1.f - lam_init) / sqrtf(tot * (1.f / 128.f) + RMS_EPS);
        bf16_t* op = AD + (size_t)qrow * 1024 + h * 128 + half * 64;
#pragma unroll
        for (int c = 0; c < 8; ++c) { u32x4 w;
            w.x = pk2(O[8 * c] * r * subg[half * 64 + 8 * c], O[8 * c + 1] * r * subg[half * 64 + 8 * c + 1]);
            w.y = pk2(O[8 * c + 2] * r * subg[half * 64 + 8 * c + 2], O[8 * c + 3] * r * subg[half * 64 + 8 * c + 3]);
            w.z = pk2(O[8 * c + 4] * r * subg[half * 64 + 8 * c + 4], O[8 * c + 5] * r * subg[half * 64 + 8 * c + 5]);
            w.w = pk2(O[8 * c + 6] * r * subg[half * 64 + 8 * c + 6], O[8 * c + 7] * r * subg[half * 64 + 8 * c + 7]);
            *(u32x4*)(op + 8 * c) = w; asm volatile("" ::: "memory"); }
    }
    __syncthreads();
}

__device__ __forceinline__ void p_gla_tail(const Frame& F0, const float* gng  , int nrows) {
    const Frame F = relaunder(F0);
    const bf16_t* P = (const bf16_t*)(F.ws + WS_P); const float* OG = (const float*)(F.ws + WS_OG); bf16_t* ACG = (bf16_t*)(F.ws + WS_ACG);
    for (int row = F.gw; row < nrows; row += F.NGW) {
        const int c0 = F.lane * 8;
        const float* o0 = OG + (size_t)row * 512 + c0; const float* o1 = OG + ((size_t)TT + row) * 512 + c0;
        f32x4 a = *(const f32x4*)o0 + *(const f32x4*)o1, b = *(const f32x4*)(o0 + 4) + *(const f32x4*)(o1 + 4);
        float ss = (a[0] * a[0] + a[1] * a[1]) + (a[2] * a[2] + a[3] * a[3]) + (b[0] * b[0] + b[1] * b[1]) + (b[2] * b[2] + b[3] * b[3]);
        ss += __shfl_xor(ss, 1); ss += __shfl_xor(ss, 2); ss += __shfl_xor(ss, 4); ss += __shfl_xor(ss, 8);
        const float rstd = 1.f / sqrtf(ss * (1.f / 128.f) + RMS_EPS);
        const f32x4 g0 = *(const f32x4*)(gng + (c0 & 127)), g1 = *(const f32x4*)(gng + (c0 & 127) + 4);
        const u32x4 rw = *(const u32x4*)(P + (size_t)row * PW + OGR + c0);
        float rr[8] = {bflo(rw.x), bfhi(rw.x), bflo(rw.y), bfhi(rw.y), bflo(rw.z), bfhi(rw.z), bflo(rw.w), bfhi(rw.w)};
        float o[8];
#pragma unroll
        for (int i = 0; i < 4; ++i) { const float y0 = a[i] * rstd * g0[i], y1 = b[i] * rstd * g1[i];
            o[i] = y0 * (rr[i] * sigmoidf_(rr[i])); o[4 + i] = y1 * (rr[4 + i] * sigmoidf_(rr[4 + i])); }
        u32x4 w; w.x = pk2(o[0], o[1]); w.y = pk2(o[2], o[3]); w.z = pk2(o[4], o[5]); w.w = pk2(o[6], o[7]);
        *(u32x4*)(ACG + (size_t)row * 1024 + 512 + c0) = w;
    }
}

__device__ __forceinline__ void p_norm2_router(const Frame& F0, int layer, int Tm) {
    const Frame F = relaunder(F0);
    const float* MOD = (const float*)(F.ws + WS_MOD) + (size_t)layer * 9 * 6144; bf16_t* H = (bf16_t*)(F.ws + WS_H); const float* XW = (const float*)(F.ws + WS_XW);
    unsigned char* rt = F.ws + WS_ROUTE + layer * ROUTE_STRIDE;
    int* TOPI = (int*)(rt + R_TOPI); float* TOPG = (float*)(rt + R_TOPG); int* CNT = (int*)(rt + R_CNT);
    const float* rw = in_ptr(F, 19) + (size_t)layer * 1024 * 32; const float* rb = in_ptr(F, 20) + layer * 32; const float* g2n = in_ptr(F, 7) + layer * 1024;
    LAS float* WT = (LAS float*)F.lds;
    LAS float* lg = (LAS float*)(F.lds + 132096) + F.wave * 32;
    LAS float* selv = (LAS float*)(F.lds + 132096 + 1024) + F.wave * 8;
    LAS int* hist = (LAS int*)(F.lds + 132096 + 2048);
    __syncthreads();
    for (int i = F.tid; i < 32768; i += NTHR) { const int k = i >> 5, e = i & 31; WT[e * 1028 + k] = rw[i]; }
    if (F.tid < 32) hist[F.tid] = 0;
    __syncthreads();
    const int RPW = Tm / F.G;
    for (int ri = F.wave; ri < RPW; ri += NWAVES) {
        const int row = blockIdx.x * RPW + ri; const int mr = row < TL ? (row >> 12) : 8;
        f32x4 v[4]; load_row(XW + (size_t)row * 1024, F.lane, v);
        norm_mod(v, g2n, MOD + (size_t)mr * 6144 + 3072, MOD + (size_t)mr * 6144 + 4096, F.lane);
        store_row_bf16(H + (size_t)row * 1024, F.lane, v);
        float p[32];
#pragma unroll
        for (int e = 0; e < 32; ++e) { float s = 0.f;
#pragma unroll
            for (int j = 0; j < 4; ++j) { const f32x4 w = *(const LAS f32x4*)(WT + e * 1028 + 256 * j + 4 * F.lane); s += (v[j][0] * w[0] + v[j][1] * w[1]) + (v[j][2] * w[2] + v[j][3] * w[3]); }
            p[e] = s; }
#pragma unroll
        for (int i = 0; i < 16; ++i) { const bool up = (F.lane & 32) != 0; const float send = up ? p[i] : p[i + 16], keep = up ? p[i + 16] : p[i]; p[i] = keep + __shfl_xor(send, 32); }
#pragma unroll
        for (int i = 0; i < 8; ++i) { const bool up = (F.lane & 16) != 0; const float send = up ? p[i] : p[i + 8], keep = up ? p[i + 8] : p[i]; p[i] = keep + __shfl_xor(send, 16); }
#pragma unroll
        for (int i = 0; i < 4; ++i) { const bool up = (F.lane & 8) != 0; const float send = up ? p[i] : p[i + 4], keep = up ? p[i + 4] : p[i]; p[i] = keep + __shfl_xor(send, 8); }
#pragma unroll
        for (int i = 0; i < 2; ++i) { const bool up = (F.lane & 4) != 0; const float send = up ? p[i] : p[i + 2], keep = up ? p[i + 2] : p[i]; p[i] = keep + __shfl_xor(send, 4); }
        { const bool up = (F.lane & 2) != 0; const float send = up ? p[0] : p[1], keep = up ? p[1] : p[0]; p[0] = keep + __shfl_xor(send, 2); }
        const int ex = F.lane >> 1;
        const float logit = p[0] + __shfl_xor(p[0], 1) + rb[ex];
        if ((F.lane & 1) == 0) lg[ex] = logit;
        LDS_WAIT(); asm volatile("" ::: "memory");
        int rank = 0;
#pragma unroll
        for (int e = 0; e < 32; ++e) { const float o = lg[e]; rank += (o > logit || (o == logit && e < ex)) ? 1 : 0; }
        if ((F.lane & 1) == 0 && rank < 4) { selv[rank * 2] = logit; selv[rank * 2 + 1] = __builtin_bit_cast(float, ex); }
        LDS_WAIT(); asm volatile("" ::: "memory");
        const float v0 = selv[0], v1 = selv[2], v2 = selv[4], v3 = selv[6];
        const float e0 = 1.f, e1 = __expf(v1 - v0), e2 = __expf(v2 - v0), e3 = __expf(v3 - v0); const float inv = 1.f / (e0 + e1 + e2 + e3);
        if (F.lane < 4) { const int ej = __builtin_bit_cast(int, selv[F.lane * 2 + 1]); const float gj = (F.lane == 0 ? e0 : F.lane == 1 ? e1 : F.lane == 2 ? e2 : e3) * inv;
            TOPI[(size_t)row * 4 + F.lane] = ej; TOPG[(size_t)row * 4 + F.lane] = gj; __hip_atomic_fetch_add(hist + ej, 1, __ATOMIC_RELAXED, __HIP_MEMORY_SCOPE_WORKGROUP); }
        LDS_WAIT(); asm volatile("" ::: "memory");
    }
    __syncthreads();
    if (F.tid < 32) CNT[blockIdx.x * 32 + F.tid] = hist[F.tid];
}

__device__ __forceinline__ void p_route_gather(const Frame& F0, int layer, int Tm) {
    const Frame F = relaunder(F0);
    unsigned char* rt = F.ws + WS_ROUTE + layer * ROUTE_STRIDE;
    const int* TOPI = (const int*)(rt + R_TOPI); int* POSOF = (int*)(rt + R_POSOF); int* ROWTOK = (int*)(rt + R_ROWTOK); const int* CNT = (const int*)(rt + R_CNT);
    int* TILEEXP = (int*)(rt + R_TILEEXP); int* NT = (int*)(rt + R_NT);
    const bf16_t* H = (const bf16_t*)(F.ws + WS_H); bf16_t* XS = (bf16_t*)(F.ws + WS_XS);
    LAS int* tot = (LAS int*)F.lds;
    LAS int* mine = tot + 32;
    LAS int* pst = mine + 32;
    LAS int* es = pst + 64;
    LAS int* ps = es + 1024;
    const int RPW = Tm / F.G, NP = RPW * 4;
    __syncthreads();
    if (F.tid < 32) { int t = 0, m = 0; for (int w = 0; w < F.G; ++w) { const int c = __builtin_nontemporal_load(CNT + w * 32 + F.tid); t += c; if (w < (int)blockIdx.x) m += c; } tot[F.tid] = t; mine[F.tid] = m; }
    for (int i = F.tid; i < NP; i += NTHR) es[i] = __builtin_nontemporal_load(TOPI + (size_t)blockIdx.x * NP + i);
    __syncthreads();
    if (F.tid == 0) { int s = 0; for (int e = 0; e < 32; ++e) { pst[e] = s; s += (tot[e] + 255) & ~255; } pst[32] = s; }
    __syncthreads();
    for (int i = F.tid; i < NP; i += NTHR) { const int e = es[i]; int r = 0; for (int j = 0; j < i; ++j) r += (es[j] == e) ? 1 : 0;
        const int pos = pst[e] + mine[e] + r; ps[i] = pos; const int tok = blockIdx.x * RPW + (i >> 2);
        ROWTOK[pos] = tok; POSOF[(size_t)tok * 4 + (i & 3)] = pos; }
    const int ntiles = pst[32] >> 8;
    if (blockIdx.x == 0) { for (int t = F.tid; t < ntiles; t += NTHR) { int e = 0; for (int q = 0; q < 32; ++q) if (pst[q] <= t * 256) e = q; TILEEXP[t] = e; }
        if (F.tid == 0) NT[0] = ntiles; }
    __syncthreads();
    for (int i = F.wave; i < NP; i += NWAVES) { const int tok = blockIdx.x * RPW + (i >> 2); const int pos = ps[i];
        const u32x4* src = (const u32x4*)(H + (size_t)tok * 1024); u32x4* dst = (u32x4*)(XS + (size_t)pos * 1024);
        dst[F.lane] = src[F.lane]; dst[64 + F.lane] = src[64 + F.lane]; }
    if (blockIdx.x < 32) { const int e = blockIdx.x; const int r0 = pst[e] + tot[e], r1 = pst[e + 1];
        for (int r = r0 + F.wave; r < r1; r += NWAVES) { u32x4* dst = (u32x4*)(XS + (size_t)r * 1024); dst[F.lane] = (u32x4){0u, 0u, 0u, 0u}; dst[64 + F.lane] = (u32x4){0u, 0u, 0u, 0u}; if (F.lane == 0) ROWTOK[r] = 0; } }
}

__device__ __forceinline__ void p_combine(const Frame& F0, int layer, int Tm) {
    const Frame F = relaunder(F0);
    const float* MODL = (const float*)(F.ws + WS_MOD) + (size_t)layer * 9 * 6144;
    const float* MODN = (const float*)(F.ws + WS_MOD) + (size_t)(layer + 1) * 9 * 6144;
    unsigned char* rt = F.ws + WS_ROUTE + layer * ROUTE_STRIDE;
    const int* POSOF = (const int*)(rt + R_POSOF); const float* TOPG = (const float*)(rt + R_TOPG);
    const bf16_t* YY = (const bf16_t*)(F.ws + WS_XS); float* XW = (float*)(F.ws + WS_XW); bf16_t* H = (bf16_t*)(F.ws + WS_H);
    const bool last = layer == 1;
    for (int row = F.gw; row < Tm; row += F.NGW) {
        const int mr = row < TL ? (row >> 12) : 8;
        f32x4 v[4]; load_row(XW + (size_t)row * 1024, F.lane, v);
        f32x4 y[4];
#pragma unroll
        for (int j = 0; j < 4; ++j) y[j] = (f32x4){0.f, 0.f, 0.f, 0.f};
#pragma unroll
        for (int s = 0; s < 4; ++s) { const int pos = __builtin_nontemporal_load(POSOF + (size_t)row * 4 + s); const float gt = __builtin_nontemporal_load(TOPG + (size_t)row * 4 + s);
            const bf16_t* yp = YY + (size_t)pos * 1024;
#pragma unroll
            for (int j = 0; j < 4; ++j) { const u32x2 w = *(const u32x2*)(yp + 256 * j + 4 * F.lane); y[j] = y[j] + gt * (f32x4){bflo(w.x), bfhi(w.x), bflo(w.y), bfhi(w.y)}; } }
        const float* g2 = MODL + (size_t)mr * 6144 + 5120;
#pragma unroll
        for (int j = 0; j < 4; ++j) v[j] = v[j] + *(const f32x4*)(g2 + 256 * j + 4 * F.lane) * y[j];
        if (!last) {
#pragma unroll
            for (int j = 0; j < 4; ++j) *(f32x4*)(XW + (size_t)row * 1024 + 256 * j + 4 * F.lane) = v[j];
            norm_mod(v, in_ptr(F, 6) + 1024, MODN + (size_t)mr * 6144, MODN + (size_t)mr * 6144 + 1024, F.lane);
            store_row_bf16(H + (size_t)row * 1024, F.lane, v);
        } else {
            const float rstd = row_rstd(v);
#pragma unroll
            for (int j = 0; j < 4; ++j) *(f32x4*)(out_ptr(F) + (size_t)row * 1024 + 256 * j + 4 * F.lane) = v[j] * rstd * *(const f32x4*)(in_ptr(F, 25) + 256 * j + 4 * F.lane);
        }
    }
}
typedef float f32x16 __attribute__((ext_vector_type(16)));
typedef short bf16x8 __attribute__((ext_vector_type(8)));

constexpr int VT_PITCH = 4352;
__device__ __forceinline__ void p_vt(const Frame& F0) {
    const Frame F = relaunder(F0);
    const bf16_t* P = (const bf16_t*)(F.ws + WS_P); bf16_t* VT = (bf16_t*)(F.ws + WS_VT);
    LAS bf16_t* T = (LAS bf16_t*)F.lds;
    for (int it = blockIdx.x; it < 8 * 8 * 68; it += F.G) {
        const int b = it / 544, rem = it % 544, h = rem / 68, t = rem % 68;
        const int row0 = t < 64 ? b * 4096 + 64 * t : TL + b * 256 + 64 * (t - 64);
        __syncthreads();
#pragma unroll
        for (int i = 0; i < 2; ++i) { const int e = F.tid + 512 * i, key = e >> 4, ch = e & 15;
            const u32x4 w = *(const u32x4*)(P + (size_t)(row0 + key) * PW + OV + h * 128 + ch * 8);
            const int kvo = key & 15, q4 = kvo >> 2; const int pos = (key & ~15) + ((q4 == 1) ? 8 : (q4 == 2) ? 4 : q4 * 4) + (kvo & 3);
#pragma unroll
            for (int j = 0; j < 4; ++j) { T[(ch * 8 + 2 * j) * 72 + pos] = (bf16_t)(w[j] & 0xffffu); T[(ch * 8 + 2 * j + 1) * 72 + pos] = (bf16_t)(w[j] >> 16); } }
        __syncthreads();
#pragma unroll
        for (int i = 0; i < 2; ++i) { const int e = F.tid + 512 * i, dvr = e >> 3, ch = e & 7;
            const u32x4 w = *(const LAS u32x4*)(T + dvr * 72 + ch * 8);
            *(u32x4*)(VT + ((size_t)(b * 8 + h) * 128 + dvr) * VT_PITCH + t * 64 + ch * 8) = w; }
    }
    __syncthreads();
}

__device__ __forceinline__ unsigned cvt_pk(float lo, float hi) { unsigned r; asm volatile("v_cvt_pk_bf16_f32 %0, %1, %2" : "=v"(r) : "v"(lo), "v"(hi)); return r; }

constexpr int AK_STRIDE = 272, AV_STRIDE = 144, AK_BYTES = 64 * AK_STRIDE, AV_BYTES = 128 * AV_STRIDE;
__device__ __forceinline__ void attn_unit(const Frame& F, int u, float lam, float osc, const float* subg) {
    const bf16_t* P = (const bf16_t*)(F.ws + WS_P); const bf16_t* VT = (const bf16_t*)(F.ws + WS_VT); bf16_t* AD = (bf16_t*)(F.ws + WS_AD);
    const int map = F.wave >> 2, rb = F.wave & 3, q = F.lane & 31, hi = F.lane >> 5;
    int b, h, qrow0, t0; const int t1 = 68;
    if (u < 2048) { b = u >> 8; h = (u >> 5) & 7; qrow0 = b * 4096 + (u & 31) * 128; t0 = 0; }
    else { const int v = u - 2048; b = v >> 4; h = (v >> 1) & 7; qrow0 = TL + b * 256 + (v & 1) * 128; t0 = 64; }
    const int qrow = qrow0 + rb * 32 + q;
    bf16x8 qf[4];
#pragma unroll
    for (int ks = 0; ks < 4; ++ks) qf[ks] = *(const bf16x8*)(P + (size_t)qrow * PW + OQ + h * 128 + map * 64 + 16 * ks + 8 * hi);
    f32x16 O[4];
#pragma unroll
    for (int d = 0; d < 4; ++d)
#pragma unroll
        for (int r = 0; r < 16; ++r) O[d][r] = 0.f;
    float mrun = -1e30f, lrun = 0.f;
    const int e0 = F.tid, e1 = F.tid + 512;
    const int kkey0 = e0 >> 4, kch0 = e0 & 15, kkey1 = e1 >> 4, kch1 = e1 & 15;
    const int vdv0 = e0 >> 3, vch0 = e0 & 7, vdv1 = e1 >> 3, vch1 = e1 & 7;
    const bf16_t* vbase = VT + (size_t)(b * 8 + h) * 128 * VT_PITCH;
    u32x4 kr0, kr1, vr0, vr1;
#define ATT_LOAD(t) do { const int krow0_ = (t) < 64 ? b * 4096 + 64 * (t) : TL + b * 256 + 64 * ((t) - 64); \
        kr0 = *(const u32x4*)(P + (size_t)(krow0_ + kkey0) * PW + OKK + h * 128 + kch0 * 8); kr1 = *(const u32x4*)(P + (size_t)(krow0_ + kkey1) * PW + OKK + h * 128 + kch1 * 8); \
        vr0 = *(const u32x4*)(vbase + (size_t)vdv0 * VT_PITCH + (t) * 64 + vch0 * 8); vr1 = *(const u32x4*)(vbase + (size_t)vdv1 * VT_PITCH + (t) * 64 + vch1 * 8); } while (0)
#define ATT_STORE(buf) do { LAS unsigned char* kb_ = F.lds + (buf) * AK_BYTES; LAS unsigned char* vb_ = F.lds + 2 * AK_BYTES + (buf) * AV_BYTES; \
        *(LAS u32x4*)(kb_ + kkey0 * AK_STRIDE + kch0 * 16) = kr0; *(LAS u32x4*)(kb_ + kkey1 * AK_STRIDE + kch1 * 16) = kr1; \
        *(LAS u32x4*)(vb_ + vdv0 * AV_STRIDE + vch0 * 16) = vr0; *(LAS u32x4*)(vb_ + vdv1 * AV_STRIDE + vch1 * 16) = vr1; } while (0)
    ATT_LOAD(t0);
    __syncthreads();
    ATT_STORE(0);
    __syncthreads();
#pragma unroll 1
    for (int t = t0; t < t1; ++t) {
        const int cur = (t - t0) & 1;
        if (t + 1 < t1) ATT_LOAD(t + 1);
        const LAS unsigned char* kb = F.lds + cur * AK_BYTES + q * AK_STRIDE + map * 128 + hi * 16;
        const LAS unsigned char* vb = F.lds + 2 * AK_BYTES + cur * AV_BYTES + q * AV_STRIDE + hi * 16;
        f32x16 s0, s1;
#pragma unroll
        for (int r = 0; r < 16; ++r) { s0[r] = 0.f; s1[r] = 0.f; }
#pragma unroll
        for (int ks = 0; ks < 4; ++ks) {
            const bf16x8 a0 = *(const LAS bf16x8*)(kb + ks * 32), a1 = *(const LAS bf16x8*)(kb + 32 * AK_STRIDE + ks * 32);
            s0 = __builtin_amdgcn_mfma_f32_32x32x16_bf16(a0, qf[ks], s0, 0, 0, 0);
            s1 = __builtin_amdgcn_mfma_f32_32x32x16_bf16(a1, qf[ks], s1, 0, 0, 0);
        }
        float mx = fmaxf(s0[0], s1[0]);
#pragma unroll
        for (int r = 1; r < 16; ++r) mx = fmaxf(mx, fmaxf(s0[r], s1[r]));
        mx = fmaxf(mx, __shfl_xor(mx, 32));
        const float mn = fmaxf(mrun, mx); const float alpha = __builtin_amdgcn_exp2f(mrun - mn); mrun = mn;
        float ls = 0.f;
#pragma unroll
        for (int r = 0; r < 16; ++r) { s0[r] = __builtin_amdgcn_exp2f(s0[r] - mn); s1[r] = __builtin_amdgcn_exp2f(s1[r] - mn); ls += s0[r] + s1[r]; }
        lrun = lrun * alpha + ls;
#pragma unroll
        for (int d = 0; d < 4; ++d)
#pragma unroll
            for (int r = 0; r < 16; ++r) O[d][r] *= alpha;
        bf16x8 pf[4];
#pragma unroll
        for (int s = 0; s < 4; ++s) { u32x4 w;
#pragma unroll
            for (int j = 0; j < 4; ++j) { const int r = 8 * (s & 1) + 2 * j; w[j] = (s < 2) ? cvt_pk(s0[r], s0[r + 1]) : cvt_pk(s1[r], s1[r + 1]); }
            pf[s] = __builtin_bit_cast(bf16x8, w); }
#pragma unroll
        for (int d = 0; d < 4; ++d)
#pragma unroll
            for (int s = 0; s < 4; ++s) { const bf16x8 a = *(const LAS bf16x8*)(vb + d * 32 * AV_STRIDE + s * 32);
                O[d] = __builtin_amdgcn_mfma_f32_32x32x16_bf16(a, pf[s], O[d], 0, 0, 0); }
        if (t + 1 < t1) ATT_STORE(cur ^ 1);
        __syncthreads();
    }
#undef ATT_LOAD
#undef ATT_STORE
    const float inv = 1.f / (lrun + __shfl_xor(lrun, 32));
    LAS float* xb = (LAS float*)F.lds;
    if (map == 1) {
#pragma unroll
        for (int d = 0; d < 4; ++d)
#pragma unroll
            for (int r = 0; r < 16; ++r) { const int dv = 32 * d + (r & 3) + 8 * (r >> 2) + 4 * hi; xb[(rb * 128 + dv) * 32 + q] = O[d][r] * inv; }
    }
    __syncthreads();
    if (map == 0) {
        float ss = 0.f;
#pragma unroll
        for (int d = 0; d < 4; ++d)
#pragma unroll
            for (int r = 0; r < 16; ++r) { const int dv = 32 * d + (r & 3) + 8 * (r >> 2) + 4 * hi; const float o = O[d][r] * inv - lam * xb[(rb * 128 + dv) * 32 + q]; O[d][r] = o; ss += o * o; }
        ss += __shfl_xor(ss, 32);
        const float rs = osc / sqrtf(ss * (1.f / 128.f) + RMS_EPS);
        bf16_t* op = AD + (size_t)qrow * 1024 + h * 128;
#pragma unroll
        for (int d = 0; d < 4; ++d)
#pragma unroll
            for (int g = 0; g < 4; ++g) { const int dv = 32 * d + 8 * g + 4 * hi; const f32x4 gv = *(const f32x4*)(subg + dv);
                u32x2 w; w.x = pk2(O[d][4 * g] * rs * gv[0], O[d][4 * g + 1] * rs * gv[1]); w.y = pk2(O[d][4 * g + 2] * rs * gv[2], O[d][4 * g + 3] * rs * gv[3]);
                *(u32x2*)(op + dv) = w; }
    }
}

__device__ __forceinline__ void p_gla_chain2(const Frame& F, const float* wa2  , const float* ba  , int chain) {
    const bf16_t* P = (const bf16_t*)(F.ws + WS_P); const float* GA = (const float*)(F.ws + WS_GA); float* OG = (float*)(F.ws + WS_OG);
    const int b = chain >> 4, h = (chain >> 2) & 3, dir = (chain >> 1) & 1, vh = chain & 1;
    LAS float* Wa = (LAS float*)F.lds;
    LAS float* bav = Wa + 1024;
    LAS float* gas = bav + 64;
    LAS float* qs = gas + 256;
    LAS float* ks = qs + 1024;
    LAS float* egs = ks + 1024;
    LAS float* vs = egs + 1024;
    LAS float* po = vs + 1024;
    const int tid = F.tid, dkg = tid >> 6, dv = tid & 63;
    __syncthreads();
    for (int i = tid; i < 1024; i += NTHR) { const int r = i >> 6, dk = i & 63; Wa[i] = wa2[(size_t)(dir * 16 + r) * 256 + h * 64 + dk]; }
    if (tid < 64) bav[tid] = ba[dir * 256 + h * 64 + tid];
    float S[8];
#pragma unroll
    for (int i = 0; i < 8; ++i) S[i] = 0.f;
    const int role = tid >> 7, li = tid & 127, ltk = li >> 3, lch = li & 7;
    u32x4 ld; f32x4 lda_ = (f32x4){0.f, 0.f, 0.f, 0.f};
#define GLA_LOAD(blk) do { const int row_ = gla_row((blk) * 16 + ltk, b, dir); \
        if (role == 0) ld = *(const u32x4*)(P + (size_t)row_ * PW + OGQ + h * 64 + lch * 8); \
        else if (role == 1) ld = *(const u32x4*)(P + (size_t)row_ * PW + OGK + h * 64 + lch * 8); \
        else if (role == 2) ld = *(const u32x4*)(P + (size_t)row_ * PW + OGV + h * 128 + vh * 64 + lch * 8); \
        else if (li < 64) { const int row2_ = gla_row((blk) * 16 + (li >> 2), b, dir); lda_ = *(const f32x4*)(GA + (size_t)row2_ * 32 + dir * 16 + (li & 3) * 4); } } while (0)
    GLA_LOAD(0);
    for (int blk = 0; blk < 272; ++blk) {
        __syncthreads();
        if (role < 3) { LAS float* dst = (role == 0 ? qs : role == 1 ? ks : vs) + ltk * 64 + lch * 8;
            *(LAS f32x4*)dst = (f32x4){bflo(ld.x), bfhi(ld.x), bflo(ld.y), bfhi(ld.y)}; *(LAS f32x4*)(dst + 4) = (f32x4){bflo(ld.z), bfhi(ld.z), bflo(ld.w), bfhi(ld.w)}; }
        else if (li < 64) *(LAS f32x4*)(gas + (li >> 2) * 16 + (li & 3) * 4) = lda_;
        if (blk + 1 < 272) GLA_LOAD(blk + 1);
        __syncthreads();
        for (int e = tid; e < 1024; e += NTHR) { const int tk = e >> 6, dk = e & 63; float z = bav[dk];
#pragma unroll
            for (int r = 0; r < 16; ++r) z += gas[tk * 16 + r] * Wa[r * 64 + dk];
            const float ls = fminf(z, 0.f) - log1pf(__expf(-fabsf(z)));
            egs[e] = __expf(ls * (1.f / 16.f)); }
        __syncthreads();
#pragma unroll 1
        for (int tk = 0; tk < 16; ++tk) {
            const float vv = vs[tk * 64 + dv]; float pacc = 0.f;
            const f32x4 e0 = *(const LAS f32x4*)(egs + tk * 64 + dkg * 8), e1 = *(const LAS f32x4*)(egs + tk * 64 + dkg * 8 + 4);
            const f32x4 k0 = *(const LAS f32x4*)(ks + tk * 64 + dkg * 8), k1 = *(const LAS f32x4*)(ks + tk * 64 + dkg * 8 + 4);
            const f32x4 q0 = *(const LAS f32x4*)(qs + tk * 64 + dkg * 8), q1 = *(const LAS f32x4*)(qs + tk * 64 + dkg * 8 + 4);
#pragma unroll
            for (int i = 0; i < 4; ++i) { S[i] = e0[i] * S[i] + k0[i] * vv; pacc += q0[i] * S[i]; S[4 + i] = e1[i] * S[4 + i] + k1[i] * vv; pacc += q1[i] * S[4 + i]; }
            po[(tk * 8 + dkg) * 64 + dv] = pacc;
        }
        __syncthreads();
        for (int e = tid; e < 1024; e += NTHR) { const int tk = e >> 6, d = e & 63; const int row = gla_row(blk * 16 + tk, b, dir);
            float o = 0.f;
#pragma unroll
            for (int g = 0; g < 8; ++g) o += po[(tk * 8 + g) * 64 + d];
            OG[((size_t)dir * TT + row) * 512 + h * 128 + vh * 64 + d] = o * 0.125f; }
    }
#undef GLA_LOAD
    __syncthreads();
}

__device__ __forceinline__ void p_attn_phase(const Frame& F0, int layer) {
    const Frame F = relaunder(F0);
    if (blockIdx.x < 128) p_gla_chain2(F, in_ptr(F, 14) + (size_t)layer * 2 * 16 * 256, in_ptr(F, 15) + (size_t)layer * 2 * 256, (int)blockIdx.x);
    const float lam = __builtin_nontemporal_load((const float*)(F.ws + WS_LAM) + layer);
    const float osc = 1.f - (0.8f - 0.6f * expf(-0.3f * (float)layer));
    const float* subg = in_ptr(F, 10) + (size_t)layer * 128;
    const int nunits = layer == 0 ? 2048 + 128 : 2048;
    unsigned* qctr = (unsigned*)(F.ws + WS_CTL) + 8192 + 64 * layer;
    volatile LAS int* ubox = (volatile LAS int*)(F.lds + MISC_OFF + 128);
    for (;;) {
        __syncthreads();
        if (F.tid == 0) ubox[0] = (int)__hip_atomic_fetch_add(qctr, 1u, __ATOMIC_RELAXED, __HIP_MEMORY_SCOPE_AGENT);
        __syncthreads();
        const int u = __builtin_amdgcn_readfirstlane(ubox[0]);
        if (u >= nunits) break;
        attn_unit(F, u, lam, osc, subg);
    }
    __syncthreads();
}
__global__ void __launch_bounds__(NTHR, 2) fwd(Args args) {
    extern __shared__ __attribute__((aligned(16))) unsigned char lds_raw[];
    Frame F;
    F.lds = (LAS unsigned char*)lds_raw; F.ws = args.ws;
    F.tid = threadIdx.x; F.lane = F.tid & 63; F.wave = __builtin_amdgcn_readfirstlane(F.tid >> 6);
    F.G = gridDim.x; F.gw = blockIdx.x * NWAVES + F.wave; F.NGW = F.G * NWAVES;
    volatile LAS unsigned* MISC = (volatile LAS unsigned*)(F.lds + MISC_OFF);
    if (F.tid < 64) MISC[F.tid] = 0u;
    if (F.tid < 27) ((volatile LAS unsigned long long*)(F.lds + PTR_OFF))[F.tid] = (unsigned long long)(F.tid < 26 ? (const void*)args.in[F.tid] : (const void*)args.out);
    __syncthreads();
    XcdBarrier bar; bar.bar = (unsigned*)(args.ws + WS_CTL) + 4096; bar.x = 0; bar.st = nullptr;
    if (N_LAUNCH_MODE == 1) bar = xcd_barrier_post((unsigned*)(args.ws + WS_CTL) + 4096, MISC + 8);
    const int lo = args.ph_lo, hi = args.ph_hi;
#ifndef DISABLE_MASK
#define DISABLE_MASK 0
#endif
#define EN(k) (!((DISABLE_MASK >> (k)) & 1))
#define IN(k) (lo <= (k) && (k) < hi)
#define SEAM(k) do { if (IN(k) && IN((k) + 1)) xcd_barrier(bar); } while (0)
    unsigned char* ws = args.ws;

    if (EN(12) && IN(0)) { p0_prologue(F); } SEAM(0);

#pragma unroll
    for (int L = 0; L < 2; ++L) {
        const int pb = 1 + 12 * L; const bool lastL = (L == 1);
        const int Tm = lastL ? TL : TT;
        const float* MODL = (const float*)(ws + WS_MOD) + (size_t)L * 9 * 6144;
        if (EN(0) && IN(pb + 0)) { if (L == 0) p_norm1_l0(F); } SEAM(pb + 0);
        if (EN(1) && IN(pb + 1)) {
            pg8::Gemm g{(const bf16_t*)(ws + WS_H), (const bf16_t*)(ws + WS_WIN + L * WIN_STRIDE), 1024, 1024, 1024};
            pg8::StaticOrder S; S.init(TT, NIN, F.G, (int)blockIdx.x);
            EpiIn E{(bf16_t*)(ws + WS_P), (float*)(ws + WS_GA), (const float*)(ws + WS_ROPE), (const float*)(ws + WS_ROPE) + 1024};
            pg8::gemm_phase<EpiIn, pg8::StaticOrder, true, true>(F.lds, g, S, E);
        } SEAM(pb + 1);
        if (EN(2) && IN(pb + 2)) {
            p_conv(F, in_ptr(F, 12) + (size_t)L * 3 * 512);
#if ATTN_IMPL == 0
            if (blockIdx.x < 64) p_gla_chain(F, in_ptr(F, 14) + (size_t)L * 2 * 16 * 256, in_ptr(F, 15) + (size_t)L * 2 * 256, (int)blockIdx.x);
#else
            p_vt(F);
#endif
        } SEAM(pb + 2);
#if ATTN_IMPL == 0
        if (EN(3) && IN(pb + 3)) { p_attn_naive(F, L, in_ptr(F, 10) + (size_t)L * 128); } SEAM(pb + 3);
#else
        if (EN(3) && IN(pb + 3)) { p_attn_phase(F, L); } SEAM(pb + 3);
#endif
        if (EN(4) && IN(pb + 4)) { p_gla_tail(F, in_ptr(F, 16) + (size_t)L * 128, Tm); } SEAM(pb + 4);
        if (EN(5) && IN(pb + 5)) {
            pg8::StaticOrder S; S.init(Tm, 1024, F.G, (int)blockIdx.x);
            const bf16_t* P = (const bf16_t*)(ws + WS_P); float* M32 = (float*)(ws + WS_OG); bf16_t* MG = (bf16_t*)(ws + WS_MERGED);
            { pg8::Gemm g{(const bf16_t*)(ws + WS_AD), (const bf16_t*)(ws + WS_WD + L * W1K_STRIDE), 1024, 1024, 1024};
              EpiGate<0> E{P, M32, MG}; pg8::gemm_phase<EpiGate<0>, pg8::StaticOrder, true, true>(F.lds, g, S, E); }
            { pg8::Gemm g{(const bf16_t*)(ws + WS_ACG), (const bf16_t*)(ws + WS_WCG + L * W1K_STRIDE), 512, 1024, 1024};
              EpiGate<1> E{P, M32, MG}; pg8::gemm_phase<EpiGate<1>, pg8::StaticOrder, true, true>(F.lds, g, S, E); }
            { pg8::Gemm g{(const bf16_t*)(ws + WS_ACG) + 512, (const bf16_t*)(ws + WS_WCG + L * W1K_STRIDE) + 512, 512, 1024, 1024};
              EpiGate<2> E{P, M32, MG}; pg8::gemm_phase<EpiGate<2>, pg8::StaticOrder, true, true>(F.lds, g, S, E); }
        } SEAM(pb + 5);
        if (EN(6) && IN(pb + 6)) {
            pg8::Gemm g{(const bf16_t*)(ws + WS_MERGED), (const bf16_t*)(ws + WS_WO + L * W1K_STRIDE), 1024, 1024, 1024};
            pg8::StaticOrder S; S.init(Tm, 1024, F.G, (int)blockIdx.x);
            const float* xl = L == 0 ? in_ptr(F, 0) : (const float*)(ws + WS_XW);
            const float* xc = L == 0 ? in_ptr(F, 2) - (size_t)TL * 1024 : (const float*)(ws + WS_XW);
            EpiRes E{xl, xc, (float*)(ws + WS_XW), MODL};
            pg8::gemm_phase<EpiRes, pg8::StaticOrder, true, true>(F.lds, g, S, E);
        } SEAM(pb + 6);
        if (EN(7) && IN(pb + 7)) { p_norm2_router(F, L, Tm); } SEAM(pb + 7);
        if (EN(8) && IN(pb + 8)) { p_route_gather(F, L, Tm); } SEAM(pb + 8);
        unsigned char* rt = ws + WS_ROUTE + L * ROUTE_STRIDE;
        if (EN(9) && IN(pb + 9)) {
            const int nt = __builtin_amdgcn_readfirstlane(__builtin_nontemporal_load((const int*)(rt + R_NT)));
            pg8::Gemm g{(const bf16_t*)(ws + WS_XS), (const bf16_t*)(ws + WS_W1 + L * W1_STRIDE), 1024, 1024, 1024};
            MoeOrder S{nt, 8, F.G, (int)blockIdx.x, (const int*)(rt + R_TILEEXP)};
            EpiSwiglu E{(bf16_t*)(ws + WS_HH), in_ptr(F, 22) + (size_t)L * 32 * 2048};
            pg8::gemm_phase<EpiSwiglu, MoeOrder, true, true>(F.lds, g, S, E);
        } SEAM(pb + 9);
        if (EN(10) && IN(pb + 10)) {
            const int nt = __builtin_amdgcn_readfirstlane(__builtin_nontemporal_load((const int*)(rt + R_NT)));
            pg8::Gemm g{(const bf16_t*)(ws + WS_HH), (const bf16_t*)(ws + WS_W2 + L * W2_STRIDE), 1024, 1024, 1024};
            MoeOrder S{nt, 4, F.G, (int)blockIdx.x, (const int*)(rt + R_TILEEXP)};
            EpiY E{(bf16_t*)(ws + WS_XS), in_ptr(F, 24) + (size_t)L * 32 * 1024};
            pg8::gemm_phase<EpiY, MoeOrder, true, true>(F.lds, g, S, E);
        } SEAM(pb + 10);
        if (EN(11) && IN(pb + 11)) { p_combine(F, L, Tm); } SEAM(pb + 11);
    }
#undef IN
#undef SEAM
#ifdef DBG_STOP
    if (lo == 100) {
        float* out = out_ptr(F); const int gt = F.gw * 64 + F.lane, NGT = F.NGW * 64;
#if DBG_KIND == 2
        unsigned* cnt = (unsigned*)(ws + WS_XW + 130 * MiB);
        unsigned c = 0; if (blockIdx.x == 0 && F.tid == 0) { c = cnt[0]; cnt[0] = c + 1; }
        for (size_t i = gt; i < (size_t)TL * 1024; i += NGT) out[i] = 1.0f;
        if (blockIdx.x == 0 && F.tid == 0) out[0] = (float)(c & 1023u);
#elif DBG_KIND == 0
        const float* src = (const float*)(ws + WS_XW); for (size_t i = gt; i < (size_t)TL * 1024; i += NGT) out[i] = src[i];
#elif DBG_KIND == 1
        const bf16_t* src = (const bf16_t*)(ws + DBG_OFF); for (size_t i = gt; i < (size_t)TL * 1024; i += NGT) out[i] = bf2f(src[i * DBG_STRIDE]);
#endif
    }
#endif
}

extern "C" void kernel_launch(void* const* d_in, const int* in_sizes, int n_in, void* d_out, int out_size, void* d_ws, size_t ws_size, hipStream_t stream) {
    static int grid = 0;
    if (grid == 0) {
        if (n_in != 26 || out_size != TL * DM || ws_size < WS_END) { fprintf(stderr, "kernel_launch: unexpected problem (n_in %d out %d ws %zu)\n", n_in, out_size, ws_size); grid = -1; return; }
        int dev = 0, cus = 0, per_cu = 0;
        if (hipGetDevice(&dev) != hipSuccess || hipDeviceGetAttribute(&cus, hipDeviceAttributeMultiprocessorCount, dev) != hipSuccess) { grid = -1; return; }
        if (hipFuncSetAttribute((const void*)fwd, hipFuncAttributeMaxDynamicSharedMemorySize, LDS_BYTES) != hipSuccess) { fprintf(stderr, "kernel_launch: hipFuncSetAttribute failed\n"); grid = -1; return; }
        if (hipOccupancyMaxActiveBlocksPerMultiprocessor(&per_cu, (const void*)fwd, NTHR, LDS_BYTES) != hipSuccess || per_cu < 1) fprintf(stderr, "kernel_launch: occupancy query reports %d\n", per_cu);
        (void)hipGetLastError();
        grid = cus;
        if (grid > 256) grid = 256;
    }
    if (grid < 0) return;
    (void)hipMemsetAsync((char*)d_ws + WS_CTL, 0, CTL_ZERO_BYTES, stream);
    Args a{};
    for (int i = 0; i < 26; ++i) a.in[i] = (const float*)d_in[i];
    a.out = (float*)d_out; a.ws = (unsigned char*)d_ws;
    if (N_LAUNCH_MODE == 1) { a.ph_lo = 0; a.ph_hi = NPHASE; hipLaunchKernelGGL(fwd, dim3(grid), dim3(NTHR), LDS_BYTES, stream, a); }
#ifdef DBG_STOP
    else { for (int p = 0; p <= DBG_STOP; ++p) { if (p == 13) continue; a.ph_lo = p; a.ph_hi = p + 1; hipLaunchKernelGGL(fwd, dim3(grid), dim3(NTHR), LDS_BYTES, stream, a); }
        a.ph_lo = 100; a.ph_hi = 101; hipLaunchKernelGGL(fwd, dim3(grid), dim3(NTHR), LDS_BYTES, stream, a); }
#else
    else for (int p = 0; p < NPHASE; ++p) { if (p == 13) continue; a.ph_lo = p; a.ph_hi = p + 1; hipLaunchKernelGGL(fwd, dim3(grid), dim3(NTHR), LDS_BYTES, stream, a); }
#endif
}
```

```cpp
#include <hip/hip_runtime.h>
#include <cstdio>
#include <cstdint>
#define N_LAUNCH_MODE 1
#ifndef ATT_PROBE
#define ATT_PROBE 0
#endif
#ifndef ATT_SCHED
#define ATT_SCHED 0
#endif
#ifndef ATTN_IMPL
#define ATTN_IMPL 1
#endif
#ifndef GLA_IMPL
#define GLA_IMPL 1
#endif
namespace pg8 {
#define PG8_LAS __attribute__((address_space(3)))
typedef unsigned short bf16_t;
typedef short bf16x8 __attribute__((ext_vector_type(8)));
typedef float f32x4 __attribute__((ext_vector_type(4)));
typedef float f32x2 __attribute__((ext_vector_type(2)));
typedef unsigned u32x4 __attribute__((ext_vector_type(4)));
typedef unsigned u32x2 __attribute__((ext_vector_type(2)));
constexpr int BM = 256, BK = 64, HALF = 128, HTB = HALF * BK * 2  , STAGE_BYTES = 8 * HTB, NXCD = 8, WGM = 8;

__host__ __device__ __forceinline__ int lds_byte(int r, int c) { const int st = (r >> 4) * 2 + (c >> 5), rr = r & 15, cc = c & 31, ob = rr * 64 + cc * 2; return st * 1024 + (ob ^ (((ob >> 9) & 1) << 5)); }
__host__ __device__ __forceinline__ void stage_rc(int b, int& R, int& C) { const int st = b / 1024, sb = b % 1024, swz = sb ^ (((sb >> 9) & 1) << 5); R = (st >> 1) * 16 + swz / 64; C = (st & 1) * 32 + (swz % 64) / 2; }
__host__ __device__ __forceinline__ int perm32(int rho) { const int n = rho >> 4, i = rho & 15; return 8 * (i >> 2) + 4 * n + (i & 3); }

struct Unit { int pm, pn, pb; };
struct Gemm { const bf16_t* A; const bf16_t* Bt; int K, lda, ldb; int stag = 0; };

struct StaticOrder {
    int nM, nN, nwg, G, c;
    __host__ __device__ void init(int M, int N, int G_, int c_) { nM = M / BM; nN = N / BM; nwg = nM * nN; G = G_; c = c_; }
    __host__ __device__ bool next(int i, Unit& u) const {
        const long L = (long)i * G + c; if (L >= nwg) return false;
        int wgid = (int)L; { const int q = nwg / NXCD, r = nwg % NXCD, xcd = wgid % NXCD, off = wgid / NXCD; wgid = (xcd < r ? xcd * (q + 1) : r * (q + 1) + (xcd - r) * q) + off; }
        const int nig = WGM * nN, gid = wgid / nig, fm = gid * WGM, gsz = (nM - fm) < WGM ? (nM - fm) : WGM;
        u.pm = fm + ((wgid % nig) % gsz); u.pn = (wgid % nig) / gsz; u.pb = u.pn; return true;
    }
    __device__ __forceinline__ void a_ready(const Unit&) const {}
    __device__ __forceinline__ void done(const Unit&) const {}
};


template <class Epi, class Sched, bool ALIGN_EPI = false, bool SP2 = false>
__device__ __forceinline__ void gemm_phase(PG8_LAS unsigned char* lds, const Gemm g, const Sched& S, const Epi& E, int wave_id) {
    int tid_ = wave_id * 64 + (int)__builtin_amdgcn_mbcnt_hi(~0u, __builtin_amdgcn_mbcnt_lo(~0u, 0u)); asm volatile("" : "+v"(tid_));
    const int tid = tid_, wid = __builtin_amdgcn_readfirstlane(tid >> 6), lane = tid & 63, wr = wid >> 2, wc = wid & 3, fr = lane & 15, fq = lane >> 4;
    const int K = g.K, nt = K / BK;
    unsigned voffA[2], voffB[2];
#pragma unroll
    for (int i = 0; i < 2; ++i) { int R, C; stage_rc(tid * 16 + i * 8192, R, C); const int Rb = Epi::PERM ? ((R & ~31) + perm32(R & 31)) : R;
        voffA[i] = (unsigned)(R * g.lda + C) * 2u; voffB[i] = (unsigned)(Rb * g.ldb + C) * 2u; }
    const size_t kstep = (size_t)(BK * 2);
    const size_t hstepA = (size_t)HALF * g.lda * 2, hstepB = (size_t)HALF * g.ldb * 2;
    const size_t tstepA = 2 * hstepA, tstepB = 2 * hstepB;
    const unsigned ldsw = (unsigned)wid * 1024u;
    const int aoff = lds_byte(wr * 64 + fr, fq * 8), boff = lds_byte(wc * 32 + fr, fq * 8);
#define PG8_SA(b, h) (((b) * 2 + (h)) * HTB)
#define PG8_SB(b, h) ((4 + (b) * 2 + (h)) * HTB)
#define PG8_STAGE(bufoff, gbase, voff) do { _Pragma("unroll") for (int _i = 0; _i < 2; ++_i) \
        __builtin_amdgcn_global_load_lds((const unsigned*)((const char*)(gbase) + (voff)[_i]), (PG8_LAS unsigned*)(lds + (bufoff) + ldsw + _i * 8192), 16, 0, 0); } while (0)
#define PG8_LDA(dst, b, h) do { _Pragma("unroll") for (int m = 0; m < 4; ++m) _Pragma("unroll") for (int k = 0; k < 2; ++k) dst[m][k] = *(const PG8_LAS bf16x8*)(lds + PG8_SA(b, h) + aoff + m * 2048 + k * 1024); } while (0)
#define PG8_LDB(dst, b, h) do { _Pragma("unroll") for (int n = 0; n < 2; ++n) _Pragma("unroll") for (int k = 0; k < 2; ++k) dst[n][k] = *(const PG8_LAS bf16x8*)(lds + PG8_SB(b, h) + boff + n * 2048 + k * 1024); } while (0)
#define PG8_MMA(ai, bj, At, Bt) do { __builtin_amdgcn_s_setprio(1); _Pragma("unroll") for (int m = 0; m < 4; ++m) _Pragma("unroll") for (int n = 0; n < 2; ++n) _Pragma("unroll") for (int k = 0; k < 2; ++k) \
        acc[ai][bj][m][n] = __builtin_amdgcn_mfma_f32_16x16x32_bf16(Bt[n][k], At[m][k], acc[ai][bj][m][n], 0, 0, 0); __builtin_amdgcn_s_setprio(0); } while (0)
#define PG8_WAIT_V(n) asm volatile("s_waitcnt vmcnt(" #n ")" ::: "memory")
#define PG8_WAIT_L(n) asm volatile("s_waitcnt lgkmcnt(" #n ")" ::: "memory")
#define PG8_BAR __builtin_amdgcn_s_barrier()
#define PG8_SCHED __builtin_amdgcn_sched_barrier(0)
    Unit cur, nxt; int ui = 0;
    if (!S.next(0, cur)) return;
    if (g.stag > 0) { const unsigned long long t0_ = __builtin_amdgcn_s_memrealtime(); while (__builtin_amdgcn_s_memrealtime() - t0_ < (unsigned long long)g.stag) __builtin_amdgcn_s_sleep(8); }
    f32x4 acc[2][2][4][2];
#pragma unroll
    for (int a = 0; a < 2; ++a)
#pragma unroll
        for (int b = 0; b < 2; ++b)
#pragma unroll
            for (int m = 0; m < 4; ++m)
#pragma unroll
                for (int n = 0; n < 2; ++n) acc[a][b][m][n] = (f32x4){0.f, 0.f, 0.f, 0.f};
    bf16x8 At[4][2], B0[2][2], B1[2][2];
    const char* cA = (const char*)g.A + (size_t)cur.pm * tstepA; const char* cB = (const char*)g.Bt + (size_t)cur.pb * tstepB;
    S.a_ready(cur);
    if constexpr (SP2) {
        PG8_STAGE(PG8_SB(0, 0), cB, voffB); PG8_STAGE(PG8_SB(0, 1), cB + hstepB, voffB); PG8_STAGE(PG8_SA(0, 0), cA, voffA); PG8_STAGE(PG8_SA(0, 1), cA + hstepA, voffA);
        if (wr == 1) PG8_BAR;
        PG8_WAIT_V(2); PG8_BAR;
        PG8_STAGE(PG8_SB(1, 0), cB + kstep, voffB); PG8_STAGE(PG8_SA(1, 0), cA + kstep, voffA); PG8_STAGE(PG8_SB(1, 1), cB + hstepB + kstep, voffB);
        PG8_WAIT_V(6); PG8_BAR;
    } else {
        PG8_STAGE(PG8_SB(0, 0), cB, voffB); PG8_STAGE(PG8_SA(0, 0), cA, voffA); PG8_STAGE(PG8_SB(0, 1), cB + hstepB, voffB); PG8_STAGE(PG8_SA(0, 1), cA + hstepA, voffA);
        if (wr == 1) PG8_BAR;
        PG8_WAIT_V(4); PG8_BAR;
        PG8_STAGE(PG8_SB(1, 0), cB + kstep, voffB); PG8_STAGE(PG8_SA(1, 0), cA + kstep, voffA); PG8_STAGE(PG8_SB(1, 1), cB + hstepB + kstep, voffB);
        PG8_WAIT_V(6); PG8_BAR;
    }
    for (;;) {
        const bool has_next = S.next(ui + 1, nxt);
        const char* nA = has_next ? (const char*)g.A + (size_t)nxt.pm * tstepA : cA; const char* nB = has_next ? (const char*)g.Bt + (size_t)nxt.pb * tstepB : cB;
        for (int t = 0; t < nt; t += 2) {
            const bool last = (t == nt - 2);
            const char* a1 = cA + (size_t)(t + 1) * kstep;
            const char* a2 = last ? nA : cA + (size_t)(t + 2) * kstep; const char* b2 = last ? nB : cB + (size_t)(t + 2) * kstep;
            const char* a3 = a2 + kstep; const char* b3 = b2 + kstep;
            if (last && has_next) S.a_ready(nxt);
            if constexpr (SP2) {
            PG8_LDB(B0, 0, 0); PG8_LDB(B1, 0, 1); PG8_SCHED; PG8_LDA(At, 0, 0); PG8_STAGE(PG8_SA(1, 1), a1 + hstepA, voffA);
            PG8_WAIT_V(8); PG8_WAIT_L(0); PG8_BAR; PG8_MMA(0, 0, At, B0); PG8_MMA(0, 1, At, B1); PG8_BAR; PG8_SCHED;
            PG8_LDA(At, 0, 1); PG8_STAGE(PG8_SB(0, 0), b2, voffB); PG8_STAGE(PG8_SB(0, 1), b2 + hstepB, voffB); PG8_STAGE(PG8_SA(0, 0), a2, voffA);
            PG8_WAIT_V(8); PG8_WAIT_L(0); PG8_BAR; PG8_MMA(1, 0, At, B0); PG8_MMA(1, 1, At, B1); PG8_BAR; PG8_SCHED;
            PG8_LDB(B0, 1, 0); PG8_LDB(B1, 1, 1); PG8_SCHED; PG8_LDA(At, 1, 0); PG8_STAGE(PG8_SA(0, 1), a2 + hstepA, voffA);
            PG8_WAIT_V(8); PG8_WAIT_L(0); PG8_BAR; PG8_MMA(0, 0, At, B0); PG8_MMA(0, 1, At, B1); PG8_BAR; PG8_SCHED;
            PG8_LDA(At, 1, 1); PG8_STAGE(PG8_SB(1, 0), b3, voffB); PG8_STAGE(PG8_SB(1, 1), b3 + hstepB, voffB); PG8_STAGE(PG8_SA(1, 0), a3, voffA);
            PG8_WAIT_V(8); PG8_WAIT_L(0); PG8_BAR; PG8_MMA(1, 0, At, B0); PG8_MMA(1, 1, At, B1); PG8_BAR; PG8_SCHED;
            } else {
            PG8_LDB(B0, 0, 0); PG8_SCHED; PG8_LDA(At, 0, 0); PG8_STAGE(PG8_SA(1, 1), a1 + hstepA, voffA);
            PG8_WAIT_L(8); PG8_BAR; PG8_WAIT_L(0); PG8_MMA(0, 0, At, B0); PG8_BAR; PG8_SCHED;
            PG8_LDB(B1, 0, 1); PG8_STAGE(PG8_SB(0, 0), b2, voffB);
            PG8_BAR; PG8_WAIT_L(0); PG8_MMA(0, 1, At, B1); PG8_BAR;
            PG8_LDA(At, 0, 1); PG8_STAGE(PG8_SA(0, 0), a2, voffA);
            PG8_BAR; PG8_WAIT_L(0); PG8_MMA(1, 0, At, B0); PG8_BAR; PG8_SCHED;
            PG8_STAGE(PG8_SB(0, 1), b2 + hstepB, voffB);
            PG8_WAIT_V(6); PG8_BAR; PG8_MMA(1, 1, At, B1); PG8_BAR;
            PG8_LDB(B0, 1, 0); PG8_SCHED; PG8_LDA(At, 1, 0); PG8_STAGE(PG8_SA(0, 1), a2 + hstepA, voffA);
            PG8_WAIT_L(8); PG8_BAR; PG8_WAIT_L(0); PG8_MMA(0, 0, At, B0); PG8_BAR; PG8_SCHED;
            PG8_LDB(B1, 1, 1); PG8_STAGE(PG8_SB(1, 0), b3, voffB);
            PG8_BAR; PG8_WAIT_L(0); PG8_MMA(0, 1, At, B1); PG8_BAR;
            PG8_LDA(At, 1, 1); PG8_STAGE(PG8_SA(1, 0), a3, voffA);
            PG8_BAR; PG8_WAIT_L(0); PG8_MMA(1, 0, At, B0); PG8_BAR; PG8_SCHED;
            PG8_STAGE(PG8_SB(1, 1), b3 + hstepB, voffB);
            PG8_WAIT_V(6); PG8_BAR; PG8_MMA(1, 1, At, B1); PG8_BAR;
            }
        }
        if constexpr (ALIGN_EPI) { if (wr == 0) PG8_BAR; }
        E(acc, cur, wr, wc, fr, fq);
#ifdef EPI_PROBE
        if constexpr (Epi::PROBE) { asm volatile("" ::: "memory"); E(acc, cur, wr, wc, fr, fq, EPI_PROBE_NOSTORE != 0); }
#endif
        S.done(cur);
        if (!has_next) break;
#pragma unroll
        for (int a = 0; a < 2; ++a)
#pragma unroll
            for (int b = 0; b < 2; ++b)
#pragma unroll
                for (int m = 0; m < 4; ++m)
#pragma unroll
                    for (int n = 0; n < 2; ++n) acc[a][b][m][n] = (f32x4){0.f, 0.f, 0.f, 0.f};
        cur = nxt; cA = nA; cB = nB; ++ui;
        if constexpr (ALIGN_EPI) { if (wr == 1) PG8_BAR; }
    }
    PG8_WAIT_V(0);
    if constexpr (!ALIGN_EPI) { if (wr == 0) PG8_BAR; }
    PG8_BAR;
#undef PG8_SA
#undef PG8_SB
#undef PG8_STAGE
#undef PG8_LDA
#undef PG8_LDB
#undef PG8_MMA
#undef PG8_WAIT_V
#undef PG8_WAIT_L
#undef PG8_BAR
#undef PG8_SCHED
}
template <class Epi, class Sched, bool ALIGN_EPI = false, bool SP2 = false>
__device__ __forceinline__ void gemm_phase_gather(PG8_LAS unsigned char* lds, const Gemm g, const Sched& S, const Epi& E, const int* rowidx, int wave_id) {
    int tid_ = wave_id * 64 + (int)__builtin_amdgcn_mbcnt_hi(~0u, __builtin_amdgcn_mbcnt_lo(~0u, 0u)); asm volatile("" : "+v"(tid_));
    const int tid = tid_, wid = __builtin_amdgcn_readfirstlane(tid >> 6), lane = tid & 63, wr = wid >> 2, wc = wid & 3, fr = lane & 15, fq = lane >> 4;
    const int K = g.K, nt = K / BK;
    unsigned voffA[2], voffB[2];
#pragma unroll
    for (int i = 0; i < 2; ++i) { int R, C; stage_rc(tid * 16 + i * 8192, R, C); const int Rb = Epi::PERM ? ((R & ~31) + perm32(R & 31)) : R;
        voffA[i] = (unsigned)(R * g.lda + C) * 2u; voffB[i] = (unsigned)(Rb * g.ldb + C) * 2u; }
    const size_t kstep = (size_t)(BK * 2);
    const size_t hstepA = (size_t)HALF * g.lda * 2, hstepB = (size_t)HALF * g.ldb * 2;
    const size_t tstepA = 2 * hstepA, tstepB = 2 * hstepB;
    const unsigned ldsw = (unsigned)wid * 1024u;
    const int aoff = lds_byte(wr * 64 + fr, fq * 8), boff = lds_byte(wc * 32 + fr, fq * 8);
#define PG8_SA(b, h) (((b) * 2 + (h)) * HTB)
#define PG8_SB(b, h) ((4 + (b) * 2 + (h)) * HTB)
#define PG8_STAGE(bufoff, gbase, voff) do { _Pragma("unroll") for (int _i = 0; _i < 2; ++_i) \
        __builtin_amdgcn_global_load_lds((const unsigned*)((const char*)(gbase) + (voff)[_i]), (PG8_LAS unsigned*)(lds + (bufoff) + ldsw + _i * 8192), 16, 0, 0); } while (0)
#define PG8_LDA(dst, b, h) do { _Pragma("unroll") for (int m = 0; m < 4; ++m) _Pragma("unroll") for (int k = 0; k < 2; ++k) dst[m][k] = *(const PG8_LAS bf16x8*)(lds + PG8_SA(b, h) + aoff + m * 2048 + k * 1024); } while (0)
#define PG8_LDB(dst, b, h) do { _Pragma("unroll") for (int n = 0; n < 2; ++n) _Pragma("unroll") for (int k = 0; k < 2; ++k) dst[n][k] = *(const PG8_LAS bf16x8*)(lds + PG8_SB(b, h) + boff + n * 2048 + k * 1024); } while (0)
#define PG8_MMA(ai, bj, At, Bt) do { __builtin_amdgcn_s_setprio(1); _Pragma("unroll") for (int m = 0; m < 4; ++m) _Pragma("unroll") for (int n = 0; n < 2; ++n) _Pragma("unroll") for (int k = 0; k < 2; ++k) \
        acc[ai][bj][m][n] = __builtin_amdgcn_mfma_f32_16x16x32_bf16(Bt[n][k], At[m][k], acc[ai][bj][m][n], 0, 0, 0); __builtin_amdgcn_s_setprio(0); } while (0)
#define PG8_WAIT_V(n) asm volatile("s_waitcnt vmcnt(" #n ")" ::: "memory")
#define PG8_WAIT_L(n) asm volatile("s_waitcnt lgkmcnt(" #n ")" ::: "memory")
#define PG8_BAR __builtin_amdgcn_s_barrier()
#define PG8_SCHED __builtin_amdgcn_sched_barrier(0)
    static_assert(SP2, "gather form: SP2 loop only");
    int RA[2]; { int C_; stage_rc(tid * 16, RA[0], C_); stage_rc(tid * 16 + 8192, RA[1], C_); }
    PG8_LAS unsigned char* gslot = lds + STAGE_BYTES + tid * 16;
#define PG8_GOFF(slot_, pm_) do { u32x4 o_; \
        o_[0] = (unsigned)__builtin_nontemporal_load(rowidx + (pm_) * 256 + RA[0]) * (unsigned)(g.lda * 2) + (voffA[0] - (unsigned)(RA[0] * g.lda * 2)); \
        o_[1] = (unsigned)__builtin_nontemporal_load(rowidx + (pm_) * 256 + RA[1]) * (unsigned)(g.lda * 2) + (voffA[1] - (unsigned)(RA[1] * g.lda * 2)); \
        o_[2] = (unsigned)__builtin_nontemporal_load(rowidx + (pm_) * 256 + 128 + RA[0]) * (unsigned)(g.lda * 2) + (voffA[0] - (unsigned)(RA[0] * g.lda * 2)); \
        o_[3] = (unsigned)__builtin_nontemporal_load(rowidx + (pm_) * 256 + 128 + RA[1]) * (unsigned)(g.lda * 2) + (voffA[1] - (unsigned)(RA[1] * g.lda * 2)); \
        *(PG8_LAS u32x4*)(gslot + (slot_) * 8192) = o_; } while (0)
#define PG8_GRD(slot_, h_) (*(const PG8_LAS u32x2*)(gslot + (slot_) * 8192 + (h_) * 8))
#define PG8_STAGE2(bufoff, gbase, o2) do { const u32x2 o2_ = (o2); \
        __builtin_amdgcn_global_load_lds((const unsigned*)((const char*)(gbase) + o2_[0]), (PG8_LAS unsigned*)(lds + (bufoff) + ldsw), 16, 0, 0); \
        __builtin_amdgcn_global_load_lds((const unsigned*)((const char*)(gbase) + o2_[1]), (PG8_LAS unsigned*)(lds + (bufoff) + ldsw + 8192), 16, 0, 0); } while (0)
    Unit cur, nxt; int ui = 0;
    if (!S.next(0, cur)) return;
    PG8_GOFF(0, cur.pm);
    if (g.stag > 0) { const unsigned long long t0_ = __builtin_amdgcn_s_memrealtime(); while (__builtin_amdgcn_s_memrealtime() - t0_ < (unsigned long long)g.stag) __builtin_amdgcn_s_sleep(8); }
    f32x4 acc[2][2][4][2];
#pragma unroll
    for (int a = 0; a < 2; ++a)
#pragma unroll
        for (int b = 0; b < 2; ++b)
#pragma unroll
            for (int m = 0; m < 4; ++m)
#pragma unroll
                for (int n = 0; n < 2; ++n) acc[a][b][m][n] = (f32x4){0.f, 0.f, 0.f, 0.f};
    bf16x8 At[4][2], B0[2][2], B1[2][2];
    const char* cA = (const char*)g.A; const char* cB = (const char*)g.Bt + (size_t)cur.pb * tstepB;
    S.a_ready(cur);
    if constexpr (SP2) {
        PG8_STAGE(PG8_SB(0, 0), cB, voffB); PG8_STAGE(PG8_SB(0, 1), cB + hstepB, voffB); PG8_STAGE2(PG8_SA(0, 0), cA, PG8_GRD(0, 0)); PG8_STAGE2(PG8_SA(0, 1), cA, PG8_GRD(0, 1));
        if (wr == 1) PG8_BAR;
        PG8_WAIT_V(2); PG8_BAR;
        PG8_STAGE(PG8_SB(1, 0), cB + kstep, voffB); PG8_STAGE2(PG8_SA(1, 0), cA + kstep, PG8_GRD(0, 0)); PG8_STAGE(PG8_SB(1, 1), cB + hstepB + kstep, voffB);
        PG8_WAIT_V(6); PG8_BAR;
    } else {
        PG8_STAGE(PG8_SB(0, 0), cB, voffB); PG8_STAGE(PG8_SA(0, 0), cA, voffA); PG8_STAGE(PG8_SB(0, 1), cB + hstepB, voffB); PG8_STAGE(PG8_SA(0, 1), cA + hstepA, voffA);
        if (wr == 1) PG8_BAR;
        PG8_WAIT_V(4); PG8_BAR;
        PG8_STAGE(PG8_SB(1, 0), cB + kstep, voffB); PG8_STAGE(PG8_SA(1, 0), cA + kstep, voffA); PG8_STAGE(PG8_SB(1, 1), cB + hstepB + kstep, voffB);
        PG8_WAIT_V(6); PG8_BAR;
    }
    for (;;) {
        const bool has_next = S.next(ui + 1, nxt);
        const int sc = ui & 1, sn = sc ^ 1;
        if (has_next) PG8_GOFF(sn, nxt.pm); else *(PG8_LAS u32x4*)(gslot + sn * 8192) = *(const PG8_LAS u32x4*)(gslot + sc * 8192);
        const char* nB = has_next ? (const char*)g.Bt + (size_t)nxt.pb * tstepB : cB;
        for (int t = 0; t < nt; t += 2) {
            const bool last = (t == nt - 2);
            const char* a1 = cA + (size_t)(t + 1) * kstep;
            const char* a2 = last ? cA : cA + (size_t)(t + 2) * kstep; const char* b2 = last ? nB : cB + (size_t)(t + 2) * kstep;
            const char* a3 = a2 + kstep; const char* b3 = b2 + kstep;
            if (last && has_next) S.a_ready(nxt);
            if constexpr (SP2) {
            PG8_LDB(B0, 0, 0); PG8_LDB(B1, 0, 1); PG8_SCHED; PG8_LDA(At, 0, 0); PG8_STAGE2(PG8_SA(1, 1), a1, PG8_GRD(sc, 1));
            PG8_WAIT_V(8); PG8_WAIT_L(0); PG8_BAR; PG8_MMA(0, 0, At, B0); PG8_MMA(0, 1, At, B1); PG8_BAR; PG8_SCHED;
            PG8_LDA(At, 0, 1); PG8_STAGE(PG8_SB(0, 0), b2, voffB); PG8_STAGE(PG8_SB(0, 1), b2 + hstepB, voffB); PG8_STAGE2(PG8_SA(0, 0), a2, PG8_GRD(last ? sn : sc, 0));
            PG8_WAIT_V(8); PG8_WAIT_L(0); PG8_BAR; PG8_MMA(1, 0, At, B0); PG8_MMA(1, 1, At, B1); PG8_BAR; PG8_SCHED;
            PG8_LDB(B0, 1, 0); PG8_LDB(B1, 1, 1); PG8_SCHED; PG8_LDA(At, 1, 0); PG8_STAGE2(PG8_SA(0, 1), a2, PG8_GRD(last ? sn : sc, 1));
            PG8_WAIT_V(8); PG8_WAIT_L(0); PG8_BAR; PG8_MMA(0, 0, At, B0); PG8_MMA(0, 1, At, B1); PG8_BAR; PG8_SCHED;
            PG8_LDA(At, 1, 1); PG8_STAGE(PG8_SB(1, 0), b3, voffB); PG8_STAGE(PG8_SB(1, 1), b3 + hstepB, voffB); PG8_STAGE2(PG8_SA(1, 0), a3, PG8_GRD(last ? sn : sc, 0));
            PG8_WAIT_V(8); PG8_WAIT_L(0); PG8_BAR; PG8_MMA(1, 0, At, B0); PG8_MMA(1, 1, At, B1); PG8_BAR; PG8_SCHED;
            } else {
            PG8_LDB(B0, 0, 0); PG8_SCHED; PG8_LDA(At, 0, 0); PG8_STAGE(PG8_SA(1, 1), a1 + hstepA, voffA);
            PG8_WAIT_L(8); PG8_BAR; PG8_WAIT_L(0); PG8_MMA(0, 0, At, B0); PG8_BAR; PG8_SCHED;
            PG8_LDB(B1, 0, 1); PG8_STAGE(PG8_SB(0, 0), b2, voffB);
            PG8_BAR; PG8_WAIT_L(0); PG8_MMA(0, 1, At, B1); PG8_BAR;
            PG8_LDA(At, 0, 1); PG8_STAGE(PG8_SA(0, 0), a2, voffA);
            PG8_BAR; PG8_WAIT_L(0); PG8_MMA(1, 0, At, B0); PG8_BAR; PG8_SCHED;
            PG8_STAGE(PG8_SB(0, 1), b2 + hstepB, voffB);
            PG8_WAIT_V(6); PG8_BAR; PG8_MMA(1, 1, At, B1); PG8_BAR;
            PG8_LDB(B0, 1, 0); PG8_SCHED; PG8_LDA(At, 1, 0); PG8_STAGE(PG8_SA(0, 1), a2 + hstepA, voffA);
            PG8_WAIT_L(8); PG8_BAR; PG8_WAIT_L(0); PG8_MMA(0, 0, At, B0); PG8_BAR; PG8_SCHED;
            PG8_LDB(B1, 1, 1); PG8_STAGE(PG8_SB(1, 0), b3, voffB);
            PG8_BAR; PG8_WAIT_L(0); PG8_MMA(0, 1, At, B1); PG8_BAR;
            PG8_LDA(At, 1, 1); PG8_STAGE(PG8_SA(1, 0), a3, voffA);
            PG8_BAR; PG8_WAIT_L(0); PG8_MMA(1, 0, At, B0); PG8_BAR; PG8_SCHED;
            PG8_STAGE(PG8_SB(1, 1), b3 + hstepB, voffB);
            PG8_WAIT_V(6); PG8_BAR; PG8_MMA(1, 1, At, B1); PG8_BAR;
            }
        }
        if constexpr (ALIGN_EPI) { if (wr == 0) PG8_BAR; }
        E(acc, cur, wr, wc, fr, fq);
#ifdef EPI_PROBE
        if constexpr (Epi::PROBE) { asm volatile("" ::: "memory"); E(acc, cur, wr, wc, fr, fq, EPI_PROBE_NOSTORE != 0); }
#endif
        S.done(cur);
        if (!has_next) break;
#pragma unroll
        for (int a = 0; a < 2; ++a)
#pragma unroll
            for (int b = 0; b < 2; ++b)
#pragma unroll
                for (int m = 0; m < 4; ++m)
#pragma unroll
                    for (int n = 0; n < 2; ++n) acc[a][b][m][n] = (f32x4){0.f, 0.f, 0.f, 0.f};
        cur = nxt; cB = nB; ++ui;
        if constexpr (ALIGN_EPI) { if (wr == 1) PG8_BAR; }
    }
    PG8_WAIT_V(0);
    if constexpr (!ALIGN_EPI) { if (wr == 0) PG8_BAR; }
    PG8_BAR;
#undef PG8_GOFF
#undef PG8_GRD
#undef PG8_STAGE2
#undef PG8_SA
#undef PG8_SB
#undef PG8_STAGE
#undef PG8_LDA
#undef PG8_LDB
#undef PG8_MMA
#undef PG8_WAIT_V
#undef PG8_WAIT_L
#undef PG8_BAR
#undef PG8_SCHED
}
struct UnitMS { int pm, pn, seg, nt; size_t aoff, boff; };
template <class Epi, class Sched, bool ALIGN_EPI = false, bool SP2 = false>
__device__ __forceinline__ void gemm_phase_ms(PG8_LAS unsigned char* lds, const Gemm g, const Sched& S, const Epi& E, int wave_id) {
    int tid_ = wave_id * 64 + (int)__builtin_amdgcn_mbcnt_hi(~0u, __builtin_amdgcn_mbcnt_lo(~0u, 0u)); asm volatile("" : "+v"(tid_));
    const int tid = tid_, wid = __builtin_amdgcn_readfirstlane(tid >> 6), lane = tid & 63, wr = wid >> 2, wc = wid & 3, fr = lane & 15, fq = lane >> 4;
    unsigned voffA[2], voffB[2];
#pragma unroll
    for (int i = 0; i < 2; ++i) { int R, C; stage_rc(tid * 16 + i * 8192, R, C); const int Rb = Epi::PERM ? ((R & ~31) + perm32(R & 31)) : R;
        voffA[i] = (unsigned)(R * g.lda + C) * 2u; voffB[i] = (unsigned)(Rb * g.ldb + C) * 2u; }
    const size_t kstep = (size_t)(BK * 2);
    const size_t hstepA = (size_t)HALF * g.lda * 2, hstepB = (size_t)HALF * g.ldb * 2;
    const size_t tstepA = 2 * hstepA, tstepB = 2 * hstepB;
    const unsigned ldsw = (unsigned)wid * 1024u;
    const int aoff = lds_byte(wr * 64 + fr, fq * 8), boff = lds_byte(wc * 32 + fr, fq * 8);
#define PG8_SA(b, h) (((b) * 2 + (h)) * HTB)
#define PG8_SB(b, h) ((4 + (b) * 2 + (h)) * HTB)
#define PG8_STAGE(bufoff, gbase, voff) do { _Pragma("unroll") for (int _i = 0; _i < 2; ++_i) \
        __builtin_amdgcn_global_load_lds((const unsigned*)((const char*)(gbase) + (voff)[_i]), (PG8_LAS unsigned*)(lds + (bufoff) + ldsw + _i * 8192), 16, 0, 0); } while (0)
#define PG8_LDA(dst, b, h) do { _Pragma("unroll") for (int m = 0; m < 4; ++m) _Pragma("unroll") for (int k = 0; k < 2; ++k) dst[m][k] = *(const PG8_LAS bf16x8*)(lds + PG8_SA(b, h) + aoff + m * 2048 + k * 1024); } while (0)
#define PG8_LDB(dst, b, h) do { _Pragma("unroll") for (int n = 0; n < 2; ++n) _Pragma("unroll") for (int k = 0; k < 2; ++k) dst[n][k] = *(const PG8_LAS bf16x8*)(lds + PG8_SB(b, h) + boff + n * 2048 + k * 1024); } while (0)
#define PG8_MMA(ai, bj, At, Bt) do { __builtin_amdgcn_s_setprio(1); _Pragma("unroll") for (int m = 0; m < 4; ++m) _Pragma("unroll") for (int n = 0; n < 2; ++n) _Pragma("unroll") for (int k = 0; k < 2; ++k) \
        acc[ai][bj][m][n] = __builtin_amdgcn_mfma_f32_16x16x32_bf16(Bt[n][k], At[m][k], acc[ai][bj][m][n], 0, 0, 0); __builtin_amdgcn_s_setprio(0); } while (0)
#define PG8_WAIT_V(n) asm volatile("s_waitcnt vmcnt(" #n ")" ::: "memory")
#define PG8_WAIT_L(n) asm volatile("s_waitcnt lgkmcnt(" #n ")" ::: "memory")
#define PG8_BAR __builtin_amdgcn_s_barrier()
#define PG8_SCHED __builtin_amdgcn_sched_barrier(0)
    UnitMS cur, nxt; int ui = 0;
    if (!S.next(0, cur)) return;
    f32x4 acc[2][2][4][2];
#pragma unroll
    for (int a = 0; a < 2; ++a)
#pragma unroll
        for (int b = 0; b < 2; ++b)
#pragma unroll
            for (int m = 0; m < 4; ++m)
#pragma unroll
                for (int n = 0; n < 2; ++n) acc[a][b][m][n] = (f32x4){0.f, 0.f, 0.f, 0.f};
    bf16x8 At[4][2], B0[2][2], B1[2][2];
    const char* cA = (const char*)g.A + cur.aoff; const char* cB = (const char*)g.Bt + cur.boff;
    S.a_ready(cur);
    if constexpr (SP2) {
        PG8_STAGE(PG8_SB(0, 0), cB, voffB); PG8_STAGE(PG8_SB(0, 1), cB + hstepB, voffB); PG8_STAGE(PG8_SA(0, 0), cA, voffA); PG8_STAGE(PG8_SA(0, 1), cA + hstepA, voffA);
        if (wr == 1) PG8_BAR;
        PG8_WAIT_V(2); PG8_BAR;
        PG8_STAGE(PG8_SB(1, 0), cB + kstep, voffB); PG8_STAGE(PG8_SA(1, 0), cA + kstep, voffA); PG8_STAGE(PG8_SB(1, 1), cB + hstepB + kstep, voffB);
        PG8_WAIT_V(6); PG8_BAR;
    } else {
        PG8_STAGE(PG8_SB(0, 0), cB, voffB); PG8_STAGE(PG8_SA(0, 0), cA, voffA); PG8_STAGE(PG8_SB(0, 1), cB + hstepB, voffB); PG8_STAGE(PG8_SA(0, 1), cA + hstepA, voffA);
        if (wr == 1) PG8_BAR;
        PG8_WAIT_V(4); PG8_BAR;
        PG8_STAGE(PG8_SB(1, 0), cB + kstep, voffB); PG8_STAGE(PG8_SA(1, 0), cA + kstep, voffA); PG8_STAGE(PG8_SB(1, 1), cB + hstepB + kstep, voffB);
        PG8_WAIT_V(6); PG8_BAR;
    }
    for (;;) {
        const bool has_next = S.next(ui + 1, nxt);
        const char* nA = has_next ? (const char*)g.A + nxt.aoff : cA; const char* nB = has_next ? (const char*)g.Bt + nxt.boff : cB;
        const int nt = cur.nt;
        for (int t = 0; t < nt; t += 2) {
            const bool last = (t == nt - 2);
            const char* a1 = cA + (size_t)(t + 1) * kstep;
            const char* a2 = last ? nA : cA + (size_t)(t + 2) * kstep; const char* b2 = last ? nB : cB + (size_t)(t + 2) * kstep;
            const char* a3 = a2 + kstep; const char* b3 = b2 + kstep;
            if (last && has_next) S.a_ready(nxt);
            if constexpr (SP2) {
            PG8_LDB(B0, 0, 0); PG8_LDB(B1, 0, 1); PG8_SCHED; PG8_LDA(At, 0, 0); PG8_STAGE(PG8_SA(1, 1), a1 + hstepA, voffA);
            PG8_WAIT_V(8); PG8_WAIT_L(0); PG8_BAR; PG8_MMA(0, 0, At, B0); PG8_MMA(0, 1, At, B1); PG8_BAR; PG8_SCHED;
            PG8_LDA(At, 0, 1); PG8_STAGE(PG8_SB(0, 0), b2, voffB); PG8_STAGE(PG8_SB(0, 1), b2 + hstepB, voffB); PG8_STAGE(PG8_SA(0, 0), a2, voffA);
            PG8_WAIT_V(8); PG8_WAIT_L(0); PG8_BAR; PG8_MMA(1, 0, At, B0); PG8_MMA(1, 1, At, B1); PG8_BAR; PG8_SCHED;
            PG8_LDB(B0, 1, 0); PG8_LDB(B1, 1, 1); PG8_SCHED; PG8_LDA(At, 1, 0); PG8_STAGE(PG8_SA(0, 1), a2 + hstepA, voffA);
            PG8_WAIT_V(8); PG8_WAIT_L(0); PG8_BAR; PG8_MMA(0, 0, At, B0); PG8_MMA(0, 1, At, B1); PG8_BAR; PG8_SCHED;
            PG8_LDA(At, 1, 1); PG8_STAGE(PG8_SB(1, 0), b3, voffB); PG8_STAGE(PG8_SB(1, 1), b3 + hstepB, voffB); PG8_STAGE(PG8_SA(1, 0), a3, voffA);
            PG8_WAIT_V(8); PG8_WAIT_L(0); PG8_BAR; PG8_MMA(1, 0, At, B0); PG8_MMA(1, 1, At, B1); PG8_BAR; PG8_SCHED;
            } else {
            PG8_LDB(B0, 0, 0); PG8_SCHED; PG8_LDA(At, 0, 0); PG8_STAGE(PG8_SA(1, 1), a1 + hstepA, voffA);
            PG8_WAIT_L(8); PG8_BAR; PG8_WAIT_L(0); PG8_MMA(0, 0, At, B0); PG8_BAR; PG8_SCHED;
            PG8_LDB(B1, 0, 1); PG8_STAGE(PG8_SB(0, 0), b2, voffB);
            PG8_BAR; PG8_WAIT_L(0); PG8_MMA(0, 1, At, B1); PG8_BAR;
            PG8_LDA(At, 0, 1); PG8_STAGE(PG8_SA(0, 0), a2, voffA);
            PG8_BAR; PG8_WAIT_L(0); PG8_MMA(1, 0, At, B0); PG8_BAR; PG8_SCHED;
            PG8_STAGE(PG8_SB(0, 1), b2 + hstepB, voffB);
            PG8_WAIT_V(6); PG8_BAR; PG8_MMA(1, 1, At, B1); PG8_BAR;
            PG8_LDB(B0, 1, 0); PG8_SCHED; PG8_LDA(At, 1, 0); PG8_STAGE(PG8_SA(0, 1), a2 + hstepA, voffA);
            PG8_WAIT_L(8); PG8_BAR; PG8_WAIT_L(0); PG8_MMA(0, 0, At, B0); PG8_BAR; PG8_SCHED;
            PG8_LDB(B1, 1, 1); PG8_STAGE(PG8_SB(1, 0), b3, voffB);
            PG8_BAR; PG8_WAIT_L(0); PG8_MMA(0, 1, At, B1); PG8_BAR;
            PG8_LDA(At, 1, 1); PG8_STAGE(PG8_SA(1, 0), a3, voffA);
            PG8_BAR; PG8_WAIT_L(0); PG8_MMA(1, 0, At, B0); PG8_BAR; PG8_SCHED;
            PG8_STAGE(PG8_SB(1, 1), b3 + hstepB, voffB);
            PG8_WAIT_V(6); PG8_BAR; PG8_MMA(1, 1, At, B1); PG8_BAR;
            }
        }
        if constexpr (ALIGN_EPI) { if (wr == 0) PG8_BAR; }
        E(acc, cur, wr, wc, fr, fq); S.done(cur);
        if (!has_next) break;
        if (nxt.seg == 0) {
#pragma unroll
        for (int a = 0; a < 2; ++a)
#pragma unroll
            for (int b = 0; b < 2; ++b)
#pragma unroll
                for (int m = 0; m < 4; ++m)
#pragma unroll
                    for (int n = 0; n < 2; ++n) acc[a][b][m][n] = (f32x4){0.f, 0.f, 0.f, 0.f};
        }
        cur = nxt; cA = nA; cB = nB; ++ui;
        if constexpr (ALIGN_EPI) { if (wr == 1) PG8_BAR; }
    }
    PG8_WAIT_V(0);
    if constexpr (!ALIGN_EPI) { if (wr == 0) PG8_BAR; }
    PG8_BAR;
#undef PG8_SA
#undef PG8_SB
#undef PG8_STAGE
#undef PG8_LDA
#undef PG8_LDB
#undef PG8_MMA
#undef PG8_WAIT_V
#undef PG8_WAIT_L
#undef PG8_BAR
#undef PG8_SCHED
}
}
constexpr int NB = 8, SEQ = 4096, DM = 1024, CTXL = 256;
constexpr int TL = NB * SEQ, TC = NB * CTXL, TT = TL + TC;
constexpr int NIN = 9472, PW = 9216;
constexpr int OQ = 0, OKK = 1024, OV = 2048, OCB = 3072, OCC = 3584, OCX = 4096, OGQ = 4608, OGK = 4864, OGV = 5120, OGR = 5632, OGATE = 6144;
constexpr int NEXP = 32, NRMAX = 147456;
constexpr float RMS_EPS = 1e-6f;
constexpr float QSCALE = 0.125f * 1.4426950408889634f;
constexpr int NWAVES = 8, NTHR = 512;
#ifndef N_LAUNCH_MODE
#define N_LAUNCH_MODE 0
#endif
constexpr int NPHASE = 25;

constexpr size_t MiB = 1u << 20;
constexpr size_t WS_CTL = 0, CTL_ZERO_BYTES = 1 * MiB;
constexpr size_t WS_MOD = 1 * MiB;
constexpr size_t WS_ROPE = WS_MOD + 512 * 1024;
constexpr size_t WS_LAM = WS_ROPE + 16 * 1024;
constexpr size_t WS_ROUTE = 2 * MiB, ROUTE_STRIDE = 8 * MiB;
constexpr size_t R_TOPI = 0, R_TOPG = 1 * MiB, R_POSOF = 2 * MiB, R_ROWTOK = 3 * MiB, R_CNT = 4 * MiB, R_TILEEXP = 4 * MiB + 64 * 1024, R_NT = 4 * MiB + 128 * 1024;
constexpr size_t WS_GA = 18 * MiB;
constexpr size_t WS_WIN = 24 * MiB, WIN_STRIDE = (size_t)NIN * DM * 2;
constexpr size_t WS_WD = 61 * MiB, WS_WCG = 65 * MiB, WS_WO = 69 * MiB, W1K_STRIDE = 2 * MiB;
constexpr size_t WS_W1 = 73 * MiB, W1_STRIDE = 128 * MiB;
constexpr size_t WS_W2 = 329 * MiB, W2_STRIDE = 64 * MiB;
constexpr size_t WS_H = 457 * MiB, WS_AD = 525 * MiB, WS_ACG = 593 * MiB, WS_MERGED = 661 * MiB;
constexpr size_t WS_OG = 729 * MiB;
constexpr size_t WS_XW = 865 * MiB;
constexpr size_t WS_ASCR = 1001 * MiB;
constexpr size_t WS_P = 1033 * MiB;
constexpr size_t WS_XS = WS_P, WS_HH = WS_P + 288 * MiB;
constexpr size_t WS_VT = 1645 * MiB;
constexpr size_t WS_END = 1713 * MiB;
static_assert(WS_P + (size_t)TT * PW * 2 <= WS_END && WS_HH + (size_t)NRMAX * DM * 2 <= WS_END, "ws map");

constexpr int LDS_BYTES = 163840;
constexpr int TEXP_OFF = 147456;
constexpr int MISC_OFF = LDS_BYTES - 1024;

#define GAS __attribute__((address_space(1)))
#define LAS __attribute__((address_space(3)))
typedef unsigned short bf16_t;
typedef float f32x4 __attribute__((ext_vector_type(4)));
typedef float f32x2 __attribute__((ext_vector_type(2)));
typedef unsigned u32x4 __attribute__((ext_vector_type(4)));
typedef unsigned u32x2 __attribute__((ext_vector_type(2)));
#define LDS_WAIT() asm volatile("s_waitcnt lgkmcnt(0)" ::: "memory")
#define VM_WAIT() asm volatile("s_waitcnt vmcnt(0)" ::: "memory")
__device__ __forceinline__ unsigned f2bf(float f) { unsigned u = __builtin_bit_cast(unsigned, f); return (u + 0x7fffu + ((u >> 16) & 1u)) >> 16; }
typedef __bf16 pbf2_t __attribute__((ext_vector_type(2)));
typedef float pf2_t __attribute__((ext_vector_type(2)));
__device__ __forceinline__ unsigned pk2(float lo, float hi) { const pf2_t v = {lo, hi}; return __builtin_bit_cast(unsigned, __builtin_convertvector(v, pbf2_t)); }
__device__ __forceinline__ float bflo(unsigned w) { return __builtin_bit_cast(float, w << 16); }
__device__ __forceinline__ float bfhi(unsigned w) { return __builtin_bit_cast(float, w & 0xffff0000u); }
__device__ __forceinline__ float bf2f(bf16_t b) { return __builtin_bit_cast(float, ((unsigned)b) << 16); }
__device__ __forceinline__ float wave_sum(float v) {
#pragma unroll
    for (int o = 1; o < 64; o <<= 1) v += __shfl_xor(v, o);
    return v;
}
__device__ __forceinline__ float sigmoidf_(float x) { return __builtin_amdgcn_rcpf(1.f + __builtin_amdgcn_exp2f(-1.4426950408889634f * x)); }

#define XB_TMO      128
#define XB_XCNT(j)  (256  + 64 * (j))
#define XB_XSUB(j)  (1280 + 64 * (j))
#define XB_XGEN(j)  (2304 + 64 * (j))
#define XB_TOP      3328
#define XB_TOPGEN   3392
#define XCD_BAR_WORDS 3456
#define XB_SPIN_CAP (1u << 18)
__device__ __forceinline__ unsigned xb_ld(unsigned* p)              { return __hip_atomic_load(p, __ATOMIC_RELAXED, __HIP_MEMORY_SCOPE_AGENT); }
__device__ __forceinline__ unsigned xb_add(unsigned* p, unsigned v) { return __hip_atomic_fetch_add(p, v, __ATOMIC_RELAXED, __HIP_MEMORY_SCOPE_AGENT); }
__device__ __forceinline__ unsigned xb_xcc_id() { return (unsigned)__builtin_amdgcn_s_getreg((3 << 11) | 20) & 0xFu; }
#define XB_SPIN(cond, bar) do { unsigned _sp = 0; while (cond) { __builtin_amdgcn_s_sleep(1); \
    if ((++_sp & 255u) == 0u) { if (xb_ld(&(bar)[XB_TMO])) break; if (_sp > XB_SPIN_CAP) { atomicAdd(&(bar)[XB_TMO], 1u); break; } } } } while (0)
struct XcdBarrier { unsigned* bar; unsigned x; volatile LAS unsigned* st; };
__device__ __forceinline__ XcdBarrier xcd_barrier_post(unsigned* bar, volatile LAS unsigned* st) {
    XcdBarrier b; b.bar = bar; b.x = xb_xcc_id(); b.st = st;
    if (threadIdx.x == 0) (void)xb_add(&bar[XB_XCNT(b.x)], 1u);
    return b;
}
__device__ __forceinline__ void xcd_barrier_complete(unsigned* bar, unsigned x, unsigned& nloc, unsigned& nx) {
    const unsigned G = gridDim.x * gridDim.y * gridDim.z;
    unsigned sum, cnt, mine, sp = 0u;
    for (;;) {
        sum = 0u; cnt = 0u; mine = 0u;
#pragma unroll
        for (unsigned j = 0; j < 16; ++j) { const unsigned c = xb_ld(&bar[XB_XCNT(j)]); sum += c; cnt += (c > 0u) ? 1u : 0u; mine = (j == x) ? c : mine; }
        if (sum == G) break;
        __builtin_amdgcn_s_sleep(1);
        if ((++sp & 255u) == 0u) { if (xb_ld(&bar[XB_TMO])) break; if (sp > XB_SPIN_CAP) { atomicAdd(&bar[XB_TMO], 1u); break; } }
    }
    nloc = mine > 0u ? mine : 1u; nx = cnt > 0u ? cnt : 1u;
}
__device__ __forceinline__ void xcd_barrier(const XcdBarrier& b, bool thread0) {
    asm volatile("s_waitcnt vmcnt(0)" ::: "memory");
    __syncthreads();
    if (thread0) {
        unsigned* bar = b.bar;
        __builtin_amdgcn_s_waitcnt(0);
        unsigned nloc = b.st[0], nx = b.st[1];
        if (nloc == 0u) { xcd_barrier_complete(bar, b.x, nloc, nx); b.st[0] = nloc; b.st[1] = nx; }
        const unsigned old = xb_add(&bar[XB_XSUB(b.x)], 1u);
        const unsigned gen = old / nloc;
        if (old + 1u == (gen + 1u) * nloc) {
            __builtin_amdgcn_fence(__ATOMIC_RELEASE, "agent");
            asm volatile("s_waitcnt vmcnt(0)" ::: "memory");
            const unsigned og = xb_add(&bar[XB_TOP], 1u);
            const unsigned tg = og / nx;
            if (og + 1u == (tg + 1u) * nx) xb_add(&bar[XB_TOPGEN], 1u);
            else XB_SPIN(xb_ld(&bar[XB_TOPGEN]) == tg, bar);
            __builtin_amdgcn_fence(__ATOMIC_ACQUIRE, "agent");
            xb_add(&bar[XB_XGEN(b.x)], 1u);
            asm volatile("s_waitcnt vmcnt(0)" ::: "memory");
        } else {
            XB_SPIN(xb_ld(&bar[XB_XGEN(b.x)]) == gen, bar);
            __builtin_amdgcn_fence(__ATOMIC_ACQUIRE, "agent");
            asm volatile("s_waitcnt vmcnt(0)" ::: "memory");
        }
    }
    __syncthreads();
}

#ifndef EPI_PROBE_MASK
#define EPI_PROBE_MASK 0
#endif
using pg8::Unit;
struct EpiIn {
    static constexpr bool PERM = true, PROBE = (EPI_PROBE_MASK & 1) != 0;
    bf16_t* P; float* GA; const float* cosT; const float* sinT;
    __device__ __forceinline__ void operator()(const f32x4 (&acc)[2][2][4][2], const Unit& u, int wr, int wc, int fr, int fq, bool nostore = false) const {
        const int row0 = u.pm * 256 + wr * 64 + fr; const int pn = u.pn;
        if (pn == 36) {
            if (wc == 0) {
#pragma unroll
                for (int ai = 0; ai < 2; ++ai)
#pragma unroll
                    for (int m = 0; m < 4; ++m) { const size_t row = (size_t)(row0 + ai * 128 + m * 16);
#pragma unroll
                        for (int n = 0; n < 2; ++n) *(f32x4*)(GA + row * 32 + 8 * fq + 4 * n) = acc[ai][0][m][n]; }
            }
            return;
        }
        const int colbase = pn * 256 + wc * 32 + 8 * fq;
        if (pn < 8) {
            const bool lat = u.pm < 128; const float qs = pn < 4 ? QSCALE : 1.f; const int axis = wc & 1;
#pragma unroll
            for (int ai = 0; ai < 2; ++ai)
#pragma unroll
                for (int m = 0; m < 4; ++m) { const int row = row0 + ai * 128 + m * 16; const int s = row & 4095; const int pos = axis ? (s & 63) : (s >> 6);
                    f32x4 cc = (f32x4){1.f, 1.f, 1.f, 1.f}, ss = (f32x4){0.f, 0.f, 0.f, 0.f};
                    if (lat) { cc = *(const f32x4*)(cosT + pos * 16 + 4 * fq); ss = *(const f32x4*)(sinT + pos * 16 + 4 * fq); }
                    bf16_t* rowp = P + (size_t)row * PW + colbase;
#pragma unroll
                    for (int bj = 0; bj < 2; ++bj) { const f32x4 x0 = acc[ai][bj][m][0], x1 = acc[ai][bj][m][1];
                        f32x4 o0, o1;
                        o0[0] = (x0[0] * cc[0] - x0[1] * ss[0]) * qs; o0[1] = (x0[1] * cc[0] + x0[0] * ss[0]) * qs; o0[2] = (x0[2] * cc[1] - x0[3] * ss[1]) * qs; o0[3] = (x0[3] * cc[1] + x0[2] * ss[1]) * qs;
                        o1[0] = (x1[0] * cc[2] - x1[1] * ss[2]) * qs; o1[1] = (x1[1] * cc[2] + x1[0] * ss[2]) * qs; o1[2] = (x1[2] * cc[3] - x1[3] * ss[3]) * qs; o1[3] = (x1[3] * cc[3] + x1[2] * ss[3]) * qs;
                        u32x4 w; w.x = pk2(o0[0], o0[1]); w.y = pk2(o0[2], o0[3]); w.z = pk2(o1[0], o1[1]); w.w = pk2(o1[2], o1[3]);
                        *(u32x4*)(rowp + bj * 128) = w; } }
        } else {
            const bool sg = pn >= 24;
#pragma unroll
            for (int ai = 0; ai < 2; ++ai)
#pragma unroll
                for (int m = 0; m < 4; ++m) { const int row = row0 + ai * 128 + m * 16; bf16_t* rowp = P + (size_t)row * PW + colbase;
#pragma unroll
                    for (int bj = 0; bj < 2; ++bj) { f32x4 v0 = acc[ai][bj][m][0], v1 = acc[ai][bj][m][1];
                        if (sg) {
#pragma unroll
                            for (int e = 0; e < 4; ++e) { v0[e] = fmaxf(sigmoidf_(v0[e]), 1e-25f); v1[e] = fmaxf(sigmoidf_(v1[e]), 1e-25f); } }
                        u32x4 w; w.x = pk2(v0[0], v0[1]); w.y = pk2(v0[2], v0[3]); w.z = pk2(v1[0], v1[1]); w.w = pk2(v1[2], v1[3]);
                        if (!nostore) *(u32x4*)(rowp + bj * 128) = w; else asm volatile("" :: "v"(w)); } }
        }
    }
};
template <int MODE> struct EpiGate {
    static constexpr bool PERM = false, PROBE = false;
    const bf16_t* P; float* M32; bf16_t* MG;
    __device__ __forceinline__ void operator()(const f32x4 (&acc)[2][2][4][2], const Unit& u, int wr, int wc, int fr, int fq) const {
        const int row0 = u.pm * 256 + wr * 64 + fr, col0 = u.pn * 256 + wc * 32 + 4 * fq;
#pragma unroll
        for (int ai = 0; ai < 2; ++ai)
#pragma unroll
            for (int m = 0; m < 4; ++m) { const size_t row = (size_t)(row0 + ai * 128 + m * 16);
#pragma unroll
                for (int bj = 0; bj < 2; ++bj)
#pragma unroll
                    for (int n = 0; n < 2; ++n) { const int col = col0 + bj * 128 + 16 * n;
                        const u32x2 gw = *(const u32x2*)(P + row * PW + OGATE + MODE * 1024 + col);
                        const f32x4 s = (f32x4){bflo(gw.x), bfhi(gw.x), bflo(gw.y), bfhi(gw.y)};
                        f32x4 v = s * acc[ai][bj][m][n];
                        float* mp = M32 + row * 1024 + col;
                        if (MODE >= 1) v = v + __builtin_nontemporal_load((const f32x4*)mp);
                        if (MODE <= 1) *(f32x4*)mp = v;
                        else { u32x2 w; w.x = pk2(v[0], v[1]); w.y = pk2(v[2], v[3]); *(u32x2*)(MG + row * 1024 + col) = w; } } }
    }
};
struct EpiMerge {
    static constexpr bool PERM = false;
    const bf16_t* P; bf16_t* MG;
    __device__ __forceinline__ void operator()(f32x4 (&acc)[2][2][4][2], const pg8::UnitMS& u, int wr, int wc, int fr, int fq) const {
        const int row0 = u.pm * 256 + wr * 64 + fr, col0 = u.pn * 256 + wc * 32 + 4 * fq; const int seg = u.seg;
#pragma unroll
        for (int ai = 0; ai < 2; ++ai)
#pragma unroll
            for (int m = 0; m < 4; ++m) { const size_t row = (size_t)(row0 + ai * 128 + m * 16); const bf16_t* gp = P + row * PW + OGATE + col0;
#pragma unroll
                for (int bj = 0; bj < 2; ++bj)
#pragma unroll
                    for (int n = 0; n < 2; ++n) { const int co = bj * 128 + 16 * n;
                        const u32x2 ga = *(const u32x2*)(gp + seg * 1024 + co);
                        const f32x4 sa = (f32x4){bflo(ga.x), bfhi(ga.x), bflo(ga.y), bfhi(ga.y)};
                        if (seg < 2) { const u32x2 gb = *(const u32x2*)(gp + (seg + 1) * 1024 + co);
                            const f32x4 sb = (f32x4){bflo(gb.x), bfhi(gb.x), bflo(gb.y), bfhi(gb.y)};
                            f32x4 r; r[0] = sa[0] * __builtin_amdgcn_rcpf(sb[0]); r[1] = sa[1] * __builtin_amdgcn_rcpf(sb[1]); r[2] = sa[2] * __builtin_amdgcn_rcpf(sb[2]); r[3] = sa[3] * __builtin_amdgcn_rcpf(sb[3]);
                            acc[ai][bj][m][n] = acc[ai][bj][m][n] * r;
                        } else { const f32x4 v = acc[ai][bj][m][n] * sa; u32x2 w; w.x = pk2(v[0], v[1]); w.y = pk2(v[2], v[3]); *(u32x2*)(MG + row * 1024 + col0 + co) = w; } } }
    }
};
struct OutProjOrder {
    pg8::StaticOrder so; size_t a1, b1;
    __device__ __forceinline__ bool next(int i, pg8::UnitMS& u) const {
        pg8::Unit t; if (!so.next(i / 3, t)) return false;
        const int seg = i % 3; u.pm = t.pm; u.pn = t.pn; u.seg = seg; u.nt = seg == 0 ? 16 : 8;
        const size_t ta = (size_t)t.pm * (256 * 1024 * 2), tb = (size_t)t.pn * (256 * 1024 * 2);
        u.aoff = ta + (seg == 0 ? 0 : a1 + (seg == 2 ? 1024 : 0)); u.boff = tb + (seg == 0 ? 0 : b1 + (seg == 2 ? 1024 : 0)); return true;
    }
    __device__ __forceinline__ void a_ready(const pg8::UnitMS&) const {}
    __device__ __forceinline__ void done(const pg8::UnitMS&) const {}
};
struct EpiRes {
    static constexpr bool PERM = false, PROBE = false;
    const float* xlat; const float* xctx; float* XW; const float* mod;
    __device__ __forceinline__ void operator()(const f32x4 (&acc)[2][2][4][2], const Unit& u, int wr, int wc, int fr, int fq) const {
        const int row0 = u.pm * 256 + wr * 64 + fr, col0 = u.pn * 256 + wc * 32 + 4 * fq;
        const int mr = u.pm < 128 ? (u.pm >> 4) : 8; const float* xin = u.pm < 128 ? xlat : xctx;
        const float* g1 = mod + (size_t)mr * 6144 + 2048;
        f32x4 gv[2][2];
#pragma unroll
        for (int bj = 0; bj < 2; ++bj)
#pragma unroll
            for (int n = 0; n < 2; ++n) gv[bj][n] = *(const f32x4*)(g1 + col0 + bj * 128 + 16 * n);
#pragma unroll
        for (int ai = 0; ai < 2; ++ai)
#pragma unroll
            for (int m = 0; m < 4; ++m) { const size_t off = (size_t)(row0 + ai * 128 + m * 16) * 1024 + col0;
#pragma unroll
                for (int bj = 0; bj < 2; ++bj)
#pragma unroll
                    for (int n = 0; n < 2; ++n) { const f32x4 xi = *(const f32x4*)(xin + off + bj * 128 + 16 * n);
                        *(f32x4*)(XW + off + bj * 128 + 16 * n) = xi + gv[bj][n] * acc[ai][bj][m][n]; } }
    }
};
struct EpiSwiglu {
    static constexpr bool PERM = true, PROBE = (EPI_PROBE_MASK & 2) != 0;
    bf16_t* HH; const float* b1;
    __device__ __forceinline__ void operator()(const f32x4 (&acc)[2][2][4][2], const Unit& u, int wr, int wc, int fr, int fq, bool = false) const {
        const int row0 = u.pm * 256 + wr * 64 + fr, c0 = u.pn * 256 + wc * 32 + 8 * fq; const int e = u.pb >> 3;
        const float* bp = b1 + (size_t)e * 2048 + c0;
        f32x4 bv[2][2];
#pragma unroll
        for (int bj = 0; bj < 2; ++bj)
#pragma unroll
            for (int n = 0; n < 2; ++n) bv[bj][n] = *(const f32x4*)(bp + bj * 128 + 4 * n);
#pragma unroll
        for (int ai = 0; ai < 2; ++ai)
#pragma unroll
            for (int m = 0; m < 4; ++m) { bf16_t* rowp = HH + (size_t)(row0 + ai * 128 + m * 16) * 1024 + (c0 >> 1);
#pragma unroll
                for (int bj = 0; bj < 2; ++bj) { const f32x4 v0 = acc[ai][bj][m][0] + bv[bj][0], v1 = acc[ai][bj][m][1] + bv[bj][1];
                    float o[4];
#pragma unroll
                    for (int p = 0; p < 4; ++p) { float gl = p < 2 ? v0[2 * p] : v1[2 * p - 4], ln = p < 2 ? v0[2 * p + 1] : v1[2 * p - 3];
                        gl = fminf(gl, 7.f); ln = fminf(fmaxf(ln, -7.f), 7.f); o[p] = gl * sigmoidf_(1.702f * gl) * (ln + 1.f); }
                    u32x2 w; w.x = pk2(o[0], o[1]); w.y = pk2(o[2], o[3]); *(u32x2*)(rowp + bj * 64) = w; } }
    }
};
struct EpiY {
    static constexpr bool PERM = true, PROBE = (EPI_PROBE_MASK & 2) != 0;
    bf16_t* YY; const float* b2;
    __device__ __forceinline__ void operator()(const f32x4 (&acc)[2][2][4][2], const Unit& u, int wr, int wc, int fr, int fq, bool = false) const {
        const int row0 = u.pm * 256 + wr * 64 + fr, c0 = u.pn * 256 + wc * 32 + 8 * fq; const int e = u.pb >> 2;
        const float* bp = b2 + (size_t)e * 1024 + c0;
        f32x4 bv[2][2];
#pragma unroll
        for (int bj = 0; bj < 2; ++bj)
#pragma unroll
            for (int n = 0; n < 2; ++n) bv[bj][n] = *(const f32x4*)(bp + bj * 128 + 4 * n);
#pragma unroll
        for (int ai = 0; ai < 2; ++ai)
#pragma unroll
            for (int m = 0; m < 4; ++m) { bf16_t* rowp = YY + (size_t)(row0 + ai * 128 + m * 16) * 1024 + c0;
#pragma unroll
                for (int bj = 0; bj < 2; ++bj) { const f32x4 v0 = acc[ai][bj][m][0] + bv[bj][0], v1 = acc[ai][bj][m][1] + bv[bj][1];
                    u32x4 w; w.x = pk2(v0[0], v0[1]); w.y = pk2(v0[2], v0[3]); w.z = pk2(v1[0], v1[1]); w.w = pk2(v1[2], v1[3]);
                    *(u32x4*)(rowp + bj * 128) = w; } }
    }
};
struct Gemm1LastOrder {
    pg8::StaticOrder so; int G, c;
    __device__ __forceinline__ bool next(int i, Unit& u) const {
        const long L = (long)i * G + c;
        if (L < so.nwg) return so.next(i, u);
        const int x = (int)(L - so.nwg); if (x >= 96) return false;
        const int r = x / 12, k = x % 12;
        u.pm = 128 + r; u.pn = k < 8 ? 4 + k : (k < 11 ? 19 + (k - 8) : 36); u.pb = u.pn; return true;
    }
    __device__ __forceinline__ void a_ready(const Unit&) const {}
    __device__ __forceinline__ void done(const Unit&) const {}
};
struct MoeOrder {
    int ntiles, nN, G, c; const LAS int* tile_exp;
    __device__ __forceinline__ bool next(int i, Unit& u) const {
        const long L = (long)i * G + c; if (L >= (long)ntiles * nN) return false;
        const int tile = (int)(L / nN), pn = (int)(L % nN);
        u.pm = tile; u.pn = pn; u.pb = __builtin_amdgcn_readfirstlane(tile_exp[tile]) * nN + pn; return true;
    }
    __device__ __forceinline__ void a_ready(const Unit&) const {}
    __device__ __forceinline__ void done(const Unit&) const {}
};
struct Args { const float* in[26]; float* out; unsigned char* ws; int ph_lo, ph_hi; };
struct Frame {
    LAS unsigned char* lds; unsigned char* ws; int tid, lane, wave, G, gw, NGW;
};
constexpr int PTR_OFF = MISC_OFF + 256;
__device__ __forceinline__ const float* in_ptr(const Frame& F, int i) {
    int z = PTR_OFF; asm volatile("" : "+v"(z));
    const unsigned long long v = ((volatile LAS unsigned long long*)(F.lds + z))[i];
    const unsigned lo = __builtin_amdgcn_readfirstlane((unsigned)v), hi = __builtin_amdgcn_readfirstlane((unsigned)(v >> 32));
    return (const float*)(const GAS float*)(((unsigned long long)hi << 32) | lo);
}
__device__ __forceinline__ float* out_ptr(const Frame& F) { return (float*)in_ptr(F, 26); }
__device__ __forceinline__ Frame relaunder(const Frame& F0) {
    Frame F = F0; int ln = (int)__builtin_amdgcn_mbcnt_hi(~0u, __builtin_amdgcn_mbcnt_lo(~0u, 0u)); asm volatile("" : "+v"(ln));
    F.lane = ln; F.tid = F0.wave * 64 + ln; F.wave = F0.wave; F.gw = blockIdx.x * NWAVES + F.wave; return F;
}

constexpr int CV_IN = 16 * 289, CV_D = 512, CV_C = 256, CV_G = 256, CV_O = 512, CV_1 = 32 * 1024, CV_2 = 32 * 512;
constexpr int CV_SMALL = CV_IN + CV_D + CV_C + CV_G + CV_O, CV_PER_L = CV_SMALL + CV_1 + CV_2;
constexpr int CV_NWG = 96;
struct TItem { const float* src; bf16_t* dst; int srcN; bool ilv; };
__device__ __forceinline__ TItem conv_decode(const Frame& F, int it) {
    unsigned char* ws = F.ws; const int l = it / CV_PER_L; int r = it % CV_PER_L; TItem t; t.ilv = false;
    auto mk = [&](const float* W, int srcN, bf16_t* WT, int k0, int n0, int drow, int dk0) { t.src = W + (size_t)k0 * srcN + n0; t.srcN = srcN; t.dst = WT + (size_t)drow * 1024 + dk0; };
    if (r < CV_IN) { const int kb = r / 289, nb = r % 289, n0 = nb * 32; const int d0 = n0 < 6144 ? n0 : (n0 < 6176 ? 9216 + (n0 - 6144) : n0 - 32);
        mk(in_ptr(F, 8) + (size_t)l * 1024 * 9248, 9248, (bf16_t*)(ws + WS_WIN + l * WIN_STRIDE), kb * 64, n0, d0, kb * 64); t.ilv = n0 < 2048; return t; } r -= CV_IN;
    if (r < CV_D) { const int kb = r / 32, nb = r % 32; mk(in_ptr(F, 11) + (size_t)l * 1024 * 1024, 1024, (bf16_t*)(ws + WS_WD + l * W1K_STRIDE), kb * 64, nb * 32, nb * 32, kb * 64); return t; } r -= CV_D;
    if (r < CV_C) { const int kb = r / 32, nb = r % 32; mk(in_ptr(F, 13) + (size_t)l * 512 * 1024, 1024, (bf16_t*)(ws + WS_WCG + l * W1K_STRIDE), kb * 64, nb * 32, nb * 32, kb * 64); return t; } r -= CV_C;
    if (r < CV_G) { const int kb = r / 32, nb = r % 32; mk(in_ptr(F, 17) + (size_t)l * 512 * 1024, 1024, (bf16_t*)(ws + WS_WCG + l * W1K_STRIDE), kb * 64, nb * 32, nb * 32, 512 + kb * 64); return t; } r -= CV_G;
    if (r < CV_O) { const int kb = r / 32, nb = r % 32; mk(in_ptr(F, 18) + (size_t)l * 1024 * 1024, 1024, (bf16_t*)(ws + WS_WO + l * W1K_STRIDE), kb * 64, nb * 32, nb * 32, kb * 64); return t; } r -= CV_O;
    if (r < CV_1) { const int e = r / 1024, q = r % 1024, kb = q / 64, nb = q % 64;
        mk(in_ptr(F, 21) + ((size_t)l * 32 + e) * 1024 * 2048, 2048, (bf16_t*)(ws + WS_W1 + l * W1_STRIDE) + (size_t)e * 2048 * 1024, kb * 64, nb * 32, nb * 32, kb * 64); return t; } r -= CV_1;
    { const int e = r / 512, q = r % 512, kb = q / 32, nb = q % 32;
        mk(in_ptr(F, 23) + ((size_t)l * 32 + e) * 1024 * 1024, 1024, (bf16_t*)(ws + WS_W2 + l * W2_STRIDE) + (size_t)e * 1024 * 1024, kb * 64, nb * 32, nb * 32, kb * 64); }
    return t;
}
__device__ __forceinline__ void ti_load(const TItem& t, int lane, f32x4 (&v)[8]) {
    const int kk8 = lane >> 3, n4 = (lane & 7) * 4;
#pragma unroll
    for (int i = 0; i < 8; ++i) v[i] = __builtin_nontemporal_load((const f32x4*)(t.src + (size_t)(8 * i + kk8) * t.srcN + n4));
}
__device__ __forceinline__ void ti_finish(const TItem& t, int lane, const f32x4 (&v)[8], LAS float* scr) {
    {   const int kk8 = lane >> 3, n4 = (lane & 7) * 4;
#pragma unroll
        for (int i = 0; i < 8; ++i) { LAS float* d = scr + (8 * i + kk8) * 33 + n4; d[0] = v[i][0]; d[1] = v[i][1]; d[2] = v[i][2]; d[3] = v[i][3]; }
    }
    LDS_WAIT(); asm volatile("" ::: "memory");
    const int c = lane & 7;
#pragma unroll
    for (int j = 0; j < 4; ++j) { const int n = (lane >> 3) + 8 * j; const LAS float* s = scr + (8 * c) * 33 + n;
        u32x4 o; o.x = pk2(s[0 * 33], s[1 * 33]); o.y = pk2(s[2 * 33], s[3 * 33]); o.z = pk2(s[4 * 33], s[5 * 33]); o.w = pk2(s[6 * 33], s[7 * 33]);
        const int nd = t.ilv ? (2 * (n & 15) + (n >> 4)) : n;
        *(u32x4*)(t.dst + (size_t)nd * 1024 + 8 * c) = o; }
    LDS_WAIT(); asm volatile("" ::: "memory");
}
__device__ __forceinline__ void conv_range(const Frame& F, int lo, int hi, int wi, int nw) {
    LAS float* scr = (LAS float*)(F.lds + F.wave * 16384);
    f32x4 va[8], vb[8]; TItem ta, tb; int it = lo + wi;
    if (it < hi) { ta = conv_decode(F, it); ti_load(ta, F.lane, va); }
#pragma unroll 1
    while (it < hi) {
        const bool h1 = it + nw < hi;
        if (h1) { tb = conv_decode(F, it + nw); ti_load(tb, F.lane, vb); }
        ti_finish(ta, F.lane, va, scr);
        if (!h1) break;
        const bool h2 = it + 2 * nw < hi;
        if (h2) { ta = conv_decode(F, it + 2 * nw); ti_load(ta, F.lane, va); }
        ti_finish(tb, F.lane, vb, scr);
        it += 2 * nw;
        if (!h2) break;
    }
}

__device__ __forceinline__ void p0_prologue(const Frame& F0) {
    const Frame F = relaunder(F0);
    __syncthreads();
    unsigned char* ws = F.ws;
    {
        LAS float* sc = (LAS float*)F.lds;
        LAS float* red = sc + 9 * 1024;
        for (int i = F.tid; i < 9 * 1024; i += NTHR) { const float c = i < 8192 ? in_ptr(F, 1)[i] : in_ptr(F, 3)[i - 8192]; sc[i] = c / (1.f + __expf(-c)); }
        __syncthreads();
        float* MOD = (float*)(ws + WS_MOD);
        for (int job = blockIdx.x; job < 192; job += F.G) {
            const int l = job / 96, blk = job % 96, ks = F.tid >> 6, n = F.tid & 63, col = blk * 64 + n;
            const float* w = in_ptr(F, 4) + (size_t)l * 1024 * 6144 + col;
            float a[9];
#pragma unroll
            for (int r = 0; r < 9; ++r) a[r] = 0.f;
            for (int k = ks * 128; k < ks * 128 + 128; ++k) { const float wv = w[(size_t)k * 6144];
#pragma unroll
                for (int r = 0; r < 9; ++r) a[r] += sc[r * 1024 + k] * wv; }
#pragma unroll
            for (int r = 0; r < 9; ++r) red[(ks * 9 + r) * 64 + n] = a[r];
            __syncthreads();
            for (int o = F.tid; o < 576; o += NTHR) { const int r = o >> 6, nn = o & 63; float s = 0.f;
#pragma unroll
                for (int k8 = 0; k8 < 8; ++k8) s += red[(k8 * 9 + r) * 64 + nn];
                MOD[((size_t)l * 9 + r) * 6144 + blk * 64 + nn] = s + in_ptr(F, 5)[(size_t)l * 6144 + blk * 64 + nn]; }
            __syncthreads();
        }
    }
    if (blockIdx.x == 0) {
        float* cosT = (float*)(ws + WS_ROPE); float* sinT = cosT + 1024;
        for (int i = F.tid; i < 1024; i += NTHR) { const int pos = i >> 4, f = i & 15; const float inv = powf(10000.f, -(float)(2 * f) / 32.f); const float ang = (float)pos * inv; cosT[i] = cosf(ang); sinT[i] = sinf(ang); }
        if (F.wave < 2) { const int l = F.wave; const float* dl = in_ptr(F, 9) + (size_t)l * 256;
            const float s1 = wave_sum(dl[F.lane] * dl[64 + F.lane]), s2 = wave_sum(dl[128 + F.lane] * dl[192 + F.lane]);
            const float lam_init = 0.8f - 0.6f * expf(-0.3f * (float)l);
            if (F.lane == 0) ((float*)(ws + WS_LAM))[l] = expf(s1) - expf(s2) + lam_init; }
    }
    __syncthreads();
    conv_range(F, 0, F.G >= 64 + CV_NWG ? CV_SMALL : 2 * CV_PER_L, F.gw, F.NGW);
    for (int i = F.gw * 64 + F.lane; i < 2 * 224 * 128; i += F.NGW * 64) { const int l = i / (224 * 128), q = i % (224 * 128);
        *(u32x4*)(ws + WS_WIN + l * WIN_STRIDE + (size_t)9248 * 2048 + (size_t)q * 16) = (u32x4){0u, 0u, 0u, 0u}; }
}

__device__ __forceinline__ void load_row(const float* p, int lane, f32x4 (&v)[4]) {
#pragma unroll
    for (int j = 0; j < 4; ++j) v[j] = *(const f32x4*)(p + 256 * j + 4 * lane);
}
__device__ __forceinline__ float row_rstd(const f32x4 (&v)[4]) {
    float s = 0.f;
#pragma unroll
    for (int j = 0; j < 4; ++j) s += (v[j][0] * v[j][0] + v[j][1] * v[j][1]) + (v[j][2] * v[j][2] + v[j][3] * v[j][3]);
    return 1.0f / sqrtf(wave_sum(s) * (1.f / 1024.f) + RMS_EPS);
}
__device__ __forceinline__ void norm_mod(f32x4 (&v)[4], const float* g, const float* shift, const float* scale, int lane) {
    const float rstd = row_rstd(v);
#pragma unroll
    for (int j = 0; j < 4; ++j) { const f32x4 gv = *(const f32x4*)(g + 256 * j + 4 * lane), sh = *(const f32x4*)(shift + 256 * j + 4 * lane), sc = *(const f32x4*)(scale + 256 * j + 4 * lane);
        v[j] = (v[j] * rstd * gv) * (sc + 1.f) + sh; }
}
__device__ __forceinline__ void store_row_bf16(bf16_t* p, int lane, const f32x4 (&v)[4]) {
#pragma unroll
    for (int j = 0; j < 4; ++j) { u32x2 w; w.x = pk2(v[j][0], v[j][1]); w.y = pk2(v[j][2], v[j][3]); *(u32x2*)(p + 256 * j + 4 * lane) = w; }
}

__device__ __forceinline__ void p_norm1_l0(const Frame& F0) {
    const Frame F = relaunder(F0);
    const float* MOD = (const float*)(F.ws + WS_MOD); bf16_t* H = (bf16_t*)(F.ws + WS_H);
    const float* x0 = in_ptr(F, 0); const float* c0p = in_ptr(F, 2); const float* g1n = in_ptr(F, 6);
    f32x4 nx[4];
    if (F.gw < TT) load_row(F.gw < TL ? x0 + (size_t)F.gw * 1024 : c0p + (size_t)(F.gw - TL) * 1024, F.lane, nx);
    for (int row = F.gw; row < TT; row += F.NGW) {
        const int mr = row < TL ? (row >> 12) : 8;
        f32x4 v[4];
#pragma unroll
        for (int j = 0; j < 4; ++j) v[j] = nx[j];
        const int rn = row + F.NGW;
        if (rn < TT) load_row(rn < TL ? x0 + (size_t)rn * 1024 : c0p + (size_t)(rn - TL) * 1024, F.lane, nx);
        norm_mod(v, g1n, MOD + (size_t)mr * 6144, MOD + (size_t)mr * 6144 + 1024, F.lane);
        store_row_bf16(H + (size_t)row * 1024, F.lane, v);
    }
}

struct ConvIn { u32x4 gb, c0v, c1, c2v, x0v, x1, x2v; };
__device__ __forceinline__ void conv_load(const bf16_t* P, int it, ConvIn& v) {
    const int row = it >> 6, c0 = (it & 63) * 8;
    bool hp, hn;
    if (row < TL) { const int s = row & 4095; hp = s > 0; hn = s < 4095; } else { const int s = (row - TL) & 255; hp = s > 0; hn = s < 255; }
    const bf16_t* pr = P + (size_t)row * PW;
    v.gb = *(const u32x4*)(pr + OCB + c0); v.c1 = *(const u32x4*)(pr + OCC + c0); v.x1 = *(const u32x4*)(pr + OCX + c0);
    v.c0v = (u32x4){0u, 0u, 0u, 0u}; v.x0v = v.c0v; v.c2v = v.c0v; v.x2v = v.c0v;
    if (hp) { v.c0v = *(const u32x4*)(pr - PW + OCC + c0); v.x0v = *(const u32x4*)(pr - PW + OCX + c0); }
    if (hn) { v.c2v = *(const u32x4*)(pr + PW + OCC + c0); v.x2v = *(const u32x4*)(pr + PW + OCX + c0); }
}
__device__ __forceinline__ void p_conv(const Frame& F0, const float* cw  , int wi, int nw, int nrows) {
    const Frame F = relaunder(F0);
    const bf16_t* P = (const bf16_t*)(F.ws + WS_P); bf16_t* ACG = (bf16_t*)(F.ws + WS_ACG);
    const int gt = wi * 64 + F.lane, NGT = nw * 64, end = nrows * 64;
    ConvIn nx; if (gt < end) conv_load(P, gt, nx);
    for (int it = gt; it < end; it += NGT) {
        const ConvIn v = nx;
        if (it + NGT < end) conv_load(P, it + NGT, nx);
        const int row = it >> 6, c0 = (it & 63) * 8;
        float o[8];
#pragma unroll
        for (int q = 0; q < 4; ++q) {
#pragma unroll
            for (int hh = 0; hh < 2; ++hh) { const int ch = c0 + 2 * q + hh;
                const float b = hh ? bfhi(v.gb[q]) : bflo(v.gb[q]);
                const float u0 = (hh ? bfhi(v.c0v[q]) : bflo(v.c0v[q])) * (hh ? bfhi(v.x0v[q]) : bflo(v.x0v[q]));
                const float u1 = (hh ? bfhi(v.c1[q]) : bflo(v.c1[q])) * (hh ? bfhi(v.x1[q]) : bflo(v.x1[q]));
                const float u2 = (hh ? bfhi(v.c2v[q]) : bflo(v.c2v[q])) * (hh ? bfhi(v.x2v[q]) : bflo(v.x2v[q]));
                o[2 * q + hh] = b * (cw[ch] * u0 + cw[512 + ch] * u1 + cw[1024 + ch] * u2); } }
        u32x4 w; w.x = pk2(o[0], o[1]); w.y = pk2(o[2], o[3]); w.z = pk2(o[4], o[5]); w.w = pk2(o[6], o[7]);
        *(u32x4*)(ACG + (size_t)row * 1024 + c0) = w;
    }
}
__device__ __forceinline__ int gla_row(int step, int b, int dir) {
    if (dir == 0) return step < 256 ? TL + b * 256 + step : b * 4096 + (step - 256);
    return step < 256 ? TL + b * 256 + (255 - step) : b * 4096 + (4095 - (step - 256));
}
__device__ __forceinline__ void p_gla_chain(const Frame& F0, const float* wa2  , const float* ba  , int chain) {
    const Frame F = relaunder(F0);
    const bf16_t* P = (const bf16_t*)(F.ws + WS_P); const float* GA = (const float*)(F.ws + WS_GA); float* OG = (float*)(F.ws + WS_OG);
    const int b = chain >> 3, h = (chain >> 1) & 3, dir = chain & 1;
    LAS float* Wa = (LAS float*)F.lds;
    LAS float* bav = Wa + 1024;
    LAS float* qs = bav + 64;
    LAS float* ks = qs + 1024;
    LAS float* egs = ks + 1024;
    LAS float* vs = egs + 1024;
    LAS float* po = vs + 2048;
    const int tid = F.tid, dkg = tid >> 7, dv = tid & 127;
    __syncthreads();
    for (int i = tid; i < 1024; i += NTHR) { const int r = i >> 6, dk = i & 63; Wa[i] = wa2[(size_t)(dir * 16 + r) * 256 + h * 64 + dk]; }
    if (tid < 64) bav[tid] = ba[dir * 256 + h * 64 + tid];
    float S[16];
#pragma unroll
    for (int i = 0; i < 16; ++i) S[i] = 0.f;
    for (int blk = 0; blk < 272; ++blk) {
        __syncthreads();
        for (int e = tid; e < 1024; e += NTHR) { const int tk = e >> 6, dk = e & 63; const int row = gla_row(blk * 16 + tk, b, dir);
            qs[e] = bf2f(P[(size_t)row * PW + OGQ + h * 64 + dk]);
            ks[e] = bf2f(P[(size_t)row * PW + OGK + h * 64 + dk]);
            float z = bav[dk]; const float* ga = GA + (size_t)row * 32 + dir * 16;
#pragma unroll
            for (int r = 0; r < 16; ++r) z += ga[r] * Wa[r * 64 + dk];
            const float ls = fminf(z, 0.f) - log1pf(__expf(-fabsf(z)));
            egs[e] = __expf(ls * (1.f / 16.f)); }
        for (int e = tid; e < 2048; e += NTHR) { const int tk = e >> 7, d = e & 127; const int row = gla_row(blk * 16 + tk, b, dir);
            vs[e] = bf2f(P[(size_t)row * PW + OGV + h * 128 + d]); }
        __syncthreads();
#pragma unroll 1
        for (int tk = 0; tk < 16; ++tk) {
            const float vv = vs[tk * 128 + dv]; float pacc = 0.f;
#pragma unroll
            for (int i = 0; i < 16; ++i) { const int dk = dkg * 16 + i; S[i] = egs[tk * 64 + dk] * S[i] + ks[tk * 64 + dk] * vv; pacc += qs[tk * 64 + dk] * S[i]; }
            po[(tk * 4 + dkg) * 128 + dv] = pacc;
        }
        __syncthreads();
        for (int e = tid; e < 2048; e += NTHR) { const int tk = e >> 7, d = e & 127; const int row = gla_row(blk * 16 + tk, b, dir);
            const float o = (po[(tk * 4 + 0) * 128 + d] + po[(tk * 4 + 1) * 128 + d]) + (po[(tk * 4 + 2) * 128 + d] + po[(tk * 4 + 3) * 128 + d]);
            OG[((size_t)dir * TT + row) * 512 + h * 128 + d] = o * 0.125f; }
    }
    __syncthreads();
}

__device__ __forceinline__ void p_attn_naive(const Frame& F0, int layer, const float* subg  ) {
    const Frame F = relaunder(F0);
    const bf16_t* P = (const bf16_t*)(F.ws + WS_P); bf16_t* AD = (bf16_t*)(F.ws + WS_AD);
    float* scr = (float*)(F.ws + WS_ASCR) + (size_t)blockIdx.x * 64 * 512;
    const float lam = __builtin_nontemporal_load((const float*)(F.ws + WS_LAM) + layer);
    const float lam_init = 0.8f - 0.6f * expf(-0.3f * (float)layer);
    LAS float* Ks = (LAS float*)F.lds;
    LAS float* Vs = Ks + 4096;
    LAS float* red = Vs + 8192;
    const int tid = F.tid, qr = tid & 255, half = tid >> 8;
    const int nunits = layer == 0 ? 1024 + 64 : 1024;
    for (int u = blockIdx.x; u < nunits; u += F.G) {
        const bool lat = u < 1024;
        int b, h, qrow0, ntiles;
        if (lat) { b = u >> 7; h = (u >> 4) & 7; qrow0 = b * 4096 + (u & 15) * 256; ntiles = 68; }
        else { const int v = u - 1024; b = v >> 3; h = v & 7; qrow0 = TL + b * 256; ntiles = 4; }
        const int qrow = qrow0 + qr;
        float O[64];
#pragma unroll 1
        for (int map = 1; map >= 0; --map) {
            float q[64];
            { const bf16_t* qp = P + (size_t)qrow * PW + OQ + h * 128 + map * 64;
#pragma unroll
              for (int c = 0; c < 8; ++c) { const u32x4 w = *(const u32x4*)(qp + 8 * c);
#pragma unroll
                  for (int e = 0; e < 4; ++e) { q[8 * c + 2 * e] = bflo(w[e]); q[8 * c + 2 * e + 1] = bfhi(w[e]); } asm volatile("" ::: "memory"); } }
            float mx = -1e30f, l = 0.f;
#pragma unroll
            for (int i = 0; i < 64; ++i) O[i] = 0.f;
#pragma unroll 1
            for (int t = 0; t < ntiles; ++t) {
                const int krow0 = (lat && t < 64) ? b * 4096 + t * 64 : TL + b * 256 + (t - (lat ? 64 : 0)) * 64;
                __syncthreads();
                { const int key = tid >> 3, ch = tid & 7; const u32x4 w = *(const u32x4*)(P + (size_t)(krow0 + key) * PW + OKK + h * 128 + map * 64 + ch * 8);
                  *(LAS f32x4*)(Ks + key * 64 + ch * 8) = (f32x4){bflo(w.x), bfhi(w.x), bflo(w.y), bfhi(w.y)};
                  *(LAS f32x4*)(Ks + key * 64 + ch * 8 + 4) = (f32x4){bflo(w.z), bfhi(w.z), bflo(w.w), bfhi(w.w)}; }
#pragma unroll
                for (int i2 = 0; i2 < 2; ++i2) { const int e = tid + i2 * 512, key = e >> 4, ch = e & 15; const u32x4 w = *(const u32x4*)(P + (size_t)(krow0 + key) * PW + OV + h * 128 + ch * 8);
                  *(LAS f32x4*)(Vs + key * 128 + ch * 8) = (f32x4){bflo(w.x), bfhi(w.x), bflo(w.y), bfhi(w.y)};
                  *(LAS f32x4*)(Vs + key * 128 + ch * 8 + 4) = (f32x4){bflo(w.z), bfhi(w.z), bflo(w.w), bfhi(w.w)}; }
                __syncthreads();
#pragma unroll 1
                for (int key = 0; key < 64; ++key) {
                    float s = 0.f;
#pragma unroll
                    for (int c = 0; c < 16; ++c) { const f32x4 kv = *(const LAS f32x4*)(Ks + key * 64 + 4 * c); s += (q[4 * c] * kv[0] + q[4 * c + 1] * kv[1]) + (q[4 * c + 2] * kv[2] + q[4 * c + 3] * kv[3]);
                        if ((c & 3) == 3) asm volatile("" ::: "memory"); }
                    const float mn = fmaxf(mx, s); const float alpha = __builtin_amdgcn_exp2f(mx - mn), p = __builtin_amdgcn_exp2f(s - mn);
                    l = l * alpha + p; mx = mn;
#pragma unroll
                    for (int c = 0; c < 16; ++c) { const f32x4 vv = *(const LAS f32x4*)(Vs + key * 128 + half * 64 + 4 * c);
                        O[4 * c] = O[4 * c] * alpha + p * vv[0]; O[4 * c + 1] = O[4 * c + 1] * alpha + p * vv[1]; O[4 * c + 2] = O[4 * c + 2] * alpha + p * vv[2]; O[4 * c + 3] = O[4 * c + 3] * alpha + p * vv[3];
                        if ((c & 3) == 3) asm volatile("" ::: "memory"); }
                }
            }
            const float inv = 1.f / l;
            if (map == 1) {
#pragma unroll
                for (int i = 0; i < 16; ++i) { *(f32x4*)(scr + tid * 64 + 4 * i) = (f32x4){O[4 * i] * inv, O[4 * i + 1] * inv, O[4 * i + 2] * inv, O[4 * i + 3] * inv}; if ((i & 3) == 3) asm volatile("" ::: "memory"); }
            } else {
#pragma unroll
                for (int i = 0; i < 16; ++i) { const f32x4 t = __builtin_nontemporal_load((const f32x4*)(scr + tid * 64 + 4 * i));
                    O[4 * i] = O[4 * i] * inv - lam * t[0]; O[4 * i + 1] = O[4 * i + 1] * inv - lam * t[1]; O[4 * i + 2] = O[4 * i + 2] * inv - lam * t[2]; O[4 * i + 3] = O[4 * i + 3] * inv - lam * t[3];
                    if ((i & 3) == 3) asm volatile("" ::: "memory"); }
            }
        }
        float ss = 0.f;
#pragma unroll
        for (int i = 0; i < 64; ++i) ss += O[i] * O[i];
        __syncthreads();
        red[tid] = ss;
        __syncthreads();
        const float tot = red[qr] + red[qr + 256];
        const float r = (1.f - lam_init) / sqrtf(tot * (1.f / 128.f) + RMS_EPS);
        bf16_t* op = AD + (size_t)qrow * 1024 + h * 128 + half * 64;
#pragma unroll
        for (int c = 0; c < 8; ++c) { u32x4 w;
            w.x = pk2(O[8 * c] * r * subg[half * 64 + 8 * c], O[8 * c + 1] * r * subg[half * 64 + 8 * c + 1]);
            w.y = pk2(O[8 * c + 2] * r * subg[half * 64 + 8 * c + 2], O[8 * c + 3] * r * subg[half * 64 + 8 * c + 3]);
            w.z = pk2(O[8 * c + 4] * r * subg[half * 64 + 8 * c + 4], O[8 * c + 5] * r * subg[half * 64 + 8 * c + 5]);
            w.w = pk2(O[8 * c + 6] * r * subg[half * 64 + 8 * c + 6], O[8 * c + 7] * r * subg[half * 64 + 8 * c + 7]);
            *(u32x4*)(op + 8 * c) = w; asm volatile("" ::: "memory"); }
    }
    __syncthreads();
}

__device__ __forceinline__ void p_gla_tail(const Frame& F0, const float* gng  , int row_lo, int nrows) {
    const Frame F = relaunder(F0);
    const bf16_t* P = (const bf16_t*)(F.ws + WS_P); const float* OG = (const float*)(F.ws + WS_OG); bf16_t* ACG = (bf16_t*)(F.ws + WS_ACG);
    const int c0 = F.lane * 8; const bf16_t* OGB = (const bf16_t*)OG;
    const f32x4 g0 = *(const f32x4*)(gng + (c0 & 127)), g1 = *(const f32x4*)(gng + (c0 & 127) + 4);
    u32x4 n0 = (u32x4){0u, 0u, 0u, 0u}, n1 = n0, nr = n0;
    const int r0 = row_lo + F.wave;
    if (r0 < nrows) { n0 = *(const u32x4*)(OGB + (size_t)r0 * 512 + c0); n1 = *(const u32x4*)(OGB + ((size_t)TT + r0) * 512 + c0); nr = *(const u32x4*)(P + (size_t)r0 * PW + OGR + c0); }
    for (int row = r0; row < nrows; row += NWAVES) {
        const u32x4 w0 = n0, w1 = n1, rw = nr; const int rn = row + NWAVES;
        if (rn < nrows) { n0 = *(const u32x4*)(OGB + (size_t)rn * 512 + c0); n1 = *(const u32x4*)(OGB + ((size_t)TT + rn) * 512 + c0); nr = *(const u32x4*)(P + (size_t)rn * PW + OGR + c0); }
        f32x4 a = (f32x4){bflo(w0.x) + bflo(w1.x), bfhi(w0.x) + bfhi(w1.x), bflo(w0.y) + bflo(w1.y), bfhi(w0.y) + bfhi(w1.y)};
        f32x4 b = (f32x4){bflo(w0.z) + bflo(w1.z), bfhi(w0.z) + bfhi(w1.z), bflo(w0.w) + bflo(w1.w), bfhi(w0.w) + bfhi(w1.w)};
        float ss = (a[0] * a[0] + a[1] * a[1]) + (a[2] * a[2] + a[3] * a[3]) + (b[0] * b[0] + b[1] * b[1]) + (b[2] * b[2] + b[3] * b[3]);
        ss += __shfl_xor(ss, 1); ss += __shfl_xor(ss, 2); ss += __shfl_xor(ss, 4); ss += __shfl_xor(ss, 8);
        const float rstd = 1.f / sqrtf(ss * (1.f / 128.f) + RMS_EPS);
        float rr[8] = {bflo(rw.x), bfhi(rw.x), bflo(rw.y), bfhi(rw.y), bflo(rw.z), bfhi(rw.z), bflo(rw.w), bfhi(rw.w)};
        float o[8];
#pragma unroll
        for (int i = 0; i < 4; ++i) { const float y0 = a[i] * rstd * g0[i], y1 = b[i] * rstd * g1[i];
            o[i] = y0 * (rr[i] * sigmoidf_(rr[i])); o[4 + i] = y1 * (rr[4 + i] * sigmoidf_(rr[4 + i])); }
        u32x4 w; w.x = pk2(o[0], o[1]); w.y = pk2(o[2], o[3]); w.z = pk2(o[4], o[5]); w.w = pk2(o[6], o[7]);
        *(u32x4*)(ACG + (size_t)row * 1024 + 512 + c0) = w;
    }
}

__device__ __forceinline__ void p_gla_tail_bh(const Frame& F0, const float* gng  , int b, int h, bool with_ctx) {
    const Frame F = relaunder(F0);
    const bf16_t* P = (const bf16_t*)(F.ws + WS_P); const bf16_t* OGB = (const bf16_t*)(F.ws + WS_OG); bf16_t* ACG = (bf16_t*)(F.ws + WS_ACG);
    const int sub = F.lane >> 4, c0 = h * 128 + (F.lane & 15) * 8;
    const f32x4 g0 = *(const f32x4*)(gng + (c0 & 127)), g1 = *(const f32x4*)(gng + (c0 & 127) + 4);
    const int n = with_ctx ? 4352 : 4096;
#define TBH_ROW(i_) ((i_) < 4096 ? b * 4096 + (i_) : TL + b * 256 + ((i_) - 4096))
    u32x4 n0 = (u32x4){0u, 0u, 0u, 0u}, n1 = n0, nr = n0;
    int i = F.wave * 4 + sub;
    if (i < n) { const int r_ = TBH_ROW(i); n0 = *(const u32x4*)(OGB + (size_t)r_ * 512 + c0); n1 = *(const u32x4*)(OGB + ((size_t)TT + r_) * 512 + c0); nr = *(const u32x4*)(P + (size_t)r_ * PW + OGR + c0); }
    for (; i < n; i += NWAVES * 4) {
        const u32x4 w0 = n0, w1 = n1, rw = nr; const int row = TBH_ROW(i), in = i + NWAVES * 4;
        if (in < n) { const int r_ = TBH_ROW(in); n0 = *(const u32x4*)(OGB + (size_t)r_ * 512 + c0); n1 = *(const u32x4*)(OGB + ((size_t)TT + r_) * 512 + c0); nr = *(const u32x4*)(P + (size_t)r_ * PW + OGR + c0); }
        f32x4 a = (f32x4){bflo(w0.x) + bflo(w1.x), bfhi(w0.x) + bfhi(w1.x), bflo(w0.y) + bflo(w1.y), bfhi(w0.y) + bfhi(w1.y)};
        f32x4 bq = (f32x4){bflo(w0.z) + bflo(w1.z), bfhi(w0.z) + bfhi(w1.z), bflo(w0.w) + bflo(w1.w), bfhi(w0.w) + bfhi(w1.w)};
        float ss = (a[0] * a[0] + a[1] * a[1]) + (a[2] * a[2] + a[3] * a[3]) + (bq[0] * bq[0] + bq[1] * bq[1]) + (bq[2] * bq[2] + bq[3] * bq[3]);
        ss += __shfl_xor(ss, 1); ss += __shfl_xor(ss, 2); ss += __shfl_xor(ss, 4); ss += __shfl_xor(ss, 8);
        const float rstd = 1.f / sqrtf(ss * (1.f / 128.f) + RMS_EPS);
        float rr[8] = {bflo(rw.x), bfhi(rw.x), bflo(rw.y), bfhi(rw.y), bflo(rw.z), bfhi(rw.z), bflo(rw.w), bfhi(rw.w)};
        float o[8];
#pragma unroll
        for (int k = 0; k < 4; ++k) { const float y0 = a[k] * rstd * g0[k], y1 = bq[k] * rstd * g1[k];
            o[k] = y0 * (rr[k] * sigmoidf_(rr[k])); o[4 + k] = y1 * (rr[4 + k] * sigmoidf_(rr[4 + k])); }
        u32x4 w; w.x = pk2(o[0], o[1]); w.y = pk2(o[2], o[3]); w.z = pk2(o[4], o[5]); w.w = pk2(o[6], o[7]);
        *(u32x4*)(ACG + (size_t)row * 1024 + 512 + c0) = w;
    }
#undef TBH_ROW
}

typedef float rf2_t __attribute__((ext_vector_type(2)));
__device__ __forceinline__ float router_reduce(float (&p)[32], int lane) {
#pragma unroll
    for (int i = 0; i < 16; ++i) { const bool up = (lane & 32) != 0; const float send = up ? p[i] : p[i + 16], keep = up ? p[i + 16] : p[i]; p[i] = keep + __shfl_xor(send, 32); }
#pragma unroll
    for (int i = 0; i < 8; ++i) { const bool up = (lane & 16) != 0; const float send = up ? p[i] : p[i + 8], keep = up ? p[i + 8] : p[i]; p[i] = keep + __shfl_xor(send, 16); }
#pragma unroll
    for (int i = 0; i < 4; ++i) { const bool up = (lane & 8) != 0; const float send = up ? p[i] : p[i + 4], keep = up ? p[i + 4] : p[i]; p[i] = keep + __shfl_xor(send, 8); }
#pragma unroll
    for (int i = 0; i < 2; ++i) { const bool up = (lane & 4) != 0; const float send = up ? p[i] : p[i + 2], keep = up ? p[i + 2] : p[i]; p[i] = keep + __shfl_xor(send, 4); }
    { const bool up = (lane & 2) != 0; const float send = up ? p[0] : p[1], keep = up ? p[1] : p[0]; p[0] = keep + __shfl_xor(send, 2); }
    return p[0] + __shfl_xor(p[0], 1);
}
__device__ __forceinline__ void router_topk(float logit, int row, bool valid, int lane, LAS float* lg, LAS float* selv, LAS int* hist, int* TOPI, float* TOPG) {
    const int ex = lane >> 1;
    if ((lane & 1) == 0) lg[ex] = logit;
    LDS_WAIT(); asm volatile("" ::: "memory");
    int rank = 0;
#pragma unroll
    for (int e = 0; e < 32; ++e) { const float o = lg[e]; rank += (o > logit || (o == logit && e < ex)) ? 1 : 0; }
    if ((lane & 1) == 0 && rank < 4) { selv[rank * 2] = logit; selv[rank * 2 + 1] = __builtin_bit_cast(float, ex); }
    LDS_WAIT(); asm volatile("" ::: "memory");
    const float v0 = selv[0], v1 = selv[2], v2 = selv[4], v3 = selv[6];
    const float e0 = 1.f, e1 = __expf(v1 - v0), e2 = __expf(v2 - v0), e3 = __expf(v3 - v0); const float inv = 1.f / (e0 + e1 + e2 + e3);
    if (valid && lane < 4) { const int ej = __builtin_bit_cast(int, selv[lane * 2 + 1]); const float gj = (lane == 0 ? e0 : lane == 1 ? e1 : lane == 2 ? e2 : e3) * inv;
        TOPI[(size_t)row * 4 + lane] = ej; TOPG[(size_t)row * 4 + lane] = gj; __hip_atomic_fetch_add(hist + ej, 1, __ATOMIC_RELAXED, __HIP_MEMORY_SCOPE_WORKGROUP); }
    LDS_WAIT(); asm volatile("" ::: "memory");
}
__device__ __forceinline__ void p_norm2_router(const Frame& F0, int layer, int Tm) {
    const Frame F = relaunder(F0);
    const float* MOD = (const float*)(F.ws + WS_MOD) + (size_t)layer * 9 * 6144; bf16_t* H = (bf16_t*)(F.ws + WS_H); const float* XW = (const float*)(F.ws + WS_XW);
    unsigned char* rt = F.ws + WS_ROUTE + layer * ROUTE_STRIDE;
    int* TOPI = (int*)(rt + R_TOPI); float* TOPG = (float*)(rt + R_TOPG); int* CNT = (int*)(rt + R_CNT);
    const float* rw = in_ptr(F, 19) + (size_t)layer * 1024 * 32; const float* rb = in_ptr(F, 20) + layer * 32; const float* g2n = in_ptr(F, 7) + layer * 1024;
    LAS float* WT = (LAS float*)F.lds;
    LAS float* lg = (LAS float*)(F.lds + 132096) + F.wave * 32;
    LAS float* selv = (LAS float*)(F.lds + 132096 + 1024) + F.wave * 8;
    LAS int* hist = (LAS int*)(F.lds + 132096 + 2048);
    __syncthreads();
    {
        f32x4 wv[16];
#pragma unroll
        for (int i = 0; i < 16; ++i) wv[i] = *(const f32x4*)(rw + 4 * (F.tid + NTHR * i));
#pragma unroll
        for (int i = 0; i < 16; ++i) { const int i4 = F.tid + NTHR * i, k = i4 >> 3, e0 = (i4 & 7) * 4;
            WT[(e0 + 0) * 1028 + k] = wv[i][0]; WT[(e0 + 1) * 1028 + k] = wv[i][1]; WT[(e0 + 2) * 1028 + k] = wv[i][2]; WT[(e0 + 3) * 1028 + k] = wv[i][3]; }
    }
    if (F.tid < 32) hist[F.tid] = 0;
    __syncthreads();
    const int RPW = Tm / F.G;
    const int nk = RPW / NWAVES;
    f32x4 shv[4], scv[4]; int mrc = -1;
    const int row0w = blockIdx.x * RPW + F.wave;
    f32x4 nA[4], nB[4];
    load_row(XW + (size_t)row0w * 1024, F.lane, nA); load_row(XW + (size_t)(nk > 1 ? row0w + NWAVES : row0w) * 1024, F.lane, nB);
#pragma unroll 1
    for (int k = 0; k < nk; k += 2) {
        const bool hasB = k + 1 < nk;
        const int rowA = row0w + NWAVES * k, rowB = hasB ? rowA + NWAVES : rowA;
        f32x4 vA[4], vB[4];
#pragma unroll
        for (int j = 0; j < 4; ++j) { vA[j] = nA[j]; vB[j] = nB[j]; }
        if (k + 2 < nk) { const int rA2 = rowA + 2 * NWAVES, rB2 = (k + 3 < nk) ? rA2 + NWAVES : rA2; load_row(XW + (size_t)rA2 * 1024, F.lane, nA); load_row(XW + (size_t)rB2 * 1024, F.lane, nB); }
        const int mrA = rowA < TL ? (rowA >> 12) : 8, mrB = rowB < TL ? (rowB >> 12) : 8;
        if (mrA != mrc) { mrc = mrA;
#pragma unroll
            for (int j = 0; j < 4; ++j) { shv[j] = *(const f32x4*)(MOD + (size_t)mrA * 6144 + 3072 + 256 * j + 4 * F.lane); scv[j] = *(const f32x4*)(MOD + (size_t)mrA * 6144 + 4096 + 256 * j + 4 * F.lane) + 1.f; } }
        { const float rsA = row_rstd(vA);
#pragma unroll
          for (int j = 0; j < 4; ++j) vA[j] = (vA[j] * rsA * *(const f32x4*)(g2n + 256 * j + 4 * F.lane)) * scv[j] + shv[j]; }
        if (mrB != mrc) { mrc = mrB;
#pragma unroll
            for (int j = 0; j < 4; ++j) { shv[j] = *(const f32x4*)(MOD + (size_t)mrB * 6144 + 3072 + 256 * j + 4 * F.lane); scv[j] = *(const f32x4*)(MOD + (size_t)mrB * 6144 + 4096 + 256 * j + 4 * F.lane) + 1.f; } }
        { const float rsB = row_rstd(vB);
#pragma unroll
          for (int j = 0; j < 4; ++j) vB[j] = (vB[j] * rsB * *(const f32x4*)(g2n + 256 * j + 4 * F.lane)) * scv[j] + shv[j]; }
        store_row_bf16(H + (size_t)rowA * 1024, F.lane, vA);
        if (hasB) store_row_bf16(H + (size_t)rowB * 1024, F.lane, vB);
        float pA[32], pB[32];
#pragma unroll
        for (int e4 = 0; e4 < 32; e4 += 2) {
            f32x4 w[2][4];
#pragma unroll
            for (int x = 0; x < 2; ++x)
#pragma unroll
                for (int j = 0; j < 4; ++j) w[x][j] = *(const LAS f32x4*)(WT + (e4 + x) * 1028 + 256 * j + 4 * F.lane);
            asm volatile("" ::: "memory");
            rf2_t acc2[2][2];
#pragma unroll
            for (int x = 0; x < 2; ++x) { acc2[x][0] = (rf2_t){0.f, 0.f}; acc2[x][1] = (rf2_t){0.f, 0.f}; }
#pragma unroll
            for (int j = 0; j < 4; ++j)
#pragma unroll
                for (int i = 0; i < 4; ++i) { const rf2_t ab = (rf2_t){vA[j][i], vB[j][i]};
#pragma unroll
                    for (int x = 0; x < 2; ++x) acc2[x][i & 1] = __builtin_elementwise_fma(ab, (rf2_t){w[x][j][i], w[x][j][i]}, acc2[x][i & 1]); }
#pragma unroll
            for (int x = 0; x < 2; ++x) { const rf2_t t = acc2[x][0] + acc2[x][1]; pA[e4 + x] = t[0]; pB[e4 + x] = t[1]; } }
        const int ex = F.lane >> 1; const float bias = rb[ex];
        const float logitA = router_reduce(pA, F.lane) + bias, logitB = router_reduce(pB, F.lane) + bias;
        router_topk(logitA, rowA, true, F.lane, lg, selv, hist, TOPI, TOPG);
        router_topk(logitB, rowB, hasB, F.lane, lg, selv, hist, TOPI, TOPG);
    }
    __syncthreads();
    if (F.tid < 32) CNT[blockIdx.x * 32 + F.tid] = hist[F.tid];
}

__device__ __forceinline__ void p_route_gather(const Frame& F0, int layer, int Tm) {
    const Frame F = relaunder(F0);
    unsigned char* rt = F.ws + WS_ROUTE + layer * ROUTE_STRIDE;
    const int* TOPI = (const int*)(rt + R_TOPI); int* POSOF = (int*)(rt + R_POSOF); int* ROWTOK = (int*)(rt + R_ROWTOK); const int* CNT = (const int*)(rt + R_CNT);
    int* TILEEXP = (int*)(rt + R_TILEEXP); int* NT = (int*)(rt + R_NT);
    LAS int* tot = (LAS int*)F.lds;
    LAS int* mine = tot + 32;
    LAS int* pst = mine + 32;
    LAS int* es = pst + 64;
    LAS int* ps = es + 1024;
    const int RPW = Tm / F.G, NP = RPW * 4;
    __syncthreads();
    {
        LAS int* part = ps + 1024;
        const int e = F.tid & 31, sl = F.tid >> 5; int t = 0, m = 0;
        for (int w = sl; w < F.G; w += 16) { const int c = __builtin_nontemporal_load(CNT + w * 32 + e); t += c; if (w < (int)blockIdx.x) m += c; }
        part[sl * 32 + e] = t; part[512 + sl * 32 + e] = m;
        __syncthreads();
        if (F.tid < 32) { int tt = 0, mm = 0;
#pragma unroll
            for (int k = 0; k < 16; ++k) { tt += part[k * 32 + F.tid]; mm += part[512 + k * 32 + F.tid]; }
            tot[F.tid] = tt; mine[F.tid] = mm; } }
    for (int i = F.tid; i < NP; i += NTHR) es[i] = __builtin_nontemporal_load(TOPI + (size_t)blockIdx.x * NP + i);
    __syncthreads();
    if (F.tid == 0) { int s = 0; for (int e = 0; e < 32; ++e) { pst[e] = s; s += (tot[e] + 255) & ~255; } pst[32] = s; }
    __syncthreads();
    {
        LAS int* rk = ps + 2048;
        int base[4] = {0, 0, 0, 0};
        for (int c0 = 0; c0 < NP; c0 += 64) { const int i = c0 + F.lane; const int e = i < NP ? es[i] : -1;
#pragma unroll
            for (int x = 0; x < 4; ++x) { const unsigned long long b = __ballot(e == 4 * F.wave + x);
                if (e == 4 * F.wave + x) rk[i] = base[x] + __popcll(b & ((1ull << F.lane) - 1ull));
                base[x] += __popcll(b); } }
        __syncthreads();
    }
    for (int i = F.tid; i < NP; i += NTHR) { const int e = es[i]; const int r = (ps + 2048)[i];
        const int pos = pst[e] + mine[e] + r; ps[i] = pos; const int tok = blockIdx.x * RPW + (i >> 2);
        ROWTOK[pos] = tok; POSOF[(size_t)tok * 4 + (i & 3)] = pos; }
    const int ntiles = pst[32] >> 8;
    if (blockIdx.x == 0) { for (int t = F.tid; t < ntiles; t += NTHR) { int e = 0; for (int q = 0; q < 32; ++q) if (pst[q] <= t * 256) e = q; TILEEXP[t] = e; }
        if (F.tid == 0) NT[0] = ntiles; }
    __syncthreads();
    if (blockIdx.x < 32) { const int e = blockIdx.x; const int r0 = pst[e] + tot[e], r1 = pst[e + 1];
        for (int r = r0 + F.tid; r < r1; r += NTHR) ROWTOK[r] = 0; }
}

__device__ __forceinline__ void p_combine(const Frame& F0, int layer, int Tm) {
    const Frame F = relaunder(F0);
    const float* MODL = (const float*)(F.ws + WS_MOD) + (size_t)layer * 9 * 6144;
    const float* MODN = (const float*)(F.ws + WS_MOD) + (size_t)(layer + 1) * 9 * 6144;
    unsigned char* rt = F.ws + WS_ROUTE + layer * ROUTE_STRIDE;
    const int* POSOF = (const int*)(rt + R_POSOF); const float* TOPG = (const float*)(rt + R_TOPG);
    const bf16_t* YY = (const bf16_t*)(F.ws + WS_XS); float* XW = (float*)(F.ws + WS_XW); bf16_t* H = (bf16_t*)(F.ws + WS_H);
    const bool last = layer == 1;
    const float* fin_g = in_ptr(F, 25); const float* n1g = in_ptr(F, 6) + 1024; float* outp = out_ptr(F);
    u32x4 pos4 = (u32x4){0u, 0u, 0u, 0u}; f32x4 gt4 = (f32x4){0.f, 0.f, 0.f, 0.f};
    if (F.gw < Tm) { pos4 = __builtin_nontemporal_load((const u32x4*)(POSOF + (size_t)F.gw * 4)); gt4 = __builtin_nontemporal_load((const f32x4*)(TOPG + (size_t)F.gw * 4)); }
    for (int row = F.gw; row < Tm; row += F.NGW) {
        const int mr = row < TL ? (row >> 12) : 8;
        f32x4 v[4]; load_row(XW + (size_t)row * 1024, F.lane, v);
        u32x2 yw[4][4];
#pragma unroll
        for (int s = 0; s < 4; ++s) { const bf16_t* yp = YY + (size_t)pos4[s] * 1024;
#pragma unroll
            for (int j = 0; j < 4; ++j) yw[s][j] = *(const u32x2*)(yp + 256 * j + 4 * F.lane); }
        const f32x4 gcur = gt4;
        if (row + F.NGW < Tm) { pos4 = __builtin_nontemporal_load((const u32x4*)(POSOF + (size_t)(row + F.NGW) * 4)); gt4 = __builtin_nontemporal_load((const f32x4*)(TOPG + (size_t)(row + F.NGW) * 4)); }
        f32x4 y[4];
#pragma unroll
        for (int j = 0; j < 4; ++j) y[j] = (f32x4){0.f, 0.f, 0.f, 0.f};
#pragma unroll
        for (int s = 0; s < 4; ++s)
#pragma unroll
            for (int j = 0; j < 4; ++j) y[j] = y[j] + gcur[s] * (f32x4){bflo(yw[s][j].x), bfhi(yw[s][j].x), bflo(yw[s][j].y), bfhi(yw[s][j].y)};
        const float* g2 = MODL + (size_t)mr * 6144 + 5120;
#pragma unroll
        for (int j = 0; j < 4; ++j) v[j] = v[j] + *(const f32x4*)(g2 + 256 * j + 4 * F.lane) * y[j];
        if (!last) {
#pragma unroll
            for (int j = 0; j < 4; ++j) *(f32x4*)(XW + (size_t)row * 1024 + 256 * j + 4 * F.lane) = v[j];
            norm_mod(v, n1g, MODN + (size_t)mr * 6144, MODN + (size_t)mr * 6144 + 1024, F.lane);
            store_row_bf16(H + (size_t)row * 1024, F.lane, v);
        } else {
            const float rstd = row_rstd(v);
#pragma unroll
            for (int j = 0; j < 4; ++j) *(f32x4*)(outp + (size_t)row * 1024 + 256 * j + 4 * F.lane) = v[j] * rstd * *(const f32x4*)(fin_g + 256 * j + 4 * F.lane);
        }
    }
}
typedef float f32x16 __attribute__((ext_vector_type(16)));
typedef short bf16x8 __attribute__((ext_vector_type(8)));
typedef short v4i16_t __attribute__((ext_vector_type(4)));

typedef __bf16 abf2_t __attribute__((ext_vector_type(2)));
typedef float af2_t __attribute__((ext_vector_type(2)));
__device__ __forceinline__ unsigned cvt_pk(float lo, float hi) { const af2_t v = {lo, hi}; return __builtin_bit_cast(unsigned, __builtin_convertvector(v, abf2_t)); }

constexpr int AK_STRIDE = 272, AV_STRIDE = 320, AK_BYTES = 64 * AK_STRIDE, AV_BYTES = 64 * AV_STRIDE;
constexpr int AV_OFF = 2 * AK_BYTES;
constexpr int AQ_OFF = AV_OFF + 3 * AV_BYTES;
#ifndef ATT_PROBE
#define ATT_PROBE 0
#endif
struct AttnSt { f32x16 O[4]; f32x16 negm; float mrun, lrun; };
#define ASB() __builtin_amdgcn_sched_barrier(0)
#define APIN(x) asm volatile("" : "+v"(x))
#define AMF(a, b, c) __builtin_amdgcn_mfma_f32_32x32x16_bf16(a, b, c, 0, 0, 0)
#define AMX3(a, b, c) __builtin_fmaxf(__builtin_fmaxf((a), (b)), (c))
#define AGAPA(MF, A0, A1, A2, A3, W0, W1, PW) do { MF; sacc += A0; sacc += A1; sacc += A2; sacc += A3; APIN(sacc); W0; W1; APIN(PW); ASB(); } while (0)
#define AGAPB(MF, RD, X, i) do { MF; RD; X[i] = __builtin_amdgcn_exp2f(X[i]); X[i + 1] = __builtin_amdgcn_exp2f(X[i + 1]); APIN(X); ASB(); } while (0)
__device__ __forceinline__ float attn_rowmax(const f32x16& p0, const f32x16& p1) {
    float a = AMX3(p0[0], p0[1], p1[0]), b = AMX3(p0[2], p0[3], p1[1]); a = AMX3(a, p1[2], p1[3]);
#pragma unroll
    for (int r = 4; r < 16; r += 4) { a = AMX3(a, p0[r], p0[r + 1]); b = AMX3(b, p0[r + 2], p0[r + 3]); a = AMX3(a, p1[r], p1[r + 1]); b = AMX3(b, p1[r + 2], p1[r + 3]); }
    float m = __builtin_fmaxf(a, b);
    const auto rr = __builtin_amdgcn_permlane32_swap(__builtin_bit_cast(unsigned, m), __builtin_bit_cast(unsigned, m), false, false);
    return __builtin_fmaxf(__builtin_bit_cast(float, rr[0]), __builtin_bit_cast(float, rr[1]));
}
template <int PT, bool PRE>
__device__ __forceinline__ void attn_phA(const Frame& F, AttnSt& st, f32x16& C0, f32x16& C1, f32x16& P0, f32x16& P1, u32x4& pw0, u32x4& pw1, u32x4& pw2, u32x4& pw3,
                                         bf16x8 (&vf)[4], const bf16x8 (&qf)[4], const LAS unsigned char* vb, int q, int hi, int map) {
    const LAS unsigned char* kb = F.lds + PT * AK_BYTES + q * AK_STRIDE + map * 128 + hi * 16;
    bf16x8 ra[2], rb2[2];
#define AKQ(sl, ks) do { ra[sl] = *(const LAS bf16x8*)(kb + (ks) * 32); rb2[sl] = *(const LAS bf16x8*)(kb + 32 * AK_STRIDE + (ks) * 32); } while (0)
#define ATR(p) __builtin_amdgcn_ds_read_tr16_b64_v4i16((LAS v4i16_t*)(p))
#define AVR(sl, d, s) do { const v4i16_t lo_ = ATR(vb + (s) * 16 * AV_STRIDE + (d) * 64), hi_ = ATR(vb + (s) * 16 * AV_STRIDE + 8 * AV_STRIDE + (d) * 64); \
        vf[sl] = (bf16x8){lo_[0], lo_[1], lo_[2], lo_[3], hi_[0], hi_[1], hi_[2], hi_[3]}; } while (0)
#define AVRD(d, s) do { const v4i16_t lo_ = ATR(vb + (s) * 16 * AV_STRIDE + (d) * 64), hi_ = ATR(vb + (s) * 16 * AV_STRIDE + 8 * AV_STRIDE + (d) * 64); \
        vf[d] = (bf16x8){lo_[0], lo_[1], lo_[2], lo_[3], hi_[0], hi_[1], hi_[2], hi_[3]}; } while (0)
    ASB();
    AKQ(0, 0); AKQ(1, 1);
    float sacc = P0[0] + P0[1];
    ASB();
    AGAPA(C0 = AMF(ra[0], qf[0], st.negm),  P0[2], P0[3], P0[4], P0[5],     pw0[0] = cvt_pk(P0[0], P0[1]),   pw0[1] = cvt_pk(P0[2], P0[3]),   pw0);
    AGAPA(C1 = AMF(rb2[0], qf[0], st.negm), P0[6], P0[7], P0[8], P0[9],     pw0[2] = cvt_pk(P0[4], P0[5]),   pw0[3] = cvt_pk(P0[6], P0[7]),   pw0);
    AKQ(0, 2); ASB();
    AGAPA(C0 = AMF(ra[1], qf[1], C0),   P0[10], P0[11], P0[12], P0[13], pw1[0] = cvt_pk(P0[8], P0[9]),   pw1[1] = cvt_pk(P0[10], P0[11]), pw1);
    AGAPA(C1 = AMF(rb2[1], qf[1], C1),  P0[14], P0[15], P1[0], P1[1],   pw1[2] = cvt_pk(P0[12], P0[13]), pw1[3] = cvt_pk(P0[14], P0[15]), pw1);
    AKQ(1, 3); ASB();
    AGAPA(C0 = AMF(ra[0], qf[2], C0),   P1[2], P1[3], P1[4], P1[5],     pw2[0] = cvt_pk(P1[0], P1[1]),   pw2[1] = cvt_pk(P1[2], P1[3]),   pw2);
    AGAPA(C1 = AMF(rb2[0], qf[2], C1),  P1[6], P1[7], P1[8], P1[9],     pw2[2] = cvt_pk(P1[4], P1[5]),   pw2[3] = cvt_pk(P1[6], P1[7]),   pw2);
    if (PRE) { AVRD(0, 0); AVRD(1, 0); ASB(); }
    AGAPA(C0 = AMF(ra[1], qf[3], C0),   P1[10], P1[11], P1[12], P1[13], pw3[0] = cvt_pk(P1[8], P1[9]),   pw3[1] = cvt_pk(P1[10], P1[11]), pw3);
    if (PRE) { AVRD(2, 0); AVRD(3, 0); ASB(); }
    AGAPA(C1 = AMF(rb2[1], qf[3], C1),  P1[14], P1[15], 0.f, 0.f,       pw3[2] = cvt_pk(P1[12], P1[13]), pw3[3] = cvt_pk(P1[14], P1[15]), pw3);
    st.lrun += sacc;
#undef AKQ
}
__device__ __forceinline__ void attn_mid(AttnSt& st, f32x16& C0, f32x16& C1, float& alpha, bool& resc) {
    const float mx = attn_rowmax(C0, C1);
    alpha = 1.f; resc = false;
    if (!__builtin_expect(__all(mx <= 8.f), 1)) { const float dl = fmaxf(mx, 0.f); st.mrun += dl; alpha = __builtin_amdgcn_exp2f(-dl); st.lrun *= alpha; resc = true;
#pragma unroll
        for (int r = 0; r < 16; ++r) { C0[r] -= dl; C1[r] -= dl; st.negm[r] = -st.mrun; }
        APIN(st.negm); }
    ASB();
}
template <bool PRE>
__device__ __forceinline__ void attn_phB(AttnSt& st, f32x16& C0, f32x16& C1, const u32x4& pw0, const u32x4& pw1, const u32x4& pw2, const u32x4& pw3, bf16x8 (&vf)[4],
                                         const LAS unsigned char* vb, float alpha, bool resc) {
#define APF(k) __builtin_bit_cast(bf16x8, pw##k)
    if (!PRE) { ASB(); AVR(0, 0, 0); AVR(1, 1, 0); AVR(2, 2, 0); AVR(3, 3, 0); ASB(); }
    __builtin_amdgcn_s_setprio(1); ASB();
    AGAPB(st.O[0] = AMF(vf[0], APF(0), st.O[0]), AVR(0, 0, 1), C0, 0);
    AGAPB(st.O[1] = AMF(vf[1], APF(0), st.O[1]), AVR(1, 1, 1), C0, 2);
    AGAPB(st.O[2] = AMF(vf[2], APF(0), st.O[2]), AVR(2, 2, 1), C0, 4);
    AGAPB(st.O[3] = AMF(vf[3], APF(0), st.O[3]), AVR(3, 3, 1), C0, 6);
    AGAPB(st.O[0] = AMF(vf[0], APF(1), st.O[0]), AVR(0, 0, 2), C0, 8);
    AGAPB(st.O[1] = AMF(vf[1], APF(1), st.O[1]), AVR(1, 1, 2), C0, 10);
    AGAPB(st.O[2] = AMF(vf[2], APF(1), st.O[2]), AVR(2, 2, 2), C0, 12);
    AGAPB(st.O[3] = AMF(vf[3], APF(1), st.O[3]), AVR(3, 3, 2), C0, 14);
    AGAPB(st.O[0] = AMF(vf[0], APF(2), st.O[0]), AVR(0, 0, 3), C1, 0);
    AGAPB(st.O[1] = AMF(vf[1], APF(2), st.O[1]), AVR(1, 1, 3), C1, 2);
    AGAPB(st.O[2] = AMF(vf[2], APF(2), st.O[2]), AVR(2, 2, 3), C1, 4);
    AGAPB(st.O[3] = AMF(vf[3], APF(2), st.O[3]), AVR(3, 3, 3), C1, 6);
    AGAPB(st.O[0] = AMF(vf[0], APF(3), st.O[0]), (void)0, C1, 8);
    AGAPB(st.O[1] = AMF(vf[1], APF(3), st.O[1]), (void)0, C1, 10);
    AGAPB(st.O[2] = AMF(vf[2], APF(3), st.O[2]), (void)0, C1, 12);
    AGAPB(st.O[3] = AMF(vf[3], APF(3), st.O[3]), (void)0, C1, 14);
    __builtin_amdgcn_s_setprio(0); ASB();
    if (resc) {
#pragma unroll
        for (int d = 0; d < 4; ++d)
#pragma unroll
            for (int r = 0; r < 16; ++r) st.O[d][r] *= alpha;
    }
#undef APF
}
__device__ __forceinline__ void attn_drain(AttnSt& st, f32x16& P0, f32x16& P1, const LAS unsigned char* vb) {
    float sacc = 0.f;
#pragma unroll
    for (int r = 0; r < 16; ++r) sacc += P0[r] + P1[r];
    st.lrun += sacc;
#pragma unroll
    for (int s = 0; s < 4; ++s) { u32x4 w;
#pragma unroll
        for (int j = 0; j < 4; ++j) { const int r = 8 * (s & 1) + 2 * j; w[j] = (s < 2) ? cvt_pk(P0[r], P0[r + 1]) : cvt_pk(P1[r], P1[r + 1]); }
        const bf16x8 pf = __builtin_bit_cast(bf16x8, w);
#pragma unroll
        for (int d = 0; d < 4; ++d) { const v4i16_t lo_ = ATR(vb + s * 16 * AV_STRIDE + d * 64), hi_ = ATR(vb + s * 16 * AV_STRIDE + 8 * AV_STRIDE + d * 64);
            const bf16x8 v = (bf16x8){lo_[0], lo_[1], lo_[2], lo_[3], hi_[0], hi_[1], hi_[2], hi_[3]}; st.O[d] = AMF(v, pf, st.O[d]); }
    }
}
__device__ __forceinline__ void attn_unit(const Frame& F, int u, float lam, float osc, const float* subg, int tmask = -1) {
    const bf16_t* P = (const bf16_t*)(F.ws + WS_P); bf16_t* AD = (bf16_t*)(F.ws + WS_AD);
    const int map = F.wave >> 2, rb = F.wave & 3, q = F.lane & 31, hi = F.lane >> 5;
    int b, h, qrow0, t0; const int t1 = 68;
    if (u < 2048) { b = u >> 8; h = (u >> 5) & 7; qrow0 = b * 4096 + (u & 31) * 128; t0 = 0; }
    else { const int v = u - 2048; b = v >> 4; h = (v >> 1) & 7; qrow0 = TL + b * 256 + (v & 1) * 128; t0 = 64; }
    const int qrow = qrow0 + rb * 32 + q;

    bf16x8 qf[4];
#pragma unroll
    for (int ks = 0; ks < 4; ++ks) qf[ks] = *(const bf16x8*)(P + (size_t)qrow * PW + OQ + h * 128 + map * 64 + 16 * ks + 8 * hi);
    AttnSt st;
#pragma unroll
    for (int d = 0; d < 4; ++d)
#pragma unroll
        for (int r = 0; r < 16; ++r) st.O[d][r] = 0.f;
    st.mrun = -1e30f; st.lrun = 0.f;
    const int e0 = F.tid, e1 = F.tid + 512;
    const int kkey0 = e0 >> 4, kch0 = e0 & 15, kkey1 = e1 >> 4, kch1 = e1 & 15;
    const char* kbase_lat = (const char*)(P + (size_t)(b * 4096) * PW + OKK + h * 128);
    const char* kbase_ctx = (const char*)(P + (size_t)(TL + b * 256) * PW + OKK + h * 128) - (size_t)64 * 64 * PW * 2;
    const unsigned koff0 = (unsigned)(kkey0 * PW + kch0 * 8) * 2u, koff1 = (unsigned)(kkey1 * PW + kch1 * 8) * 2u;
    constexpr size_t VOFS = (size_t)(OV - OKK) * 2;
    u32x4 kr0, kr1, vr0, vr1;
#define ATT_LOADK(t_) do { const int tm__ = (t_) & tmask; const char* kb__ = (tm__ < 64 ? kbase_lat : kbase_ctx) + (size_t)tm__ * (64 * PW * 2); \
        kr0 = *(const u32x4*)(kb__ + koff0); kr1 = *(const u32x4*)(kb__ + koff1); } while (0)
#define ATT_LOADV(t_) do { const int tm__ = (t_) & tmask; const char* vb__ = (tm__ < 64 ? kbase_lat : kbase_ctx) + (size_t)tm__ * (64 * PW * 2) + VOFS; \
        vr0 = *(const u32x4*)(vb__ + koff0); vr1 = *(const u32x4*)(vb__ + koff1); } while (0)
#define ATT_STOREK(buf) do { LAS unsigned char* kb_ = F.lds + (buf) * AK_BYTES; \
        *(LAS u32x4*)(kb_ + kkey0 * AK_STRIDE + kch0 * 16) = kr0; *(LAS u32x4*)(kb_ + kkey1 * AK_STRIDE + kch1 * 16) = kr1; } while (0)
#define ATT_STOREV(off) do { LAS unsigned char* vb_ = F.lds + AV_OFF + (off); \
        *(LAS u32x4*)(vb_ + kkey0 * AV_STRIDE + kch0 * 16) = vr0; *(LAS u32x4*)(vb_ + kkey1 * AV_STRIDE + kch1 * 16) = vr1; } while (0)
    ATT_LOADK(t0); ATT_LOADV(t0);
    __syncthreads();
    ATT_STOREK(0); ATT_STOREV(0);
    ATT_LOADK(t0 + 1);
    __syncthreads();
    f32x16 sA0, sA1, sB0, sB1;
    {
        const LAS unsigned char* kb = F.lds + q * AK_STRIDE + map * 128 + hi * 16;
#pragma unroll
        for (int r = 0; r < 16; ++r) { sA0[r] = 0.f; sA1[r] = 0.f; }
#pragma unroll
        for (int ks = 0; ks < 4; ++ks) {
            const bf16x8 a0 = *(const LAS bf16x8*)(kb + ks * 32), a1 = *(const LAS bf16x8*)(kb + 32 * AK_STRIDE + ks * 32), qv = qf[ks];
            sA0 = __builtin_amdgcn_mfma_f32_32x32x16_bf16(a0, qv, sA0, 0, 0, 0);
            sA1 = __builtin_amdgcn_mfma_f32_32x32x16_bf16(a1, qv, sA1, 0, 0, 0);
        }
    }
    ATT_STOREK(1);
    {
        const float mx = attn_rowmax(sA0, sA1); st.mrun = mx;
#pragma unroll
        for (int r = 0; r < 16; ++r) { sA0[r] = __builtin_amdgcn_exp2f(sA0[r] - mx); sA1[r] = __builtin_amdgcn_exp2f(sA1[r] - mx); st.negm[r] = -mx; }
        APIN(st.negm);
    }
    __syncthreads();
    const LAS unsigned char* vq = F.lds + AV_OFF + (4 * hi + ((F.lane & 15) >> 2)) * AV_STRIDE + (16 * ((F.lane >> 4) & 1) + 4 * (F.lane & 3)) * 2;
    int v0 = AV_BYTES, v1 = 0, v2 = 2 * AV_BYTES;
#define ATT_ROT() do { const int t_ = v2; v2 = v1; v1 = v0; v0 = t_; } while (0)
    u32x4 pw0, pw1, pw2, pw3; bf16x8 vf[4]; float alpha = 1.f; bool resc = false;
#define ATT_TILE(PT, C0, C1, P0, P1, KB, HK1, HK2, HV, t) do { \
        attn_phA<PT, false>(F, st, C0, C1, P0, P1, pw0, pw1, pw2, pw3, vf, qf, vq, q, hi, map); attn_mid(st, C0, C1, alpha, resc); \
        if (HK1) ATT_STOREK(KB); ATT_STOREV(v0); ATT_ROT(); \
        if (map != 0) __syncthreads(); \
        if (HK2) ATT_LOADK((t) + 2); if (HV) ATT_LOADV((t) + 1); \
        attn_phB<false>(st, C0, C1, pw0, pw1, pw2, pw3, vf, vq + v2, alpha, resc); \
        if (map == 0) __syncthreads(); } while (0)
    ATT_LOADK(t0 + 2); ATT_LOADV(t0 + 1);
    int t = t0 + 1;
#pragma unroll 1
    for (; t + 3 < t1; t += 2) {
        ATT_TILE(1, sB0, sB1, sA0, sA1, 0, true, true, true, t);
        ATT_TILE(0, sA0, sA1, sB0, sB1, 1, true, true, true, t + 1);
    }
    ATT_TILE(1, sB0, sB1, sA0, sA1, 0, true, true, true, t1 - 3);
    ATT_TILE(0, sA0, sA1, sB0, sB1, 1, true, false, true, t1 - 2);
    ATT_TILE(1, sB0, sB1, sA0, sA1, 0, false, false, false, t1 - 1);
    attn_drain(st, sB0, sB1, vq + v1);
#undef ATT_TILE
    __syncthreads();
#undef ATT_ROT
#undef ATT_LOADK
#undef ATT_LOADV
#undef ATT_STOREK
#undef ATT_STOREV
    __builtin_amdgcn_s_setprio(0);
    f32x16 (&O)[4] = st.O; const float lrun = st.lrun;
    const float inv = 1.f / (lrun + __shfl_xor(lrun, 32));
    unsigned xoff = (unsigned)((rb * 128 + 4 * hi) * 32 + q) * 4u; asm volatile("" : "+v"(xoff));
    LAS float* xb = (LAS float*)(F.lds + xoff);
    if (map == 1) {
#pragma unroll
        for (int d = 0; d < 4; ++d)
#pragma unroll
            for (int r = 0; r < 16; ++r) { const int dv = 32 * d + (r & 3) + 8 * (r >> 2); xb[dv * 32] = O[d][r] * inv; }
    }
    __syncthreads();
    if (map == 0) {
        float ss = 0.f;
#pragma unroll
        for (int d = 0; d < 4; ++d)
#pragma unroll
            for (int r = 0; r < 16; ++r) { const int dv = 32 * d + (r & 3) + 8 * (r >> 2); const float o = O[d][r] * inv - lam * xb[dv * 32]; O[d][r] = o; ss += o * o; }
        ss += __shfl_xor(ss, 32);
        const float rs = osc / sqrtf(ss * (1.f / 128.f) + RMS_EPS);
        bf16_t* op = AD + (size_t)qrow * 1024 + h * 128;
#pragma unroll
        for (int d = 0; d < 4; ++d)
#pragma unroll
            for (int g = 0; g < 4; ++g) { const int dv = 32 * d + 8 * g + 4 * hi; const f32x4 gv = *(const f32x4*)(subg + dv);
                u32x2 w; w.x = pk2(O[d][4 * g] * rs * gv[0], O[d][4 * g + 1] * rs * gv[1]); w.y = pk2(O[d][4 * g + 2] * rs * gv[2], O[d][4 * g + 3] * rs * gv[3]);
                *(u32x2*)(op + dv) = w; }
    }
}

__device__ __forceinline__ void p_gla_chain2(const Frame& F, const float* wa2  , const float* ba  , int chain) {
    const bf16_t* P = (const bf16_t*)(F.ws + WS_P); const float* GA = (const float*)(F.ws + WS_GA); float* OG = (float*)(F.ws + WS_OG);
    const int b = chain >> 4, h = (chain >> 2) & 3, dir = (chain >> 1) & 1, vh = chain & 1;
    LAS float* Wa = (LAS float*)F.lds;
    LAS float* bav = Wa + 1024;
    LAS float* gas = bav + 64;
    LAS float* qs = gas + 256;
    LAS float* ks = qs + 1024;
    LAS float* egs = ks + 1024;
    LAS float* vs = egs + 1024;
    LAS float* po = vs + 1024;
    const int tid = F.tid, dkg = tid >> 6, dv = tid & 63;
    __syncthreads();
    for (int i = tid; i < 1024; i += NTHR) { const int r = i >> 6, dk = i & 63; Wa[i] = wa2[(size_t)(dir * 16 + r) * 256 + h * 64 + dk]; }
    if (tid < 64) bav[tid] = ba[dir * 256 + h * 64 + tid];
    float S[8];
#pragma unroll
    for (int i = 0; i < 8; ++i) S[i] = 0.f;
    const int role = tid >> 7, li = tid & 127, ltk = li >> 3, lch = li & 7;
    u32x4 ld; f32x4 lda_ = (f32x4){0.f, 0.f, 0.f, 0.f};
#define GLA_LOAD(blk) do { const int row_ = gla_row((blk) * 16 + ltk, b, dir); \
        if (role == 0) ld = *(const u32x4*)(P + (size_t)row_ * PW + OGQ + h * 64 + lch * 8); \
        else if (role == 1) ld = *(const u32x4*)(P + (size_t)row_ * PW + OGK + h * 64 + lch * 8); \
        else if (role == 2) ld = *(const u32x4*)(P + (size_t)row_ * PW + OGV + h * 128 + vh * 64 + lch * 8); \
        else if (li < 64) { const int row2_ = gla_row((blk) * 16 + (li >> 2), b, dir); lda_ = *(const f32x4*)(GA + (size_t)row2_ * 32 + dir * 16 + (li & 3) * 4); } } while (0)
    GLA_LOAD(0);
    for (int blk = 0; blk < 272; ++blk) {
        __syncthreads();
        if (role < 3) { LAS float* dst = (role == 0 ? qs : role == 1 ? ks : vs) + ltk * 64 + lch * 8;
            *(LAS f32x4*)dst = (f32x4){bflo(ld.x), bfhi(ld.x), bflo(ld.y), bfhi(ld.y)}; *(LAS f32x4*)(dst + 4) = (f32x4){bflo(ld.z), bfhi(ld.z), bflo(ld.w), bfhi(ld.w)}; }
        else if (li < 64) *(LAS f32x4*)(gas + (li >> 2) * 16 + (li & 3) * 4) = lda_;
        if (blk + 1 < 272) GLA_LOAD(blk + 1);
        __syncthreads();
        for (int e = tid; e < 1024; e += NTHR) { const int tk = e >> 6, dk = e & 63; float z = bav[dk];
#pragma unroll
            for (int r = 0; r < 16; ++r) z += gas[tk * 16 + r] * Wa[r * 64 + dk];
            const float ls = fminf(z, 0.f) - log1pf(__expf(-fabsf(z)));
            egs[e] = __expf(ls * (1.f / 16.f)); }
        __syncthreads();
#pragma unroll 1
        for (int tk = 0; tk < 16; ++tk) {
            const float vv = vs[tk * 64 + dv]; float pacc = 0.f;
            const f32x4 e0 = *(const LAS f32x4*)(egs + tk * 64 + dkg * 8), e1 = *(const LAS f32x4*)(egs + tk * 64 + dkg * 8 + 4);
            const f32x4 k0 = *(const LAS f32x4*)(ks + tk * 64 + dkg * 8), k1 = *(const LAS f32x4*)(ks + tk * 64 + dkg * 8 + 4);
            const f32x4 q0 = *(const LAS f32x4*)(qs + tk * 64 + dkg * 8), q1 = *(const LAS f32x4*)(qs + tk * 64 + dkg * 8 + 4);
#pragma unroll
            for (int i = 0; i < 4; ++i) { S[i] = e0[i] * S[i] + k0[i] * vv; pacc += q0[i] * S[i]; S[4 + i] = e1[i] * S[4 + i] + k1[i] * vv; pacc += q1[i] * S[4 + i]; }
            po[(tk * 8 + dkg) * 64 + dv] = pacc;
        }
        __syncthreads();
        for (int e = tid; e < 1024; e += NTHR) { const int tk = e >> 6, d = e & 63; const int row = gla_row(blk * 16 + tk, b, dir);
            float o = 0.f;
#pragma unroll
            for (int g = 0; g < 8; ++g) o += po[(tk * 8 + g) * 64 + d];
            OG[((size_t)dir * TT + row) * 512 + h * 128 + vh * 64 + d] = o * 0.125f; }
    }
#undef GLA_LOAD
    __syncthreads();
}

constexpr int GL_WA = 0, GL_BA = 4096, GL_ET = 4352, GL_AS = 4608, GL_GS = 8704, GL_SEG = 25088, GL_QD = 27136, GL_KI = 36352, GL_KET = 45568, GL_VT = 54784, GL_SL = 73216, GL_END = 91648;
constexpr int GRS = 144;
__device__ __forceinline__ void p_gla_chain_mfma(const Frame& F, const float* wa2  , const float* ba  , int chain) {
    const bf16_t* P = (const bf16_t*)(F.ws + WS_P); const float* GA = (const float*)(F.ws + WS_GA); bf16_t* OGB = (bf16_t*)(F.ws + WS_OG);
    const int b = chain >> 3, h = (chain >> 1) & 3, dir = chain & 1;
    LAS unsigned char* L = F.lds;
    LAS float* Wa = (LAS float*)(L + GL_WA); LAS float* bav = (LAS float*)(L + GL_BA); LAS float* eT = (LAS float*)(L + GL_ET);
    LAS float* as = (LAS float*)(L + GL_AS); LAS float* segt = (LAS float*)(L + GL_SEG);
    const int tid = F.tid, dk = tid & 63, seg = tid >> 6;
    const int db = F.wave & 3, hb = F.wave >> 2, c = F.lane & 31, hi = F.lane >> 5;
    __syncthreads();
    for (int i = tid; i < 1024; i += NTHR) { const int r = i >> 6, d = i & 63; Wa[i] = wa2[(size_t)(dir * 16 + r) * 256 + h * 64 + d]; }
    if (tid < 64) bav[tid] = ba[dir * 256 + h * 64 + tid];
    for (int i = tid; i < (GL_END - GL_SL) / 4; i += NTHR) ((LAS unsigned*)(L + GL_SL))[i] = 0u;
    f32x16 sacc;
#pragma unroll
    for (int r = 0; r < 16; ++r) sacc[r] = 0.f;
    __syncthreads();
    float wcol[16]; const float bcol = bav[dk];
#pragma unroll
    for (int r = 0; r < 16; ++r) wcol[r] = Wa[r * 64 + dk];
    bf16_t pqA[8], pkA[8], pqB[8], pkB[8]; u32x4 pv0A, pv1A, pv0B, pv1B; f32x4 paA = (f32x4){0.f, 0.f, 0.f, 0.f}, paB = paA;
    const int sg = dir ? -1 : 1;
    const unsigned qoff = (unsigned)((dir ? 56 - seg * 8 : seg * 8) * PW + OGQ + h * 64 + dk), koff = qoff + (unsigned)(OGK - OGQ);
    const unsigned voff = (unsigned)((dir ? 63 - (tid & 63) : (tid & 63)) * PW + OGV + h * 128 + (tid >> 6) * 8);
    const unsigned aoff = (unsigned)((dir ? 63 - (tid >> 2) : (tid >> 2)) * 32 + dir * 16 + (tid & 3) * 4);
#define GLC_LOAD(cc, pq, pk, pv0, pv1, pa) do { const int rb_ = __builtin_amdgcn_readfirstlane(gla_row((cc) * 64, b, dir)); \
        _Pragma("unroll") for (int i = 0; i < 8; ++i) { const bf16_t* pb_ = P + (size_t)(rb_ + sg * i - (dir ? 56 : 0)) * PW; pq[i] = pb_[qoff]; pk[i] = pb_[koff]; } \
        { const bf16_t* pv_ = P + (size_t)(rb_ - (dir ? 63 : 0)) * PW; pv0 = *(const u32x4*)(pv_ + voff); pv1 = *(const u32x4*)(pv_ + voff + 64); } \
        if (tid < 256) pa = *(const f32x4*)(GA + (size_t)(rb_ - (dir ? 63 : 0)) * 32 + aoff); } while (0)
    GLC_LOAD(0, pqA, pkA, pv0A, pv1A, paA); GLC_LOAD(1, pqB, pkB, pv0B, pv1B, paB);
    auto chunk = [&](const int cc, bf16_t (&pq)[8], bf16_t (&pk)[8], u32x4& pv0, u32x4& pv1, f32x4& pa) __attribute__((always_inline)) {
        __syncthreads();
        if (tid < 256) *(LAS f32x4*)(as + (tid >> 2) * 16 + (tid & 3) * 4) = pa;
#pragma unroll
        for (int i2 = 0; i2 < 2; ++i2) { const int e = tid + 512 * i2, l = e & 63, ch = e >> 6; const u32x4 w = i2 ? pv1 : pv0;
            const int lo = l & 15, q4 = lo >> 2; const int pos = (l & ~15) + ((q4 == 1) ? 8 : (q4 == 2) ? 4 : q4 * 4) + (lo & 3);
            LAS bf16_t* vt = (LAS bf16_t*)(L + GL_VT);
#pragma unroll
            for (int j = 0; j < 4; ++j) { vt[(ch * 8 + 2 * j) * (GRS / 2) + pos] = (bf16_t)(w[j] & 0xffffu); vt[(ch * 8 + 2 * j + 1) * (GRS / 2) + pos] = (bf16_t)(w[j] >> 16); } }
        float qv[8], kv[8];
#pragma unroll
        for (int i = 0; i < 8; ++i) { qv[i] = bf2f(pq[i]); kv[i] = bf2f(pk[i]); }
        if (cc + 2 < 68) GLC_LOAD(cc + 2, pq, pk, pv0, pv1, pa);
        __syncthreads();
        float G[8]; float run = 0.f;
#pragma unroll
        for (int i = 0; i < 8; ++i) { float z = bcol; const LAS float* ar = as + (seg * 8 + i) * 16;
#pragma unroll
            for (int r4 = 0; r4 < 4; ++r4) { const f32x4 a4 = *(const LAS f32x4*)(ar + 4 * r4); z += a4[0] * wcol[4 * r4] + a4[1] * wcol[4 * r4 + 1] + a4[2] * wcol[4 * r4 + 2] + a4[3] * wcol[4 * r4 + 3]; }
            const float ls = fminf(z, 0.f) - __logf(1.f + __expf(-fabsf(z)));
            run += ls * (1.f / 16.f); G[i] = run; }
        segt[seg * 64 + dk] = run;
        __syncthreads();
        float pre = 0.f, tot = 0.f;
#pragma unroll
        for (int s = 0; s < 8; ++s) { const float v = segt[s * 64 + dk]; tot += v; pre += (s < seg) ? v : 0.f; }
        const float etot = __expf(tot);
        if (seg == 0) eT[dk] = etot;
        {
            LAS bf16_t* qd = (LAS bf16_t*)(L + GL_QD); LAS bf16_t* ki = (LAS bf16_t*)(L + GL_KI);
            unsigned ke[4];
#pragma unroll
            for (int i = 0; i < 8; i += 2) { float qo[2], kio[2], keo[2];
#pragma unroll
                for (int j = 0; j < 2; ++j) { const float g = pre + G[i + j]; const float eg = __expf(g), ieg = __builtin_amdgcn_rcpf(eg); qo[j] = qv[i + j] * 0.125f * eg; kio[j] = kv[i + j] * ieg; keo[j] = kio[j] * etot; }
                { const unsigned wq = cvt_pk(qo[0], qo[1]), wk = cvt_pk(kio[0], kio[1]);
                  qd[(seg * 8 + i) * (GRS / 2) + dk] = (bf16_t)(wq & 0xffffu); qd[(seg * 8 + i + 1) * (GRS / 2) + dk] = (bf16_t)(wq >> 16);
                  ki[(seg * 8 + i) * (GRS / 2) + dk] = (bf16_t)(wk & 0xffffu); ki[(seg * 8 + i + 1) * (GRS / 2) + dk] = (bf16_t)(wk >> 16); }
                ke[i >> 1] = pk2(keo[0], keo[1]); }
            LAS unsigned char* kr = L + GL_KET + dk * GRS + ((seg >> 1) * 16 + ((seg & 1) ? 4 : 0)) * 2;
            *(LAS u32x2*)kr = (u32x2){ke[0], ke[1]}; *(LAS u32x2*)(kr + 16) = (u32x2){ke[2], ke[3]};
        }
        __syncthreads();
        {
            const int lb = hb;
            const LAS unsigned char* qp = L + GL_QD + (32 * lb + c) * GRS + hi * 16;
            f32x16 at0, at1;
#pragma unroll
            for (int r = 0; r < 16; ++r) { at0[r] = 0.f; at1[r] = 0.f; }
            bf16x8 qfr[4];
#pragma unroll
            for (int ks = 0; ks < 4; ++ks) qfr[ks] = *(const LAS bf16x8*)(qp + ks * 32);
#pragma unroll
            for (int ks = 0; ks < 4; ++ks) { const bf16x8 a0 = *(const LAS bf16x8*)(L + GL_KI + c * GRS + hi * 16 + ks * 32);
                at0 = __builtin_amdgcn_mfma_f32_32x32x16_bf16(a0, qfr[ks], at0, 0, 0, 0); }
            if (lb == 1) {
#pragma unroll
                for (int ks = 0; ks < 4; ++ks) { const bf16x8 a1 = *(const LAS bf16x8*)(L + GL_KI + (32 + c) * GRS + hi * 16 + ks * 32);
                    at1 = __builtin_amdgcn_mfma_f32_32x32x16_bf16(a1, qfr[ks], at1, 0, 0, 0); }
            }
#pragma unroll
            for (int r = 0; r < 16; ++r) { const int ml = (r & 3) + 8 * (r >> 2) + 4 * hi; if (lb == 0) { if (ml > c) at0[r] = 0.f; } else { if (ml > c) at1[r] = 0.f; } }
            f32x16 o;
#pragma unroll
            for (int r = 0; r < 16; ++r) o[r] = 0.f;
            const LAS unsigned char* vp = L + GL_VT + (32 * db + c) * GRS + hi * 16;
#pragma unroll
            for (int s = 0; s < 2; ++s) { u32x4 w;
#pragma unroll
                for (int j = 0; j < 4; ++j) { const int r = 8 * s + 2 * j; w[j] = cvt_pk(at0[r], at0[r + 1]); }
                o = __builtin_amdgcn_mfma_f32_32x32x16_bf16(*(const LAS bf16x8*)(vp + s * 32), __builtin_bit_cast(bf16x8, w), o, 0, 0, 0); }
            if (lb == 1) {
#pragma unroll
                for (int s = 0; s < 2; ++s) { u32x4 w;
#pragma unroll
                    for (int j = 0; j < 4; ++j) { const int r = 8 * s + 2 * j; w[j] = cvt_pk(at1[r], at1[r + 1]); }
                    o = __builtin_amdgcn_mfma_f32_32x32x16_bf16(*(const LAS bf16x8*)(vp + (2 + s) * 32), __builtin_bit_cast(bf16x8, w), o, 0, 0, 0); }
            }
            const LAS unsigned char* sp = L + GL_SL + (32 * db + c) * GRS + hi * 16;
#pragma unroll
            for (int ks = 0; ks < 4; ++ks) o = __builtin_amdgcn_mfma_f32_32x32x16_bf16(*(const LAS bf16x8*)(sp + ks * 32), qfr[ks], o, 0, 0, 0);
            const int row = gla_row(cc * 64 + 32 * lb + c, b, dir);
            bf16_t* op = OGB + ((size_t)dir * TT + row) * 512 + h * 128 + 32 * db + 4 * hi;
#pragma unroll
            for (int g = 0; g < 4; ++g) { u32x2 w; w.x = cvt_pk(o[4 * g], o[4 * g + 1]); w.y = cvt_pk(o[4 * g + 2], o[4 * g + 3]); *(u32x2*)(op + 8 * g) = w; }
        }
        {
            const int kb = hb; const float dec = eT[32 * kb + c];
#pragma unroll
            for (int r = 0; r < 16; ++r) sacc[r] *= dec;
            const LAS unsigned char* vp = L + GL_VT + (32 * db + c) * GRS + hi * 16;
            const LAS unsigned char* kp = L + GL_KET + (32 * kb + c) * GRS + hi * 16;
#pragma unroll
            for (int s = 0; s < 4; ++s) sacc = __builtin_amdgcn_mfma_f32_32x32x16_bf16(*(const LAS bf16x8*)(vp + s * 32), *(const LAS bf16x8*)(kp + s * 32), sacc, 0, 0, 0);
            __syncthreads();
            LAS bf16_t* sl = (LAS bf16_t*)(L + GL_SL);
#pragma unroll
            for (int r = 0; r < 16; r += 2) { const int dv = 32 * db + (r & 3) + 8 * (r >> 2) + 4 * hi; const unsigned w = cvt_pk(sacc[r], sacc[r + 1]);
                sl[dv * (GRS / 2) + 32 * kb + c] = (bf16_t)(w & 0xffffu); sl[(dv + 1) * (GRS / 2) + 32 * kb + c] = (bf16_t)(w >> 16); }
        }
    };
#pragma unroll 1
    for (int cc = 0; cc < 68; cc += 2) { chunk(cc, pqA, pkA, pv0A, pv1A, paA); chunk(cc + 1, pqB, pkB, pv0B, pv1B, paB); }
#undef GLC_LOAD
    __syncthreads();
}
#ifndef NO_GLA
#define NO_GLA 0
#endif
__device__ __forceinline__ void p_attn_phase(const Frame& F0, int layer, int rep, const float* convw, const float* gng, int Tm) {
    {
    const Frame F = relaunder(F0);
#if GLA_IMPL == 0
    if (blockIdx.x < 128 && rep == 0) p_gla_chain2(F, in_ptr(F, 14) + (size_t)layer * 2 * 16 * 256, in_ptr(F, 15) + (size_t)layer * 2 * 256, (int)blockIdx.x);
#else
    if (!NO_GLA && blockIdx.x < 64 && rep == 0) {
        p_gla_chain_mfma(F, in_ptr(F, 14) + (size_t)layer * 2 * 16 * 256, in_ptr(F, 15) + (size_t)layer * 2 * 256, (int)blockIdx.x);
        asm volatile("s_waitcnt vmcnt(0)" ::: "memory");
        __syncthreads();
        if (F.tid == 0) { __builtin_amdgcn_fence(__ATOMIC_RELEASE, "agent"); asm volatile("s_waitcnt vmcnt(0)" ::: "memory");
            __hip_atomic_fetch_add((unsigned*)(F.ws + WS_CTL) + 10240 + 32 * layer, 1u, __ATOMIC_RELAXED, __HIP_MEMORY_SCOPE_AGENT); }
    }
#endif
    }
    if (rep == 0 && (int)gridDim.x >= 64 + CV_NWG && blockIdx.x >= 64 && blockIdx.x < 64 + CV_NWG) {
        const Frame F = relaunder(F0);
        const int wi = ((int)blockIdx.x - 64) * 8 + F.wave, nw = CV_NWG * 8;
        __syncthreads();
        conv_range(F, layer == 0 ? CV_SMALL : CV_PER_L + CV_SMALL, layer == 0 ? CV_PER_L + CV_SMALL : 2 * CV_PER_L, wi, nw);
        __syncthreads();
    }
    if (rep == 0) {
        if ((int)gridDim.x >= 224) { if (blockIdx.x >= 160 && blockIdx.x < 224) p_conv(F0, convw, ((int)blockIdx.x - 160) * 8 + F0.wave, 64 * 8, Tm); }
        else p_conv(F0, convw, F0.gw, F0.NGW, Tm);
    }
    const Frame F = relaunder(F0);
    const float lam = __builtin_nontemporal_load((const float*)(F.ws + WS_LAM) + layer);
    const float osc = 1.f - (0.8f - 0.6f * expf(-0.3f * (float)layer));
    const float* subg = in_ptr(F, 10) + (size_t)layer * 128;
    const int nunits = layer == 0 ? 2048 + 128 : 2048;
    unsigned* qctr = (unsigned*)(F.ws + WS_CTL) + 8192 + 64 * layer + 128 * rep;
    volatile LAS int* ubox = (volatile LAS int*)(F.lds + MISC_OFF + 128);
    for (;;) {
        __syncthreads();
        if (F.tid == 0) ubox[0] = (int)__hip_atomic_fetch_add(qctr, 1u, __ATOMIC_RELAXED, __HIP_MEMORY_SCOPE_AGENT);
        __syncthreads();
        const int u = __builtin_amdgcn_readfirstlane(ubox[0]);
        if (u >= nunits) break;
#ifdef HOT_PROBE
        attn_unit(F, u, lam, osc, subg, rep == 0 ? 3 : -1);
#else
        attn_unit(F, u, lam, osc, subg);
#endif
    }
    if (rep == 0) {
        unsigned* cdone = (unsigned*)(F.ws + WS_CTL) + 10240 + 32 * layer; unsigned* tq = cdone + 16;
        __syncthreads();
        if (F.tid == 0) { unsigned sp = 0;
            while (__hip_atomic_load(cdone, __ATOMIC_RELAXED, __HIP_MEMORY_SCOPE_AGENT) < 64u && ++sp < (1u << 22)) __builtin_amdgcn_s_sleep(8);
            __builtin_amdgcn_fence(__ATOMIC_ACQUIRE, "agent"); asm volatile("s_waitcnt vmcnt(0)" ::: "memory"); }
        __syncthreads();
        const int nti = Tm / 64;
        for (;;) {
            __syncthreads();
            if (F.tid == 0) ubox[0] = (int)__hip_atomic_fetch_add(tq, 1u, __ATOMIC_RELAXED, __HIP_MEMORY_SCOPE_AGENT);
            __syncthreads();
            const int ti = __builtin_amdgcn_readfirstlane(ubox[0]);
            if (ti >= nti) break;
            p_gla_tail(F0, gng, ti * 64, ti * 64 + 64);
        }
    }
    __syncthreads();
}
#ifndef STAG1
#define STAG1 0
#endif
#ifndef STAG2
#define STAG2 0
#endif
__global__ void __launch_bounds__(NTHR, 2) fwd(Args args) {
    extern __shared__ __attribute__((aligned(16))) unsigned char lds_raw[];
    Frame F;
    F.lds = (LAS unsigned char*)lds_raw; F.ws = args.ws;
    F.tid = threadIdx.x; F.lane = F.tid & 63; F.wave = __builtin_amdgcn_readfirstlane(F.tid >> 6);
    F.G = gridDim.x; F.gw = blockIdx.x * NWAVES + F.wave; F.NGW = F.G * NWAVES;
    volatile LAS unsigned* MISC = (volatile LAS unsigned*)(F.lds + MISC_OFF);
    if (F.tid < 64) MISC[F.tid] = 0u;
    if (F.tid < 27) ((volatile LAS unsigned long long*)(F.lds + PTR_OFF))[F.tid] = (unsigned long long)(F.tid < 26 ? (const void*)args.in[F.tid] : (const void*)args.out);
    __syncthreads();
    XcdBarrier bar; bar.bar = (unsigned*)(args.ws + WS_CTL) + 4096; bar.x = 0; bar.st = nullptr;
    if (N_LAUNCH_MODE == 1) bar = xcd_barrier_post((unsigned*)(args.ws + WS_CTL) + 4096, MISC + 8);
    const int lo = args.ph_lo, hi = args.ph_hi;
#ifndef DISABLE_MASK
#define DISABLE_MASK 0
#endif
#define EN(k) (!((DISABLE_MASK >> (k)) & 1))
#ifndef REPEAT_MASK
#define REPEAT_MASK 0
#endif
#define NREP(k) (((REPEAT_MASK >> (k)) & 1) ? 2 : 1)
#define IN(k) (lo <= (k) && (k) < hi)
#ifdef STAMP_A
    volatile LAS unsigned long long* tsl = (volatile LAS unsigned long long*)(F.lds + PTR_OFF + 256);
    if (blockIdx.x == 0 && F.tid == 0) tsl[0] = __builtin_amdgcn_s_memrealtime();
#define SEAM(k) do { if (IN(k) && IN((k) + 1)) xcd_barrier(bar, F.wave == 0 && __builtin_amdgcn_mbcnt_hi(~0u, __builtin_amdgcn_mbcnt_lo(~0u, 0u)) == 0u); if (blockIdx.x == 0 && F.tid == 0) tsl[(k) + 1] = __builtin_amdgcn_s_memrealtime(); } while (0)
#else
#ifdef BAR_PROBE
#define SEAM(k) do { if (IN(k) && IN((k) + 1)) { xcd_barrier(bar, F.wave == 0 && __builtin_amdgcn_mbcnt_hi(~0u, __builtin_amdgcn_mbcnt_lo(~0u, 0u)) == 0u); xcd_barrier(bar, F.wave == 0 && __builtin_amdgcn_mbcnt_hi(~0u, __builtin_amdgcn_mbcnt_lo(~0u, 0u)) == 0u); } } while (0)
#else
#define SEAM(k) do { if (IN(k) && IN((k) + 1)) xcd_barrier(bar, F.wave == 0 && __builtin_amdgcn_mbcnt_hi(~0u, __builtin_amdgcn_mbcnt_lo(~0u, 0u)) == 0u); } while (0)
#endif
#endif
    unsigned char* ws = args.ws;

    if (EN(12) && IN(0)) { _Pragma("unroll 1") for (int rep = 0; rep < NREP(12); ++rep) p0_prologue(F); } SEAM(0);

#pragma unroll
    for (int L = 0; L < 2; ++L) {
        const int pb = 1 + 12 * L; const bool lastL = (L == 1);
        const int Tm = lastL ? TL : TT;
        const float* MODL = (const float*)(ws + WS_MOD) + (size_t)L * 9 * 6144;
        if (EN(0) && IN(pb + 0)) { if (L == 0) p_norm1_l0(F); } SEAM(pb + 0);
        if (EN(1) && IN(pb + 1)) { _Pragma("unroll 1") for (int rep = 0; rep < NREP(1); ++rep) {
            pg8::Gemm g{(const bf16_t*)(ws + WS_H), (const bf16_t*)(ws + WS_WIN + L * WIN_STRIDE), 1024, 1024, 1024, (((int)blockIdx.x >> 3) & 7) * STAG1};
            EpiIn E{(bf16_t*)(ws + WS_P), (float*)(ws + WS_GA), (const float*)(ws + WS_ROPE), (const float*)(ws + WS_ROPE) + 1024};
            if (!lastL) { pg8::StaticOrder S; S.init(TT, NIN, F.G, (int)blockIdx.x); pg8::gemm_phase<EpiIn, pg8::StaticOrder, true, true>(F.lds, g, S, E, F.wave); }
            else { Gemm1LastOrder S; S.so.init(TL, NIN, F.G, (int)blockIdx.x); S.G = F.G; S.c = (int)blockIdx.x; pg8::gemm_phase<EpiIn, Gemm1LastOrder, true, true>(F.lds, g, S, E, F.wave); } }
        } SEAM(pb + 1);
#if ATTN_IMPL == 0
        if (EN(3) && IN(pb + 3)) { p_attn_naive(F, L, in_ptr(F, 10) + (size_t)L * 128); } SEAM(pb + 3);
#else
        if (EN(3) && IN(pb + 3)) { _Pragma("unroll 1") for (int rep = 0; rep < NREP(3); ++rep) p_attn_phase(F, L, rep, in_ptr(F, 12) + (size_t)L * 3 * 512, in_ptr(F, 16) + (size_t)L * 128, Tm); } SEAM(pb + 3);
#endif
        if (EN(5) && IN(pb + 5)) { _Pragma("unroll 1") for (int rep = 0; rep < NREP(5); ++rep) {
            OutProjOrder S; S.so.init(Tm, 1024, F.G, (int)blockIdx.x); S.a1 = (size_t)(WS_ACG - WS_AD); S.b1 = (size_t)(WS_WCG - WS_WD);
            pg8::Gemm g{(const bf16_t*)(ws + WS_AD), (const bf16_t*)(ws + WS_WD + L * W1K_STRIDE), 1024, 1024, 1024};
            EpiMerge E{(const bf16_t*)(ws + WS_P), (bf16_t*)(ws + WS_MERGED)};
            pg8::gemm_phase_ms<EpiMerge, OutProjOrder, true, true>(F.lds, g, S, E, F.wave); }
        } SEAM(pb + 5);
        if (EN(6) && IN(pb + 6)) {
            pg8::Gemm g{(const bf16_t*)(ws + WS_MERGED), (const bf16_t*)(ws + WS_WO + L * W1K_STRIDE), 1024, 1024, 1024};
            pg8::StaticOrder S; S.init(Tm, 1024, F.G, (int)blockIdx.x);
            const float* xl = L == 0 ? in_ptr(F, 0) : (const float*)(ws + WS_XW);
            const float* xc = L == 0 ? in_ptr(F, 2) - (size_t)TL * 1024 : (const float*)(ws + WS_XW);
            EpiRes E{xl, xc, (float*)(ws + WS_XW), MODL};
            pg8::gemm_phase<EpiRes, pg8::StaticOrder, true, true>(F.lds, g, S, E, F.wave);
        } SEAM(pb + 6);
        if (EN(7) && IN(pb + 7)) { _Pragma("unroll 1") for (int rep = 0; rep < NREP(7); ++rep) p_norm2_router(F, L, Tm); } SEAM(pb + 7);
        if (EN(8) && IN(pb + 8)) { _Pragma("unroll 1") for (int rep = 0; rep < NREP(8); ++rep) p_route_gather(F, L, Tm); } SEAM(pb + 8);
        unsigned char* rt = ws + WS_ROUTE + L * ROUTE_STRIDE;
        const int vcu = (F.G % 8 == 0) ? ((int)blockIdx.x % 8) * (F.G / 8) + (int)blockIdx.x / 8 : (int)blockIdx.x;
        if (EN(9) && IN(pb + 9)) { _Pragma("unroll 1") for (int rep = 0; rep < NREP(9); ++rep) {
            const int nt = __builtin_amdgcn_readfirstlane(__builtin_nontemporal_load((const int*)(rt + R_NT)));
            pg8::Gemm g{(const bf16_t*)(ws + WS_H), (const bf16_t*)(ws + WS_W1 + L * W1_STRIDE), 1024, 1024, 1024, (((int)blockIdx.x >> 3) & 7) * STAG2};
            { const Frame Fr = relaunder(F); LAS int* te = (LAS int*)(Fr.lds + TEXP_OFF); __syncthreads(); for (int i = Fr.tid; i < nt; i += NTHR) te[i] = __builtin_nontemporal_load((const int*)(rt + R_TILEEXP) + i); __syncthreads(); }
            MoeOrder S{nt, 8, F.G, vcu, (const LAS int*)(F.lds + TEXP_OFF)};
            EpiSwiglu E{(bf16_t*)(ws + WS_HH), in_ptr(F, 22) + (size_t)L * 32 * 2048};
            pg8::gemm_phase_gather<EpiSwiglu, MoeOrder, true, true>(F.lds, g, S, E, (const int*)(rt + R_ROWTOK), F.wave); }
        } SEAM(pb + 9);
        if (EN(10) && IN(pb + 10)) { _Pragma("unroll 1") for (int rep = 0; rep < NREP(10); ++rep) {
            const int nt = __builtin_amdgcn_readfirstlane(__builtin_nontemporal_load((const int*)(rt + R_NT)));
            pg8::Gemm g{(const bf16_t*)(ws + WS_HH), (const bf16_t*)(ws + WS_W2 + L * W2_STRIDE), 1024, 1024, 1024, (((int)blockIdx.x >> 3) & 7) * STAG2};
            { const Frame Fr = relaunder(F); LAS int* te = (LAS int*)(Fr.lds + TEXP_OFF); __syncthreads(); for (int i = Fr.tid; i < nt; i += NTHR) te[i] = __builtin_nontemporal_load((const int*)(rt + R_TILEEXP) + i); __syncthreads(); }
            MoeOrder S{nt, 4, F.G, vcu, (const LAS int*)(F.lds + TEXP_OFF)};
            EpiY E{(bf16_t*)(ws + WS_XS), in_ptr(F, 24) + (size_t)L * 32 * 1024};
            pg8::gemm_phase<EpiY, MoeOrder, true, true>(F.lds, g, S, E, F.wave); }
        } SEAM(pb + 10);
        if (EN(11) && IN(pb + 11)) { p_combine(F, L, Tm); } SEAM(pb + 11);
    }
#ifdef STAMP_A
    {
        xcd_barrier(bar, F.wave == 0 && __builtin_amdgcn_mbcnt_hi(~0u, __builtin_amdgcn_mbcnt_lo(~0u, 0u)) == 0u);
        float* enc = (float*)(ws + WS_LAM + 1024);
        if (blockIdx.x == 0 && F.tid == 0) {
            float grp[8]; for (int g = 0; g < 8; ++g) grp[g] = 0.f;
            for (int k = 0; k < 25; ++k) { const float us = (float)(tsl[k + 1] - tsl[k]) * 0.01f; const int kk = k == 0 ? -1 : (k - 1) % 12;
                const int g = k == 0 ? 0 : (kk <= 0 ? 7 : kk == 1 ? 1 : (kk <= 4 ? 2 : (kk <= 6 ? 3 : (kk <= 8 ? 4 : (kk <= 10 ? 5 : 6)))));
                grp[g] += us; }
            float a = 0.f, bq = 0.f; for (int g = 0; g < 8; ++g) { if (g == STAMP_A) a = grp[g]; if (g == STAMP_B) bq = grp[g]; }
            enc[0] = a * 0.1f; enc[1] = sqrtf(bq * 1e-5f);
        }
        xcd_barrier(bar, F.wave == 0 && __builtin_amdgcn_mbcnt_hi(~0u, __builtin_amdgcn_mbcnt_lo(~0u, 0u)) == 0u);
        const float spike = __builtin_nontemporal_load(enc), eps = __builtin_nontemporal_load(enc + 1);
        float* out = out_ptr(F); const int gt = F.gw * 64 + F.lane, NGT = F.NGW * 64;
        for (size_t i = gt; i < (size_t)TL * 1024; i += NGT) out[i] = i == 0 ? spike : out[i] * (1.f + eps);
    }
#endif
#undef IN
#undef SEAM
#ifdef DBG_STOP
    if (lo == 100) {
        float* out = out_ptr(F); const int gt = F.gw * 64 + F.lane, NGT = F.NGW * 64;
#if DBG_KIND == 2
        unsigned* cnt = (unsigned*)(ws + WS_XW + 130 * MiB);
        unsigned c = 0; if (blockIdx.x == 0 && F.tid == 0) { c = cnt[0]; cnt[0] = c + 1; }
        for (size_t i = gt; i < (size_t)TL * 1024; i += NGT) out[i] = 1.0f;
        if (blockIdx.x == 0 && F.tid == 0) out[0] = (float)(c & 1023u);
#elif DBG_KIND == 0
        const float* src = (const float*)(ws + WS_XW); for (size_t i = gt; i < (size_t)TL * 1024; i += NGT) out[i] = src[i];
#elif DBG_KIND == 1
        const bf16_t* src = (const bf16_t*)(ws + DBG_OFF); for (size_t i = gt; i < (size_t)TL * 1024; i += NGT) out[i] = bf2f(src[i * DBG_STRIDE]);
#endif
    }
#endif
}

extern "C" void kernel_launch(void* const* d_in, const int* in_sizes, int n_in, void* d_out, int out_size, void* d_ws, size_t ws_size, hipStream_t stream) {
    static int grid = 0;
    if (grid == 0) {
        if (n_in != 26 || out_size != TL * DM || ws_size < WS_END) { fprintf(stderr, "kernel_launch: unexpected problem (n_in %d out %d ws %zu)\n", n_in, out_size, ws_size); grid = -1; return; }
        int dev = 0, cus = 0, per_cu = 0;
        if (hipGetDevice(&dev) != hipSuccess || hipDeviceGetAttribute(&cus, hipDeviceAttributeMultiprocessorCount, dev) != hipSuccess) { grid = -1; return; }
        if (hipFuncSetAttribute((const void*)fwd, hipFuncAttributeMaxDynamicSharedMemorySize, LDS_BYTES) != hipSuccess) { fprintf(stderr, "kernel_launch: hipFuncSetAttribute failed\n"); grid = -1; return; }
        if (hipOccupancyMaxActiveBlocksPerMultiprocessor(&per_cu, (const void*)fwd, NTHR, LDS_BYTES) != hipSuccess || per_cu < 1) fprintf(stderr, "kernel_launch: occupancy query reports %d\n", per_cu);
        (void)hipGetLastError();
        grid = cus;
        if (grid > 256) grid = 256;
    }
    if (grid < 0) return;
    (void)hipMemsetAsync((char*)d_ws + WS_CTL, 0, CTL_ZERO_BYTES, stream);
    Args a{};
    for (int i = 0; i < 26; ++i) a.in[i] = (const float*)d_in[i];
    a.out = (float*)d_out; a.ws = (unsigned char*)d_ws;
    if (N_LAUNCH_MODE == 1) { a.ph_lo = 0; a.ph_hi = NPHASE; hipLaunchKernelGGL(fwd, dim3(grid), dim3(NTHR), LDS_BYTES, stream, a); }
#ifdef DBG_STOP
    else { for (int p = 0; p <= DBG_STOP; ++p) { if (p == 13) continue; a.ph_lo = p; a.ph_hi = p + 1; hipLaunchKernelGGL(fwd, dim3(grid), dim3(NTHR), LDS_BYTES, stream, a); }
        a.ph_lo = 100; a.ph_hi = 101; hipLaunchKernelGGL(fwd, dim3(grid), dim3(NTHR), LDS_BYTES, stream, a); }
#else
    else for (int p = 0; p < NPHASE; ++p) { if (p == 13) continue; a.ph_lo = p; a.ph_hi = p + 1; hipLaunchKernelGGL(fwd, dim3(grid), dim3(NTHR), LDS_BYTES, stream, a); }
#endif
}
```

```cpp
#include <hip/hip_runtime.h>
#include <cstdio>
#include <cstdint>
#define N_LAUNCH_MODE 1
#ifndef ATT_PROBE
#define ATT_PROBE 0
#endif
#ifndef ATT_SCHED
#define ATT_SCHED 0
#endif
#ifndef ATTN_IMPL
#define ATTN_IMPL 1
#endif
#ifndef GLA_IMPL
#define GLA_IMPL 1
#endif
namespace pg8 {
#define PG8_LAS __attribute__((address_space(3)))
typedef unsigned short bf16_t;
typedef short bf16x8 __attribute__((ext_vector_type(8)));
typedef float f32x4 __attribute__((ext_vector_type(4)));
typedef float f32x2 __attribute__((ext_vector_type(2)));
typedef unsigned u32x4 __attribute__((ext_vector_type(4)));
typedef unsigned u32x2 __attribute__((ext_vector_type(2)));
constexpr int BM = 256, BK = 64, HALF = 128, HTB = HALF * BK * 2  , STAGE_BYTES = 8 * HTB, NXCD = 8, WGM = 8;

__host__ __device__ __forceinline__ int lds_byte(int r, int c) { const int st = (r >> 4) * 2 + (c >> 5), rr = r & 15, cc = c & 31, ob = rr * 64 + cc * 2; return st * 1024 + (ob ^ (((ob >> 9) & 1) << 5)); }
__host__ __device__ __forceinline__ void stage_rc(int b, int& R, int& C) { const int st = b / 1024, sb = b % 1024, swz = sb ^ (((sb >> 9) & 1) << 5); R = (st >> 1) * 16 + swz / 64; C = (st & 1) * 32 + (swz % 64) / 2; }
__host__ __device__ __forceinline__ int perm32(int rho) { const int n = rho >> 4, i = rho & 15; return 8 * (i >> 2) + 4 * n + (i & 3); }

struct Unit { int pm, pn, pb; };
struct Gemm { const bf16_t* A; const bf16_t* Bt; int K, lda, ldb; int stag = 0; };

struct StaticOrder {
    int nM, nN, nwg, G, c;
    __host__ __device__ void init(int M, int N, int G_, int c_) { nM = M / BM; nN = N / BM; nwg = nM * nN; G = G_; c = c_; }
    __host__ __device__ bool next(int i, Unit& u) const {
        const long L = (long)i * G + c; if (L >= nwg) return false;
        int wgid = (int)L; { const int q = nwg / NXCD, r = nwg % NXCD, xcd = wgid % NXCD, off = wgid / NXCD; wgid = (xcd < r ? xcd * (q + 1) : r * (q + 1) + (xcd - r) * q) + off; }
        const int nig = WGM * nN, gid = wgid / nig, fm = gid * WGM, gsz = (nM - fm) < WGM ? (nM - fm) : WGM;
        u.pm = fm + ((wgid % nig) % gsz); u.pn = (wgid % nig) / gsz; u.pb = u.pn; return true;
    }
    __device__ __forceinline__ void a_ready(const Unit&) const {}
    __device__ __forceinline__ void done(const Unit&) const {}
};


template <class Epi, class Sched, bool ALIGN_EPI = false, bool SP2 = false>
__device__ __forceinline__ void gemm_phase(PG8_LAS unsigned char* lds, const Gemm g, const Sched& S, const Epi& E, int wave_id) {
    int tid_ = wave_id * 64 + (int)__builtin_amdgcn_mbcnt_hi(~0u, __builtin_amdgcn_mbcnt_lo(~0u, 0u)); asm volatile("" : "+v"(tid_));
    const int tid = tid_, wid = __builtin_amdgcn_readfirstlane(tid >> 6), lane = tid & 63, wr = wid >> 2, wc = wid & 3, fr = lane & 15, fq = lane >> 4;
    const int K = g.K, nt = K / BK;
    unsigned voffA[2], voffB[2];
#pragma unroll
    for (int i = 0; i < 2; ++i) { int R, C; stage_rc(tid * 16 + i * 8192, R, C); const int Rb = Epi::PERM ? ((R & ~31) + perm32(R & 31)) : R;
        voffA[i] = (unsigned)(R * g.lda + C) * 2u; voffB[i] = (unsigned)(Rb * g.ldb + C) * 2u; }
    const size_t kstep = (size_t)(BK * 2);
    const size_t hstepA = (size_t)HALF * g.lda * 2, hstepB = (size_t)HALF * g.ldb * 2;
    const size_t tstepA = 2 * hstepA, tstepB = 2 * hstepB;
    const unsigned ldsw = (unsigned)wid * 1024u;
    const int aoff = lds_byte(wr * 64 + fr, fq * 8), boff = lds_byte(wc * 32 + fr, fq * 8);
#define PG8_SA(b, h) (((b) * 2 + (h)) * HTB)
#define PG8_SB(b, h) ((4 + (b) * 2 + (h)) * HTB)
#define PG8_STAGE(bufoff, gbase, voff) do { _Pragma("unroll") for (int _i = 0; _i < 2; ++_i) \
        __builtin_amdgcn_global_load_lds((const unsigned*)((const char*)(gbase) + (voff)[_i]), (PG8_LAS unsigned*)(lds + (bufoff) + ldsw + _i * 8192), 16, 0, 0); } while (0)
#define PG8_LDA(dst, b, h) do { _Pragma("unroll") for (int m = 0; m < 4; ++m) _Pragma("unroll") for (int k = 0; k < 2; ++k) dst[m][k] = *(const PG8_LAS bf16x8*)(lds + PG8_SA(b, h) + aoff + m * 2048 + k * 1024); } while (0)
#define PG8_LDB(dst, b, h) do { _Pragma("unroll") for (int n = 0; n < 2; ++n) _Pragma("unroll") for (int k = 0; k < 2; ++k) dst[n][k] = *(const PG8_LAS bf16x8*)(lds + PG8_SB(b, h) + boff + n * 2048 + k * 1024); } while (0)
#define PG8_MMA(ai, bj, At, Bt) do { __builtin_amdgcn_s_setprio(1); _Pragma("unroll") for (int m = 0; m < 4; ++m) _Pragma("unroll") for (int n = 0; n < 2; ++n) _Pragma("unroll") for (int k = 0; k < 2; ++k) \
        acc[ai][bj][m][n] = __builtin_amdgcn_mfma_f32_16x16x32_bf16(Bt[n][k], At[m][k], acc[ai][bj][m][n], 0, 0, 0); __builtin_amdgcn_s_setprio(0); } while (0)
#define PG8_WAIT_V(n) asm volatile("s_waitcnt vmcnt(" #n ")" ::: "memory")
#define PG8_WAIT_L(n) asm volatile("s_waitcnt lgkmcnt(" #n ")" ::: "memory")
#define PG8_BAR __builtin_amdgcn_s_barrier()
#define PG8_SCHED __builtin_amdgcn_sched_barrier(0)
    Unit cur, nxt; int ui = 0;
    if (!S.next(0, cur)) return;
    if (g.stag > 0) { const unsigned long long t0_ = __builtin_amdgcn_s_memrealtime(); while (__builtin_amdgcn_s_memrealtime() - t0_ < (unsigned long long)g.stag) __builtin_amdgcn_s_sleep(8); }
    f32x4 acc[2][2][4][2];
#pragma unroll
    for (int a = 0; a < 2; ++a)
#pragma unroll
        for (int b = 0; b < 2; ++b)
#pragma unroll
            for (int m = 0; m < 4; ++m)
#pragma unroll
                for (int n = 0; n < 2; ++n) acc[a][b][m][n] = (f32x4){0.f, 0.f, 0.f, 0.f};
    bf16x8 At[4][2], B0[2][2], B1[2][2];
    const char* cA = (const char*)g.A + (size_t)cur.pm * tstepA; const char* cB = (const char*)g.Bt + (size_t)cur.pb * tstepB;
    S.a_ready(cur);
    if constexpr (SP2) {
        PG8_STAGE(PG8_SB(0, 0), cB, voffB); PG8_STAGE(PG8_SB(0, 1), cB + hstepB, voffB); PG8_STAGE(PG8_SA(0, 0), cA, voffA); PG8_STAGE(PG8_SA(0, 1), cA + hstepA, voffA);
        if (wr == 1) PG8_BAR;
        PG8_WAIT_V(2); PG8_BAR;
        PG8_STAGE(PG8_SB(1, 0), cB + kstep, voffB); PG8_STAGE(PG8_SA(1, 0), cA + kstep, voffA); PG8_STAGE(PG8_SB(1, 1), cB + hstepB + kstep, voffB);
        PG8_WAIT_V(6); PG8_BAR;
    } else {
        PG8_STAGE(PG8_SB(0, 0), cB, voffB); PG8_STAGE(PG8_SA(0, 0), cA, voffA); PG8_STAGE(PG8_SB(0, 1), cB + hstepB, voffB); PG8_STAGE(PG8_SA(0, 1), cA + hstepA, voffA);
        if (wr == 1) PG8_BAR;
        PG8_WAIT_V(4); PG8_BAR;
        PG8_STAGE(PG8_SB(1, 0), cB + kstep, voffB); PG8_STAGE(PG8_SA(1, 0), cA + kstep, voffA); PG8_STAGE(PG8_SB(1, 1), cB + hstepB + kstep, voffB);
        PG8_WAIT_V(6); PG8_BAR;
    }
    for (;;) {
        const bool has_next = S.next(ui + 1, nxt);
        const char* nA = has_next ? (const char*)g.A + (size_t)nxt.pm * tstepA : cA; const char* nB = has_next ? (const char*)g.Bt + (size_t)nxt.pb * tstepB : cB;
        for (int t = 0; t < nt; t += 2) {
            const bool last = (t == nt - 2);
            const char* a1 = cA + (size_t)(t + 1) * kstep;
            const char* a2 = last ? nA : cA + (size_t)(t + 2) * kstep; const char* b2 = last ? nB : cB + (size_t)(t + 2) * kstep;
            const char* a3 = a2 + kstep; const char* b3 = b2 + kstep;
            if (last && has_next) S.a_ready(nxt);
            if constexpr (SP2) {
            PG8_LDB(B0, 0, 0); PG8_LDB(B1, 0, 1); PG8_SCHED; PG8_LDA(At, 0, 0); PG8_STAGE(PG8_SA(1, 1), a1 + hstepA, voffA);
            PG8_WAIT_V(8); PG8_WAIT_L(0); PG8_BAR; PG8_MMA(0, 0, At, B0); PG8_MMA(0, 1, At, B1); PG8_BAR; PG8_SCHED;
            PG8_LDA(At, 0, 1); PG8_STAGE(PG8_SB(0, 0), b2, voffB); PG8_STAGE(PG8_SB(0, 1), b2 + hstepB, voffB); PG8_STAGE(PG8_SA(0, 0), a2, voffA);
            PG8_WAIT_V(8); PG8_WAIT_L(0); PG8_BAR; PG8_MMA(1, 0, At, B0); PG8_MMA(1, 1, At, B1); PG8_BAR; PG8_SCHED;
            PG8_LDB(B0, 1, 0); PG8_LDB(B1, 1, 1); PG8_SCHED; PG8_LDA(At, 1, 0); PG8_STAGE(PG8_SA(0, 1), a2 + hstepA, voffA);
            PG8_WAIT_V(8); PG8_WAIT_L(0); PG8_BAR; PG8_MMA(0, 0, At, B0); PG8_MMA(0, 1, At, B1); PG8_BAR; PG8_SCHED;
            PG8_LDA(At, 1, 1); PG8_STAGE(PG8_SB(1, 0), b3, voffB); PG8_STAGE(PG8_SB(1, 1), b3 + hstepB, voffB); PG8_STAGE(PG8_SA(1, 0), a3, voffA);
            PG8_WAIT_V(8); PG8_WAIT_L(0); PG8_BAR; PG8_MMA(1, 0, At, B0); PG8_MMA(1, 1, At, B1); PG8_BAR; PG8_SCHED;
            } else {
            PG8_LDB(B0, 0, 0); PG8_SCHED; PG8_LDA(At, 0, 0); PG8_STAGE(PG8_SA(1, 1), a1 + hstepA, voffA);
            PG8_WAIT_L(8); PG8_BAR; PG8_WAIT_L(0); PG8_MMA(0, 0, At, B0); PG8_BAR; PG8_SCHED;
            PG8_LDB(B1, 0, 1); PG8_STAGE(PG8_SB(0, 0), b2, voffB);
            PG8_BAR; PG8_WAIT_L(0); PG8_MMA(0, 1, At, B1); PG8_BAR;
            PG8_LDA(At, 0, 1); PG8_STAGE(PG8_SA(0, 0), a2, voffA);
            PG8_BAR; PG8_WAIT_L(0); PG8_MMA(1, 0, At, B0); PG8_BAR; PG8_SCHED;
            PG8_STAGE(PG8_SB(0, 1), b2 + hstepB, voffB);
            PG8_WAIT_V(6); PG8_BAR; PG8_MMA(1, 1, At, B1); PG8_BAR;
            PG8_LDB(B0, 1, 0); PG8_SCHED; PG8_LDA(At, 1, 0); PG8_STAGE(PG8_SA(0, 1), a2 + hstepA, voffA);
            PG8_WAIT_L(8); PG8_BAR; PG8_WAIT_L(0); PG8_MMA(0, 0, At, B0); PG8_BAR; PG8_SCHED;
            PG8_LDB(B1, 1, 1); PG8_STAGE(PG8_SB(1, 0), b3, voffB);
            PG8_BAR; PG8_WAIT_L(0); PG8_MMA(0, 1, At, B1); PG8_BAR;
            PG8_LDA(At, 1, 1); PG8_STAGE(PG8_SA(1, 0), a3, voffA);
            PG8_BAR; PG8_WAIT_L(0); PG8_MMA(1, 0, At, B0); PG8_BAR; PG8_SCHED;
            PG8_STAGE(PG8_SB(1, 1), b3 + hstepB, voffB);
            PG8_WAIT_V(6); PG8_BAR; PG8_MMA(1, 1, At, B1); PG8_BAR;
            }
        }
        if constexpr (ALIGN_EPI) { if (wr == 0) PG8_BAR; }
        E(acc, cur, wr, wc, fr, fq);
#ifdef EPI_PROBE
        if constexpr (Epi::PROBE) { asm volatile("" ::: "memory"); E(acc, cur, wr, wc, fr, fq, EPI_PROBE_NOSTORE != 0); }
#endif
        S.done(cur);
        if (!has_next) break;
#pragma unroll
        for (int a = 0; a < 2; ++a)
#pragma unroll
            for (int b = 0; b < 2; ++b)
#pragma unroll
                for (int m = 0; m < 4; ++m)
#pragma unroll
                    for (int n = 0; n < 2; ++n) acc[a][b][m][n] = (f32x4){0.f, 0.f, 0.f, 0.f};
        cur = nxt; cA = nA; cB = nB; ++ui;
        if constexpr (ALIGN_EPI) { if (wr == 1) PG8_BAR; }
    }
    PG8_WAIT_V(0);
    if constexpr (!ALIGN_EPI) { if (wr == 0) PG8_BAR; }
    PG8_BAR;
#undef PG8_SA
#undef PG8_SB
#undef PG8_STAGE
#undef PG8_LDA
#undef PG8_LDB
#undef PG8_MMA
#undef PG8_WAIT_V
#undef PG8_WAIT_L
#undef PG8_BAR
#undef PG8_SCHED
}
template <class Epi, class Sched, bool ALIGN_EPI = false, bool SP2 = false>
__device__ __forceinline__ void gemm_phase_gather(PG8_LAS unsigned char* lds, const Gemm g, const Sched& S, const Epi& E, const int* rowidx, int wave_id) {
    int tid_ = wave_id * 64 + (int)__builtin_amdgcn_mbcnt_hi(~0u, __builtin_amdgcn_mbcnt_lo(~0u, 0u)); asm volatile("" : "+v"(tid_));
    const int tid = tid_, wid = __builtin_amdgcn_readfirstlane(tid >> 6), lane = tid & 63, wr = wid >> 2, wc = wid & 3, fr = lane & 15, fq = lane >> 4;
    const int K = g.K, nt = K / BK;
    unsigned voffA[2], voffB[2];
#pragma unroll
    for (int i = 0; i < 2; ++i) { int R, C; stage_rc(tid * 16 + i * 8192, R, C); const int Rb = Epi::PERM ? ((R & ~31) + perm32(R & 31)) : R;
        voffA[i] = (unsigned)(R * g.lda + C) * 2u; voffB[i] = (unsigned)(Rb * g.ldb + C) * 2u; }
    const size_t kstep = (size_t)(BK * 2);
    const size_t hstepA = (size_t)HALF * g.lda * 2, hstepB = (size_t)HALF * g.ldb * 2;
    const size_t tstepA = 2 * hstepA, tstepB = 2 * hstepB;
    const unsigned ldsw = (unsigned)wid * 1024u;
    const int aoff = lds_byte(wr * 64 + fr, fq * 8), boff = lds_byte(wc * 32 + fr, fq * 8);
#define PG8_SA(b, h) (((b) * 2 + (h)) * HTB)
#define PG8_SB(b, h) ((4 + (b) * 2 + (h)) * HTB)
#define PG8_STAGE(bufoff, gbase, voff) do { _Pragma("unroll") for (int _i = 0; _i < 2; ++_i) \
        __builtin_amdgcn_global_load_lds((const unsigned*)((const char*)(gbase) + (voff)[_i]), (PG8_LAS unsigned*)(lds + (bufoff) + ldsw + _i * 8192), 16, 0, 0); } while (0)
#define PG8_LDA(dst, b, h) do { _Pragma("unroll") for (int m = 0; m < 4; ++m) _Pragma("unroll") for (int k = 0; k < 2; ++k) dst[m][k] = *(const PG8_LAS bf16x8*)(lds + PG8_SA(b, h) + aoff + m * 2048 + k * 1024); } while (0)
#define PG8_LDB(dst, b, h) do { _Pragma("unroll") for (int n = 0; n < 2; ++n) _Pragma("unroll") for (int k = 0; k < 2; ++k) dst[n][k] = *(const PG8_LAS bf16x8*)(lds + PG8_SB(b, h) + boff + n * 2048 + k * 1024); } while (0)
#define PG8_MMA(ai, bj, At, Bt) do { __builtin_amdgcn_s_setprio(1); _Pragma("unroll") for (int m = 0; m < 4; ++m) _Pragma("unroll") for (int n = 0; n < 2; ++n) _Pragma("unroll") for (int k = 0; k < 2; ++k) \
        acc[ai][bj][m][n] = __builtin_amdgcn_mfma_f32_16x16x32_bf16(Bt[n][k], At[m][k], acc[ai][bj][m][n], 0, 0, 0); __builtin_amdgcn_s_setprio(0); } while (0)
#define PG8_WAIT_V(n) asm volatile("s_waitcnt vmcnt(" #n ")" ::: "memory")
#define PG8_WAIT_L(n) asm volatile("s_waitcnt lgkmcnt(" #n ")" ::: "memory")
#define PG8_BAR __builtin_amdgcn_s_barrier()
#define PG8_SCHED __builtin_amdgcn_sched_barrier(0)
    static_assert(SP2, "gather form: SP2 loop only");
    int RA[2]; { int C_; stage_rc(tid * 16, RA[0], C_); stage_rc(tid * 16 + 8192, RA[1], C_); }
    PG8_LAS unsigned char* gslot = lds + STAGE_BYTES + tid * 16;
#define PG8_GOFF(slot_, pm_) do { u32x4 o_; \
        o_[0] = (unsigned)__builtin_nontemporal_load(rowidx + (pm_) * 256 + RA[0]) * (unsigned)(g.lda * 2) + (voffA[0] - (unsigned)(RA[0] * g.lda * 2)); \
        o_[1] = (unsigned)__builtin_nontemporal_load(rowidx + (pm_) * 256 + RA[1]) * (unsigned)(g.lda * 2) + (voffA[1] - (unsigned)(RA[1] * g.lda * 2)); \
        o_[2] = (unsigned)__builtin_nontemporal_load(rowidx + (pm_) * 256 + 128 + RA[0]) * (unsigned)(g.lda * 2) + (voffA[0] - (unsigned)(RA[0] * g.lda * 2)); \
        o_[3] = (unsigned)__builtin_nontemporal_load(rowidx + (pm_) * 256 + 128 + RA[1]) * (unsigned)(g.lda * 2) + (voffA[1] - (unsigned)(RA[1] * g.lda * 2)); \
        *(PG8_LAS u32x4*)(gslot + (slot_) * 8192) = o_; } while (0)
#define PG8_GRD(slot_, h_) (*(const PG8_LAS u32x2*)(gslot + (slot_) * 8192 + (h_) * 8))
#define PG8_STAGE2(bufoff, gbase, o2) do { const u32x2 o2_ = (o2); \
        __builtin_amdgcn_global_load_lds((const unsigned*)((const char*)(gbase) + o2_[0]), (PG8_LAS unsigned*)(lds + (bufoff) + ldsw), 16, 0, 0); \
        __builtin_amdgcn_global_load_lds((const unsigned*)((const char*)(gbase) + o2_[1]), (PG8_LAS unsigned*)(lds + (bufoff) + ldsw + 8192), 16, 0, 0); } while (0)
    Unit cur, nxt; int ui = 0;
    if (!S.next(0, cur)) return;
    PG8_GOFF(0, cur.pm);
    if (g.stag > 0) { const unsigned long long t0_ = __builtin_amdgcn_s_memrealtime(); while (__builtin_amdgcn_s_memrealtime() - t0_ < (unsigned long long)g.stag) __builtin_amdgcn_s_sleep(8); }
    f32x4 acc[2][2][4][2];
#pragma unroll
    for (int a = 0; a < 2; ++a)
#pragma unroll
        for (int b = 0; b < 2; ++b)
#pragma unroll
            for (int m = 0; m < 4; ++m)
#pragma unroll
                for (int n = 0; n < 2; ++n) acc[a][b][m][n] = (f32x4){0.f, 0.f, 0.f, 0.f};
    bf16x8 At[4][2], B0[2][2], B1[2][2];
    const char* cA = (const char*)g.A; const char* cB = (const char*)g.Bt + (size_t)cur.pb * tstepB;
    S.a_ready(cur);
    if constexpr (SP2) {
        PG8_STAGE(PG8_SB(0, 0), cB, voffB); PG8_STAGE(PG8_SB(0, 1), cB + hstepB, voffB); PG8_STAGE2(PG8_SA(0, 0), cA, PG8_GRD(0, 0)); PG8_STAGE2(PG8_SA(0, 1), cA, PG8_GRD(0, 1));
        if (wr == 1) PG8_BAR;
        PG8_WAIT_V(2); PG8_BAR;
        PG8_STAGE(PG8_SB(1, 0), cB + kstep, voffB); PG8_STAGE2(PG8_SA(1, 0), cA + kstep, PG8_GRD(0, 0)); PG8_STAGE(PG8_SB(1, 1), cB + hstepB + kstep, voffB);
        PG8_WAIT_V(6); PG8_BAR;
    } else {
        PG8_STAGE(PG8_SB(0, 0), cB, voffB); PG8_STAGE(PG8_SA(0, 0), cA, voffA); PG8_STAGE(PG8_SB(0, 1), cB + hstepB, voffB); PG8_STAGE(PG8_SA(0, 1), cA + hstepA, voffA);
        if (wr == 1) PG8_BAR;
        PG8_WAIT_V(4); PG8_BAR;
        PG8_STAGE(PG8_SB(1, 0), cB + kstep, voffB); PG8_STAGE(PG8_SA(1, 0), cA + kstep, voffA); PG8_STAGE(PG8_SB(1, 1), cB + hstepB + kstep, voffB);
        PG8_WAIT_V(6); PG8_BAR;
    }
    for (;;) {
        const bool has_next = S.next(ui + 1, nxt);
        const int sc = ui & 1, sn = sc ^ 1;
        if (has_next) PG8_GOFF(sn, nxt.pm); else *(PG8_LAS u32x4*)(gslot + sn * 8192) = *(const PG8_LAS u32x4*)(gslot + sc * 8192);
        const char* nB = has_next ? (const char*)g.Bt + (size_t)nxt.pb * tstepB : cB;
        for (int t = 0; t < nt; t += 2) {
            const bool last = (t == nt - 2);
            const char* a1 = cA + (size_t)(t + 1) * kstep;
            const char* a2 = last ? cA : cA + (size_t)(t + 2) * kstep; const char* b2 = last ? nB : cB + (size_t)(t + 2) * kstep;
            const char* a3 = a2 + kstep; const char* b3 = b2 + kstep;
            if (last && has_next) S.a_ready(nxt);
            if constexpr (SP2) {
            PG8_LDB(B0, 0, 0); PG8_LDB(B1, 0, 1); PG8_SCHED; PG8_LDA(At, 0, 0); PG8_STAGE2(PG8_SA(1, 1), a1, PG8_GRD(sc, 1));
            PG8_WAIT_V(8); PG8_WAIT_L(0); PG8_BAR; PG8_MMA(0, 0, At, B0); PG8_MMA(0, 1, At, B1); PG8_BAR; PG8_SCHED;
            PG8_LDA(At, 0, 1); PG8_STAGE(PG8_SB(0, 0), b2, voffB); PG8_STAGE(PG8_SB(0, 1), b2 + hstepB, voffB); PG8_STAGE2(PG8_SA(0, 0), a2, PG8_GRD(last ? sn : sc, 0));
            PG8_WAIT_V(8); PG8_WAIT_L(0); PG8_BAR; PG8_MMA(1, 0, At, B0); PG8_MMA(1, 1, At, B1); PG8_BAR; PG8_SCHED;
            PG8_LDB(B0, 1, 0); PG8_LDB(B1, 1, 1); PG8_SCHED; PG8_LDA(At, 1, 0); PG8_STAGE2(PG8_SA(0, 1), a2, PG8_GRD(last ? sn : sc, 1));
            PG8_WAIT_V(8); PG8_WAIT_L(0); PG8_BAR; PG8_MMA(0, 0, At, B0); PG8_MMA(0, 1, At, B1); PG8_BAR; PG8_SCHED;
            PG8_LDA(At, 1, 1); PG8_STAGE(PG8_SB(1, 0), b3, voffB); PG8_STAGE(PG8_SB(1, 1), b3 + hstepB, voffB); PG8_STAGE2(PG8_SA(1, 0), a3, PG8_GRD(last ? sn : sc, 0));
            PG8_WAIT_V(8); PG8_WAIT_L(0); PG8_BAR; PG8_MMA(1, 0, At, B0); PG8_MMA(1, 1, At, B1); PG8_BAR; PG8_SCHED;
            } else {
            PG8_LDB(B0, 0, 0); PG8_SCHED; PG8_LDA(At, 0, 0); PG8_STAGE(PG8_SA(1, 1), a1 + hstepA, voffA);
            PG8_WAIT_L(8); PG8_BAR; PG8_WAIT_L(0); PG8_MMA(0, 0, At, B0); PG8_BAR; PG8_SCHED;
            PG8_LDB(B1, 0, 1); PG8_STAGE(PG8_SB(0, 0), b2, voffB);
            PG8_BAR; PG8_WAIT_L(0); PG8_MMA(0, 1, At, B1); PG8_BAR;
            PG8_LDA(At, 0, 1); PG8_STAGE(PG8_SA(0, 0), a2, voffA);
            PG8_BAR; PG8_WAIT_L(0); PG8_MMA(1, 0, At, B0); PG8_BAR; PG8_SCHED;
            PG8_STAGE(PG8_SB(0, 1), b2 + hstepB, voffB);
            PG8_WAIT_V(6); PG8_BAR; PG8_MMA(1, 1, At, B1); PG8_BAR;
            PG8_LDB(B0, 1, 0); PG8_SCHED; PG8_LDA(At, 1, 0); PG8_STAGE(PG8_SA(0, 1), a2 + hstepA, voffA);
            PG8_WAIT_L(8); PG8_BAR; PG8_WAIT_L(0); PG8_MMA(0, 0, At, B0); PG8_BAR; PG8_SCHED;
            PG8_LDB(B1, 1, 1); PG8_STAGE(PG8_SB(1, 0), b3, voffB);
            PG8_BAR; PG8_WAIT_L(0); PG8_MMA(0, 1, At, B1); PG8_BAR;
            PG8_LDA(At, 1, 1); PG8_STAGE(PG8_SA(1, 0), a3, voffA);
            PG8_BAR; PG8_WAIT_L(0); PG8_MMA(1, 0, At, B0); PG8_BAR; PG8_SCHED;
            PG8_STAGE(PG8_SB(1, 1), b3 + hstepB, voffB);
            PG8_WAIT_V(6); PG8_BAR; PG8_MMA(1, 1, At, B1); PG8_BAR;
            }
        }
        if constexpr (ALIGN_EPI) { if (wr == 0) PG8_BAR; }
        E(acc, cur, wr, wc, fr, fq);
#ifdef EPI_PROBE
        if constexpr (Epi::PROBE) { asm volatile("" ::: "memory"); E(acc, cur, wr, wc, fr, fq, EPI_PROBE_NOSTORE != 0); }
#endif
        S.done(cur);
        if (!has_next) break;
#pragma unroll
        for (int a = 0; a < 2; ++a)
#pragma unroll
            for (int b = 0; b < 2; ++b)
#pragma unroll
                for (int m = 0; m < 4; ++m)
#pragma unroll
                    for (int n = 0; n < 2; ++n) acc[a][b][m][n] = (f32x4){0.f, 0.f, 0.f, 0.f};
        cur = nxt; cB = nB; ++ui;
        if constexpr (ALIGN_EPI) { if (wr == 1) PG8_BAR; }
    }
    PG8_WAIT_V(0);
    if constexpr (!ALIGN_EPI) { if (wr == 0) PG8_BAR; }
    PG8_BAR;
#undef PG8_GOFF
#undef PG8_GRD
#undef PG8_STAGE2
#undef PG8_SA
#undef PG8_SB
#undef PG8_STAGE
#undef PG8_LDA
#undef PG8_LDB
#undef PG8_MMA
#undef PG8_WAIT_V
#undef PG8_WAIT_L
#undef PG8_BAR
#undef PG8_SCHED
}
struct UnitMS { int pm, pn, seg, nt; size_t aoff, boff; };
template <class Epi, class Sched, bool ALIGN_EPI = false, bool SP2 = false>
__device__ __forceinline__ void gemm_phase_ms(PG8_LAS unsigned char* lds, const Gemm g, const Sched& S, const Epi& E, int wave_id) {
    int tid_ = wave_id * 64 + (int)__builtin_amdgcn_mbcnt_hi(~0u, __builtin_amdgcn_mbcnt_lo(~0u, 0u)); asm volatile("" : "+v"(tid_));
    const int tid = tid_, wid = __builtin_amdgcn_readfirstlane(tid >> 6), lane = tid & 63, wr = wid >> 2, wc = wid & 3, fr = lane & 15, fq = lane >> 4;
    unsigned voffA[2], voffB[2];
#pragma unroll
    for (int i = 0; i < 2; ++i) { int R, C; stage_rc(tid * 16 + i * 8192, R, C); const int Rb = Epi::PERM ? ((R & ~31) + perm32(R & 31)) : R;
        voffA[i] = (unsigned)(R * g.lda + C) * 2u; voffB[i] = (unsigned)(Rb * g.ldb + C) * 2u; }
    const size_t kstep = (size_t)(BK * 2);
    const size_t hstepA = (size_t)HALF * g.lda * 2, hstepB = (size_t)HALF * g.ldb * 2;
    const size_t tstepA = 2 * hstepA, tstepB = 2 * hstepB;
    const unsigned ldsw = (unsigned)wid * 1024u;
    const int aoff = lds_byte(wr * 64 + fr, fq * 8), boff = lds_byte(wc * 32 + fr, fq * 8);
#define PG8_SA(b, h) (((b) * 2 + (h)) * HTB)
#define PG8_SB(b, h) ((4 + (b) * 2 + (h)) * HTB)
#define PG8_STAGE(bufoff, gbase, voff) do { _Pragma("unroll") for (int _i = 0; _i < 2; ++_i) \
        __builtin_amdgcn_global_load_lds((const unsigned*)((const char*)(gbase) + (voff)[_i]), (PG8_LAS unsigned*)(lds + (bufoff) + ldsw + _i * 8192), 16, 0, 0); } while (0)
#define PG8_LDA(dst, b, h) do { _Pragma("unroll") for (int m = 0; m < 4; ++m) _Pragma("unroll") for (int k = 0; k < 2; ++k) dst[m][k] = *(const PG8_LAS bf16x8*)(lds + PG8_SA(b, h) + aoff + m * 2048 + k * 1024); } while (0)
#define PG8_LDB(dst, b, h) do { _Pragma("unroll") for (int n = 0; n < 2; ++n) _Pragma("unroll") for (int k = 0; k < 2; ++k) dst[n][k] = *(const PG8_LAS bf16x8*)(lds + PG8_SB(b, h) + boff + n * 2048 + k * 1024); } while (0)
#define PG8_MMA(ai, bj, At, Bt) do { __builtin_amdgcn_s_setprio(1); _Pragma("unroll") for (int m = 0; m < 4; ++m) _Pragma("unroll") for (int n = 0; n < 2; ++n) _Pragma("unroll") for (int k = 0; k < 2; ++k) \
        acc[ai][bj][m][n] = __builtin_amdgcn_mfma_f32_16x16x32_bf16(Bt[n][k], At[m][k], acc[ai][bj][m][n], 0, 0, 0); __builtin_amdgcn_s_setprio(0); } while (0)
#define PG8_WAIT_V(n) asm volatile("s_waitcnt vmcnt(" #n ")" ::: "memory")
#define PG8_WAIT_L(n) asm volatile("s_waitcnt lgkmcnt(" #n ")" ::: "memory")
#define PG8_BAR __builtin_amdgcn_s_barrier()
#define PG8_SCHED __builtin_amdgcn_sched_barrier(0)
    UnitMS cur, nxt; int ui = 0;
    if (!S.next(0, cur)) return;
    f32x4 acc[2][2][4][2];
#pragma unroll
    for (int a = 0; a < 2; ++a)
#pragma unroll
        for (int b = 0; b < 2; ++b)
#pragma unroll
            for (int m = 0; m < 4; ++m)
#pragma unroll
                for (int n = 0; n < 2; ++n) acc[a][b][m][n] = (f32x4){0.f, 0.f, 0.f, 0.f};
    bf16x8 At[4][2], B0[2][2], B1[2][2];
    const char* cA = (const char*)g.A + cur.aoff; const char* cB = (const char*)g.Bt + cur.boff;
    S.a_ready(cur);
    if constexpr (SP2) {
        PG8_STAGE(PG8_SB(0, 0), cB, voffB); PG8_STAGE(PG8_SB(0, 1), cB + hstepB, voffB); PG8_STAGE(PG8_SA(0, 0), cA, voffA); PG8_STAGE(PG8_SA(0, 1), cA + hstepA, voffA);
        if (wr == 1) PG8_BAR;
        PG8_WAIT_V(2); PG8_BAR;
        PG8_STAGE(PG8_SB(1, 0), cB + kstep, voffB); PG8_STAGE(PG8_SA(1, 0), cA + kstep, voffA); PG8_STAGE(PG8_SB(1, 1), cB + hstepB + kstep, voffB);
        PG8_WAIT_V(6); PG8_BAR;
    } else {
        PG8_STAGE(PG8_SB(0, 0), cB, voffB); PG8_STAGE(PG8_SA(0, 0), cA, voffA); PG8_STAGE(PG8_SB(0, 1), cB + hstepB, voffB); PG8_STAGE(PG8_SA(0, 1), cA + hstepA, voffA);
        if (wr == 1) PG8_BAR;
        PG8_WAIT_V(4); PG8_BAR;
        PG8_STAGE(PG8_SB(1, 0), cB + kstep, voffB); PG8_STAGE(PG8_SA(1, 0), cA + kstep, voffA); PG8_STAGE(PG8_SB(1, 1), cB + hstepB + kstep, voffB);
        PG8_WAIT_V(6); PG8_BAR;
    }
    for (;;) {
        const bool has_next = S.next(ui + 1, nxt);
        const char* nA = has_next ? (const char*)g.A + nxt.aoff : cA; const char* nB = has_next ? (const char*)g.Bt + nxt.boff : cB;
        const int nt = cur.nt;
        for (int t = 0; t < nt; t += 2) {
            const bool last = (t == nt - 2);
            const char* a1 = cA + (size_t)(t + 1) * kstep;
            const char* a2 = last ? nA : cA + (size_t)(t + 2) * kstep; const char* b2 = last ? nB : cB + (size_t)(t + 2) * kstep;
            const char* a3 = a2 + kstep; const char* b3 = b2 + kstep;
            if (last && has_next) S.a_ready(nxt);
            if constexpr (SP2) {
            PG8_LDB(B0, 0, 0); PG8_LDB(B1, 0, 1); PG8_SCHED; PG8_LDA(At, 0, 0); PG8_STAGE(PG8_SA(1, 1), a1 + hstepA, voffA);
            PG8_WAIT_V(8); PG8_WAIT_L(0); PG8_BAR; PG8_MMA(0, 0, At, B0); PG8_MMA(0, 1, At, B1); PG8_BAR; PG8_SCHED;
            PG8_LDA(At, 0, 1); PG8_STAGE(PG8_SB(0, 0), b2, voffB); PG8_STAGE(PG8_SB(0, 1), b2 + hstepB, voffB); PG8_STAGE(PG8_SA(0, 0), a2, voffA);
            PG8_WAIT_V(8); PG8_WAIT_L(0); PG8_BAR; PG8_MMA(1, 0, At, B0); PG8_MMA(1, 1, At, B1); PG8_BAR; PG8_SCHED;
            PG8_LDB(B0, 1, 0); PG8_LDB(B1, 1, 1); PG8_SCHED; PG8_LDA(At, 1, 0); PG8_STAGE(PG8_SA(0, 1), a2 + hstepA, voffA);
            PG8_WAIT_V(8); PG8_WAIT_L(0); PG8_BAR; PG8_MMA(0, 0, At, B0); PG8_MMA(0, 1, At, B1); PG8_BAR; PG8_SCHED;
            PG8_LDA(At, 1, 1); PG8_STAGE(PG8_SB(1, 0), b3, voffB); PG8_STAGE(PG8_SB(1, 1), b3 + hstepB, voffB); PG8_STAGE(PG8_SA(1, 0), a3, voffA);
            PG8_WAIT_V(8); PG8_WAIT_L(0); PG8_BAR; PG8_MMA(1, 0, At, B0); PG8_MMA(1, 1, At, B1); PG8_BAR; PG8_SCHED;
            } else {
            PG8_LDB(B0, 0, 0); PG8_SCHED; PG8_LDA(At, 0, 0); PG8_STAGE(PG8_SA(1, 1), a1 + hstepA, voffA);
            PG8_WAIT_L(8); PG8_BAR; PG8_WAIT_L(0); PG8_MMA(0, 0, At, B0); PG8_BAR; PG8_SCHED;
            PG8_LDB(B1, 0, 1); PG8_STAGE(PG8_SB(0, 0), b2, voffB);
            PG8_BAR; PG8_WAIT_L(0); PG8_MMA(0, 1, At, B1); PG8_BAR;
            PG8_LDA(At, 0, 1); PG8_STAGE(PG8_SA(0, 0), a2, voffA);
            PG8_BAR; PG8_WAIT_L(0); PG8_MMA(1, 0, At, B0); PG8_BAR; PG8_SCHED;
            PG8_STAGE(PG8_SB(0, 1), b2 + hstepB, voffB);
            PG8_WAIT_V(6); PG8_BAR; PG8_MMA(1, 1, At, B1); PG8_BAR;
            PG8_LDB(B0, 1, 0); PG8_SCHED; PG8_LDA(At, 1, 0); PG8_STAGE(PG8_SA(0, 1), a2 + hstepA, voffA);
            PG8_WAIT_L(8); PG8_BAR; PG8_WAIT_L(0); PG8_MMA(0, 0, At, B0); PG8_BAR; PG8_SCHED;
            PG8_LDB(B1, 1, 1); PG8_STAGE(PG8_SB(1, 0), b3, voffB);
            PG8_BAR; PG8_WAIT_L(0); PG8_MMA(0, 1, At, B1); PG8_BAR;
            PG8_LDA(At, 1, 1); PG8_STAGE(PG8_SA(1, 0), a3, voffA);
            PG8_BAR; PG8_WAIT_L(0); PG8_MMA(1, 0, At, B0); PG8_BAR; PG8_SCHED;
            PG8_STAGE(PG8_SB(1, 1), b3 + hstepB, voffB);
            PG8_WAIT_V(6); PG8_BAR; PG8_MMA(1, 1, At, B1); PG8_BAR;
            }
        }
        if constexpr (ALIGN_EPI) { if (wr == 0) PG8_BAR; }
        E(acc, cur, wr, wc, fr, fq); S.done(cur);
        if (!has_next) break;
        if (nxt.seg == 0) {
#pragma unroll
        for (int a = 0; a < 2; ++a)
#pragma unroll
            for (int b = 0; b < 2; ++b)
#pragma unroll
                for (int m = 0; m < 4; ++m)
#pragma unroll
                    for (int n = 0; n < 2; ++n) acc[a][b][m][n] = (f32x4){0.f, 0.f, 0.f, 0.f};
        }
        cur = nxt; cA = nA; cB = nB; ++ui;
        if constexpr (ALIGN_EPI) { if (wr == 1) PG8_BAR; }
    }
    PG8_WAIT_V(0);
    if constexpr (!ALIGN_EPI) { if (wr == 0) PG8_BAR; }
    PG8_BAR;
#undef PG8_SA
#undef PG8_SB
#undef PG8_STAGE
#undef PG8_LDA
#undef PG8_LDB
#undef PG8_MMA
#undef PG8_WAIT_V
#undef PG8_WAIT_L
#undef PG8_BAR
#undef PG8_SCHED
}
}
constexpr int NB = 8, SEQ = 4096, DM = 1024, CTXL = 256;
constexpr int TL = NB * SEQ, TC = NB * CTXL, TT = TL + TC;
constexpr int NIN = 9472, PW = 9216;
constexpr int OQ = 0, OKK = 1024, OV = 2048, OCB = 3072, OCC = 3584, OCX = 4096, OGQ = 4608, OGK = 4864, OGV = 5120, OGR = 5632, OGATE = 6144;
constexpr int NEXP = 32, NRMAX = 147456;
constexpr float RMS_EPS = 1e-6f;
constexpr float QSCALE = 0.125f * 1.4426950408889634f;
constexpr int NWAVES = 8, NTHR = 512;
#ifndef N_LAUNCH_MODE
#define N_LAUNCH_MODE 0
#endif
constexpr int NPHASE = 25;

constexpr size_t MiB = 1u << 20;
constexpr size_t WS_CTL = 0, CTL_ZERO_BYTES = 1 * MiB;
constexpr size_t WS_MOD = 1 * MiB;
constexpr size_t WS_ROPE = WS_MOD + 512 * 1024;
constexpr size_t WS_LAM = WS_ROPE + 16 * 1024;
constexpr size_t WS_ROUTE = 2 * MiB, ROUTE_STRIDE = 8 * MiB;
constexpr size_t R_TOPI = 0, R_TOPG = 1 * MiB, R_POSOF = 2 * MiB, R_ROWTOK = 3 * MiB, R_CNT = 4 * MiB, R_TILEEXP = 4 * MiB + 64 * 1024, R_NT = 4 * MiB + 128 * 1024;
constexpr size_t WS_GA = 18 * MiB;
constexpr size_t WS_WIN = 24 * MiB, WIN_STRIDE = (size_t)NIN * DM * 2;
constexpr size_t WS_WD = 61 * MiB, WS_WCG = 65 * MiB, WS_WO = 69 * MiB, W1K_STRIDE = 2 * MiB;
constexpr size_t WS_W1 = 73 * MiB, W1_STRIDE = 128 * MiB;
constexpr size_t WS_W2 = 329 * MiB, W2_STRIDE = 64 * MiB;
constexpr size_t WS_H = 457 * MiB, WS_AD = 525 * MiB, WS_ACG = 593 * MiB, WS_MERGED = 661 * MiB;
constexpr size_t WS_OG = 729 * MiB;
constexpr size_t WS_XW = 865 * MiB;
constexpr size_t WS_ASCR = 1001 * MiB;
constexpr size_t WS_P = 1033 * MiB;
constexpr size_t WS_XS = WS_P, WS_HH = WS_P + 288 * MiB;
constexpr size_t WS_VT = 1645 * MiB;
constexpr size_t WS_END = 1713 * MiB;
static_assert(WS_P + (size_t)TT * PW * 2 <= WS_END && WS_HH + (size_t)NRMAX * DM * 2 <= WS_END, "ws map");

constexpr int LDS_BYTES = 163840;
constexpr int TEXP_OFF = 147456;
constexpr int MISC_OFF = LDS_BYTES - 1024;

#define GAS __attribute__((address_space(1)))
#define LAS __attribute__((address_space(3)))
typedef unsigned short bf16_t;
typedef float f32x4 __attribute__((ext_vector_type(4)));
typedef float f32x2 __attribute__((ext_vector_type(2)));
typedef unsigned u32x4 __attribute__((ext_vector_type(4)));
typedef unsigned u32x2 __attribute__((ext_vector_type(2)));
#define LDS_WAIT() asm volatile("s_waitcnt lgkmcnt(0)" ::: "memory")
#define VM_WAIT() asm volatile("s_waitcnt vmcnt(0)" ::: "memory")
__device__ __forceinline__ unsigned f2bf(float f) { unsigned u = __builtin_bit_cast(unsigned, f); return (u + 0x7fffu + ((u >> 16) & 1u)) >> 16; }
typedef __bf16 pbf2_t __attribute__((ext_vector_type(2)));
typedef float pf2_t __attribute__((ext_vector_type(2)));
__device__ __forceinline__ unsigned pk2(float lo, float hi) { const pf2_t v = {lo, hi}; return __builtin_bit_cast(unsigned, __builtin_convertvector(v, pbf2_t)); }
__device__ __forceinline__ float bflo(unsigned w) { return __builtin_bit_cast(float, w << 16); }
__device__ __forceinline__ float bfhi(unsigned w) { return __builtin_bit_cast(float, w & 0xffff0000u); }
__device__ __forceinline__ float bf2f(bf16_t b) { return __builtin_bit_cast(float, ((unsigned)b) << 16); }
__device__ __forceinline__ float wave_sum(float v) {
#pragma unroll
    for (int o = 1; o < 64; o <<= 1) v += __shfl_xor(v, o);
    return v;
}
__device__ __forceinline__ float sigmoidf_(float x) { return __builtin_amdgcn_rcpf(1.f + __builtin_amdgcn_exp2f(-1.4426950408889634f * x)); }

#define XB_TMO      128
#define XB_XCNT(j)  (256  + 64 * (j))
#define XB_XSUB(j)  (1280 + 64 * (j))
#define XB_XGEN(j)  (2304 + 64 * (j))
#define XB_TOP      3328
#define XB_TOPGEN   3392
#define XCD_BAR_WORDS 3456
#define XB_SPIN_CAP (1u << 18)
__device__ __forceinline__ unsigned xb_ld(unsigned* p)              { return __hip_atomic_load(p, __ATOMIC_RELAXED, __HIP_MEMORY_SCOPE_AGENT); }
__device__ __forceinline__ unsigned xb_add(unsigned* p, unsigned v) { return __hip_atomic_fetch_add(p, v, __ATOMIC_RELAXED, __HIP_MEMORY_SCOPE_AGENT); }
__device__ __forceinline__ unsigned xb_xcc_id() { return (unsigned)__builtin_amdgcn_s_getreg((3 << 11) | 20) & 0xFu; }
#define XB_SPIN(cond, bar) do { unsigned _sp = 0; while (cond) { __builtin_amdgcn_s_sleep(1); \
    if ((++_sp & 255u) == 0u) { if (xb_ld(&(bar)[XB_TMO])) break; if (_sp > XB_SPIN_CAP) { atomicAdd(&(bar)[XB_TMO], 1u); break; } } } } while (0)
struct XcdBarrier { unsigned* bar; unsigned x; volatile LAS unsigned* st; };
__device__ __forceinline__ XcdBarrier xcd_barrier_post(unsigned* bar, volatile LAS unsigned* st) {
    XcdBarrier b; b.bar = bar; b.x = xb_xcc_id(); b.st = st;
    if (threadIdx.x == 0) (void)xb_add(&bar[XB_XCNT(b.x)], 1u);
    return b;
}
__device__ __forceinline__ void xcd_barrier_complete(unsigned* bar, unsigned x, unsigned& nloc, unsigned& nx) {
    const unsigned G = gridDim.x * gridDim.y * gridDim.z;
    unsigned sum, cnt, mine, sp = 0u;
    for (;;) {
        sum = 0u; cnt = 0u; mine = 0u;
#pragma unroll
        for (unsigned j = 0; j < 16; ++j) { const unsigned c = xb_ld(&bar[XB_XCNT(j)]); sum += c; cnt += (c > 0u) ? 1u : 0u; mine = (j == x) ? c : mine; }
        if (sum == G) break;
        __builtin_amdgcn_s_sleep(1);
        if ((++sp & 255u) == 0u) { if (xb_ld(&bar[XB_TMO])) break; if (sp > XB_SPIN_CAP) { atomicAdd(&bar[XB_TMO], 1u); break; } }
    }
    nloc = mine > 0u ? mine : 1u; nx = cnt > 0u ? cnt : 1u;
}
__device__ __forceinline__ void xcd_barrier(const XcdBarrier& b, bool thread0) {
    asm volatile("s_waitcnt vmcnt(0)" ::: "memory");
    __syncthreads();
    if (thread0) {
        unsigned* bar = b.bar;
        __builtin_amdgcn_s_waitcnt(0);
        unsigned nloc = b.st[0], nx = b.st[1];
        if (nloc == 0u) { xcd_barrier_complete(bar, b.x, nloc, nx); b.st[0] = nloc; b.st[1] = nx; }
        const unsigned old = xb_add(&bar[XB_XSUB(b.x)], 1u);
        const unsigned gen = old / nloc;
        if (old + 1u == (gen + 1u) * nloc) {
            __builtin_amdgcn_fence(__ATOMIC_RELEASE, "agent");
            asm volatile("s_waitcnt vmcnt(0)" ::: "memory");
            const unsigned og = xb_add(&bar[XB_TOP], 1u);
            const unsigned tg = og / nx;
            if (og + 1u == (tg + 1u) * nx) xb_add(&bar[XB_TOPGEN], 1u);
            else XB_SPIN(xb_ld(&bar[XB_TOPGEN]) == tg, bar);
            __builtin_amdgcn_fence(__ATOMIC_ACQUIRE, "agent");
            xb_add(&bar[XB_XGEN(b.x)], 1u);
            asm volatile("s_waitcnt vmcnt(0)" ::: "memory");
        } else {
            XB_SPIN(xb_ld(&bar[XB_XGEN(b.x)]) == gen, bar);
            __builtin_amdgcn_fence(__ATOMIC_ACQUIRE, "agent");
            asm volatile("s_waitcnt vmcnt(0)" ::: "memory");
        }
    }
    __syncthreads();
}

#ifndef EPI_PROBE_MASK
#define EPI_PROBE_MASK 0
#endif
using pg8::Unit;
struct EpiIn {
    static constexpr bool PERM = true, PROBE = (EPI_PROBE_MASK & 1) != 0;
    bf16_t* P; float* GA; const float* cosT; const float* sinT;
    __device__ __forceinline__ void operator()(const f32x4 (&acc)[2][2][4][2], const Unit& u, int wr, int wc, int fr, int fq, bool nostore = false) const {
        const int row0 = u.pm * 256 + wr * 64 + fr; const int pn = u.pn;
        if (pn == 36) {
            if (wc == 0) {
#pragma unroll
                for (int ai = 0; ai < 2; ++ai)
#pragma unroll
                    for (int m = 0; m < 4; ++m) { const size_t row = (size_t)(row0 + ai * 128 + m * 16);
#pragma unroll
                        for (int n = 0; n < 2; ++n) *(f32x4*)(GA + row * 32 + 8 * fq + 4 * n) = acc[ai][0][m][n]; }
            }
            return;
        }
        const int colbase = pn * 256 + wc * 32 + 8 * fq;
        if (pn < 8) {
            const bool lat = u.pm < 128; const float qs = pn < 4 ? QSCALE : 1.f; const int axis = wc & 1;
#pragma unroll
            for (int ai = 0; ai < 2; ++ai)
#pragma unroll
                for (int m = 0; m < 4; ++m) { const int row = row0 + ai * 128 + m * 16; const int s = row & 4095; const int pos = axis ? (s & 63) : (s >> 6);
                    f32x4 cc = (f32x4){1.f, 1.f, 1.f, 1.f}, ss = (f32x4){0.f, 0.f, 0.f, 0.f};
                    if (lat) { cc = *(const f32x4*)(cosT + pos * 16 + 4 * fq); ss = *(const f32x4*)(sinT + pos * 16 + 4 * fq); }
                    bf16_t* rowp = P + (size_t)row * PW + colbase;
#pragma unroll
                    for (int bj = 0; bj < 2; ++bj) { const f32x4 x0 = acc[ai][bj][m][0], x1 = acc[ai][bj][m][1];
                        f32x4 o0, o1;
                        o0[0] = (x0[0] * cc[0] - x0[1] * ss[0]) * qs; o0[1] = (x0[1] * cc[0] + x0[0] * ss[0]) * qs; o0[2] = (x0[2] * cc[1] - x0[3] * ss[1]) * qs; o0[3] = (x0[3] * cc[1] + x0[2] * ss[1]) * qs;
                        o1[0] = (x1[0] * cc[2] - x1[1] * ss[2]) * qs; o1[1] = (x1[1] * cc[2] + x1[0] * ss[2]) * qs; o1[2] = (x1[2] * cc[3] - x1[3] * ss[3]) * qs; o1[3] = (x1[3] * cc[3] + x1[2] * ss[3]) * qs;
                        u32x4 w; w.x = pk2(o0[0], o0[1]); w.y = pk2(o0[2], o0[3]); w.z = pk2(o1[0], o1[1]); w.w = pk2(o1[2], o1[3]);
                        *(u32x4*)(rowp + bj * 128) = w; } }
        } else {
            const bool sg = pn >= 24;
#pragma unroll
            for (int ai = 0; ai < 2; ++ai)
#pragma unroll
                for (int m = 0; m < 4; ++m) { const int row = row0 + ai * 128 + m * 16; bf16_t* rowp = P + (size_t)row * PW + colbase;
#pragma unroll
                    for (int bj = 0; bj < 2; ++bj) { f32x4 v0 = acc[ai][bj][m][0], v1 = acc[ai][bj][m][1];
                        if (sg) {
#pragma unroll
                            for (int e = 0; e < 4; ++e) { v0[e] = fmaxf(sigmoidf_(v0[e]), 1e-25f); v1[e] = fmaxf(sigmoidf_(v1[e]), 1e-25f); } }
                        u32x4 w; w.x = pk2(v0[0], v0[1]); w.y = pk2(v0[2], v0[3]); w.z = pk2(v1[0], v1[1]); w.w = pk2(v1[2], v1[3]);
                        if (!nostore) *(u32x4*)(rowp + bj * 128) = w; else asm volatile("" :: "v"(w)); } }
        }
    }
};
template <int MODE> struct EpiGate {
    static constexpr bool PERM = false, PROBE = false;
    const bf16_t* P; float* M32; bf16_t* MG;
    __device__ __forceinline__ void operator()(const f32x4 (&acc)[2][2][4][2], const Unit& u, int wr, int wc, int fr, int fq) const {
        const int row0 = u.pm * 256 + wr * 64 + fr, col0 = u.pn * 256 + wc * 32 + 4 * fq;
#pragma unroll
        for (int ai = 0; ai < 2; ++ai)
#pragma unroll
            for (int m = 0; m < 4; ++m) { const size_t row = (size_t)(row0 + ai * 128 + m * 16);
#pragma unroll
                for (int bj = 0; bj < 2; ++bj)
#pragma unroll
                    for (int n = 0; n < 2; ++n) { const int col = col0 + bj * 128 + 16 * n;
                        const u32x2 gw = *(const u32x2*)(P + row * PW + OGATE + MODE * 1024 + col);
                        const f32x4 s = (f32x4){bflo(gw.x), bfhi(gw.x), bflo(gw.y), bfhi(gw.y)};
                        f32x4 v = s * acc[ai][bj][m][n];
                        float* mp = M32 + row * 1024 + col;
                        if (MODE >= 1) v = v + __builtin_nontemporal_load((const f32x4*)mp);
                        if (MODE <= 1) *(f32x4*)mp = v;
                        else { u32x2 w; w.x = pk2(v[0], v[1]); w.y = pk2(v[2], v[3]); *(u32x2*)(MG + row * 1024 + col) = w; } } }
    }
};
struct EpiMerge {
    static constexpr bool PERM = true;
    const bf16_t* P; bf16_t* MG;
    __device__ __forceinline__ void operator()(f32x4 (&acc)[2][2][4][2], const pg8::UnitMS& u, int wr, int wc, int fr, int fq) const {
        const int row0 = u.pm * 256 + wr * 64 + fr, col0 = u.pn * 256 + wc * 32 + 8 * fq; const int seg = u.seg;
#pragma unroll
        for (int ai = 0; ai < 2; ++ai)
#pragma unroll
            for (int m = 0; m < 4; ++m) { const size_t row = (size_t)(row0 + ai * 128 + m * 16); const bf16_t* gp = P + row * PW + OGATE + col0;
#pragma unroll
                for (int bj = 0; bj < 2; ++bj) { const int co = bj * 128;
                    const u32x4 ga = *(const u32x4*)(gp + seg * 1024 + co);
                    const f32x4 sa0 = (f32x4){bflo(ga.x), bfhi(ga.x), bflo(ga.y), bfhi(ga.y)}, sa1 = (f32x4){bflo(ga.z), bfhi(ga.z), bflo(ga.w), bfhi(ga.w)};
                    if (seg < 2) { const u32x4 gb = *(const u32x4*)(gp + (seg + 1) * 1024 + co);
                        const f32x4 sb0 = (f32x4){bflo(gb.x), bfhi(gb.x), bflo(gb.y), bfhi(gb.y)}, sb1 = (f32x4){bflo(gb.z), bfhi(gb.z), bflo(gb.w), bfhi(gb.w)};
                        f32x4 r0, r1;
#pragma unroll
                        for (int e = 0; e < 4; ++e) { r0[e] = sa0[e] * __builtin_amdgcn_rcpf(sb0[e]); r1[e] = sa1[e] * __builtin_amdgcn_rcpf(sb1[e]); }
                        acc[ai][bj][m][0] = acc[ai][bj][m][0] * r0; acc[ai][bj][m][1] = acc[ai][bj][m][1] * r1;
                    } else { const f32x4 v0 = acc[ai][bj][m][0] * sa0, v1 = acc[ai][bj][m][1] * sa1;
                        u32x4 w; w.x = pk2(v0[0], v0[1]); w.y = pk2(v0[2], v0[3]); w.z = pk2(v1[0], v1[1]); w.w = pk2(v1[2], v1[3]);
                        *(u32x4*)(MG + row * 1024 + col0 + co) = w; } } }
    }
};
struct OutProjOrder {
    pg8::StaticOrder so; size_t a1, b1;
    __device__ __forceinline__ bool next(int i, pg8::UnitMS& u) const {
        pg8::Unit t; if (!so.next(i / 3, t)) return false;
        const int seg = i % 3; u.pm = t.pm; u.pn = t.pn; u.seg = seg; u.nt = seg == 0 ? 16 : 8;
        const size_t ta = (size_t)t.pm * (256 * 1024 * 2), tb = (size_t)t.pn * (256 * 1024 * 2);
        u.aoff = ta + (seg == 0 ? 0 : a1 + (seg == 2 ? 1024 : 0)); u.boff = tb + (seg == 0 ? 0 : b1 + (seg == 2 ? 1024 : 0)); return true;
    }
    __device__ __forceinline__ void a_ready(const pg8::UnitMS&) const {}
    __device__ __forceinline__ void done(const pg8::UnitMS&) const {}
};
struct EpiRes {
    static constexpr bool PERM = false, PROBE = false;
    const float* xlat; const float* xctx; float* XW; const float* mod;
    __device__ __forceinline__ void operator()(const f32x4 (&acc)[2][2][4][2], const Unit& u, int wr, int wc, int fr, int fq) const {
        const int row0 = u.pm * 256 + wr * 64 + fr, col0 = u.pn * 256 + wc * 32 + 4 * fq;
        const int mr = u.pm < 128 ? (u.pm >> 4) : 8; const float* xin = u.pm < 128 ? xlat : xctx;
        const float* g1 = mod + (size_t)mr * 6144 + 2048;
        f32x4 gv[2][2];
#pragma unroll
        for (int bj = 0; bj < 2; ++bj)
#pragma unroll
            for (int n = 0; n < 2; ++n) gv[bj][n] = *(const f32x4*)(g1 + col0 + bj * 128 + 16 * n);
#pragma unroll
        for (int ai = 0; ai < 2; ++ai)
#pragma unroll
            for (int m = 0; m < 4; ++m) { const size_t off = (size_t)(row0 + ai * 128 + m * 16) * 1024 + col0;
#pragma unroll
                for (int bj = 0; bj < 2; ++bj)
#pragma unroll
                    for (int n = 0; n < 2; ++n) { const f32x4 xi = *(const f32x4*)(xin + off + bj * 128 + 16 * n);
                        *(f32x4*)(XW + off + bj * 128 + 16 * n) = xi + gv[bj][n] * acc[ai][bj][m][n]; } }
    }
};
struct EpiSwiglu {
    static constexpr bool PERM = true, PROBE = (EPI_PROBE_MASK & 2) != 0;
    bf16_t* HH; const float* b1;
    __device__ __forceinline__ void operator()(const f32x4 (&acc)[2][2][4][2], const Unit& u, int wr, int wc, int fr, int fq, bool = false) const {
        const int row0 = u.pm * 256 + wr * 64 + fr, c0 = u.pn * 256 + wc * 32 + 8 * fq; const int e = u.pb >> 3;
        const float* bp = b1 + (size_t)e * 2048 + c0;
        f32x4 bv[2][2];
#pragma unroll
        for (int bj = 0; bj < 2; ++bj)
#pragma unroll
            for (int n = 0; n < 2; ++n) bv[bj][n] = *(const f32x4*)(bp + bj * 128 + 4 * n);
#pragma unroll
        for (int ai = 0; ai < 2; ++ai)
#pragma unroll
            for (int m = 0; m < 4; ++m) { bf16_t* rowp = HH + (size_t)(row0 + ai * 128 + m * 16) * 1024 + (c0 >> 1);
#pragma unroll
                for (int bj = 0; bj < 2; ++bj) { const f32x4 v0 = acc[ai][bj][m][0] + bv[bj][0], v1 = acc[ai][bj][m][1] + bv[bj][1];
                    float o[4];
#pragma unroll
                    for (int p = 0; p < 4; ++p) { float gl = p < 2 ? v0[2 * p] : v1[2 * p - 4], ln = p < 2 ? v0[2 * p + 1] : v1[2 * p - 3];
                        gl = fminf(gl, 7.f); ln = fminf(fmaxf(ln, -7.f), 7.f); o[p] = gl * sigmoidf_(1.702f * gl) * (ln + 1.f); }
                    u32x2 w; w.x = pk2(o[0], o[1]); w.y = pk2(o[2], o[3]); *(u32x2*)(rowp + bj * 64) = w; } }
    }
};
struct EpiY {
    static constexpr bool PERM = true, PROBE = (EPI_PROBE_MASK & 2) != 0;
    bf16_t* YY; const float* b2;
    __device__ __forceinline__ void operator()(const f32x4 (&acc)[2][2][4][2], const Unit& u, int wr, int wc, int fr, int fq, bool = false) const {
        const int row0 = u.pm * 256 + wr * 64 + fr, c0 = u.pn * 256 + wc * 32 + 8 * fq; const int e = u.pb >> 2;
        const float* bp = b2 + (size_t)e * 1024 + c0;
        f32x4 bv[2][2];
#pragma unroll
        for (int bj = 0; bj < 2; ++bj)
#pragma unroll
            for (int n = 0; n < 2; ++n) bv[bj][n] = *(const f32x4*)(bp + bj * 128 + 4 * n);
#pragma unroll
        for (int ai = 0; ai < 2; ++ai)
#pragma unroll
            for (int m = 0; m < 4; ++m) { bf16_t* rowp = YY + (size_t)(row0 + ai * 128 + m * 16) * 1024 + c0;
#pragma unroll
                for (int bj = 0; bj < 2; ++bj) { const f32x4 v0 = acc[ai][bj][m][0] + bv[bj][0], v1 = acc[ai][bj][m][1] + bv[bj][1];
                    u32x4 w; w.x = pk2(v0[0], v0[1]); w.y = pk2(v0[2], v0[3]); w.z = pk2(v1[0], v1[1]); w.w = pk2(v1[2], v1[3]);
                    *(u32x4*)(rowp + bj * 128) = w; } }
    }
};
struct Gemm1LastOrder {
    pg8::StaticOrder so; int G, c;
    __device__ __forceinline__ bool next(int i, Unit& u) const {
        const long L = (long)i * G + c;
        if (L < so.nwg) return so.next(i, u);
        const int x = (int)(L - so.nwg); if (x >= 96) return false;
        const int r = x / 12, k = x % 12;
        u.pm = 128 + r; u.pn = k < 8 ? 4 + k : (k < 11 ? 19 + (k - 8) : 36); u.pb = u.pn; return true;
    }
    __device__ __forceinline__ void a_ready(const Unit&) const {}
    __device__ __forceinline__ void done(const Unit&) const {}
};
struct MoeOrder {
    int ntiles, nN, G, c; const LAS int* tile_exp;
    __device__ __forceinline__ bool next(int i, Unit& u) const {
        const long L = (long)i * G + c; if (L >= (long)ntiles * nN) return false;
        const int tile = (int)(L / nN), pn = (int)(L % nN);
        u.pm = tile; u.pn = pn; u.pb = __builtin_amdgcn_readfirstlane(tile_exp[tile]) * nN + pn; return true;
    }
    __device__ __forceinline__ void a_ready(const Unit&) const {}
    __device__ __forceinline__ void done(const Unit&) const {}
};
struct Args { const float* in[26]; float* out; unsigned char* ws; int ph_lo, ph_hi; };
struct Frame {
    LAS unsigned char* lds; unsigned char* ws; int tid, lane, wave, G, gw, NGW;
};
constexpr int PTR_OFF = MISC_OFF + 256;
__device__ __forceinline__ const float* in_ptr(const Frame& F, int i) {
    int z = PTR_OFF; asm volatile("" : "+v"(z));
    const unsigned long long v = ((volatile LAS unsigned long long*)(F.lds + z))[i];
    const unsigned lo = __builtin_amdgcn_readfirstlane((unsigned)v), hi = __builtin_amdgcn_readfirstlane((unsigned)(v >> 32));
    return (const float*)(const GAS float*)(((unsigned long long)hi << 32) | lo);
}
__device__ __forceinline__ float* out_ptr(const Frame& F) { return (float*)in_ptr(F, 26); }
__device__ __forceinline__ Frame relaunder(const Frame& F0) {
    Frame F = F0; int ln = (int)__builtin_amdgcn_mbcnt_hi(~0u, __builtin_amdgcn_mbcnt_lo(~0u, 0u)); asm volatile("" : "+v"(ln));
    F.lane = ln; F.tid = F0.wave * 64 + ln; F.wave = F0.wave; F.gw = blockIdx.x * NWAVES + F.wave; return F;
}

constexpr int CV_IN = 16 * 289, CV_D = 512, CV_C = 256, CV_G = 256, CV_O = 512, CV_1 = 32 * 1024, CV_2 = 32 * 512;
constexpr int CV_SMALL = CV_IN + CV_D + CV_C + CV_G + CV_O, CV_PER_L = CV_SMALL + CV_1 + CV_2;
constexpr int CV_NWG = 96;
struct TItem { const float* src; bf16_t* dst; int srcN; bool ilv; };
__device__ __forceinline__ TItem conv_decode(const Frame& F, int it) {
    unsigned char* ws = F.ws; const int l = it / CV_PER_L; int r = it % CV_PER_L; TItem t; t.ilv = false;
    auto mk = [&](const float* W, int srcN, bf16_t* WT, int k0, int n0, int drow, int dk0) { t.src = W + (size_t)k0 * srcN + n0; t.srcN = srcN; t.dst = WT + (size_t)drow * 1024 + dk0; };
    if (r < CV_IN) { const int kb = r / 289, nb = r % 289, n0 = nb * 32; const int d0 = n0 < 6144 ? n0 : (n0 < 6176 ? 9216 + (n0 - 6144) : n0 - 32);
        mk(in_ptr(F, 8) + (size_t)l * 1024 * 9248, 9248, (bf16_t*)(ws + WS_WIN + l * WIN_STRIDE), kb * 64, n0, d0, kb * 64); t.ilv = n0 < 2048; return t; } r -= CV_IN;
    if (r < CV_D) { const int kb = r / 32, nb = r % 32; mk(in_ptr(F, 11) + (size_t)l * 1024 * 1024, 1024, (bf16_t*)(ws + WS_WD + l * W1K_STRIDE), kb * 64, nb * 32, nb * 32, kb * 64); return t; } r -= CV_D;
    if (r < CV_C) { const int kb = r / 32, nb = r % 32; mk(in_ptr(F, 13) + (size_t)l * 512 * 1024, 1024, (bf16_t*)(ws + WS_WCG + l * W1K_STRIDE), kb * 64, nb * 32, nb * 32, kb * 64); return t; } r -= CV_C;
    if (r < CV_G) { const int kb = r / 32, nb = r % 32; mk(in_ptr(F, 17) + (size_t)l * 512 * 1024, 1024, (bf16_t*)(ws + WS_WCG + l * W1K_STRIDE), kb * 64, nb * 32, nb * 32, 512 + kb * 64); return t; } r -= CV_G;
    if (r < CV_O) { const int kb = r / 32, nb = r % 32; mk(in_ptr(F, 18) + (size_t)l * 1024 * 1024, 1024, (bf16_t*)(ws + WS_WO + l * W1K_STRIDE), kb * 64, nb * 32, nb * 32, kb * 64); return t; } r -= CV_O;
    if (r < CV_1) { const int e = r / 1024, q = r % 1024, kb = q / 64, nb = q % 64;
        mk(in_ptr(F, 21) + ((size_t)l * 32 + e) * 1024 * 2048, 2048, (bf16_t*)(ws + WS_W1 + l * W1_STRIDE) + (size_t)e * 2048 * 1024, kb * 64, nb * 32, nb * 32, kb * 64); return t; } r -= CV_1;
    { const int e = r / 512, q = r % 512, kb = q / 32, nb = q % 32;
        mk(in_ptr(F, 23) + ((size_t)l * 32 + e) * 1024 * 1024, 1024, (bf16_t*)(ws + WS_W2 + l * W2_STRIDE) + (size_t)e * 1024 * 1024, kb * 64, nb * 32, nb * 32, kb * 64); }
    return t;
}
__device__ __forceinline__ void ti_load(const TItem& t, int lane, f32x4 (&v)[8]) {
    const int kk8 = lane >> 3, n4 = (lane & 7) * 4;
#pragma unroll
    for (int i = 0; i < 8; ++i) v[i] = __builtin_nontemporal_load((const f32x4*)(t.src + (size_t)(8 * i + kk8) * t.srcN + n4));
}
__device__ __forceinline__ void ti_finish(const TItem& t, int lane, const f32x4 (&v)[8], LAS float* scr) {
    {   const int kk8 = lane >> 3, n4 = (lane & 7) * 4;
#pragma unroll
        for (int i = 0; i < 8; ++i) { LAS float* d = scr + (8 * i + kk8) * 33 + n4; d[0] = v[i][0]; d[1] = v[i][1]; d[2] = v[i][2]; d[3] = v[i][3]; }
    }
    LDS_WAIT(); asm volatile("" ::: "memory");
    const int c = lane & 7;
#pragma unroll
    for (int j = 0; j < 4; ++j) { const int n = (lane >> 3) + 8 * j; const LAS float* s = scr + (8 * c) * 33 + n;
        u32x4 o; o.x = pk2(s[0 * 33], s[1 * 33]); o.y = pk2(s[2 * 33], s[3 * 33]); o.z = pk2(s[4 * 33], s[5 * 33]); o.w = pk2(s[6 * 33], s[7 * 33]);
        const int nd = t.ilv ? (2 * (n & 15) + (n >> 4)) : n;
        *(u32x4*)(t.dst + (size_t)nd * 1024 + 8 * c) = o; }
    LDS_WAIT(); asm volatile("" ::: "memory");
}
__device__ __forceinline__ void conv_range(const Frame& F, int lo, int hi, int wi, int nw) {
    LAS float* scr = (LAS float*)(F.lds + F.wave * 16384);
    f32x4 va[8], vb[8]; TItem ta, tb; int it = lo + wi;
    if (it < hi) { ta = conv_decode(F, it); ti_load(ta, F.lane, va); }
#pragma unroll 1
    while (it < hi) {
        const bool h1 = it + nw < hi;
        if (h1) { tb = conv_decode(F, it + nw); ti_load(tb, F.lane, vb); }
        ti_finish(ta, F.lane, va, scr);
        if (!h1) break;
        const bool h2 = it + 2 * nw < hi;
        if (h2) { ta = conv_decode(F, it + 2 * nw); ti_load(ta, F.lane, va); }
        ti_finish(tb, F.lane, vb, scr);
        it += 2 * nw;
        if (!h2) break;
    }
}

__device__ __forceinline__ void p0_prologue(const Frame& F0) {
    const Frame F = relaunder(F0);
    __syncthreads();
    unsigned char* ws = F.ws;
    {
        LAS float* sc = (LAS float*)F.lds;
        LAS float* red = sc + 9 * 1024;
        for (int i = F.tid; i < 9 * 1024; i += NTHR) { const float c = i < 8192 ? in_ptr(F, 1)[i] : in_ptr(F, 3)[i - 8192]; sc[i] = c / (1.f + __expf(-c)); }
        __syncthreads();
        float* MOD = (float*)(ws + WS_MOD);
        for (int job = blockIdx.x; job < 192; job += F.G) {
            const int l = job / 96, blk = job % 96, ks = F.tid >> 6, n = F.tid & 63, col = blk * 64 + n;
            const float* w = in_ptr(F, 4) + (size_t)l * 1024 * 6144 + col;
            float a[9];
#pragma unroll
            for (int r = 0; r < 9; ++r) a[r] = 0.f;
            for (int k = ks * 128; k < ks * 128 + 128; ++k) { const float wv = w[(size_t)k * 6144];
#pragma unroll
                for (int r = 0; r < 9; ++r) a[r] += sc[r * 1024 + k] * wv; }
#pragma unroll
            for (int r = 0; r < 9; ++r) red[(ks * 9 + r) * 64 + n] = a[r];
            __syncthreads();
            for (int o = F.tid; o < 576; o += NTHR) { const int r = o >> 6, nn = o & 63; float s = 0.f;
#pragma unroll
                for (int k8 = 0; k8 < 8; ++k8) s += red[(k8 * 9 + r) * 64 + nn];
                MOD[((size_t)l * 9 + r) * 6144 + blk * 64 + nn] = s + in_ptr(F, 5)[(size_t)l * 6144 + blk * 64 + nn]; }
            __syncthreads();
        }
    }
    if (blockIdx.x == 0) {
        float* cosT = (float*)(ws + WS_ROPE); float* sinT = cosT + 1024;
        for (int i = F.tid; i < 1024; i += NTHR) { const int pos = i >> 4, f = i & 15; const float inv = powf(10000.f, -(float)(2 * f) / 32.f); const float ang = (float)pos * inv; cosT[i] = cosf(ang); sinT[i] = sinf(ang); }
        if (F.wave < 2) { const int l = F.wave; const float* dl = in_ptr(F, 9) + (size_t)l * 256;
            const float s1 = wave_sum(dl[F.lane] * dl[64 + F.lane]), s2 = wave_sum(dl[128 + F.lane] * dl[192 + F.lane]);
            const float lam_init = 0.8f - 0.6f * expf(-0.3f * (float)l);
            if (F.lane == 0) ((float*)(ws + WS_LAM))[l] = expf(s1) - expf(s2) + lam_init; }
    }
    __syncthreads();
    conv_range(F, 0, F.G >= 64 + CV_NWG ? CV_SMALL : 2 * CV_PER_L, F.gw, F.NGW);
    for (int i = F.gw * 64 + F.lane; i < 2 * 224 * 128; i += F.NGW * 64) { const int l = i / (224 * 128), q = i % (224 * 128);
        *(u32x4*)(ws + WS_WIN + l * WIN_STRIDE + (size_t)9248 * 2048 + (size_t)q * 16) = (u32x4){0u, 0u, 0u, 0u}; }
}

__device__ __forceinline__ void load_row(const float* p, int lane, f32x4 (&v)[4]) {
#pragma unroll
    for (int j = 0; j < 4; ++j) v[j] = *(const f32x4*)(p + 256 * j + 4 * lane);
}
__device__ __forceinline__ float row_rstd(const f32x4 (&v)[4]) {
    float s = 0.f;
#pragma unroll
    for (int j = 0; j < 4; ++j) s += (v[j][0] * v[j][0] + v[j][1] * v[j][1]) + (v[j][2] * v[j][2] + v[j][3] * v[j][3]);
    return 1.0f / sqrtf(wave_sum(s) * (1.f / 1024.f) + RMS_EPS);
}
__device__ __forceinline__ void norm_mod(f32x4 (&v)[4], const float* g, const float* shift, const float* scale, int lane) {
    const float rstd = row_rstd(v);
#pragma unroll
    for (int j = 0; j < 4; ++j) { const f32x4 gv = *(const f32x4*)(g + 256 * j + 4 * lane), sh = *(const f32x4*)(shift + 256 * j + 4 * lane), sc = *(const f32x4*)(scale + 256 * j + 4 * lane);
        v[j] = (v[j] * rstd * gv) * (sc + 1.f) + sh; }
}
__device__ __forceinline__ void store_row_bf16(bf16_t* p, int lane, const f32x4 (&v)[4]) {
#pragma unroll
    for (int j = 0; j < 4; ++j) { u32x2 w; w.x = pk2(v[j][0], v[j][1]); w.y = pk2(v[j][2], v[j][3]); *(u32x2*)(p + 256 * j + 4 * lane) = w; }
}

__device__ __forceinline__ void p_norm1_l0(const Frame& F0) {
    const Frame F = relaunder(F0);
    const float* MOD = (const float*)(F.ws + WS_MOD); bf16_t* H = (bf16_t*)(F.ws + WS_H);
    const float* x0 = in_ptr(F, 0); const float* c0p = in_ptr(F, 2); const float* g1n = in_ptr(F, 6);
    f32x4 nx[4];
    if (F.gw < TT) load_row(F.gw < TL ? x0 + (size_t)F.gw * 1024 : c0p + (size_t)(F.gw - TL) * 1024, F.lane, nx);
    for (int row = F.gw; row < TT; row += F.NGW) {
        const int mr = row < TL ? (row >> 12) : 8;
        f32x4 v[4];
#pragma unroll
        for (int j = 0; j < 4; ++j) v[j] = nx[j];
        const int rn = row + F.NGW;
        if (rn < TT) load_row(rn < TL ? x0 + (size_t)rn * 1024 : c0p + (size_t)(rn - TL) * 1024, F.lane, nx);
        norm_mod(v, g1n, MOD + (size_t)mr * 6144, MOD + (size_t)mr * 6144 + 1024, F.lane);
        store_row_bf16(H + (size_t)row * 1024, F.lane, v);
    }
}

struct ConvIn { u32x4 gb, c0v, c1, c2v, x0v, x1, x2v; };
__device__ __forceinline__ void conv_load(const bf16_t* P, int it, ConvIn& v) {
    const int row = it >> 6, c0 = (it & 63) * 8;
    bool hp, hn;
    if (row < TL) { const int s = row & 4095; hp = s > 0; hn = s < 4095; } else { const int s = (row - TL) & 255; hp = s > 0; hn = s < 255; }
    const bf16_t* pr = P + (size_t)row * PW;
    v.gb = *(const u32x4*)(pr + OCB + c0); v.c1 = *(const u32x4*)(pr + OCC + c0); v.x1 = *(const u32x4*)(pr + OCX + c0);
    v.c0v = (u32x4){0u, 0u, 0u, 0u}; v.x0v = v.c0v; v.c2v = v.c0v; v.x2v = v.c0v;
    if (hp) { v.c0v = *(const u32x4*)(pr - PW + OCC + c0); v.x0v = *(const u32x4*)(pr - PW + OCX + c0); }
    if (hn) { v.c2v = *(const u32x4*)(pr + PW + OCC + c0); v.x2v = *(const u32x4*)(pr + PW + OCX + c0); }
}
__device__ __forceinline__ void p_conv(const Frame& F0, const float* cw  , int wi, int nw, int nrows) {
    const Frame F = relaunder(F0);
    const bf16_t* P = (const bf16_t*)(F.ws + WS_P); bf16_t* ACG = (bf16_t*)(F.ws + WS_ACG);
    const int gt = wi * 64 + F.lane, NGT = nw * 64, end = nrows * 64;
    ConvIn nx; if (gt < end) conv_load(P, gt, nx);
    for (int it = gt; it < end; it += NGT) {
        const ConvIn v = nx;
        if (it + NGT < end) conv_load(P, it + NGT, nx);
        const int row = it >> 6, c0 = (it & 63) * 8;
        float o[8];
#pragma unroll
        for (int q = 0; q < 4; ++q) {
#pragma unroll
            for (int hh = 0; hh < 2; ++hh) { const int ch = c0 + 2 * q + hh;
                const float b = hh ? bfhi(v.gb[q]) : bflo(v.gb[q]);
                const float u0 = (hh ? bfhi(v.c0v[q]) : bflo(v.c0v[q])) * (hh ? bfhi(v.x0v[q]) : bflo(v.x0v[q]));
                const float u1 = (hh ? bfhi(v.c1[q]) : bflo(v.c1[q])) * (hh ? bfhi(v.x1[q]) : bflo(v.x1[q]));
                const float u2 = (hh ? bfhi(v.c2v[q]) : bflo(v.c2v[q])) * (hh ? bfhi(v.x2v[q]) : bflo(v.x2v[q]));
                o[2 * q + hh] = b * (cw[ch] * u0 + cw[512 + ch] * u1 + cw[1024 + ch] * u2); } }
        u32x4 w; w.x = pk2(o[0], o[1]); w.y = pk2(o[2], o[3]); w.z = pk2(o[4], o[5]); w.w = pk2(o[6], o[7]);
        *(u32x4*)(ACG + (size_t)row * 1024 + c0) = w;
    }
}
__device__ __forceinline__ int gla_row(int step, int b, int dir) {
    if (dir == 0) return step < 256 ? TL + b * 256 + step : b * 4096 + (step - 256);
    return step < 256 ? TL + b * 256 + (255 - step) : b * 4096 + (4095 - (step - 256));
}
__device__ __forceinline__ void p_gla_chain(const Frame& F0, const float* wa2  , const float* ba  , int chain) {
    const Frame F = relaunder(F0);
    const bf16_t* P = (const bf16_t*)(F.ws + WS_P); const float* GA = (const float*)(F.ws + WS_GA); float* OG = (float*)(F.ws + WS_OG);
    const int b = chain >> 3, h = (chain >> 1) & 3, dir = chain & 1;
    LAS float* Wa = (LAS float*)F.lds;
    LAS float* bav = Wa + 1024;
    LAS float* qs = bav + 64;
    LAS float* ks = qs + 1024;
    LAS float* egs = ks + 1024;
    LAS float* vs = egs + 1024;
    LAS float* po = vs + 2048;
    const int tid = F.tid, dkg = tid >> 7, dv = tid & 127;
    __syncthreads();
    for (int i = tid; i < 1024; i += NTHR) { const int r = i >> 6, dk = i & 63; Wa[i] = wa2[(size_t)(dir * 16 + r) * 256 + h * 64 + dk]; }
    if (tid < 64) bav[tid] = ba[dir * 256 + h * 64 + tid];
    float S[16];
#pragma unroll
    for (int i = 0; i < 16; ++i) S[i] = 0.f;
    for (int blk = 0; blk < 272; ++blk) {
        __syncthreads();
        for (int e = tid; e < 1024; e += NTHR) { const int tk = e >> 6, dk = e & 63; const int row = gla_row(blk * 16 + tk, b, dir);
            qs[e] = bf2f(P[(size_t)row * PW + OGQ + h * 64 + dk]);
            ks[e] = bf2f(P[(size_t)row * PW + OGK + h * 64 + dk]);
            float z = bav[dk]; const float* ga = GA + (size_t)row * 32 + dir * 16;
#pragma unroll
            for (int r = 0; r < 16; ++r) z += ga[r] * Wa[r * 64 + dk];
            const float ls = fminf(z, 0.f) - log1pf(__expf(-fabsf(z)));
            egs[e] = __expf(ls * (1.f / 16.f)); }
        for (int e = tid; e < 2048; e += NTHR) { const int tk = e >> 7, d = e & 127; const int row = gla_row(blk * 16 + tk, b, dir);
            vs[e] = bf2f(P[(size_t)row * PW + OGV + h * 128 + d]); }
        __syncthreads();
#pragma unroll 1
        for (int tk = 0; tk < 16; ++tk) {
            const float vv = vs[tk * 128 + dv]; float pacc = 0.f;
#pragma unroll
            for (int i = 0; i < 16; ++i) { const int dk = dkg * 16 + i; S[i] = egs[tk * 64 + dk] * S[i] + ks[tk * 64 + dk] * vv; pacc += qs[tk * 64 + dk] * S[i]; }
            po[(tk * 4 + dkg) * 128 + dv] = pacc;
        }
        __syncthreads();
        for (int e = tid; e < 2048; e += NTHR) { const int tk = e >> 7, d = e & 127; const int row = gla_row(blk * 16 + tk, b, dir);
            const float o = (po[(tk * 4 + 0) * 128 + d] + po[(tk * 4 + 1) * 128 + d]) + (po[(tk * 4 + 2) * 128 + d] + po[(tk * 4 + 3) * 128 + d]);
            OG[((size_t)dir * TT + row) * 512 + h * 128 + d] = o * 0.125f; }
    }
    __syncthreads();
}

__device__ __forceinline__ void p_attn_naive(const Frame& F0, int layer, const float* subg  ) {
    const Frame F = relaunder(F0);
    const bf16_t* P = (const bf16_t*)(F.ws + WS_P); bf16_t* AD = (bf16_t*)(F.ws + WS_AD);
    float* scr = (float*)(F.ws + WS_ASCR) + (size_t)blockIdx.x * 64 * 512;
    const float lam = __builtin_nontemporal_load((const float*)(F.ws + WS_LAM) + layer);
    const float lam_init = 0.8f - 0.6f * expf(-0.3f * (float)layer);
    LAS float* Ks = (LAS float*)F.lds;
    LAS float* Vs = Ks + 4096;
    LAS float* red = Vs + 8192;
    const int tid = F.tid, qr = tid & 255, half = tid >> 8;
    const int nunits = layer == 0 ? 1024 + 64 : 1024;
    for (int u = blockIdx.x; u < nunits; u += F.G) {
        const bool lat = u < 1024;
        int b, h, qrow0, ntiles;
        if (lat) { b = u >> 7; h = (u >> 4) & 7; qrow0 = b * 4096 + (u & 15) * 256; ntiles = 68; }
        else { const int v = u - 1024; b = v >> 3; h = v & 7; qrow0 = TL + b * 256; ntiles = 4; }
        const int qrow = qrow0 + qr;
        float O[64];
#pragma unroll 1
        for (int map = 1; map >= 0; --map) {
            float q[64];
            { const bf16_t* qp = P + (size_t)qrow * PW + OQ + h * 128 + map * 64;
#pragma unroll
              for (int c = 0; c < 8; ++c) { const u32x4 w = *(const u32x4*)(qp + 8 * c);
#pragma unroll
                  for (int e = 0; e < 4; ++e) { q[8 * c + 2 * e] = bflo(w[e]); q[8 * c + 2 * e + 1] = bfhi(w[e]); } asm volatile("" ::: "memory"); } }
            float mx = -1e30f, l = 0.f;
#pragma unroll
            for (int i = 0; i < 64; ++i) O[i] = 0.f;
#pragma unroll 1
            for (int t = 0; t < ntiles; ++t) {
                const int krow0 = (lat && t < 64) ? b * 4096 + t * 64 : TL + b * 256 + (t - (lat ? 64 : 0)) * 64;
                __syncthreads();
                { const int key = tid >> 3, ch = tid & 7; const u32x4 w = *(const u32x4*)(P + (size_t)(krow0 + key) * PW + OKK + h * 128 + map * 64 + ch * 8);
                  *(LAS f32x4*)(Ks + key * 64 + ch * 8) = (f32x4){bflo(w.x), bfhi(w.x), bflo(w.y), bfhi(w.y)};
                  *(LAS f32x4*)(Ks + key * 64 + ch * 8 + 4) = (f32x4){bflo(w.z), bfhi(w.z), bflo(w.w), bfhi(w.w)}; }
#pragma unroll
                for (int i2 = 0; i2 < 2; ++i2) { const int e = tid + i2 * 512, key = e >> 4, ch = e & 15; const u32x4 w = *(const u32x4*)(P + (size_t)(krow0 + key) * PW + OV + h * 128 + ch * 8);
                  *(LAS f32x4*)(Vs + key * 128 + ch * 8) = (f32x4){bflo(w.x), bfhi(w.x), bflo(w.y), bfhi(w.y)};
                  *(LAS f32x4*)(Vs + key * 128 + ch * 8 + 4) = (f32x4){bflo(w.z), bfhi(w.z), bflo(w.w), bfhi(w.w)}; }
                __syncthreads();
#pragma unroll 1
                for (int key = 0; key < 64; ++key) {
                    float s = 0.f;
#pragma unroll
                    for (int c = 0; c < 16; ++c) { const f32x4 kv = *(const LAS f32x4*)(Ks + key * 64 + 4 * c); s += (q[4 * c] * kv[0] + q[4 * c + 1] * kv[1]) + (q[4 * c + 2] * kv[2] + q[4 * c + 3] * kv[3]);
                        if ((c & 3) == 3) asm volatile("" ::: "memory"); }
                    const float mn = fmaxf(mx, s); const float alpha = __builtin_amdgcn_exp2f(mx - mn), p = __builtin_amdgcn_exp2f(s - mn);
                    l = l * alpha + p; mx = mn;
#pragma unroll
                    for (int c = 0; c < 16; ++c) { const f32x4 vv = *(const LAS f32x4*)(Vs + key * 128 + half * 64 + 4 * c);
                        O[4 * c] = O[4 * c] * alpha + p * vv[0]; O[4 * c + 1] = O[4 * c + 1] * alpha + p * vv[1]; O[4 * c + 2] = O[4 * c + 2] * alpha + p * vv[2]; O[4 * c + 3] = O[4 * c + 3] * alpha + p * vv[3];
                        if ((c & 3) == 3) asm volatile("" ::: "memory"); }
                }
            }
            const float inv = 1.f / l;
            if (map == 1) {
#pragma unroll
                for (int i = 0; i < 16; ++i) { *(f32x4*)(scr + tid * 64 + 4 * i) = (f32x4){O[4 * i] * inv, O[4 * i + 1] * inv, O[4 * i + 2] * inv, O[4 * i + 3] * inv}; if ((i & 3) == 3) asm volatile("" ::: "memory"); }
            } else {
#pragma unroll
                for (int i = 0; i < 16; ++i) { const f32x4 t = __builtin_nontemporal_load((const f32x4*)(scr + tid * 64 + 4 * i));
                    O[4 * i] = O[4 * i] * inv - lam * t[0]; O[4 * i + 1] = O[4 * i + 1] * inv - lam * t[1]; O[4 * i + 2] = O[4 * i + 2] * inv - lam * t[2]; O[4 * i + 3] = O[4 * i + 3] * inv - lam * t[3];
                    if ((i & 3) == 3) asm volatile("" ::: "memory"); }
            }
        }
        float ss = 0.f;
#pragma unroll
        for (int i = 0; i < 64; ++i) ss += O[i] * O[i];
        __syncthreads();
        red[tid] = ss;
        __syncthreads();
        const float tot = red[qr] + red[qr + 256];
        const float r = (1.f - lam_init) / sqrtf(tot * (1.f / 128.f) + RMS_EPS);
        bf16_t* op = AD + (size_t)qrow * 1024 + h * 128 + half * 64;
#pragma unroll
        for (int c = 0; c < 8; ++c) { u32x4 w;
            w.x = pk2(O[8 * c] * r * subg[half * 64 + 8 * c], O[8 * c + 1] * r * subg[half * 64 + 8 * c + 1]);
            w.y = pk2(O[8 * c + 2] * r * subg[half * 64 + 8 * c + 2], O[8 * c + 3] * r * subg[half * 64 + 8 * c + 3]);
            w.z = pk2(O[8 * c + 4] * r * subg[half * 64 + 8 * c + 4], O[8 * c + 5] * r * subg[half * 64 + 8 * c + 5]);
            w.w = pk2(O[8 * c + 6] * r * subg[half * 64 + 8 * c + 6], O[8 * c + 7] * r * subg[half * 64 + 8 * c + 7]);
            *(u32x4*)(op + 8 * c) = w; asm volatile("" ::: "memory"); }
    }
    __syncthreads();
}

__device__ __forceinline__ void p_gla_tail(const Frame& F0, const float* gng  , int row_lo, int nrows) {
    const Frame F = relaunder(F0);
    const bf16_t* P = (const bf16_t*)(F.ws + WS_P); const float* OG = (const float*)(F.ws + WS_OG); bf16_t* ACG = (bf16_t*)(F.ws + WS_ACG);
    const int c0 = F.lane * 8; const bf16_t* OGB = (const bf16_t*)OG;
    const f32x4 g0 = *(const f32x4*)(gng + (c0 & 127)), g1 = *(const f32x4*)(gng + (c0 & 127) + 4);
    u32x4 n0 = (u32x4){0u, 0u, 0u, 0u}, n1 = n0, nr = n0;
    const int r0 = row_lo + F.wave;
    if (r0 < nrows) { n0 = *(const u32x4*)(OGB + (size_t)r0 * 512 + c0); n1 = *(const u32x4*)(OGB + ((size_t)TT + r0) * 512 + c0); nr = *(const u32x4*)(P + (size_t)r0 * PW + OGR + c0); }
    for (int row = r0; row < nrows; row += NWAVES) {
        const u32x4 w0 = n0, w1 = n1, rw = nr; const int rn = row + NWAVES;
        if (rn < nrows) { n0 = *(const u32x4*)(OGB + (size_t)rn * 512 + c0); n1 = *(const u32x4*)(OGB + ((size_t)TT + rn) * 512 + c0); nr = *(const u32x4*)(P + (size_t)rn * PW + OGR + c0); }
        f32x4 a = (f32x4){bflo(w0.x) + bflo(w1.x), bfhi(w0.x) + bfhi(w1.x), bflo(w0.y) + bflo(w1.y), bfhi(w0.y) + bfhi(w1.y)};
        f32x4 b = (f32x4){bflo(w0.z) + bflo(w1.z), bfhi(w0.z) + bfhi(w1.z), bflo(w0.w) + bflo(w1.w), bfhi(w0.w) + bfhi(w1.w)};
        float ss = (a[0] * a[0] + a[1] * a[1]) + (a[2] * a[2] + a[3] * a[3]) + (b[0] * b[0] + b[1] * b[1]) + (b[2] * b[2] + b[3] * b[3]);
        ss += __shfl_xor(ss, 1); ss += __shfl_xor(ss, 2); ss += __shfl_xor(ss, 4); ss += __shfl_xor(ss, 8);
        const float rstd = 1.f / sqrtf(ss * (1.f / 128.f) + RMS_EPS);
        float rr[8] = {bflo(rw.x), bfhi(rw.x), bflo(rw.y), bfhi(rw.y), bflo(rw.z), bfhi(rw.z), bflo(rw.w), bfhi(rw.w)};
        float o[8];
#pragma unroll
        for (int i = 0; i < 4; ++i) { const float y0 = a[i] * rstd * g0[i], y1 = b[i] * rstd * g1[i];
            o[i] = y0 * (rr[i] * sigmoidf_(rr[i])); o[4 + i] = y1 * (rr[4 + i] * sigmoidf_(rr[4 + i])); }
        u32x4 w; w.x = pk2(o[0], o[1]); w.y = pk2(o[2], o[3]); w.z = pk2(o[4], o[5]); w.w = pk2(o[6], o[7]);
        *(u32x4*)(ACG + (size_t)row * 1024 + 512 + c0) = w;
    }
}

__device__ __forceinline__ void p_gla_tail_bh(const Frame& F0, const float* gng  , int b, int h, bool with_ctx) {
    const Frame F = relaunder(F0);
    const bf16_t* P = (const bf16_t*)(F.ws + WS_P); const bf16_t* OGB = (const bf16_t*)(F.ws + WS_OG); bf16_t* ACG = (bf16_t*)(F.ws + WS_ACG);
    const int sub = F.lane >> 4, c0 = h * 128 + (F.lane & 15) * 8;
    const f32x4 g0 = *(const f32x4*)(gng + (c0 & 127)), g1 = *(const f32x4*)(gng + (c0 & 127) + 4);
    const int n = with_ctx ? 4352 : 4096;
#define TBH_ROW(i_) ((i_) < 4096 ? b * 4096 + (i_) : TL + b * 256 + ((i_) - 4096))
    u32x4 n0 = (u32x4){0u, 0u, 0u, 0u}, n1 = n0, nr = n0;
    int i = F.wave * 4 + sub;
    if (i < n) { const int r_ = TBH_ROW(i); n0 = *(const u32x4*)(OGB + (size_t)r_ * 512 + c0); n1 = *(const u32x4*)(OGB + ((size_t)TT + r_) * 512 + c0); nr = *(const u32x4*)(P + (size_t)r_ * PW + OGR + c0); }
    for (; i < n; i += NWAVES * 4) {
        const u32x4 w0 = n0, w1 = n1, rw = nr; const int row = TBH_ROW(i), in = i + NWAVES * 4;
        if (in < n) { const int r_ = TBH_ROW(in); n0 = *(const u32x4*)(OGB + (size_t)r_ * 512 + c0); n1 = *(const u32x4*)(OGB + ((size_t)TT + r_) * 512 + c0); nr = *(const u32x4*)(P + (size_t)r_ * PW + OGR + c0); }
        f32x4 a = (f32x4){bflo(w0.x) + bflo(w1.x), bfhi(w0.x) + bfhi(w1.x), bflo(w0.y) + bflo(w1.y), bfhi(w0.y) + bfhi(w1.y)};
        f32x4 bq = (f32x4){bflo(w0.z) + bflo(w1.z), bfhi(w0.z) + bfhi(w1.z), bflo(w0.w) + bflo(w1.w), bfhi(w0.w) + bfhi(w1.w)};
        float ss = (a[0] * a[0] + a[1] * a[1]) + (a[2] * a[2] + a[3] * a[3]) + (bq[0] * bq[0] + bq[1] * bq[1]) + (bq[2] * bq[2] + bq[3] * bq[3]);
        ss += __shfl_xor(ss, 1); ss += __shfl_xor(ss, 2); ss += __shfl_xor(ss, 4); ss += __shfl_xor(ss, 8);
        const float rstd = 1.f / sqrtf(ss * (1.f / 128.f) + RMS_EPS);
        float rr[8] = {bflo(rw.x), bfhi(rw.x), bflo(rw.y), bfhi(rw.y), bflo(rw.z), bfhi(rw.z), bflo(rw.w), bfhi(rw.w)};
        float o[8];
#pragma unroll
        for (int k = 0; k < 4; ++k) { const float y0 = a[k] * rstd * g0[k], y1 = bq[k] * rstd * g1[k];
            o[k] = y0 * (rr[k] * sigmoidf_(rr[k])); o[4 + k] = y1 * (rr[4 + k] * sigmoidf_(rr[4 + k])); }
        u32x4 w; w.x = pk2(o[0], o[1]); w.y = pk2(o[2], o[3]); w.z = pk2(o[4], o[5]); w.w = pk2(o[6], o[7]);
        *(u32x4*)(ACG + (size_t)row * 1024 + 512 + c0) = w;
    }
#undef TBH_ROW
}

typedef float rf2_t __attribute__((ext_vector_type(2)));
__device__ __forceinline__ float router_reduce(float (&p)[32], int lane) {
#pragma unroll
    for (int i = 0; i < 16; ++i) { const bool up = (lane & 32) != 0; const float send = up ? p[i] : p[i + 16], keep = up ? p[i + 16] : p[i]; p[i] = keep + __shfl_xor(send, 32); }
#pragma unroll
    for (int i = 0; i < 8; ++i) { const bool up = (lane & 16) != 0; const float send = up ? p[i] : p[i + 8], keep = up ? p[i + 8] : p[i]; p[i] = keep + __shfl_xor(send, 16); }
#pragma unroll
    for (int i = 0; i < 4; ++i) { const bool up = (lane & 8) != 0; const float send = up ? p[i] : p[i + 4], keep = up ? p[i + 4] : p[i]; p[i] = keep + __shfl_xor(send, 8); }
#pragma unroll
    for (int i = 0; i < 2; ++i) { const bool up = (lane & 4) != 0; const float send = up ? p[i] : p[i + 2], keep = up ? p[i + 2] : p[i]; p[i] = keep + __shfl_xor(send, 4); }
    { const bool up = (lane & 2) != 0; const float send = up ? p[0] : p[1], keep = up ? p[1] : p[0]; p[0] = keep + __shfl_xor(send, 2); }
    return p[0] + __shfl_xor(p[0], 1);
}
__device__ __forceinline__ void router_topk(float logit, int row, bool valid, int lane, LAS float* lg, LAS float* selv, LAS int* hist, int* TOPI, float* TOPG) {
    const int ex = lane >> 1;
    if ((lane & 1) == 0) lg[ex] = logit;
    LDS_WAIT(); asm volatile("" ::: "memory");
    int rank = 0;
#pragma unroll
    for (int e = 0; e < 32; ++e) { const float o = lg[e]; rank += (o > logit || (o == logit && e < ex)) ? 1 : 0; }
    if ((lane & 1) == 0 && rank < 4) { selv[rank * 2] = logit; selv[rank * 2 + 1] = __builtin_bit_cast(float, ex); }
    LDS_WAIT(); asm volatile("" ::: "memory");
    const float v0 = selv[0], v1 = selv[2], v2 = selv[4], v3 = selv[6];
    const float e0 = 1.f, e1 = __expf(v1 - v0), e2 = __expf(v2 - v0), e3 = __expf(v3 - v0); const float inv = 1.f / (e0 + e1 + e2 + e3);
    if (valid && lane < 4) { const int ej = __builtin_bit_cast(int, selv[lane * 2 + 1]); const float gj = (lane == 0 ? e0 : lane == 1 ? e1 : lane == 2 ? e2 : e3) * inv;
        TOPI[(size_t)row * 4 + lane] = ej; TOPG[(size_t)row * 4 + lane] = gj; __hip_atomic_fetch_add(hist + ej, 1, __ATOMIC_RELAXED, __HIP_MEMORY_SCOPE_WORKGROUP); }
    LDS_WAIT(); asm volatile("" ::: "memory");
}
__device__ __forceinline__ void p_norm2_router(const Frame& F0, int layer, int Tm) {
    const Frame F = relaunder(F0);
    const float* MOD = (const float*)(F.ws + WS_MOD) + (size_t)layer * 9 * 6144; bf16_t* H = (bf16_t*)(F.ws + WS_H); const float* XW = (const float*)(F.ws + WS_XW);
    unsigned char* rt = F.ws + WS_ROUTE + layer * ROUTE_STRIDE;
    int* TOPI = (int*)(rt + R_TOPI); float* TOPG = (float*)(rt + R_TOPG); int* CNT = (int*)(rt + R_CNT);
    const float* rw = in_ptr(F, 19) + (size_t)layer * 1024 * 32; const float* rb = in_ptr(F, 20) + layer * 32; const float* g2n = in_ptr(F, 7) + layer * 1024;
    LAS float* WT = (LAS float*)F.lds;
    LAS float* lg = (LAS float*)(F.lds + 132096) + F.wave * 32;
    LAS float* selv = (LAS float*)(F.lds + 132096 + 1024) + F.wave * 8;
    LAS int* hist = (LAS int*)(F.lds + 132096 + 2048);
    __syncthreads();
    {
        f32x4 wv[16];
#pragma unroll
        for (int i = 0; i < 16; ++i) wv[i] = *(const f32x4*)(rw + 4 * (F.tid + NTHR * i));
#pragma unroll
        for (int i = 0; i < 16; ++i) { const int i4 = F.tid + NTHR * i, k = i4 >> 3, e0 = (i4 & 7) * 4;
            WT[(e0 + 0) * 1028 + k] = wv[i][0]; WT[(e0 + 1) * 1028 + k] = wv[i][1]; WT[(e0 + 2) * 1028 + k] = wv[i][2]; WT[(e0 + 3) * 1028 + k] = wv[i][3]; }
    }
    if (F.tid < 32) hist[F.tid] = 0;
    __syncthreads();
    const int RPW = Tm / F.G;
    const int nk = RPW / NWAVES;
    f32x4 shv[4], scv[4]; int mrc = -1;
    const int row0w = blockIdx.x * RPW + F.wave;
    f32x4 nA[4], nB[4];
    load_row(XW + (size_t)row0w * 1024, F.lane, nA); load_row(XW + (size_t)(nk > 1 ? row0w + NWAVES : row0w) * 1024, F.lane, nB);
#pragma unroll 1
    for (int k = 0; k < nk; k += 2) {
        const bool hasB = k + 1 < nk;
        const int rowA = row0w + NWAVES * k, rowB = hasB ? rowA + NWAVES : rowA;
        f32x4 vA[4], vB[4];
#pragma unroll
        for (int j = 0; j < 4; ++j) { vA[j] = nA[j]; vB[j] = nB[j]; }
        if (k + 2 < nk) { const int rA2 = rowA + 2 * NWAVES, rB2 = (k + 3 < nk) ? rA2 + NWAVES : rA2; load_row(XW + (size_t)rA2 * 1024, F.lane, nA); load_row(XW + (size_t)rB2 * 1024, F.lane, nB); }
        const int mrA = rowA < TL ? (rowA >> 12) : 8, mrB = rowB < TL ? (rowB >> 12) : 8;
        if (mrA != mrc) { mrc = mrA;
#pragma unroll
            for (int j = 0; j < 4; ++j) { shv[j] = *(const f32x4*)(MOD + (size_t)mrA * 6144 + 3072 + 256 * j + 4 * F.lane); scv[j] = *(const f32x4*)(MOD + (size_t)mrA * 6144 + 4096 + 256 * j + 4 * F.lane) + 1.f; } }
        { const float rsA = row_rstd(vA);
#pragma unroll
          for (int j = 0; j < 4; ++j) vA[j] = (vA[j] * rsA * *(const f32x4*)(g2n + 256 * j + 4 * F.lane)) * scv[j] + shv[j]; }
        if (mrB != mrc) { mrc = mrB;
#pragma unroll
            for (int j = 0; j < 4; ++j) { shv[j] = *(const f32x4*)(MOD + (size_t)mrB * 6144 + 3072 + 256 * j + 4 * F.lane); scv[j] = *(const f32x4*)(MOD + (size_t)mrB * 6144 + 4096 + 256 * j + 4 * F.lane) + 1.f; } }
        { const float rsB = row_rstd(vB);
#pragma unroll
          for (int j = 0; j < 4; ++j) vB[j] = (vB[j] * rsB * *(const f32x4*)(g2n + 256 * j + 4 * F.lane)) * scv[j] + shv[j]; }
        store_row_bf16(H + (size_t)rowA * 1024, F.lane, vA);
        if (hasB) store_row_bf16(H + (size_t)rowB * 1024, F.lane, vB);
        float pA[32], pB[32];
#pragma unroll
        for (int e4 = 0; e4 < 32; e4 += 2) {
            f32x4 w[2][4];
#pragma unroll
            for (int x = 0; x < 2; ++x)
#pragma unroll
                for (int j = 0; j < 4; ++j) w[x][j] = *(const LAS f32x4*)(WT + (e4 + x) * 1028 + 256 * j + 4 * F.lane);
            asm volatile("" ::: "memory");
            rf2_t acc2[2][2];
#pragma unroll
            for (int x = 0; x < 2; ++x) { acc2[x][0] = (rf2_t){0.f, 0.f}; acc2[x][1] = (rf2_t){0.f, 0.f}; }
#pragma unroll
            for (int j = 0; j < 4; ++j)
#pragma unroll
                for (int i = 0; i < 4; ++i) { const rf2_t ab = (rf2_t){vA[j][i], vB[j][i]};
#pragma unroll
                    for (int x = 0; x < 2; ++x) acc2[x][i & 1] = __builtin_elementwise_fma(ab, (rf2_t){w[x][j][i], w[x][j][i]}, acc2[x][i & 1]); }
#pragma unroll
            for (int x = 0; x < 2; ++x) { const rf2_t t = acc2[x][0] + acc2[x][1]; pA[e4 + x] = t[0]; pB[e4 + x] = t[1]; } }
        const int ex = F.lane >> 1; const float bias = rb[ex];
        const float logitA = router_reduce(pA, F.lane) + bias, logitB = router_reduce(pB, F.lane) + bias;
        router_topk(logitA, rowA, true, F.lane, lg, selv, hist, TOPI, TOPG);
        router_topk(logitB, rowB, hasB, F.lane, lg, selv, hist, TOPI, TOPG);
    }
    __syncthreads();
    if (F.tid < 32) CNT[blockIdx.x * 32 + F.tid] = hist[F.tid];
}

__device__ __forceinline__ void p_route_gather(const Frame& F0, int layer, int Tm) {
    const Frame F = relaunder(F0);
    unsigned char* rt = F.ws + WS_ROUTE + layer * ROUTE_STRIDE;
    const int* TOPI = (const int*)(rt + R_TOPI); int* POSOF = (int*)(rt + R_POSOF); int* ROWTOK = (int*)(rt + R_ROWTOK); const int* CNT = (const int*)(rt + R_CNT);
    int* TILEEXP = (int*)(rt + R_TILEEXP); int* NT = (int*)(rt + R_NT);
    LAS int* tot = (LAS int*)F.lds;
    LAS int* mine = tot + 32;
    LAS int* pst = mine + 32;
    LAS int* es = pst + 64;
    LAS int* ps = es + 1024;
    const int RPW = Tm / F.G, NP = RPW * 4;
    __syncthreads();
    {
        LAS int* part = ps + 1024;
        const int e = F.tid & 31, sl = F.tid >> 5; int t = 0, m = 0;
        for (int w = sl; w < F.G; w += 16) { const int c = __builtin_nontemporal_load(CNT + w * 32 + e); t += c; if (w < (int)blockIdx.x) m += c; }
        part[sl * 32 + e] = t; part[512 + sl * 32 + e] = m;
        __syncthreads();
        if (F.tid < 32) { int tt = 0, mm = 0;
#pragma unroll
            for (int k = 0; k < 16; ++k) { tt += part[k * 32 + F.tid]; mm += part[512 + k * 32 + F.tid]; }
            tot[F.tid] = tt; mine[F.tid] = mm; } }
    for (int i = F.tid; i < NP; i += NTHR) es[i] = __builtin_nontemporal_load(TOPI + (size_t)blockIdx.x * NP + i);
    __syncthreads();
    if (F.tid == 0) { int s = 0; for (int e = 0; e < 32; ++e) { pst[e] = s; s += (tot[e] + 255) & ~255; } pst[32] = s; }
    __syncthreads();
    {
        LAS int* rk = ps + 2048;
        int base[4] = {0, 0, 0, 0};
        for (int c0 = 0; c0 < NP; c0 += 64) { const int i = c0 + F.lane; const int e = i < NP ? es[i] : -1;
#pragma unroll
            for (int x = 0; x < 4; ++x) { const unsigned long long b = __ballot(e == 4 * F.wave + x);
                if (e == 4 * F.wave + x) rk[i] = base[x] + __popcll(b & ((1ull << F.lane) - 1ull));
                base[x] += __popcll(b); } }
        __syncthreads();
    }
    for (int i = F.tid; i < NP; i += NTHR) { const int e = es[i]; const int r = (ps + 2048)[i];
        const int pos = pst[e] + mine[e] + r; ps[i] = pos; const int tok = blockIdx.x * RPW + (i >> 2);
        ROWTOK[pos] = tok; POSOF[(size_t)tok * 4 + (i & 3)] = pos; }
    const int ntiles = pst[32] >> 8;
    if (blockIdx.x == 0) { for (int t = F.tid; t < ntiles; t += NTHR) { int e = 0; for (int q = 0; q < 32; ++q) if (pst[q] <= t * 256) e = q; TILEEXP[t] = e; }
        if (F.tid == 0) NT[0] = ntiles; }
    __syncthreads();
    if (blockIdx.x < 32) { const int e = blockIdx.x; const int r0 = pst[e] + tot[e], r1 = pst[e + 1];
        for (int r = r0 + F.tid; r < r1; r += NTHR) ROWTOK[r] = 0; }
}

__device__ __forceinline__ void p_combine(const Frame& F0, int layer, int Tm) {
    const Frame F = relaunder(F0);
    const float* MODL = (const float*)(F.ws + WS_MOD) + (size_t)layer * 9 * 6144;
    const float* MODN = (const float*)(F.ws + WS_MOD) + (size_t)(layer + 1) * 9 * 6144;
    unsigned char* rt = F.ws + WS_ROUTE + layer * ROUTE_STRIDE;
    const int* POSOF = (const int*)(rt + R_POSOF); const float* TOPG = (const float*)(rt + R_TOPG);
    const bf16_t* YY = (const bf16_t*)(F.ws + WS_XS); float* XW = (float*)(F.ws + WS_XW); bf16_t* H = (bf16_t*)(F.ws + WS_H);
    const bool last = layer == 1;
    const float* fin_g = in_ptr(F, 25); const float* n1g = in_ptr(F, 6) + 1024; float* outp = out_ptr(F);
    u32x4 pos4 = (u32x4){0u, 0u, 0u, 0u}; f32x4 gt4 = (f32x4){0.f, 0.f, 0.f, 0.f};
    if (F.gw < Tm) { pos4 = __builtin_nontemporal_load((const u32x4*)(POSOF + (size_t)F.gw * 4)); gt4 = __builtin_nontemporal_load((const f32x4*)(TOPG + (size_t)F.gw * 4)); }
    for (int row = F.gw; row < Tm; row += F.NGW) {
        const int mr = row < TL ? (row >> 12) : 8;
        f32x4 v[4]; load_row(XW + (size_t)row * 1024, F.lane, v);
        u32x2 yw[4][4];
#pragma unroll
        for (int s = 0; s < 4; ++s) { const bf16_t* yp = YY + (size_t)pos4[s] * 1024;
#pragma unroll
            for (int j = 0; j < 4; ++j) yw[s][j] = *(const u32x2*)(yp + 256 * j + 4 * F.lane); }
        const f32x4 gcur = gt4;
        if (row + F.NGW < Tm) { pos4 = __builtin_nontemporal_load((const u32x4*)(POSOF + (size_t)(row + F.NGW) * 4)); gt4 = __builtin_nontemporal_load((const f32x4*)(TOPG + (size_t)(row + F.NGW) * 4)); }
        f32x4 y[4];
#pragma unroll
        for (int j = 0; j < 4; ++j) y[j] = (f32x4){0.f, 0.f, 0.f, 0.f};
#pragma unroll
        for (int s = 0; s < 4; ++s)
#pragma unroll
            for (int j = 0; j < 4; ++j) y[j] = y[j] + gcur[s] * (f32x4){bflo(yw[s][j].x), bfhi(yw[s][j].x), bflo(yw[s][j].y), bfhi(yw[s][j].y)};
        const float* g2 = MODL + (size_t)mr * 6144 + 5120;
#pragma unroll
        for (int j = 0; j < 4; ++j) v[j] = v[j] + *(const f32x4*)(g2 + 256 * j + 4 * F.lane) * y[j];
        if (!last) {
#pragma unroll
            for (int j = 0; j < 4; ++j) *(f32x4*)(XW + (size_t)row * 1024 + 256 * j + 4 * F.lane) = v[j];
            norm_mod(v, n1g, MODN + (size_t)mr * 6144, MODN + (size_t)mr * 6144 + 1024, F.lane);
            store_row_bf16(H + (size_t)row * 1024, F.lane, v);
        } else {
            const float rstd = row_rstd(v);
#pragma unroll
            for (int j = 0; j < 4; ++j) *(f32x4*)(outp + (size_t)row * 1024 + 256 * j + 4 * F.lane) = v[j] * rstd * *(const f32x4*)(fin_g + 256 * j + 4 * F.lane);
        }
    }
}
typedef float f32x16 __attribute__((ext_vector_type(16)));
typedef short bf16x8 __attribute__((ext_vector_type(8)));
typedef short v4i16_t __attribute__((ext_vector_type(4)));

typedef __bf16 abf2_t __attribute__((ext_vector_type(2)));
typedef float af2_t __attribute__((ext_vector_type(2)));
__device__ __forceinline__ unsigned cvt_pk(float lo, float hi) { const af2_t v = {lo, hi}; return __builtin_bit_cast(unsigned, __builtin_convertvector(v, abf2_t)); }

constexpr int AK_STRIDE = 272, AV_STRIDE = 320, AK_BYTES = 64 * AK_STRIDE, AV_BYTES = 64 * AV_STRIDE;
constexpr int AV_OFF = 2 * AK_BYTES;
constexpr int AQ_OFF = AV_OFF + 3 * AV_BYTES;
#ifndef ATT_PROBE
#define ATT_PROBE 0
#endif
struct AttnSt { f32x16 O[4]; f32x16 negm; float mrun, lrun; };
#define ASB() __builtin_amdgcn_sched_barrier(0)
#define APIN(x) asm volatile("" : "+v"(x))
#define AMF(a, b, c) __builtin_amdgcn_mfma_f32_32x32x16_bf16(a, b, c, 0, 0, 0)
#define AMX3(a, b, c) __builtin_fmaxf(__builtin_fmaxf((a), (b)), (c))
#define AGAPA(MF, A0, A1, A2, A3, W0, W1, PW) do { MF; sacc += A0; sacc += A1; sacc += A2; sacc += A3; APIN(sacc); W0; W1; APIN(PW); ASB(); } while (0)
#define AGAPB(MF, RD, X, i) do { MF; RD; X[i] = __builtin_amdgcn_exp2f(X[i]); X[i + 1] = __builtin_amdgcn_exp2f(X[i + 1]); APIN(X); ASB(); } while (0)
__device__ __forceinline__ float attn_rowmax(const f32x16& p0, const f32x16& p1) {
    float a = AMX3(p0[0], p0[1], p1[0]), b = AMX3(p0[2], p0[3], p1[1]); a = AMX3(a, p1[2], p1[3]);
#pragma unroll
    for (int r = 4; r < 16; r += 4) { a = AMX3(a, p0[r], p0[r + 1]); b = AMX3(b, p0[r + 2], p0[r + 3]); a = AMX3(a, p1[r], p1[r + 1]); b = AMX3(b, p1[r + 2], p1[r + 3]); }
    float m = __builtin_fmaxf(a, b);
    const auto rr = __builtin_amdgcn_permlane32_swap(__builtin_bit_cast(unsigned, m), __builtin_bit_cast(unsigned, m), false, false);
    return __builtin_fmaxf(__builtin_bit_cast(float, rr[0]), __builtin_bit_cast(float, rr[1]));
}
template <int PT, bool PRE>
__device__ __forceinline__ void attn_phA(const Frame& F, AttnSt& st, f32x16& C0, f32x16& C1, f32x16& P0, f32x16& P1, u32x4& pw0, u32x4& pw1, u32x4& pw2, u32x4& pw3,
                                         bf16x8 (&vf)[4], const bf16x8 (&qf)[4], const LAS unsigned char* vb, int q, int hi, int map) {
    const LAS unsigned char* kb = F.lds + PT * AK_BYTES + q * AK_STRIDE + map * 128 + hi * 16;
    bf16x8 ra[2], rb2[2];
#define AKQ(sl, ks) do { ra[sl] = *(const LAS bf16x8*)(kb + (ks) * 32); rb2[sl] = *(const LAS bf16x8*)(kb + 32 * AK_STRIDE + (ks) * 32); } while (0)
#define ATR(p) __builtin_amdgcn_ds_read_tr16_b64_v4i16((LAS v4i16_t*)(p))
#define AVR(sl, d, s) do { const v4i16_t lo_ = ATR(vb + (s) * 16 * AV_STRIDE + (d) * 64), hi_ = ATR(vb + (s) * 16 * AV_STRIDE + 8 * AV_STRIDE + (d) * 64); \
        vf[sl] = (bf16x8){lo_[0], lo_[1], lo_[2], lo_[3], hi_[0], hi_[1], hi_[2], hi_[3]}; } while (0)
#define AVRD(d, s) do { const v4i16_t lo_ = ATR(vb + (s) * 16 * AV_STRIDE + (d) * 64), hi_ = ATR(vb + (s) * 16 * AV_STRIDE + 8 * AV_STRIDE + (d) * 64); \
        vf[d] = (bf16x8){lo_[0], lo_[1], lo_[2], lo_[3], hi_[0], hi_[1], hi_[2], hi_[3]}; } while (0)
    ASB();
    AKQ(0, 0); AKQ(1, 1);
    float sacc = P0[0] + P0[1];
    ASB();
    AGAPA(C0 = AMF(ra[0], qf[0], st.negm),  P0[2], P0[3], P0[4], P0[5],     pw0[0] = cvt_pk(P0[0], P0[1]),   pw0[1] = cvt_pk(P0[2], P0[3]),   pw0);
    AGAPA(C1 = AMF(rb2[0], qf[0], st.negm), P0[6], P0[7], P0[8], P0[9],     pw0[2] = cvt_pk(P0[4], P0[5]),   pw0[3] = cvt_pk(P0[6], P0[7]),   pw0);
    AKQ(0, 2); ASB();
    AGAPA(C0 = AMF(ra[1], qf[1], C0),   P0[10], P0[11], P0[12], P0[13], pw1[0] = cvt_pk(P0[8], P0[9]),   pw1[1] = cvt_pk(P0[10], P0[11]), pw1);
    AGAPA(C1 = AMF(rb2[1], qf[1], C1),  P0[14], P0[15], P1[0], P1[1],   pw1[2] = cvt_pk(P0[12], P0[13]), pw1[3] = cvt_pk(P0[14], P0[15]), pw1);
    AKQ(1, 3); ASB();
    AGAPA(C0 = AMF(ra[0], qf[2], C0),   P1[2], P1[3], P1[4], P1[5],     pw2[0] = cvt_pk(P1[0], P1[1]),   pw2[1] = cvt_pk(P1[2], P1[3]),   pw2);
    AGAPA(C1 = AMF(rb2[0], qf[2], C1),  P1[6], P1[7], P1[8], P1[9],     pw2[2] = cvt_pk(P1[4], P1[5]),   pw2[3] = cvt_pk(P1[6], P1[7]),   pw2);
    if (PRE) { AVRD(0, 0); AVRD(1, 0); ASB(); }
    AGAPA(C0 = AMF(ra[1], qf[3], C0),   P1[10], P1[11], P1[12], P1[13], pw3[0] = cvt_pk(P1[8], P1[9]),   pw3[1] = cvt_pk(P1[10], P1[11]), pw3);
    if (PRE) { AVRD(2, 0); AVRD(3, 0); ASB(); }
    AGAPA(C1 = AMF(rb2[1], qf[3], C1),  P1[14], P1[15], 0.f, 0.f,       pw3[2] = cvt_pk(P1[12], P1[13]), pw3[3] = cvt_pk(P1[14], P1[15]), pw3);
    st.lrun += sacc;
#undef AKQ
}
__device__ __forceinline__ void attn_mid(AttnSt& st, f32x16& C0, f32x16& C1, float& alpha, bool& resc) {
    const float mx = attn_rowmax(C0, C1);
    alpha = 1.f; resc = false;
    if (!__builtin_expect(__all(mx <= 8.f), 1)) { const float dl = fmaxf(mx, 0.f); st.mrun += dl; alpha = __builtin_amdgcn_exp2f(-dl); st.lrun *= alpha; resc = true;
#pragma unroll
        for (int r = 0; r < 16; ++r) { C0[r] -= dl; C1[r] -= dl; st.negm[r] = -st.mrun; }
        APIN(st.negm); }
    ASB();
}
template <bool PRE>
__device__ __forceinline__ void attn_phB(AttnSt& st, f32x16& C0, f32x16& C1, const u32x4& pw0, const u32x4& pw1, const u32x4& pw2, const u32x4& pw3, bf16x8 (&vf)[4],
                                         const LAS unsigned char* vb, float alpha, bool resc) {
#define APF(k) __builtin_bit_cast(bf16x8, pw##k)
    if (!PRE) { ASB(); AVR(0, 0, 0); AVR(1, 1, 0); AVR(2, 2, 0); AVR(3, 3, 0); ASB(); }
    __builtin_amdgcn_s_setprio(1); ASB();
    AGAPB(st.O[0] = AMF(vf[0], APF(0), st.O[0]), AVR(0, 0, 1), C0, 0);
    AGAPB(st.O[1] = AMF(vf[1], APF(0), st.O[1]), AVR(1, 1, 1), C0, 2);
    AGAPB(st.O[2] = AMF(vf[2], APF(0), st.O[2]), AVR(2, 2, 1), C0, 4);
    AGAPB(st.O[3] = AMF(vf[3], APF(0), st.O[3]), AVR(3, 3, 1), C0, 6);
    AGAPB(st.O[0] = AMF(vf[0], APF(1), st.O[0]), AVR(0, 0, 2), C0, 8);
    AGAPB(st.O[1] = AMF(vf[1], APF(1), st.O[1]), AVR(1, 1, 2), C0, 10);
    AGAPB(st.O[2] = AMF(vf[2], APF(1), st.O[2]), AVR(2, 2, 2), C0, 12);
    AGAPB(st.O[3] = AMF(vf[3], APF(1), st.O[3]), AVR(3, 3, 2), C0, 14);
    AGAPB(st.O[0] = AMF(vf[0], APF(2), st.O[0]), AVR(0, 0, 3), C1, 0);
    AGAPB(st.O[1] = AMF(vf[1], APF(2), st.O[1]), AVR(1, 1, 3), C1, 2);
    AGAPB(st.O[2] = AMF(vf[2], APF(2), st.O[2]), AVR(2, 2, 3), C1, 4);
    AGAPB(st.O[3] = AMF(vf[3], APF(2), st.O[3]), AVR(3, 3, 3), C1, 6);
    AGAPB(st.O[0] = AMF(vf[0], APF(3), st.O[0]), (void)0, C1, 8);
    AGAPB(st.O[1] = AMF(vf[1], APF(3), st.O[1]), (void)0, C1, 10);
    AGAPB(st.O[2] = AMF(vf[2], APF(3), st.O[2]), (void)0, C1, 12);
    AGAPB(st.O[3] = AMF(vf[3], APF(3), st.O[3]), (void)0, C1, 14);
    __builtin_amdgcn_s_setprio(0); ASB();
    if (resc) {
#pragma unroll
        for (int d = 0; d < 4; ++d)
#pragma unroll
            for (int r = 0; r < 16; ++r) st.O[d][r] *= alpha;
    }
#undef APF
}
__device__ __forceinline__ void attn_drain(AttnSt& st, f32x16& P0, f32x16& P1, const LAS unsigned char* vb) {
    float sacc = 0.f;
#pragma unroll
    for (int r = 0; r < 16; ++r) sacc += P0[r] + P1[r];
    st.lrun += sacc;
#pragma unroll
    for (int s = 0; s < 4; ++s) { u32x4 w;
#pragma unroll
        for (int j = 0; j < 4; ++j) { const int r = 8 * (s & 1) + 2 * j; w[j] = (s < 2) ? cvt_pk(P0[r], P0[r + 1]) : cvt_pk(P1[r], P1[r + 1]); }
        const bf16x8 pf = __builtin_bit_cast(bf16x8, w);
#pragma unroll
        for (int d = 0; d < 4; ++d) { const v4i16_t lo_ = ATR(vb + s * 16 * AV_STRIDE + d * 64), hi_ = ATR(vb + s * 16 * AV_STRIDE + 8 * AV_STRIDE + d * 64);
            const bf16x8 v = (bf16x8){lo_[0], lo_[1], lo_[2], lo_[3], hi_[0], hi_[1], hi_[2], hi_[3]}; st.O[d] = AMF(v, pf, st.O[d]); }
    }
}
__device__ __forceinline__ void attn_unit(const Frame& F, int u, float lam, float osc, const float* subg, int tmask = -1) {
    const bf16_t* P = (const bf16_t*)(F.ws + WS_P); bf16_t* AD = (bf16_t*)(F.ws + WS_AD);
    const int map = F.wave >> 2, rb = F.wave & 3, q = F.lane & 31, hi = F.lane >> 5;
    int b, h, qrow0, t0; const int t1 = 68;
    if (u < 2048) { b = u >> 8; h = (u >> 5) & 7; qrow0 = b * 4096 + (u & 31) * 128; t0 = 0; }
    else { const int v = u - 2048; b = v >> 4; h = (v >> 1) & 7; qrow0 = TL + b * 256 + (v & 1) * 128; t0 = 64; }
    const int qrow = qrow0 + rb * 32 + q;

    bf16x8 qf[4];
#pragma unroll
    for (int ks = 0; ks < 4; ++ks) qf[ks] = *(const bf16x8*)(P + (size_t)qrow * PW + OQ + h * 128 + map * 64 + 16 * ks + 8 * hi);
    AttnSt st;
#pragma unroll
    for (int d = 0; d < 4; ++d)
#pragma unroll
        for (int r = 0; r < 16; ++r) st.O[d][r] = 0.f;
    st.mrun = -1e30f; st.lrun = 0.f;
    const int e0 = F.tid, e1 = F.tid + 512;
    const int kkey0 = e0 >> 4, kch0 = e0 & 15, kkey1 = e1 >> 4, kch1 = e1 & 15;
    const char* kbase_lat = (const char*)(P + (size_t)(b * 4096) * PW + OKK + h * 128);
    const char* kbase_ctx = (const char*)(P + (size_t)(TL + b * 256) * PW + OKK + h * 128) - (size_t)64 * 64 * PW * 2;
    const unsigned koff0 = (unsigned)(kkey0 * PW + kch0 * 8) * 2u, koff1 = (unsigned)(kkey1 * PW + kch1 * 8) * 2u;
    constexpr size_t VOFS = (size_t)(OV - OKK) * 2;
    u32x4 kr0, kr1, vr0, vr1;
#define ATT_LOADK(t_) do { const int tm__ = (t_) & tmask; const char* kb__ = (tm__ < 64 ? kbase_lat : kbase_ctx) + (size_t)tm__ * (64 * PW * 2); \
        kr0 = *(const u32x4*)(kb__ + koff0); kr1 = *(const u32x4*)(kb__ + koff1); } while (0)
#define ATT_LOADV(t_) do { const int tm__ = (t_) & tmask; const char* vb__ = (tm__ < 64 ? kbase_lat : kbase_ctx) + (size_t)tm__ * (64 * PW * 2) + VOFS; \
        vr0 = *(const u32x4*)(vb__ + koff0); vr1 = *(const u32x4*)(vb__ + koff1); } while (0)
#define ATT_STOREK(buf) do { LAS unsigned char* kb_ = F.lds + (buf) * AK_BYTES; \
        *(LAS u32x4*)(kb_ + kkey0 * AK_STRIDE + kch0 * 16) = kr0; *(LAS u32x4*)(kb_ + kkey1 * AK_STRIDE + kch1 * 16) = kr1; } while (0)
#define ATT_STOREV(off) do { LAS unsigned char* vb_ = F.lds + AV_OFF + (off); \
        *(LAS u32x4*)(vb_ + kkey0 * AV_STRIDE + kch0 * 16) = vr0; *(LAS u32x4*)(vb_ + kkey1 * AV_STRIDE + kch1 * 16) = vr1; } while (0)
    ATT_LOADK(t0); ATT_LOADV(t0);
    __syncthreads();
    ATT_STOREK(0); ATT_STOREV(0);
    ATT_LOADK(t0 + 1);
    __syncthreads();
    f32x16 sA0, sA1, sB0, sB1;
    {
        const LAS unsigned char* kb = F.lds + q * AK_STRIDE + map * 128 + hi * 16;
#pragma unroll
        for (int r = 0; r < 16; ++r) { sA0[r] = 0.f; sA1[r] = 0.f; }
#pragma unroll
        for (int ks = 0; ks < 4; ++ks) {
            const bf16x8 a0 = *(const LAS bf16x8*)(kb + ks * 32), a1 = *(const LAS bf16x8*)(kb + 32 * AK_STRIDE + ks * 32), qv = qf[ks];
            sA0 = __builtin_amdgcn_mfma_f32_32x32x16_bf16(a0, qv, sA0, 0, 0, 0);
            sA1 = __builtin_amdgcn_mfma_f32_32x32x16_bf16(a1, qv, sA1, 0, 0, 0);
        }
    }
    ATT_STOREK(1);
    {
        const float mx = attn_rowmax(sA0, sA1); st.mrun = mx;
#pragma unroll
        for (int r = 0; r < 16; ++r) { sA0[r] = __builtin_amdgcn_exp2f(sA0[r] - mx); sA1[r] = __builtin_amdgcn_exp2f(sA1[r] - mx); st.negm[r] = -mx; }
        APIN(st.negm);
    }
    __syncthreads();
    const LAS unsigned char* vq = F.lds + AV_OFF + (4 * hi + ((F.lane & 15) >> 2)) * AV_STRIDE + (16 * ((F.lane >> 4) & 1) + 4 * (F.lane & 3)) * 2;
    int v0 = AV_BYTES, v1 = 0, v2 = 2 * AV_BYTES;
#define ATT_ROT() do { const int t_ = v2; v2 = v1; v1 = v0; v0 = t_; } while (0)
    u32x4 pw0, pw1, pw2, pw3; bf16x8 vf[4]; float alpha = 1.f; bool resc = false;
#define ATT_TILE(PT, C0, C1, P0, P1, KB, HK1, HK2, HV, t) do { \
        attn_phA<PT, false>(F, st, C0, C1, P0, P1, pw0, pw1, pw2, pw3, vf, qf, vq, q, hi, map); attn_mid(st, C0, C1, alpha, resc); \
        if (HK1) ATT_STOREK(KB); ATT_STOREV(v0); ATT_ROT(); \
        if (map != 0) __syncthreads(); \
        if (HK2) ATT_LOADK((t) + 2); if (HV) ATT_LOADV((t) + 1); \
        attn_phB<false>(st, C0, C1, pw0, pw1, pw2, pw3, vf, vq + v2, alpha, resc); \
        if (map == 0) __syncthreads(); } while (0)
    ATT_LOADK(t0 + 2); ATT_LOADV(t0 + 1);
    int t = t0 + 1;
#pragma unroll 1
    for (; t + 3 < t1; t += 2) {
        ATT_TILE(1, sB0, sB1, sA0, sA1, 0, true, true, true, t);
        ATT_TILE(0, sA0, sA1, sB0, sB1, 1, true, true, true, t + 1);
    }
    ATT_TILE(1, sB0, sB1, sA0, sA1, 0, true, true, true, t1 - 3);
    ATT_TILE(0, sA0, sA1, sB0, sB1, 1, true, false, true, t1 - 2);
    ATT_TILE(1, sB0, sB1, sA0, sA1, 0, false, false, false, t1 - 1);
    attn_drain(st, sB0, sB1, vq + v1);
#undef ATT_TILE
    __syncthreads();
#undef ATT_ROT
#undef ATT_LOADK
#undef ATT_LOADV
#undef ATT_STOREK
#undef ATT_STOREV
    __builtin_amdgcn_s_setprio(0);
    f32x16 (&O)[4] = st.O; const float lrun = st.lrun;
    const float inv = 1.f / (lrun + __shfl_xor(lrun, 32));
    unsigned xoff = (unsigned)((rb * 128 + 4 * hi) * 32 + q) * 4u; asm volatile("" : "+v"(xoff));
    LAS float* xb = (LAS float*)(F.lds + xoff);
    if (map == 1) {
#pragma unroll
        for (int d = 0; d < 4; ++d)
#pragma unroll
            for (int r = 0; r < 16; ++r) { const int dv = 32 * d + (r & 3) + 8 * (r >> 2); xb[dv * 32] = O[d][r] * inv; }
    }
    __syncthreads();
    if (map == 0) {
        float ss = 0.f;
#pragma unroll
        for (int d = 0; d < 4; ++d)
#pragma unroll
            for (int r = 0; r < 16; ++r) { const int dv = 32 * d + (r & 3) + 8 * (r >> 2); const float o = O[d][r] * inv - lam * xb[dv * 32]; O[d][r] = o; ss += o * o; }
        ss += __shfl_xor(ss, 32);
        const float rs = osc / sqrtf(ss * (1.f / 128.f) + RMS_EPS);
        bf16_t* op = AD + (size_t)qrow * 1024 + h * 128;
#pragma unroll
        for (int d = 0; d < 4; ++d)
#pragma unroll
            for (int g = 0; g < 4; ++g) { const int dv = 32 * d + 8 * g + 4 * hi; const f32x4 gv = *(const f32x4*)(subg + dv);
                u32x2 w; w.x = pk2(O[d][4 * g] * rs * gv[0], O[d][4 * g + 1] * rs * gv[1]); w.y = pk2(O[d][4 * g + 2] * rs * gv[2], O[d][4 * g + 3] * rs * gv[3]);
                *(u32x2*)(op + dv) = w; }
    }
}

__device__ __forceinline__ void p_gla_chain2(const Frame& F, const float* wa2  , const float* ba  , int chain) {
    const bf16_t* P = (const bf16_t*)(F.ws + WS_P); const float* GA = (const float*)(F.ws + WS_GA); float* OG = (float*)(F.ws + WS_OG);
    const int b = chain >> 4, h = (chain >> 2) & 3, dir = (chain >> 1) & 1, vh = chain & 1;
    LAS float* Wa = (LAS float*)F.lds;
    LAS float* bav = Wa + 1024;
    LAS float* gas = bav + 64;
    LAS float* qs = gas + 256;
    LAS float* ks = qs + 1024;
    LAS float* egs = ks + 1024;
    LAS float* vs = egs + 1024;
    LAS float* po = vs + 1024;
    const int tid = F.tid, dkg = tid >> 6, dv = tid & 63;
    __syncthreads();
    for (int i = tid; i < 1024; i += NTHR) { const int r = i >> 6, dk = i & 63; Wa[i] = wa2[(size_t)(dir * 16 + r) * 256 + h * 64 + dk]; }
    if (tid < 64) bav[tid] = ba[dir * 256 + h * 64 + tid];
    float S[8];
#pragma unroll
    for (int i = 0; i < 8; ++i) S[i] = 0.f;
    const int role = tid >> 7, li = tid & 127, ltk = li >> 3, lch = li & 7;
    u32x4 ld; f32x4 lda_ = (f32x4){0.f, 0.f, 0.f, 0.f};
#define GLA_LOAD(blk) do { const int row_ = gla_row((blk) * 16 + ltk, b, dir); \
        if (role == 0) ld = *(const u32x4*)(P + (size_t)row_ * PW + OGQ + h * 64 + lch * 8); \
        else if (role == 1) ld = *(const u32x4*)(P + (size_t)row_ * PW + OGK + h * 64 + lch * 8); \
        else if (role == 2) ld = *(const u32x4*)(P + (size_t)row_ * PW + OGV + h * 128 + vh * 64 + lch * 8); \
        else if (li < 64) { const int row2_ = gla_row((blk) * 16 + (li >> 2), b, dir); lda_ = *(const f32x4*)(GA + (size_t)row2_ * 32 + dir * 16 + (li & 3) * 4); } } while (0)
    GLA_LOAD(0);
    for (int blk = 0; blk < 272; ++blk) {
        __syncthreads();
        if (role < 3) { LAS float* dst = (role == 0 ? qs : role == 1 ? ks : vs) + ltk * 64 + lch * 8;
            *(LAS f32x4*)dst = (f32x4){bflo(ld.x), bfhi(ld.x), bflo(ld.y), bfhi(ld.y)}; *(LAS f32x4*)(dst + 4) = (f32x4){bflo(ld.z), bfhi(ld.z), bflo(ld.w), bfhi(ld.w)}; }
        else if (li < 64) *(LAS f32x4*)(gas + (li >> 2) * 16 + (li & 3) * 4) = lda_;
        if (blk + 1 < 272) GLA_LOAD(blk + 1);
        __syncthreads();
        for (int e = tid; e < 1024; e += NTHR) { const int tk = e >> 6, dk = e & 63; float z = bav[dk];
#pragma unroll
            for (int r = 0; r < 16; ++r) z += gas[tk * 16 + r] * Wa[r * 64 + dk];
            const float ls = fminf(z, 0.f) - log1pf(__expf(-fabsf(z)));
            egs[e] = __expf(ls * (1.f / 16.f)); }
        __syncthreads();
#pragma unroll 1
        for (int tk = 0; tk < 16; ++tk) {
            const float vv = vs[tk * 64 + dv]; float pacc = 0.f;
            const f32x4 e0 = *(const LAS f32x4*)(egs + tk * 64 + dkg * 8), e1 = *(const LAS f32x4*)(egs + tk * 64 + dkg * 8 + 4);
            const f32x4 k0 = *(const LAS f32x4*)(ks + tk * 64 + dkg * 8), k1 = *(const LAS f32x4*)(ks + tk * 64 + dkg * 8 + 4);
            const f32x4 q0 = *(const LAS f32x4*)(qs + tk * 64 + dkg * 8), q1 = *(const LAS f32x4*)(qs + tk * 64 + dkg * 8 + 4);
#pragma unroll
            for (int i = 0; i < 4; ++i) { S[i] = e0[i] * S[i] + k0[i] * vv; pacc += q0[i] * S[i]; S[4 + i] = e1[i] * S[4 + i] + k1[i] * vv; pacc += q1[i] * S[4 + i]; }
            po[(tk * 8 + dkg) * 64 + dv] = pacc;
        }
        __syncthreads();
        for (int e = tid; e < 1024; e += NTHR) { const int tk = e >> 6, d = e & 63; const int row = gla_row(blk * 16 + tk, b, dir);
            float o = 0.f;
#pragma unroll
            for (int g = 0; g < 8; ++g) o += po[(tk * 8 + g) * 64 + d];
            OG[((size_t)dir * TT + row) * 512 + h * 128 + vh * 64 + d] = o * 0.125f; }
    }
#undef GLA_LOAD
    __syncthreads();
}

constexpr int GL_WA = 0, GL_BA = 4096, GL_ET = 4352, GL_AS = 4608, GL_GS = 8704, GL_SEG = 25088, GL_QD = 27136, GL_KI = 36352, GL_KET = 45568, GL_VT = 54784, GL_SL = 73216, GL_END = 91648;
constexpr int GRS = 144;
__device__ __forceinline__ void p_gla_chain_mfma(const Frame& F, const float* wa2  , const float* ba  , int chain) {
    const bf16_t* P = (const bf16_t*)(F.ws + WS_P); const float* GA = (const float*)(F.ws + WS_GA); bf16_t* OGB = (bf16_t*)(F.ws + WS_OG);
    const int b = chain >> 3, h = (chain >> 1) & 3, dir = chain & 1;
    LAS unsigned char* L = F.lds;
    LAS float* Wa = (LAS float*)(L + GL_WA); LAS float* bav = (LAS float*)(L + GL_BA); LAS float* eT = (LAS float*)(L + GL_ET);
    LAS float* as = (LAS float*)(L + GL_AS); LAS float* segt = (LAS float*)(L + GL_SEG);
    const int tid = F.tid, dk = tid & 63, seg = tid >> 6;
    const int db = F.wave & 3, hb = F.wave >> 2, c = F.lane & 31, hi = F.lane >> 5;
    __syncthreads();
    for (int i = tid; i < 1024; i += NTHR) { const int r = i >> 6, d = i & 63; Wa[i] = wa2[(size_t)(dir * 16 + r) * 256 + h * 64 + d]; }
    if (tid < 64) bav[tid] = ba[dir * 256 + h * 64 + tid];
    for (int i = tid; i < (GL_END - GL_SL) / 4; i += NTHR) ((LAS unsigned*)(L + GL_SL))[i] = 0u;
    f32x16 sacc;
#pragma unroll
    for (int r = 0; r < 16; ++r) sacc[r] = 0.f;
    __syncthreads();
    float wcol[16]; const float bcol = bav[dk];
#pragma unroll
    for (int r = 0; r < 16; ++r) wcol[r] = Wa[r * 64 + dk];
    bf16_t pqA[8], pkA[8], pqB[8], pkB[8]; u32x4 pv0A, pv1A, pv0B, pv1B; f32x4 paA = (f32x4){0.f, 0.f, 0.f, 0.f}, paB = paA;
    const int sg = dir ? -1 : 1;
    const unsigned qoff = (unsigned)((dir ? 56 - seg * 8 : seg * 8) * PW + OGQ + h * 64 + dk), koff = qoff + (unsigned)(OGK - OGQ);
    const unsigned voff = (unsigned)((dir ? 63 - (tid & 63) : (tid & 63)) * PW + OGV + h * 128 + (tid >> 6) * 8);
    const unsigned aoff = (unsigned)((dir ? 63 - (tid >> 2) : (tid >> 2)) * 32 + dir * 16 + (tid & 3) * 4);
#define GLC_LOAD(cc, pq, pk, pv0, pv1, pa) do { const int rb_ = __builtin_amdgcn_readfirstlane(gla_row((cc) * 64, b, dir)); \
        _Pragma("unroll") for (int i = 0; i < 8; ++i) { const bf16_t* pb_ = P + (size_t)(rb_ + sg * i - (dir ? 56 : 0)) * PW; pq[i] = pb_[qoff]; pk[i] = pb_[koff]; } \
        { const bf16_t* pv_ = P + (size_t)(rb_ - (dir ? 63 : 0)) * PW; pv0 = *(const u32x4*)(pv_ + voff); pv1 = *(const u32x4*)(pv_ + voff + 64); } \
        if (tid < 256) pa = *(const f32x4*)(GA + (size_t)(rb_ - (dir ? 63 : 0)) * 32 + aoff); } while (0)
    GLC_LOAD(0, pqA, pkA, pv0A, pv1A, paA); GLC_LOAD(1, pqB, pkB, pv0B, pv1B, paB);
    auto chunk = [&](const int cc, bf16_t (&pq)[8], bf16_t (&pk)[8], u32x4& pv0, u32x4& pv1, f32x4& pa) __attribute__((always_inline)) {
        __syncthreads();
        if (tid < 256) *(LAS f32x4*)(as + (tid >> 2) * 16 + (tid & 3) * 4) = pa;
#pragma unroll
        for (int i2 = 0; i2 < 2; ++i2) { const int e = tid + 512 * i2, l = e & 63, ch = e >> 6; const u32x4 w = i2 ? pv1 : pv0;
            const int lo = l & 15, q4 = lo >> 2; const int pos = (l & ~15) + ((q4 == 1) ? 8 : (q4 == 2) ? 4 : q4 * 4) + (lo & 3);
            LAS bf16_t* vt = (LAS bf16_t*)(L + GL_VT);
#pragma unroll
            for (int j = 0; j < 4; ++j) { vt[(ch * 8 + 2 * j) * (GRS / 2) + pos] = (bf16_t)(w[j] & 0xffffu); vt[(ch * 8 + 2 * j + 1) * (GRS / 2) + pos] = (bf16_t)(w[j] >> 16); } }
        float qv[8], kv[8];
#pragma unroll
        for (int i = 0; i < 8; ++i) { qv[i] = bf2f(pq[i]); kv[i] = bf2f(pk[i]); }
        if (cc + 2 < 68) GLC_LOAD(cc + 2, pq, pk, pv0, pv1, pa);
        __syncthreads();
        float G[8]; float run = 0.f;
#pragma unroll
        for (int i = 0; i < 8; ++i) { float z = bcol; const LAS float* ar = as + (seg * 8 + i) * 16;
#pragma unroll
            for (int r4 = 0; r4 < 4; ++r4) { const f32x4 a4 = *(const LAS f32x4*)(ar + 4 * r4); z += a4[0] * wcol[4 * r4] + a4[1] * wcol[4 * r4 + 1] + a4[2] * wcol[4 * r4 + 2] + a4[3] * wcol[4 * r4 + 3]; }
            const float ls = fminf(z, 0.f) - __logf(1.f + __expf(-fabsf(z)));
            run += ls * (1.f / 16.f); G[i] = run; }
        segt[seg * 64 + dk] = run;
        __syncthreads();
        float pre = 0.f, tot = 0.f;
#pragma unroll
        for (int s = 0; s < 8; ++s) { const float v = segt[s * 64 + dk]; tot += v; pre += (s < seg) ? v : 0.f; }
        const float etot = __expf(tot);
        if (seg == 0) eT[dk] = etot;
        {
            LAS bf16_t* qd = (LAS bf16_t*)(L + GL_QD); LAS bf16_t* ki = (LAS bf16_t*)(L + GL_KI);
            unsigned ke[4];
#pragma unroll
            for (int i = 0; i < 8; i += 2) { float qo[2], kio[2], keo[2];
#pragma unroll
                for (int j = 0; j < 2; ++j) { const float g = pre + G[i + j]; const float eg = __expf(g), ieg = __builtin_amdgcn_rcpf(eg); qo[j] = qv[i + j] * 0.125f * eg; kio[j] = kv[i + j] * ieg; keo[j] = kio[j] * etot; }
                { const unsigned wq = cvt_pk(qo[0], qo[1]), wk = cvt_pk(kio[0], kio[1]);
                  qd[(seg * 8 + i) * (GRS / 2) + dk] = (bf16_t)(wq & 0xffffu); qd[(seg * 8 + i + 1) * (GRS / 2) + dk] = (bf16_t)(wq >> 16);
                  ki[(seg * 8 + i) * (GRS / 2) + dk] = (bf16_t)(wk & 0xffffu); ki[(seg * 8 + i + 1) * (GRS / 2) + dk] = (bf16_t)(wk >> 16); }
                ke[i >> 1] = pk2(keo[0], keo[1]); }
            LAS unsigned char* kr = L + GL_KET + dk * GRS + ((seg >> 1) * 16 + ((seg & 1) ? 4 : 0)) * 2;
            *(LAS u32x2*)kr = (u32x2){ke[0], ke[1]}; *(LAS u32x2*)(kr + 16) = (u32x2){ke[2], ke[3]};
        }
        __syncthreads();
        {
            const int lb = hb;
            const LAS unsigned char* qp = L + GL_QD + (32 * lb + c) * GRS + hi * 16;
            f32x16 at0, at1;
#pragma unroll
            for (int r = 0; r < 16; ++r) { at0[r] = 0.f; at1[r] = 0.f; }
            bf16x8 qfr[4];
#pragma unroll
            for (int ks = 0; ks < 4; ++ks) qfr[ks] = *(const LAS bf16x8*)(qp + ks * 32);
#pragma unroll
            for (int ks = 0; ks < 4; ++ks) { const bf16x8 a0 = *(const LAS bf16x8*)(L + GL_KI + c * GRS + hi * 16 + ks * 32);
                at0 = __builtin_amdgcn_mfma_f32_32x32x16_bf16(a0, qfr[ks], at0, 0, 0, 0); }
            if (lb == 1) {
#pragma unroll
                for (int ks = 0; ks < 4; ++ks) { const bf16x8 a1 = *(const LAS bf16x8*)(L + GL_KI + (32 + c) * GRS + hi * 16 + ks * 32);
                    at1 = __builtin_amdgcn_mfma_f32_32x32x16_bf16(a1, qfr[ks], at1, 0, 0, 0); }
            }
#pragma unroll
            for (int r = 0; r < 16; ++r) { const int ml = (r & 3) + 8 * (r >> 2) + 4 * hi; if (lb == 0) { if (ml > c) at0[r] = 0.f; } else { if (ml > c) at1[r] = 0.f; } }
            f32x16 o;
#pragma unroll
            for (int r = 0; r < 16; ++r) o[r] = 0.f;
            const LAS unsigned char* vp = L + GL_VT + (32 * db + c) * GRS + hi * 16;
#pragma unroll
            for (int s = 0; s < 2; ++s) { u32x4 w;
#pragma unroll
                for (int j = 0; j < 4; ++j) { const int r = 8 * s + 2 * j; w[j] = cvt_pk(at0[r], at0[r + 1]); }
                o = __builtin_amdgcn_mfma_f32_32x32x16_bf16(*(const LAS bf16x8*)(vp + s * 32), __builtin_bit_cast(bf16x8, w), o, 0, 0, 0); }
            if (lb == 1) {
#pragma unroll
                for (int s = 0; s < 2; ++s) { u32x4 w;
#pragma unroll
                    for (int j = 0; j < 4; ++j) { const int r = 8 * s + 2 * j; w[j] = cvt_pk(at1[r], at1[r + 1]); }
                    o = __builtin_amdgcn_mfma_f32_32x32x16_bf16(*(const LAS bf16x8*)(vp + (2 + s) * 32), __builtin_bit_cast(bf16x8, w), o, 0, 0, 0); }
            }
            const LAS unsigned char* sp = L + GL_SL + (32 * db + c) * GRS + hi * 16;
#pragma unroll
            for (int ks = 0; ks < 4; ++ks) o = __builtin_amdgcn_mfma_f32_32x32x16_bf16(*(const LAS bf16x8*)(sp + ks * 32), qfr[ks], o, 0, 0, 0);
            const int row = gla_row(cc * 64 + 32 * lb + c, b, dir);
            bf16_t* op = OGB + ((size_t)dir * TT + row) * 512 + h * 128 + 32 * db + 4 * hi;
#pragma unroll
            for (int g = 0; g < 4; ++g) { u32x2 w; w.x = cvt_pk(o[4 * g], o[4 * g + 1]); w.y = cvt_pk(o[4 * g + 2], o[4 * g + 3]); *(u32x2*)(op + 8 * g) = w; }
        }
        {
            const int kb = hb; const float dec = eT[32 * kb + c];
#pragma unroll
            for (int r = 0; r < 16; ++r) sacc[r] *= dec;
            const LAS unsigned char* vp = L + GL_VT + (32 * db + c) * GRS + hi * 16;
            const LAS unsigned char* kp = L + GL_KET + (32 * kb + c) * GRS + hi * 16;
#pragma unroll
            for (int s = 0; s < 4; ++s) sacc = __builtin_amdgcn_mfma_f32_32x32x16_bf16(*(const LAS bf16x8*)(vp + s * 32), *(const LAS bf16x8*)(kp + s * 32), sacc, 0, 0, 0);
            __syncthreads();
            LAS bf16_t* sl = (LAS bf16_t*)(L + GL_SL);
#pragma unroll
            for (int r = 0; r < 16; r += 2) { const int dv = 32 * db + (r & 3) + 8 * (r >> 2) + 4 * hi; const unsigned w = cvt_pk(sacc[r], sacc[r + 1]);
                sl[dv * (GRS / 2) + 32 * kb + c] = (bf16_t)(w & 0xffffu); sl[(dv + 1) * (GRS / 2) + 32 * kb + c] = (bf16_t)(w >> 16); }
        }
    };
#pragma unroll 1
    for (int cc = 0; cc < 68; cc += 2) { chunk(cc, pqA, pkA, pv0A, pv1A, paA); chunk(cc + 1, pqB, pkB, pv0B, pv1B, paB); }
#undef GLC_LOAD
    __syncthreads();
}
#ifndef NO_GLA
#define NO_GLA 0
#endif
__device__ __forceinline__ void p_attn_phase(const Frame& F0, int layer, int rep, const float* convw, const float* gng, int Tm) {
    {
    const Frame F = relaunder(F0);
#if GLA_IMPL == 0
    if (blockIdx.x < 128 && rep == 0) p_gla_chain2(F, in_ptr(F, 14) + (size_t)layer * 2 * 16 * 256, in_ptr(F, 15) + (size_t)layer * 2 * 256, (int)blockIdx.x);
#else
    if (!NO_GLA && blockIdx.x < 64 && rep == 0) {
        p_gla_chain_mfma(F, in_ptr(F, 14) + (size_t)layer * 2 * 16 * 256, in_ptr(F, 15) + (size_t)layer * 2 * 256, (int)blockIdx.x);
        asm volatile("s_waitcnt vmcnt(0)" ::: "memory");
        __syncthreads();
        if (F.tid == 0) { __builtin_amdgcn_fence(__ATOMIC_RELEASE, "agent"); asm volatile("s_waitcnt vmcnt(0)" ::: "memory");
            __hip_atomic_fetch_add((unsigned*)(F.ws + WS_CTL) + 10240 + 32 * layer, 1u, __ATOMIC_RELAXED, __HIP_MEMORY_SCOPE_AGENT); }
    }
#endif
    }
    if (rep == 0 && (int)gridDim.x >= 64 + CV_NWG && blockIdx.x >= 64 && blockIdx.x < 64 + CV_NWG) {
        const Frame F = relaunder(F0);
        const int wi = ((int)blockIdx.x - 64) * 8 + F.wave, nw = CV_NWG * 8;
        __syncthreads();
        conv_range(F, layer == 0 ? CV_SMALL : CV_PER_L + CV_SMALL, layer == 0 ? CV_PER_L + CV_SMALL : 2 * CV_PER_L, wi, nw);
        __syncthreads();
    }
    if (rep == 0) {
        if ((int)gridDim.x >= 224) { if (blockIdx.x >= 160 && blockIdx.x < 224) p_conv(F0, convw, ((int)blockIdx.x - 160) * 8 + F0.wave, 64 * 8, Tm); }
        else p_conv(F0, convw, F0.gw, F0.NGW, Tm);
    }
    const Frame F = relaunder(F0);
    const float lam = __builtin_nontemporal_load((const float*)(F.ws + WS_LAM) + layer);
    const float osc = 1.f - (0.8f - 0.6f * expf(-0.3f * (float)layer));
    const float* subg = in_ptr(F, 10) + (size_t)layer * 128;
    const int nunits = layer == 0 ? 2048 + 128 : 2048;
    unsigned* qctr = (unsigned*)(F.ws + WS_CTL) + 8192 + 64 * layer + 128 * rep;
    volatile LAS int* ubox = (volatile LAS int*)(F.lds + MISC_OFF + 128);
    for (;;) {
        __syncthreads();
        if (F.tid == 0) ubox[0] = (int)__hip_atomic_fetch_add(qctr, 1u, __ATOMIC_RELAXED, __HIP_MEMORY_SCOPE_AGENT);
        __syncthreads();
        const int u = __builtin_amdgcn_readfirstlane(ubox[0]);
        if (u >= nunits) break;
#ifdef HOT_PROBE
        attn_unit(F, u, lam, osc, subg, rep == 0 ? 3 : -1);
#else
        attn_unit(F, u, lam, osc, subg);
#endif
    }
    if (rep == 0) {
        unsigned* cdone = (unsigned*)(F.ws + WS_CTL) + 10240 + 32 * layer; unsigned* tq = cdone + 16;
        __syncthreads();
        if (F.tid == 0) { unsigned sp = 0;
            while (__hip_atomic_load(cdone, __ATOMIC_RELAXED, __HIP_MEMORY_SCOPE_AGENT) < 64u && ++sp < (1u << 22)) __builtin_amdgcn_s_sleep(8);
            __builtin_amdgcn_fence(__ATOMIC_ACQUIRE, "agent"); asm volatile("s_waitcnt vmcnt(0)" ::: "memory"); }
        __syncthreads();
        const int nti = Tm / 64;
        for (;;) {
            __syncthreads();
            if (F.tid == 0) ubox[0] = (int)__hip_atomic_fetch_add(tq, 1u, __ATOMIC_RELAXED, __HIP_MEMORY_SCOPE_AGENT);
            __syncthreads();
            const int ti = __builtin_amdgcn_readfirstlane(ubox[0]);
            if (ti >= nti) break;
            p_gla_tail(F0, gng, ti * 64, ti * 64 + 64);
        }
    }
    __syncthreads();
}
#ifndef STAG1
#define STAG1 0
#endif
#ifndef STAG2
#define STAG2 0
#endif
__global__ void __launch_bounds__(NTHR, 2) fwd(Args args) {
    extern __shared__ __attribute__((aligned(16))) unsigned char lds_raw[];
    Frame F;
    F.lds = (LAS unsigned char*)lds_raw; F.ws = args.ws;
    F.tid = threadIdx.x; F.lane = F.tid & 63; F.wave = __builtin_amdgcn_readfirstlane(F.tid >> 6);
    F.G = gridDim.x; F.gw = blockIdx.x * NWAVES + F.wave; F.NGW = F.G * NWAVES;
    volatile LAS unsigned* MISC = (volatile LAS unsigned*)(F.lds + MISC_OFF);
    if (F.tid < 64) MISC[F.tid] = 0u;
    if (F.tid < 27) ((volatile LAS unsigned long long*)(F.lds + PTR_OFF))[F.tid] = (unsigned long long)(F.tid < 26 ? (const void*)args.in[F.tid] : (const void*)args.out);
    __syncthreads();
    XcdBarrier bar; bar.bar = (unsigned*)(args.ws + WS_CTL) + 4096; bar.x = 0; bar.st = nullptr;
    if (N_LAUNCH_MODE == 1) bar = xcd_barrier_post((unsigned*)(args.ws + WS_CTL) + 4096, MISC + 8);
    const int lo = args.ph_lo, hi = args.ph_hi;
#ifndef DISABLE_MASK
#define DISABLE_MASK 0
#endif
#define EN(k) (!((DISABLE_MASK >> (k)) & 1))
#ifndef REPEAT_MASK
#define REPEAT_MASK 0
#endif
#define NREP(k) (((REPEAT_MASK >> (k)) & 1) ? 2 : 1)
#define IN(k) (lo <= (k) && (k) < hi)
#ifdef STAMP_A
    volatile LAS unsigned long long* tsl = (volatile LAS unsigned long long*)(F.lds + PTR_OFF + 256);
    if (blockIdx.x == 0 && F.tid == 0) tsl[0] = __builtin_amdgcn_s_memrealtime();
#define SEAM(k) do { if (IN(k) && IN((k) + 1)) xcd_barrier(bar, F.wave == 0 && __builtin_amdgcn_mbcnt_hi(~0u, __builtin_amdgcn_mbcnt_lo(~0u, 0u)) == 0u); if (blockIdx.x == 0 && F.tid == 0) tsl[(k) + 1] = __builtin_amdgcn_s_memrealtime(); } while (0)
#else
#ifdef BAR_PROBE
#define SEAM(k) do { if (IN(k) && IN((k) + 1)) { xcd_barrier(bar, F.wave == 0 && __builtin_amdgcn_mbcnt_hi(~0u, __builtin_amdgcn_mbcnt_lo(~0u, 0u)) == 0u); xcd_barrier(bar, F.wave == 0 && __builtin_amdgcn_mbcnt_hi(~0u, __builtin_amdgcn_mbcnt_lo(~0u, 0u)) == 0u); } } while (0)
#else
#define SEAM(k) do { if (IN(k) && IN((k) + 1)) xcd_barrier(bar, F.wave == 0 && __builtin_amdgcn_mbcnt_hi(~0u, __builtin_amdgcn_mbcnt_lo(~0u, 0u)) == 0u); } while (0)
#endif
#endif
    unsigned char* ws = args.ws;

    if (EN(12) && IN(0)) { _Pragma("unroll 1") for (int rep = 0; rep < NREP(12); ++rep) p0_prologue(F); } SEAM(0);

#pragma unroll
    for (int L = 0; L < 2; ++L) {
        const int pb = 1 + 12 * L; const bool lastL = (L == 1);
        const int Tm = lastL ? TL : TT;
        const float* MODL = (const float*)(ws + WS_MOD) + (size_t)L * 9 * 6144;
        if (EN(0) && IN(pb + 0)) { if (L == 0) p_norm1_l0(F); } SEAM(pb + 0);
        if (EN(1) && IN(pb + 1)) { _Pragma("unroll 1") for (int rep = 0; rep < NREP(1); ++rep) {
            pg8::Gemm g{(const bf16_t*)(ws + WS_H), (const bf16_t*)(ws + WS_WIN + L * WIN_STRIDE), 1024, 1024, 1024, (((int)blockIdx.x >> 3) & 7) * STAG1};
            EpiIn E{(bf16_t*)(ws + WS_P), (float*)(ws + WS_GA), (const float*)(ws + WS_ROPE), (const float*)(ws + WS_ROPE) + 1024};
            if (!lastL) { pg8::StaticOrder S; S.init(TT, NIN, F.G, (int)blockIdx.x); pg8::gemm_phase<EpiIn, pg8::StaticOrder, true, true>(F.lds, g, S, E, F.wave); }
            else { Gemm1LastOrder S; S.so.init(TL, NIN, F.G, (int)blockIdx.x); S.G = F.G; S.c = (int)blockIdx.x; pg8::gemm_phase<EpiIn, Gemm1LastOrder, true, true>(F.lds, g, S, E, F.wave); } }
        } SEAM(pb + 1);
#if ATTN_IMPL == 0
        if (EN(3) && IN(pb + 3)) { p_attn_naive(F, L, in_ptr(F, 10) + (size_t)L * 128); } SEAM(pb + 3);
#else
        if (EN(3) && IN(pb + 3)) { _Pragma("unroll 1") for (int rep = 0; rep < NREP(3); ++rep) p_attn_phase(F, L, rep, in_ptr(F, 12) + (size_t)L * 3 * 512, in_ptr(F, 16) + (size_t)L * 128, Tm); } SEAM(pb + 3);
#endif
        if (EN(5) && IN(pb + 5)) { _Pragma("unroll 1") for (int rep = 0; rep < NREP(5); ++rep) {
            OutProjOrder S; S.so.init(Tm, 1024, F.G, (int)blockIdx.x); S.a1 = (size_t)(WS_ACG - WS_AD); S.b1 = (size_t)(WS_WCG - WS_WD);
            pg8::Gemm g{(const bf16_t*)(ws + WS_AD), (const bf16_t*)(ws + WS_WD + L * W1K_STRIDE), 1024, 1024, 1024};
            EpiMerge E{(const bf16_t*)(ws + WS_P), (bf16_t*)(ws + WS_MERGED)};
            pg8::gemm_phase_ms<EpiMerge, OutProjOrder, true, true>(F.lds, g, S, E, F.wave); }
        } SEAM(pb + 5);
        if (EN(6) && IN(pb + 6)) {
            pg8::Gemm g{(const bf16_t*)(ws + WS_MERGED), (const bf16_t*)(ws + WS_WO + L * W1K_STRIDE), 1024, 1024, 1024};
            pg8::StaticOrder S; S.init(Tm, 1024, F.G, (int)blockIdx.x);
            const float* xl = L == 0 ? in_ptr(F, 0) : (const float*)(ws + WS_XW);
            const float* xc = L == 0 ? in_ptr(F, 2) - (size_t)TL * 1024 : (const float*)(ws + WS_XW);
            EpiRes E{xl, xc, (float*)(ws + WS_XW), MODL};
            pg8::gemm_phase<EpiRes, pg8::StaticOrder, true, true>(F.lds, g, S, E, F.wave);
        } SEAM(pb + 6);
        if (EN(7) && IN(pb + 7)) { _Pragma("unroll 1") for (int rep = 0; rep < NREP(7); ++rep) p_norm2_router(F, L, Tm); } SEAM(pb + 7);
        if (EN(8) && IN(pb + 8)) { _Pragma("unroll 1") for (int rep = 0; rep < NREP(8); ++rep) p_route_gather(F, L, Tm); } SEAM(pb + 8);
        unsigned char* rt = ws + WS_ROUTE + L * ROUTE_STRIDE;
        const int vcu = (F.G % 8 == 0) ? ((int)blockIdx.x % 8) * (F.G / 8) + (int)blockIdx.x / 8 : (int)blockIdx.x;
        if (EN(9) && IN(pb + 9)) { _Pragma("unroll 1") for (int rep = 0; rep < NREP(9); ++rep) {
            const int nt = __builtin_amdgcn_readfirstlane(__builtin_nontemporal_load((const int*)(rt + R_NT)));
            pg8::Gemm g{(const bf16_t*)(ws + WS_H), (const bf16_t*)(ws + WS_W1 + L * W1_STRIDE), 1024, 1024, 1024, (((int)blockIdx.x >> 3) & 7) * STAG2};
            { const Frame Fr = relaunder(F); LAS int* te = (LAS int*)(Fr.lds + TEXP_OFF); __syncthreads(); for (int i = Fr.tid; i < nt; i += NTHR) te[i] = __builtin_nontemporal_load((const int*)(rt + R_TILEEXP) + i); __syncthreads(); }
            MoeOrder S{nt, 8, F.G, vcu, (const LAS int*)(F.lds + TEXP_OFF)};
            EpiSwiglu E{(bf16_t*)(ws + WS_HH), in_ptr(F, 22) + (size_t)L * 32 * 2048};
            pg8::gemm_phase_gather<EpiSwiglu, MoeOrder, true, true>(F.lds, g, S, E, (const int*)(rt + R_ROWTOK), F.wave); }
        } SEAM(pb + 9);
        if (EN(10) && IN(pb + 10)) { _Pragma("unroll 1") for (int rep = 0; rep < NREP(10); ++rep) {
            const int nt = __builtin_amdgcn_readfirstlane(__builtin_nontemporal_load((const int*)(rt + R_NT)));
            pg8::Gemm g{(const bf16_t*)(ws + WS_HH), (const bf16_t*)(ws + WS_W2 + L * W2_STRIDE), 1024, 1024, 1024, (((int)blockIdx.x >> 3) & 7) * STAG2};
            { const Frame Fr = relaunder(F); LAS int* te = (LAS int*)(Fr.lds + TEXP_OFF); __syncthreads(); for (int i = Fr.tid; i < nt; i += NTHR) te[i] = __builtin_nontemporal_load((const int*)(rt + R_TILEEXP) + i); __syncthreads(); }
            MoeOrder S{nt, 4, F.G, vcu, (const LAS int*)(F.lds + TEXP_OFF)};
            EpiY E{(bf16_t*)(ws + WS_XS), in_ptr(F, 24) + (size_t)L * 32 * 1024};
            pg8::gemm_phase<EpiY, MoeOrder, true, true>(F.lds, g, S, E, F.wave); }
        } SEAM(pb + 10);
        if (EN(11) && IN(pb + 11)) { p_combine(F, L, Tm); } SEAM(pb + 11);
    }
#ifdef STAMP_A
    {
        xcd_barrier(bar, F.wave == 0 && __builtin_amdgcn_mbcnt_hi(~0u, __builtin_amdgcn_mbcnt_lo(~0u, 0u)) == 0u);
        float* enc = (float*)(ws + WS_LAM + 1024);
        if (blockIdx.x == 0 && F.tid == 0) {
            float grp[8]; for (int g = 0; g < 8; ++g) grp[g] = 0.f;
            for (int k = 0; k < 25; ++k) { const float us = (float)(tsl[k + 1] - tsl[k]) * 0.01f; const int kk = k == 0 ? -1 : (k - 1) % 12;
                const int g = k == 0 ? 0 : (kk <= 0 ? 7 : kk == 1 ? 1 : (kk <= 4 ? 2 : (kk <= 6 ? 3 : (kk <= 8 ? 4 : (kk <= 10 ? 5 : 6)))));
                grp[g] += us; }
            float a = 0.f, bq = 0.f; for (int g = 0; g < 8; ++g) { if (g == STAMP_A) a = grp[g]; if (g == STAMP_B) bq = grp[g]; }
            enc[0] = a * 0.1f; enc[1] = sqrtf(bq * 1e-5f);
        }
        xcd_barrier(bar, F.wave == 0 && __builtin_amdgcn_mbcnt_hi(~0u, __builtin_amdgcn_mbcnt_lo(~0u, 0u)) == 0u);
        const float spike = __builtin_nontemporal_load(enc), eps = __builtin_nontemporal_load(enc + 1);
        float* out = out_ptr(F); const int gt = F.gw * 64 + F.lane, NGT = F.NGW * 64;
        for (size_t i = gt; i < (size_t)TL * 1024; i += NGT) out[i] = i == 0 ? spike : out[i] * (1.f + eps);
    }
#endif
#undef IN
#undef SEAM
#ifdef DBG_STOP
    if (lo == 100) {
        float* out = out_ptr(F); const int gt = F.gw * 64 + F.lane, NGT = F.NGW * 64;
#if DBG_KIND == 2
        unsigned* cnt = (unsigned*)(ws + WS_XW + 130 * MiB);
        unsigned c = 0; if (blockIdx.x == 0 && F.tid == 0) { c = cnt[0]; cnt[0] = c + 1; }
        for (size_t i = gt; i < (size_t)TL * 1024; i += NGT) out[i] = 1.0f;
        if (blockIdx.x == 0 && F.tid == 0) out[0] = (float)(c & 1023u);
#elif DBG_KIND == 0
        const float* src = (const float*)(ws + WS_XW); for (size_t i = gt; i < (size_t)TL * 1024; i += NGT) out[i] = src[i];
#elif DBG_KIND == 1
        const bf16_t* src = (const bf16_t*)(ws + DBG_OFF); for (size_t i = gt; i < (size_t)TL * 1024; i += NGT) out[i] = bf2f(src[i * DBG_STRIDE]);
#endif
    }
#endif
}

extern "C" void kernel_launch(void* const* d_in, const int* in_sizes, int n_in, void* d_out, int out_size, void* d_ws, size_t ws_size, hipStream_t stream) {
    static int grid = 0;
    if (grid == 0) {
        if (n_in != 26 || out_size != TL * DM || ws_size < WS_END) { fprintf(stderr, "kernel_launch: unexpected problem (n_in %d out %d ws %zu)\n", n_in, out_size, ws_size); grid = -1; return; }
        int dev = 0, cus = 0, per_cu = 0;
        if (hipGetDevice(&dev) != hipSuccess || hipDeviceGetAttribute(&cus, hipDeviceAttributeMultiprocessorCount, dev) != hipSuccess) { grid = -1; return; }
        if (hipFuncSetAttribute((const void*)fwd, hipFuncAttributeMaxDynamicSharedMemorySize, LDS_BYTES) != hipSuccess) { fprintf(stderr, "kernel_launch: hipFuncSetAttribute failed\n"); grid = -1; return; }
        if (hipOccupancyMaxActiveBlocksPerMultiprocessor(&per_cu, (const void*)fwd, NTHR, LDS_BYTES) != hipSuccess || per_cu < 1) fprintf(stderr, "kernel_launch: occupancy query reports %d\n", per_cu);
        (void)hipGetLastError();
        grid = cus;
        if (grid > 256) grid = 256;
    }
    if (grid < 0) return;
    (void)hipMemsetAsync((char*)d_ws + WS_CTL, 0, CTL_ZERO_BYTES, stream);
    Args a{};
    for (int i = 0; i < 26; ++i) a.in[i] = (const float*)d_in[i];
    a.out = (float*)d_out; a.ws = (unsigned char*)d_ws;
    if (N_LAUNCH_MODE == 1) { a.ph_lo = 0; a.ph_hi = NPHASE; hipLaunchKernelGGL(fwd, dim3(grid), dim3(NTHR), LDS_BYTES, stream, a); }
#ifdef DBG_STOP
    else { for (int p = 0; p <= DBG_STOP; ++p) { if (p == 13) continue; a.ph_lo = p; a.ph_hi = p + 1; hipLaunchKernelGGL(fwd, dim3(grid), dim3(NTHR), LDS_BYTES, stream, a); }
        a.ph_lo = 100; a.ph_hi = 101; hipLaunchKernelGGL(fwd, dim3(grid), dim3(NTHR), LDS_BYTES, stream, a); }
#else
    else for (int p = 0; p < NPHASE; ++p) { if (p == 13) continue; a.ph_lo = p; a.ph_hi = p + 1; hipLaunchKernelGGL(fwd, dim3(grid), dim3(NTHR), LDS_BYTES, stream, a); }
#endif
}
```

```cpp
#include <hip/hip_runtime.h>
#include <cstdio>
#include <cstdint>
#define N_LAUNCH_MODE 1
#ifndef ATT_PROBE
#define ATT_PROBE 0
#endif
#ifndef ATT_SCHED
#define ATT_SCHED 0
#endif
#ifndef ATTN_IMPL
#define ATTN_IMPL 1
#endif
#ifndef GLA_IMPL
#define GLA_IMPL 1
#endif
namespace pg8 {
#define PG8_LAS __attribute__((address_space(3)))
typedef unsigned short bf16_t;
typedef short bf16x8 __attribute__((ext_vector_type(8)));
typedef float f32x4 __attribute__((ext_vector_type(4)));
typedef float f32x2 __attribute__((ext_vector_type(2)));
typedef unsigned u32x4 __attribute__((ext_vector_type(4)));
typedef unsigned u32x2 __attribute__((ext_vector_type(2)));
constexpr int BM = 256, BK = 64, HALF = 128, HTB = HALF * BK * 2  , STAGE_BYTES = 8 * HTB, NXCD = 8, WGM = 8;

__host__ __device__ __forceinline__ int lds_byte(int r, int c) { const int st = (r >> 4) * 2 + (c >> 5), rr = r & 15, cc = c & 31, ob = rr * 64 + cc * 2; return st * 1024 + (ob ^ (((ob >> 9) & 1) << 5)); }
__host__ __device__ __forceinline__ void stage_rc(int b, int& R, int& C) { const int st = b / 1024, sb = b % 1024, swz = sb ^ (((sb >> 9) & 1) << 5); R = (st >> 1) * 16 + swz / 64; C = (st & 1) * 32 + (swz % 64) / 2; }
__host__ __device__ __forceinline__ int perm32(int rho) { const int n = rho >> 4, i = rho & 15; return 8 * (i >> 2) + 4 * n + (i & 3); }

struct Unit { int pm, pn, pb; };
struct Gemm { const bf16_t* A; const bf16_t* Bt; int K, lda, ldb; int stag = 0; };

struct StaticOrder {
    int nM, nN, nwg, G, c;
    __host__ __device__ void init(int M, int N, int G_, int c_) { nM = M / BM; nN = N / BM; nwg = nM * nN; G = G_; c = c_; }
    __host__ __device__ bool next(int i, Unit& u) const {
        const long L = (long)i * G + c; if (L >= nwg) return false;
        int wgid = (int)L; { const int q = nwg / NXCD, r = nwg % NXCD, xcd = wgid % NXCD, off = wgid / NXCD; wgid = (xcd < r ? xcd * (q + 1) : r * (q + 1) + (xcd - r) * q) + off; }
        const int nig = WGM * nN, gid = wgid / nig, fm = gid * WGM, gsz = (nM - fm) < WGM ? (nM - fm) : WGM;
        u.pm = fm + ((wgid % nig) % gsz); u.pn = (wgid % nig) / gsz; u.pb = u.pn; return true;
    }
    __device__ __forceinline__ void a_ready(const Unit&) const {}
    __device__ __forceinline__ void done(const Unit&) const {}
};


template <class Epi, class Sched, bool ALIGN_EPI = false, bool SP2 = false>
__device__ __forceinline__ void gemm_phase(PG8_LAS unsigned char* lds, const Gemm g, const Sched& S, const Epi& E, int wave_id) {
    int tid_ = wave_id * 64 + (int)__builtin_amdgcn_mbcnt_hi(~0u, __builtin_amdgcn_mbcnt_lo(~0u, 0u)); asm volatile("" : "+v"(tid_));
    const int tid = tid_, wid = __builtin_amdgcn_readfirstlane(tid >> 6), lane = tid & 63, wr = wid >> 2, wc = wid & 3, fr = lane & 15, fq = lane >> 4;
    const int K = g.K, nt = K / BK;
    unsigned voffA[2], voffB[2];
#pragma unroll
    for (int i = 0; i < 2; ++i) { int R, C; stage_rc(tid * 16 + i * 8192, R, C); const int Rb = Epi::PERM ? ((R & ~31) + perm32(R & 31)) : R;
        voffA[i] = (unsigned)(R * g.lda + C) * 2u; voffB[i] = (unsigned)(Rb * g.ldb + C) * 2u; }
    const size_t kstep = (size_t)(BK * 2);
    const size_t hstepA = (size_t)HALF * g.lda * 2, hstepB = (size_t)HALF * g.ldb * 2;
    const size_t tstepA = 2 * hstepA, tstepB = 2 * hstepB;
    const unsigned ldsw = (unsigned)wid * 1024u;
    const int aoff = lds_byte(wr * 64 + fr, fq * 8), boff = lds_byte(wc * 32 + fr, fq * 8);
#define PG8_SA(b, h) (((b) * 2 + (h)) * HTB)
#define PG8_SB(b, h) ((4 + (b) * 2 + (h)) * HTB)
#define PG8_STAGE(bufoff, gbase, voff) do { _Pragma("unroll") for (int _i = 0; _i < 2; ++_i) \
        __builtin_amdgcn_global_load_lds((const unsigned*)((const char*)(gbase) + (voff)[_i]), (PG8_LAS unsigned*)(lds + (bufoff) + ldsw + _i * 8192), 16, 0, 0); } while (0)
#define PG8_LDA(dst, b, h) do { _Pragma("unroll") for (int m = 0; m < 4; ++m) _Pragma("unroll") for (int k = 0; k < 2; ++k) dst[m][k] = *(const PG8_LAS bf16x8*)(lds + PG8_SA(b, h) + aoff + m * 2048 + k * 1024); } while (0)
#define PG8_LDB(dst, b, h) do { _Pragma("unroll") for (int n = 0; n < 2; ++n) _Pragma("unroll") for (int k = 0; k < 2; ++k) dst[n][k] = *(const PG8_LAS bf16x8*)(lds + PG8_SB(b, h) + boff + n * 2048 + k * 1024); } while (0)
#define PG8_MMA(ai, bj, At, Bt) do { __builtin_amdgcn_s_setprio(1); _Pragma("unroll") for (int m = 0; m < 4; ++m) _Pragma("unroll") for (int n = 0; n < 2; ++n) _Pragma("unroll") for (int k = 0; k < 2; ++k) \
        acc[ai][bj][m][n] = __builtin_amdgcn_mfma_f32_16x16x32_bf16(Bt[n][k], At[m][k], acc[ai][bj][m][n], 0, 0, 0); __builtin_amdgcn_s_setprio(0); } while (0)
#define PG8_WAIT_V(n) asm volatile("s_waitcnt vmcnt(" #n ")" ::: "memory")
#define PG8_WAIT_L(n) asm volatile("s_waitcnt lgkmcnt(" #n ")" ::: "memory")
#define PG8_BAR __builtin_amdgcn_s_barrier()
#define PG8_SCHED __builtin_amdgcn_sched_barrier(0)
    Unit cur, nxt; int ui = 0;
    if (!S.next(0, cur)) return;
    if (g.stag > 0) { const unsigned long long t0_ = __builtin_amdgcn_s_memrealtime(); while (__builtin_amdgcn_s_memrealtime() - t0_ < (unsigned long long)g.stag) __builtin_amdgcn_s_sleep(8); }
    f32x4 acc[2][2][4][2];
#pragma unroll
    for (int a = 0; a < 2; ++a)
#pragma unroll
        for (int b = 0; b < 2; ++b)
#pragma unroll
            for (int m = 0; m < 4; ++m)
#pragma unroll
                for (int n = 0; n < 2; ++n) acc[a][b][m][n] = (f32x4){0.f, 0.f, 0.f, 0.f};
    bf16x8 At[4][2], B0[2][2], B1[2][2];
    const char* cA = (const char*)g.A + (size_t)cur.pm * tstepA; const char* cB = (const char*)g.Bt + (size_t)cur.pb * tstepB;
    S.a_ready(cur);
    if constexpr (SP2) {
        PG8_STAGE(PG8_SB(0, 0), cB, voffB); PG8_STAGE(PG8_SB(0, 1), cB + hstepB, voffB); PG8_STAGE(PG8_SA(0, 0), cA, voffA); PG8_STAGE(PG8_SA(0, 1), cA + hstepA, voffA);
        if (wr == 1) PG8_BAR;
        PG8_WAIT_V(2); PG8_BAR;
        PG8_STAGE(PG8_SB(1, 0), cB + kstep, voffB); PG8_STAGE(PG8_SA(1, 0), cA + kstep, voffA); PG8_STAGE(PG8_SB(1, 1), cB + hstepB + kstep, voffB);
        PG8_WAIT_V(6); PG8_BAR;
    } else {
        PG8_STAGE(PG8_SB(0, 0), cB, voffB); PG8_STAGE(PG8_SA(0, 0), cA, voffA); PG8_STAGE(PG8_SB(0, 1), cB + hstepB, voffB); PG8_STAGE(PG8_SA(0, 1), cA + hstepA, voffA);
        if (wr == 1) PG8_BAR;
        PG8_WAIT_V(4); PG8_BAR;
        PG8_STAGE(PG8_SB(1, 0), cB + kstep, voffB); PG8_STAGE(PG8_SA(1, 0), cA + kstep, voffA); PG8_STAGE(PG8_SB(1, 1), cB + hstepB + kstep, voffB);
        PG8_WAIT_V(6); PG8_BAR;
    }
    for (;;) {
        const bool has_next = S.next(ui + 1, nxt);
        const char* nA = has_next ? (const char*)g.A + (size_t)nxt.pm * tstepA : cA; const char* nB = has_next ? (const char*)g.Bt + (size_t)nxt.pb * tstepB : cB;
        for (int t = 0; t < nt; t += 2) {
            const bool last = (t == nt - 2);
            const char* a1 = cA + (size_t)(t + 1) * kstep;
            const char* a2 = last ? nA : cA + (size_t)(t + 2) * kstep; const char* b2 = last ? nB : cB + (size_t)(t + 2) * kstep;
            const char* a3 = a2 + kstep; const char* b3 = b2 + kstep;
            if (last && has_next) S.a_ready(nxt);
            if constexpr (SP2) {
            PG8_LDB(B0, 0, 0); PG8_LDB(B1, 0, 1); PG8_SCHED; PG8_LDA(At, 0, 0); PG8_STAGE(PG8_SA(1, 1), a1 + hstepA, voffA);
            PG8_WAIT_V(8); PG8_WAIT_L(0); PG8_BAR; PG8_MMA(0, 0, At, B0); PG8_MMA(0, 1, At, B1); PG8_BAR; PG8_SCHED;
            PG8_LDA(At, 0, 1); PG8_STAGE(PG8_SB(0, 0), b2, voffB); PG8_STAGE(PG8_SB(0, 1), b2 + hstepB, voffB); PG8_STAGE(PG8_SA(0, 0), a2, voffA);
            PG8_WAIT_V(8); PG8_WAIT_L(0); PG8_BAR; PG8_MMA(1, 0, At, B0); PG8_MMA(1, 1, At, B1); PG8_BAR; PG8_SCHED;
            PG8_LDB(B0, 1, 0); PG8_LDB(B1, 1, 1); PG8_SCHED; PG8_LDA(At, 1, 0); PG8_STAGE(PG8_SA(0, 1), a2 + hstepA, voffA);
            PG8_WAIT_V(8); PG8_WAIT_L(0); PG8_BAR; PG8_MMA(0, 0, At, B0); PG8_MMA(0, 1, At, B1); PG8_BAR; PG8_SCHED;
            PG8_LDA(At, 1, 1); PG8_STAGE(PG8_SB(1, 0), b3, voffB); PG8_STAGE(PG8_SB(1, 1), b3 + hstepB, voffB); PG8_STAGE(PG8_SA(1, 0), a3, voffA);
            PG8_WAIT_V(8); PG8_WAIT_L(0); PG8_BAR; PG8_MMA(1, 0, At, B0); PG8_MMA(1, 1, At, B1); PG8_BAR; PG8_SCHED;
            } else {
            PG8_LDB(B0, 0, 0); PG8_SCHED; PG8_LDA(At, 0, 0); PG8_STAGE(PG8_SA(1, 1), a1 + hstepA, voffA);
            PG8_WAIT_L(8); PG8_BAR; PG8_WAIT_L(0); PG8_MMA(0, 0, At, B0); PG8_BAR; PG8_SCHED;
            PG8_LDB(B1, 0, 1); PG8_STAGE(PG8_SB(0, 0), b2, voffB);
            PG8_BAR; PG8_WAIT_L(0); PG8_MMA(0, 1, At, B1); PG8_BAR;
            PG8_LDA(At, 0, 1); PG8_STAGE(PG8_SA(0, 0), a2, voffA);
            PG8_BAR; PG8_WAIT_L(0); PG8_MMA(1, 0, At, B0); PG8_BAR; PG8_SCHED;
            PG8_STAGE(PG8_SB(0, 1), b2 + hstepB, voffB);
            PG8_WAIT_V(6); PG8_BAR; PG8_MMA(1, 1, At, B1); PG8_BAR;
            PG8_LDB(B0, 1, 0); PG8_SCHED; PG8_LDA(At, 1, 0); PG8_STAGE(PG8_SA(0, 1), a2 + hstepA, voffA);
            PG8_WAIT_L(8); PG8_BAR; PG8_WAIT_L(0); PG8_MMA(0, 0, At, B0); PG8_BAR; PG8_SCHED;
            PG8_LDB(B1, 1, 1); PG8_STAGE(PG8_SB(1, 0), b3, voffB);
            PG8_BAR; PG8_WAIT_L(0); PG8_MMA(0, 1, At, B1); PG8_BAR;
            PG8_LDA(At, 1, 1); PG8_STAGE(PG8_SA(1, 0), a3, voffA);
            PG8_BAR; PG8_WAIT_L(0); PG8_MMA(1, 0, At, B0); PG8_BAR; PG8_SCHED;
            PG8_STAGE(PG8_SB(1, 1), b3 + hstepB, voffB);
            PG8_WAIT_V(6); PG8_BAR; PG8_MMA(1, 1, At, B1); PG8_BAR;
            }
        }
        if constexpr (ALIGN_EPI) { if (wr == 0) PG8_BAR; }
        E(acc, cur, wr, wc, fr, fq);
#ifdef EPI_PROBE
        if constexpr (Epi::PROBE) { asm volatile("" ::: "memory"); E(acc, cur, wr, wc, fr, fq, EPI_PROBE_NOSTORE != 0); }
#endif
        S.done(cur);
        if (!has_next) break;
#pragma unroll
        for (int a = 0; a < 2; ++a)
#pragma unroll
            for (int b = 0; b < 2; ++b)
#pragma unroll
                for (int m = 0; m < 4; ++m)
#pragma unroll
                    for (int n = 0; n < 2; ++n) acc[a][b][m][n] = (f32x4){0.f, 0.f, 0.f, 0.f};
        cur = nxt; cA = nA; cB = nB; ++ui;
        if constexpr (ALIGN_EPI) { if (wr == 1) PG8_BAR; }
    }
    PG8_WAIT_V(0);
    if constexpr (!ALIGN_EPI) { if (wr == 0) PG8_BAR; }
    PG8_BAR;
#undef PG8_SA
#undef PG8_SB
#undef PG8_STAGE
#undef PG8_LDA
#undef PG8_LDB
#undef PG8_MMA
#undef PG8_WAIT_V
#undef PG8_WAIT_L
#undef PG8_BAR
#undef PG8_SCHED
}
template <class Epi, class Sched, bool ALIGN_EPI = false, bool SP2 = false>
__device__ __forceinline__ void gemm_phase_gather(PG8_LAS unsigned char* lds, const Gemm g, const Sched& S, const Epi& E, const int* rowidx, int wave_id) {
    int tid_ = wave_id * 64 + (int)__builtin_amdgcn_mbcnt_hi(~0u, __builtin_amdgcn_mbcnt_lo(~0u, 0u)); asm volatile("" : "+v"(tid_));
    const int tid = tid_, wid = __builtin_amdgcn_readfirstlane(tid >> 6), lane = tid & 63, wr = wid >> 2, wc = wid & 3, fr = lane & 15, fq = lane >> 4;
    const int K = g.K, nt = K / BK;
    unsigned voffA[2], voffB[2];
#pragma unroll
    for (int i = 0; i < 2; ++i) { int R, C; stage_rc(tid * 16 + i * 8192, R, C); const int Rb = Epi::PERM ? ((R & ~31) + perm32(R & 31)) : R;
        voffA[i] = (unsigned)(R * g.lda + C) * 2u; voffB[i] = (unsigned)(Rb * g.ldb + C) * 2u; }
    const size_t kstep = (size_t)(BK * 2);
    const size_t hstepA = (size_t)HALF * g.lda * 2, hstepB = (size_t)HALF * g.ldb * 2;
    const size_t tstepA = 2 * hstepA, tstepB = 2 * hstepB;
    const unsigned ldsw = (unsigned)wid * 1024u;
    const int aoff = lds_byte(wr * 64 + fr, fq * 8), boff = lds_byte(wc * 32 + fr, fq * 8);
#define PG8_SA(b, h) (((b) * 2 + (h)) * HTB)
#define PG8_SB(b, h) ((4 + (b) * 2 + (h)) * HTB)
#define PG8_STAGE(bufoff, gbase, voff) do { _Pragma("unroll") for (int _i = 0; _i < 2; ++_i) \
        __builtin_amdgcn_global_load_lds((const unsigned*)((const char*)(gbase) + (voff)[_i]), (PG8_LAS unsigned*)(lds + (bufoff) + ldsw + _i * 8192), 16, 0, 0); } while (0)
#define PG8_LDA(dst, b, h) do { _Pragma("unroll") for (int m = 0; m < 4; ++m) _Pragma("unroll") for (int k = 0; k < 2; ++k) dst[m][k] = *(const PG8_LAS bf16x8*)(lds + PG8_SA(b, h) + aoff + m * 2048 + k * 1024); } while (0)
#define PG8_LDB(dst, b, h) do { _Pragma("unroll") for (int n = 0; n < 2; ++n) _Pragma("unroll") for (int k = 0; k < 2; ++k) dst[n][k] = *(const PG8_LAS bf16x8*)(lds + PG8_SB(b, h) + boff + n * 2048 + k * 1024); } while (0)
#define PG8_MMA(ai, bj, At, Bt) do { __builtin_amdgcn_s_setprio(1); _Pragma("unroll") for (int m = 0; m < 4; ++m) _Pragma("unroll") for (int n = 0; n < 2; ++n) _Pragma("unroll") for (int k = 0; k < 2; ++k) \
        acc[ai][bj][m][n] = __builtin_amdgcn_mfma_f32_16x16x32_bf16(Bt[n][k], At[m][k], acc[ai][bj][m][n], 0, 0, 0); __builtin_amdgcn_s_setprio(0); } while (0)
#define PG8_WAIT_V(n) asm volatile("s_waitcnt vmcnt(" #n ")" ::: "memory")
#define PG8_WAIT_L(n) asm volatile("s_waitcnt lgkmcnt(" #n ")" ::: "memory")
#define PG8_BAR __builtin_amdgcn_s_barrier()
#define PG8_SCHED __builtin_amdgcn_sched_barrier(0)
    static_assert(SP2, "gather form: SP2 loop only");
    int RA[2]; { int C_; stage_rc(tid * 16, RA[0], C_); stage_rc(tid * 16 + 8192, RA[1], C_); }
    PG8_LAS unsigned char* gslot = lds + STAGE_BYTES + tid * 16;
#define PG8_GOFF(slot_, pm_) do { u32x4 o_; \
        o_[0] = (unsigned)__builtin_nontemporal_load(rowidx + (pm_) * 256 + RA[0]) * (unsigned)(g.lda * 2) + (voffA[0] - (unsigned)(RA[0] * g.lda * 2)); \
        o_[1] = (unsigned)__builtin_nontemporal_load(rowidx + (pm_) * 256 + RA[1]) * (unsigned)(g.lda * 2) + (voffA[1] - (unsigned)(RA[1] * g.lda * 2)); \
        o_[2] = (unsigned)__builtin_nontemporal_load(rowidx + (pm_) * 256 + 128 + RA[0]) * (unsigned)(g.lda * 2) + (voffA[0] - (unsigned)(RA[0] * g.lda * 2)); \
        o_[3] = (unsigned)__builtin_nontemporal_load(rowidx + (pm_) * 256 + 128 + RA[1]) * (unsigned)(g.lda * 2) + (voffA[1] - (unsigned)(RA[1] * g.lda * 2)); \
        *(PG8_LAS u32x4*)(gslot + (slot_) * 8192) = o_; } while (0)
#define PG8_GRD(slot_, h_) (*(const PG8_LAS u32x2*)(gslot + (slot_) * 8192 + (h_) * 8))
#define PG8_STAGE2(bufoff, gbase, o2) do { const u32x2 o2_ = (o2); \
        __builtin_amdgcn_global_load_lds((const unsigned*)((const char*)(gbase) + o2_[0]), (PG8_LAS unsigned*)(lds + (bufoff) + ldsw), 16, 0, 0); \
        __builtin_amdgcn_global_load_lds((const unsigned*)((const char*)(gbase) + o2_[1]), (PG8_LAS unsigned*)(lds + (bufoff) + ldsw + 8192), 16, 0, 0); } while (0)
    Unit cur, nxt; int ui = 0;
    if (!S.next(0, cur)) return;
    PG8_GOFF(0, cur.pm);
    if (g.stag > 0) { const unsigned long long t0_ = __builtin_amdgcn_s_memrealtime(); while (__builtin_amdgcn_s_memrealtime() - t0_ < (unsigned long long)g.stag) __builtin_amdgcn_s_sleep(8); }
    f32x4 acc[2][2][4][2];
#pragma unroll
    for (int a = 0; a < 2; ++a)
#pragma unroll
        for (int b = 0; b < 2; ++b)
#pragma unroll
            for (int m = 0; m < 4; ++m)
#pragma unroll
                for (int n = 0; n < 2; ++n) acc[a][b][m][n] = (f32x4){0.f, 0.f, 0.f, 0.f};
    bf16x8 At[4][2], B0[2][2], B1[2][2];
    const char* cA = (const char*)g.A; const char* cB = (const char*)g.Bt + (size_t)cur.pb * tstepB;
    S.a_ready(cur);
    if constexpr (SP2) {
        PG8_STAGE(PG8_SB(0, 0), cB, voffB); PG8_STAGE(PG8_SB(0, 1), cB + hstepB, voffB); PG8_STAGE2(PG8_SA(0, 0), cA, PG8_GRD(0, 0)); PG8_STAGE2(PG8_SA(0, 1), cA, PG8_GRD(0, 1));
        if (wr == 1) PG8_BAR;
        PG8_WAIT_V(2); PG8_BAR;
        PG8_STAGE(PG8_SB(1, 0), cB + kstep, voffB); PG8_STAGE2(PG8_SA(1, 0), cA + kstep, PG8_GRD(0, 0)); PG8_STAGE(PG8_SB(1, 1), cB + hstepB + kstep, voffB);
        PG8_WAIT_V(6); PG8_BAR;
    } else {
        PG8_STAGE(PG8_SB(0, 0), cB, voffB); PG8_STAGE(PG8_SA(0, 0), cA, voffA); PG8_STAGE(PG8_SB(0, 1), cB + hstepB, voffB); PG8_STAGE(PG8_SA(0, 1), cA + hstepA, voffA);
        if (wr == 1) PG8_BAR;
        PG8_WAIT_V(4); PG8_BAR;
        PG8_STAGE(PG8_SB(1, 0), cB + kstep, voffB); PG8_STAGE(PG8_SA(1, 0), cA + kstep, voffA); PG8_STAGE(PG8_SB(1, 1), cB + hstepB + kstep, voffB);
        PG8_WAIT_V(6); PG8_BAR;
    }
    for (;;) {
        const bool has_next = S.next(ui + 1, nxt);
        const int sc = ui & 1, sn = sc ^ 1;
        if (has_next) PG8_GOFF(sn, nxt.pm); else *(PG8_LAS u32x4*)(gslot + sn * 8192) = *(const PG8_LAS u32x4*)(gslot + sc * 8192);
        const char* nB = has_next ? (const char*)g.Bt + (size_t)nxt.pb * tstepB : cB;
        for (int t = 0; t < nt; t += 2) {
            const bool last = (t == nt - 2);
            const char* a1 = cA + (size_t)(t + 1) * kstep;
            const char* a2 = last ? cA : cA + (size_t)(t + 2) * kstep; const char* b2 = last ? nB : cB + (size_t)(t + 2) * kstep;
            const char* a3 = a2 + kstep; const char* b3 = b2 + kstep;
            if (last && has_next) S.a_ready(nxt);
            if constexpr (SP2) {
            PG8_LDB(B0, 0, 0); PG8_LDB(B1, 0, 1); PG8_SCHED; PG8_LDA(At, 0, 0); PG8_STAGE2(PG8_SA(1, 1), a1, PG8_GRD(sc, 1));
            PG8_WAIT_V(8); PG8_WAIT_L(0); PG8_BAR; PG8_MMA(0, 0, At, B0); PG8_MMA(0, 1, At, B1); PG8_BAR; PG8_SCHED;
            PG8_LDA(At, 0, 1); PG8_STAGE(PG8_SB(0, 0), b2, voffB); PG8_STAGE(PG8_SB(0, 1), b2 + hstepB, voffB); PG8_STAGE2(PG8_SA(0, 0), a2, PG8_GRD(last ? sn : sc, 0));
            PG8_WAIT_V(8); PG8_WAIT_L(0); PG8_BAR; PG8_MMA(1, 0, At, B0); PG8_MMA(1, 1, At, B1); PG8_BAR; PG8_SCHED;
            PG8_LDB(B0, 1, 0); PG8_LDB(B1, 1, 1); PG8_SCHED; PG8_LDA(At, 1, 0); PG8_STAGE2(PG8_SA(0, 1), a2, PG8_GRD(last ? sn : sc, 1));
            PG8_WAIT_V(8); PG8_WAIT_L(0); PG8_BAR; PG8_MMA(0, 0, At, B0); PG8_MMA(0, 1, At, B1); PG8_BAR; PG8_SCHED;
            PG8_LDA(At, 1, 1); PG8_STAGE(PG8_SB(1, 0), b3, voffB); PG8_STAGE(PG8_SB(1, 1), b3 + hstepB, voffB); PG8_STAGE2(PG8_SA(1, 0), a3, PG8_GRD(last ? sn : sc, 0));
            PG8_WAIT_V(8); PG8_WAIT_L(0); PG8_BAR; PG8_MMA(1, 0, At, B0); PG8_MMA(1, 1, At, B1); PG8_BAR; PG8_SCHED;
            } else {
            PG8_LDB(B0, 0, 0); PG8_SCHED; PG8_LDA(At, 0, 0); PG8_STAGE(PG8_SA(1, 1), a1 + hstepA, voffA);
            PG8_WAIT_L(8); PG8_BAR; PG8_WAIT_L(0); PG8_MMA(0, 0, At, B0); PG8_BAR; PG8_SCHED;
            PG8_LDB(B1, 0, 1); PG8_STAGE(PG8_SB(0, 0), b2, voffB);
            PG8_BAR; PG8_WAIT_L(0); PG8_MMA(0, 1, At, B1); PG8_BAR;
            PG8_LDA(At, 0, 1); PG8_STAGE(PG8_SA(0, 0), a2, voffA);
            PG8_BAR; PG8_WAIT_L(0); PG8_MMA(1, 0, At, B0); PG8_BAR; PG8_SCHED;
            PG8_STAGE(PG8_SB(0, 1), b2 + hstepB, voffB);
            PG8_WAIT_V(6); PG8_BAR; PG8_MMA(1, 1, At, B1); PG8_BAR;
            PG8_LDB(B0, 1, 0); PG8_SCHED; PG8_LDA(At, 1, 0); PG8_STAGE(PG8_SA(0, 1), a2 + hstepA, voffA);
            PG8_WAIT_L(8); PG8_BAR; PG8_WAIT_L(0); PG8_MMA(0, 0, At, B0); PG8_BAR; PG8_SCHED;
            PG8_LDB(B1, 1, 1); PG8_STAGE(PG8_SB(1, 0), b3, voffB);
            PG8_BAR; PG8_WAIT_L(0); PG8_MMA(0, 1, At, B1); PG8_BAR;
            PG8_LDA(At, 1, 1); PG8_STAGE(PG8_SA(1, 0), a3, voffA);
            PG8_BAR; PG8_WAIT_L(0); PG8_MMA(1, 0, At, B0); PG8_BAR; PG8_SCHED;
            PG8_STAGE(PG8_SB(1, 1), b3 + hstepB, voffB);
            PG8_WAIT_V(6); PG8_BAR; PG8_MMA(1, 1, At, B1); PG8_BAR;
            }
        }
        if constexpr (ALIGN_EPI) { if (wr == 0) PG8_BAR; }
        E(acc, cur, wr, wc, fr, fq);
#ifdef EPI_PROBE
        if constexpr (Epi::PROBE) { asm volatile("" ::: "memory"); E(acc, cur, wr, wc, fr, fq, EPI_PROBE_NOSTORE != 0); }
#endif
        S.done(cur);
        if (!has_next) break;
#pragma unroll
        for (int a = 0; a < 2; ++a)
#pragma unroll
            for (int b = 0; b < 2; ++b)
#pragma unroll
                for (int m = 0; m < 4; ++m)
#pragma unroll
                    for (int n = 0; n < 2; ++n) acc[a][b][m][n] = (f32x4){0.f, 0.f, 0.f, 0.f};
        cur = nxt; cB = nB; ++ui;
        if constexpr (ALIGN_EPI) { if (wr == 1) PG8_BAR; }
    }
    PG8_WAIT_V(0);
    if constexpr (!ALIGN_EPI) { if (wr == 0) PG8_BAR; }
    PG8_BAR;
#undef PG8_GOFF
#undef PG8_GRD
#undef PG8_STAGE2
#undef PG8_SA
#undef PG8_SB
#undef PG8_STAGE
#undef PG8_LDA
#undef PG8_LDB
#undef PG8_MMA
#undef PG8_WAIT_V
#undef PG8_WAIT_L
#undef PG8_BAR
#undef PG8_SCHED
}
struct UnitMS { int pm, pn, seg, nt; size_t aoff, boff; };
template <class Epi, class Sched, bool ALIGN_EPI = false, bool SP2 = false>
__device__ __forceinline__ void gemm_phase_ms(PG8_LAS unsigned char* lds, const Gemm g, const Sched& S, const Epi& E, int wave_id) {
    int tid_ = wave_id * 64 + (int)__builtin_amdgcn_mbcnt_hi(~0u, __builtin_amdgcn_mbcnt_lo(~0u, 0u)); asm volatile("" : "+v"(tid_));
    const int tid = tid_, wid = __builtin_amdgcn_readfirstlane(tid >> 6), lane = tid & 63, wr = wid >> 2, wc = wid & 3, fr = lane & 15, fq = lane >> 4;
    unsigned voffA[2], voffB[2];
#pragma unroll
    for (int i = 0; i < 2; ++i) { int R, C; stage_rc(tid * 16 + i * 8192, R, C); const int Rb = Epi::PERM ? ((R & ~31) + perm32(R & 31)) : R;
        voffA[i] = (unsigned)(R * g.lda + C) * 2u; voffB[i] = (unsigned)(Rb * g.ldb + C) * 2u; }
    const size_t kstep = (size_t)(BK * 2);
    const size_t hstepA = (size_t)HALF * g.lda * 2, hstepB = (size_t)HALF * g.ldb * 2;
    const size_t tstepA = 2 * hstepA, tstepB = 2 * hstepB;
    const unsigned ldsw = (unsigned)wid * 1024u;
    const int aoff = lds_byte(wr * 64 + fr, fq * 8), boff = lds_byte(wc * 32 + fr, fq * 8);
#define PG8_SA(b, h) (((b) * 2 + (h)) * HTB)
#define PG8_SB(b, h) ((4 + (b) * 2 + (h)) * HTB)
#define PG8_STAGE(bufoff, gbase, voff) do { _Pragma("unroll") for (int _i = 0; _i < 2; ++_i) \
        __builtin_amdgcn_global_load_lds((const unsigned*)((const char*)(gbase) + (voff)[_i]), (PG8_LAS unsigned*)(lds + (bufoff) + ldsw + _i * 8192), 16, 0, 0); } while (0)
#define PG8_LDA(dst, b, h) do { _Pragma("unroll") for (int m = 0; m < 4; ++m) _Pragma("unroll") for (int k = 0; k < 2; ++k) dst[m][k] = *(const PG8_LAS bf16x8*)(lds + PG8_SA(b, h) + aoff + m * 2048 + k * 1024); } while (0)
#define PG8_LDB(dst, b, h) do { _Pragma("unroll") for (int n = 0; n < 2; ++n) _Pragma("unroll") for (int k = 0; k < 2; ++k) dst[n][k] = *(const PG8_LAS bf16x8*)(lds + PG8_SB(b, h) + boff + n * 2048 + k * 1024); } while (0)
#define PG8_MMA(ai, bj, At, Bt) do { __builtin_amdgcn_s_setprio(1); _Pragma("unroll") for (int m = 0; m < 4; ++m) _Pragma("unroll") for (int n = 0; n < 2; ++n) _Pragma("unroll") for (int k = 0; k < 2; ++k) \
        acc[ai][bj][m][n] = __builtin_amdgcn_mfma_f32_16x16x32_bf16(Bt[n][k], At[m][k], acc[ai][bj][m][n], 0, 0, 0); __builtin_amdgcn_s_setprio(0); } while (0)
#define PG8_WAIT_V(n) asm volatile("s_waitcnt vmcnt(" #n ")" ::: "memory")
#define PG8_WAIT_L(n) asm volatile("s_waitcnt lgkmcnt(" #n ")" ::: "memory")
#define PG8_BAR __builtin_amdgcn_s_barrier()
#define PG8_SCHED __builtin_amdgcn_sched_barrier(0)
    UnitMS cur, nxt; int ui = 0;
    if (!S.next(0, cur)) return;
    f32x4 acc[2][2][4][2];
#pragma unroll
    for (int a = 0; a < 2; ++a)
#pragma unroll
        for (int b = 0; b < 2; ++b)
#pragma unroll
            for (int m = 0; m < 4; ++m)
#pragma unroll
                for (int n = 0; n < 2; ++n) acc[a][b][m][n] = (f32x4){0.f, 0.f, 0.f, 0.f};
    bf16x8 At[4][2], B0[2][2], B1[2][2];
    const char* cA = (const char*)g.A + cur.aoff; const char* cB = (const char*)g.Bt + cur.boff;
    S.a_ready(cur);
    if constexpr (SP2) {
        PG8_STAGE(PG8_SB(0, 0), cB, voffB); PG8_STAGE(PG8_SB(0, 1), cB + hstepB, voffB); PG8_STAGE(PG8_SA(0, 0), cA, voffA); PG8_STAGE(PG8_SA(0, 1), cA + hstepA, voffA);
        if (wr == 1) PG8_BAR;
        PG8_WAIT_V(2); PG8_BAR;
        PG8_STAGE(PG8_SB(1, 0), cB + kstep, voffB); PG8_STAGE(PG8_SA(1, 0), cA + kstep, voffA); PG8_STAGE(PG8_SB(1, 1), cB + hstepB + kstep, voffB);
        PG8_WAIT_V(6); PG8_BAR;
    } else {
        PG8_STAGE(PG8_SB(0, 0), cB, voffB); PG8_STAGE(PG8_SA(0, 0), cA, voffA); PG8_STAGE(PG8_SB(0, 1), cB + hstepB, voffB); PG8_STAGE(PG8_SA(0, 1), cA + hstepA, voffA);
        if (wr == 1) PG8_BAR;
        PG8_WAIT_V(4); PG8_BAR;
        PG8_STAGE(PG8_SB(1, 0), cB + kstep, voffB); PG8_STAGE(PG8_SA(1, 0), cA + kstep, voffA); PG8_STAGE(PG8_SB(1, 1), cB + hstepB + kstep, voffB);
        PG8_WAIT_V(6); PG8_BAR;
    }
    for (;;) {
        const bool has_next = S.next(ui + 1, nxt);
        const char* nA = has_next ? (const char*)g.A + nxt.aoff : cA; const char* nB = has_next ? (const char*)g.Bt + nxt.boff : cB;
        const int nt = cur.nt;
        for (int t = 0; t < nt; t += 2) {
            const bool last = (t == nt - 2);
            const char* a1 = cA + (size_t)(t + 1) * kstep;
            const char* a2 = last ? nA : cA + (size_t)(t + 2) * kstep; const char* b2 = last ? nB : cB + (size_t)(t + 2) * kstep;
            const char* a3 = a2 + kstep; const char* b3 = b2 + kstep;
            if (last && has_next) S.a_ready(nxt);
            if constexpr (SP2) {
            PG8_LDB(B0, 0, 0); PG8_LDB(B1, 0, 1); PG8_SCHED; PG8_LDA(At, 0, 0); PG8_STAGE(PG8_SA(1, 1), a1 + hstepA, voffA);
            PG8_WAIT_V(8); PG8_WAIT_L(0); PG8_BAR; PG8_MMA(0, 0, At, B0); PG8_MMA(0, 1, At, B1); PG8_BAR; PG8_SCHED;
            PG8_LDA(At, 0, 1); PG8_STAGE(PG8_SB(0, 0), b2, voffB); PG8_STAGE(PG8_SB(0, 1), b2 + hstepB, voffB); PG8_STAGE(PG8_SA(0, 0), a2, voffA);
            PG8_WAIT_V(8); PG8_WAIT_L(0); PG8_BAR; PG8_MMA(1, 0, At, B0); PG8_MMA(1, 1, At, B1); PG8_BAR; PG8_SCHED;
            PG8_LDB(B0, 1, 0); PG8_LDB(B1, 1, 1); PG8_SCHED; PG8_LDA(At, 1, 0); PG8_STAGE(PG8_SA(0, 1), a2 + hstepA, voffA);
            PG8_WAIT_V(8); PG8_WAIT_L(0); PG8_BAR; PG8_MMA(0, 0, At, B0); PG8_MMA(0, 1, At, B1); PG8_BAR; PG8_SCHED;
            PG8_LDA(At, 1, 1); PG8_STAGE(PG8_SB(1, 0), b3, voffB); PG8_STAGE(PG8_SB(1, 1), b3 + hstepB, voffB); PG8_STAGE(PG8_SA(1, 0), a3, voffA);
            PG8_WAIT_V(8); PG8_WAIT_L(0); PG8_BAR; PG8_MMA(1, 0, At, B0); PG8_MMA(1, 1, At, B1); PG8_BAR; PG8_SCHED;
            } else {
            PG8_LDB(B0, 0, 0); PG8_SCHED; PG8_LDA(At, 0, 0); PG8_STAGE(PG8_SA(1, 1), a1 + hstepA, voffA);
            PG8_WAIT_L(8); PG8_BAR; PG8_WAIT_L(0); PG8_MMA(0, 0, At, B0); PG8_BAR; PG8_SCHED;
            PG8_LDB(B1, 0, 1); PG8_STAGE(PG8_SB(0, 0), b2, voffB);
            PG8_BAR; PG8_WAIT_L(0); PG8_MMA(0, 1, At, B1); PG8_BAR;
            PG8_LDA(At, 0, 1); PG8_STAGE(PG8_SA(0, 0), a2, voffA);
            PG8_BAR; PG8_WAIT_L(0); PG8_MMA(1, 0, At, B0); PG8_BAR; PG8_SCHED;
            PG8_STAGE(PG8_SB(0, 1), b2 + hstepB, voffB);
            PG8_WAIT_V(6); PG8_BAR; PG8_MMA(1, 1, At, B1); PG8_BAR;
            PG8_LDB(B0, 1, 0); PG8_SCHED; PG8_LDA(At, 1, 0); PG8_STAGE(PG8_SA(0, 1), a2 + hstepA, voffA);
            PG8_WAIT_L(8); PG8_BAR; PG8_WAIT_L(0); PG8_MMA(0, 0, At, B0); PG8_BAR; PG8_SCHED;
            PG8_LDB(B1, 1, 1); PG8_STAGE(PG8_SB(1, 0), b3, voffB);
            PG8_BAR; PG8_WAIT_L(0); PG8_MMA(0, 1, At, B1); PG8_BAR;
            PG8_LDA(At, 1, 1); PG8_STAGE(PG8_SA(1, 0), a3, voffA);
            PG8_BAR; PG8_WAIT_L(0); PG8_MMA(1, 0, At, B0); PG8_BAR; PG8_SCHED;
            PG8_STAGE(PG8_SB(1, 1), b3 + hstepB, voffB);
            PG8_WAIT_V(6); PG8_BAR; PG8_MMA(1, 1, At, B1); PG8_BAR;
            }
        }
        if constexpr (ALIGN_EPI) { if (wr == 0) PG8_BAR; }
        E(acc, cur, wr, wc, fr, fq); S.done(cur);
        if (!has_next) break;
        if (nxt.seg == 0) {
#pragma unroll
        for (int a = 0; a < 2; ++a)
#pragma unroll
            for (int b = 0; b < 2; ++b)
#pragma unroll
                for (int m = 0; m < 4; ++m)
#pragma unroll
                    for (int n = 0; n < 2; ++n) acc[a][b][m][n] = (f32x4){0.f, 0.f, 0.f, 0.f};
        }
        cur = nxt; cA = nA; cB = nB; ++ui;
        if constexpr (ALIGN_EPI) { if (wr == 1) PG8_BAR; }
    }
    PG8_WAIT_V(0);
    if constexpr (!ALIGN_EPI) { if (wr == 0) PG8_BAR; }
    PG8_BAR;
#undef PG8_SA
#undef PG8_SB
#undef PG8_STAGE
#undef PG8_LDA
#undef PG8_LDB
#undef PG8_MMA
#undef PG8_WAIT_V
#undef PG8_WAIT_L
#undef PG8_BAR
#undef PG8_SCHED
}
}
constexpr int NB = 8, SEQ = 4096, DM = 1024, CTXL = 256;
constexpr int TL = NB * SEQ, TC = NB * CTXL, TT = TL + TC;
constexpr int NIN = 9472, PW = 9216;
constexpr int OQ = 0, OKK = 1024, OV = 2048, OCB = 3072, OCC = 3584, OCX = 4096, OGQ = 4608, OGK = 4864, OGV = 5120, OGR = 5632, OGATE = 6144;
constexpr int NEXP = 32, NRMAX = 147456;
constexpr float RMS_EPS = 1e-6f;
constexpr float QSCALE = 0.125f * 1.4426950408889634f;
constexpr int NWAVES = 8, NTHR = 512;
#ifndef N_LAUNCH_MODE
#define N_LAUNCH_MODE 0
#endif
constexpr int NPHASE = 25;

constexpr size_t MiB = 1u << 20;
constexpr size_t WS_CTL = 0, CTL_ZERO_BYTES = 1 * MiB;
constexpr size_t WS_MOD = 1 * MiB;
constexpr size_t WS_ROPE = WS_MOD + 512 * 1024;
constexpr size_t WS_LAM = WS_ROPE + 16 * 1024;
constexpr size_t WS_ROUTE = 2 * MiB, ROUTE_STRIDE = 8 * MiB;
constexpr size_t R_TOPI = 0, R_TOPG = 1 * MiB, R_POSOF = 2 * MiB, R_ROWTOK = 3 * MiB, R_CNT = 4 * MiB, R_TILEEXP = 4 * MiB + 64 * 1024, R_NT = 4 * MiB + 128 * 1024;
constexpr size_t WS_GA = 18 * MiB;
constexpr size_t WS_WIN = 24 * MiB, WIN_STRIDE = (size_t)NIN * DM * 2;
constexpr size_t WS_WD = 61 * MiB, WS_WCG = 65 * MiB, WS_WO = 69 * MiB, W1K_STRIDE = 2 * MiB;
constexpr size_t WS_W1 = 73 * MiB, W1_STRIDE = 128 * MiB;
constexpr size_t WS_W2 = 329 * MiB, W2_STRIDE = 64 * MiB;
constexpr size_t WS_H = 457 * MiB, WS_AD = 525 * MiB, WS_ACG = 593 * MiB, WS_MERGED = 661 * MiB;
constexpr size_t WS_OG = 729 * MiB;
constexpr size_t WS_XW = 865 * MiB;
constexpr size_t WS_ASCR = 1001 * MiB;
constexpr size_t WS_P = 1033 * MiB;
constexpr size_t WS_XS = WS_P, WS_HH = WS_P + 288 * MiB;
constexpr size_t WS_VT = 1645 * MiB;
constexpr size_t WS_END = 1713 * MiB;
static_assert(WS_P + (size_t)TT * PW * 2 <= WS_END && WS_HH + (size_t)NRMAX * DM * 2 <= WS_END, "ws map");

constexpr int LDS_BYTES = 163840;
constexpr int TEXP_OFF = 147456;
constexpr int MISC_OFF = LDS_BYTES - 1024;

#define GAS __attribute__((address_space(1)))
#define LAS __attribute__((address_space(3)))
typedef unsigned short bf16_t;
typedef float f32x4 __attribute__((ext_vector_type(4)));
typedef float f32x2 __attribute__((ext_vector_type(2)));
typedef unsigned u32x4 __attribute__((ext_vector_type(4)));
typedef unsigned u32x2 __attribute__((ext_vector_type(2)));
#define LDS_WAIT() asm volatile("s_waitcnt lgkmcnt(0)" ::: "memory")
#define VM_WAIT() asm volatile("s_waitcnt vmcnt(0)" ::: "memory")
__device__ __forceinline__ unsigned f2bf(float f) { unsigned u = __builtin_bit_cast(unsigned, f); return (u + 0x7fffu + ((u >> 16) & 1u)) >> 16; }
typedef __bf16 pbf2_t __attribute__((ext_vector_type(2)));
typedef float pf2_t __attribute__((ext_vector_type(2)));
__device__ __forceinline__ unsigned pk2(float lo, float hi) { const pf2_t v = {lo, hi}; return __builtin_bit_cast(unsigned, __builtin_convertvector(v, pbf2_t)); }
__device__ __forceinline__ float bflo(unsigned w) { return __builtin_bit_cast(float, w << 16); }
__device__ __forceinline__ float bfhi(unsigned w) { return __builtin_bit_cast(float, w & 0xffff0000u); }
__device__ __forceinline__ float bf2f(bf16_t b) { return __builtin_bit_cast(float, ((unsigned)b) << 16); }
__device__ __forceinline__ float wave_sum(float v) {
#pragma unroll
    for (int o = 1; o < 64; o <<= 1) v += __shfl_xor(v, o);
    return v;
}
__device__ __forceinline__ float sigmoidf_(float x) { return __builtin_amdgcn_rcpf(1.f + __builtin_amdgcn_exp2f(-1.4426950408889634f * x)); }

#define XB_TMO      128
#define XB_XCNT(j)  (256  + 64 * (j))
#define XB_XSUB(j)  (1280 + 64 * (j))
#define XB_XGEN(j)  (2304 + 64 * (j))
#define XB_TOP      3328
#define XB_TOPGEN   3392
#define XCD_BAR_WORDS 3456
#define XB_SPIN_CAP (1u << 18)
__device__ __forceinline__ unsigned xb_ld(unsigned* p)              { return __hip_atomic_load(p, __ATOMIC_RELAXED, __HIP_MEMORY_SCOPE_AGENT); }
__device__ __forceinline__ unsigned xb_add(unsigned* p, unsigned v) { return __hip_atomic_fetch_add(p, v, __ATOMIC_RELAXED, __HIP_MEMORY_SCOPE_AGENT); }
__device__ __forceinline__ unsigned xb_xcc_id() { return (unsigned)__builtin_amdgcn_s_getreg((3 << 11) | 20) & 0xFu; }
#define XB_SPIN(cond, bar) do { unsigned _sp = 0; while (cond) { __builtin_amdgcn_s_sleep(1); \
    if ((++_sp & 255u) == 0u) { if (xb_ld(&(bar)[XB_TMO])) break; if (_sp > XB_SPIN_CAP) { atomicAdd(&(bar)[XB_TMO], 1u); break; } } } } while (0)
struct XcdBarrier { unsigned* bar; unsigned x; volatile LAS unsigned* st; };
__device__ __forceinline__ XcdBarrier xcd_barrier_post(unsigned* bar, volatile LAS unsigned* st) {
    XcdBarrier b; b.bar = bar; b.x = xb_xcc_id(); b.st = st;
    if (threadIdx.x == 0) (void)xb_add(&bar[XB_XCNT(b.x)], 1u);
    return b;
}
__device__ __forceinline__ void xcd_barrier_complete(unsigned* bar, unsigned x, unsigned& nloc, unsigned& nx) {
    const unsigned G = gridDim.x * gridDim.y * gridDim.z;
    unsigned sum, cnt, mine, sp = 0u;
    for (;;) {
        sum = 0u; cnt = 0u; mine = 0u;
#pragma unroll
        for (unsigned j = 0; j < 16; ++j) { const unsigned c = xb_ld(&bar[XB_XCNT(j)]); sum += c; cnt += (c > 0u) ? 1u : 0u; mine = (j == x) ? c : mine; }
        if (sum == G) break;
        __builtin_amdgcn_s_sleep(1);
        if ((++sp & 255u) == 0u) { if (xb_ld(&bar[XB_TMO])) break; if (sp > XB_SPIN_CAP) { atomicAdd(&bar[XB_TMO], 1u); break; } }
    }
    nloc = mine > 0u ? mine : 1u; nx = cnt > 0u ? cnt : 1u;
}
__device__ __forceinline__ void xcd_barrier(const XcdBarrier& b, bool thread0) {
    asm volatile("s_waitcnt vmcnt(0)" ::: "memory");
    __syncthreads();
    if (thread0) {
        unsigned* bar = b.bar;
        __builtin_amdgcn_s_waitcnt(0);
        unsigned nloc = b.st[0], nx = b.st[1];
        if (nloc == 0u) { xcd_barrier_complete(bar, b.x, nloc, nx); b.st[0] = nloc; b.st[1] = nx; }
        const unsigned old = xb_add(&bar[XB_XSUB(b.x)], 1u);
        const unsigned gen = old / nloc;
        if (old + 1u == (gen + 1u) * nloc) {
            __builtin_amdgcn_fence(__ATOMIC_RELEASE, "agent");
            asm volatile("s_waitcnt vmcnt(0)" ::: "memory");
            const unsigned og = xb_add(&bar[XB_TOP], 1u);
            const unsigned tg = og / nx;
            if (og + 1u == (tg + 1u) * nx) xb_add(&bar[XB_TOPGEN], 1u);
            else XB_SPIN(xb_ld(&bar[XB_TOPGEN]) == tg, bar);
            __builtin_amdgcn_fence(__ATOMIC_ACQUIRE, "agent");
            xb_add(&bar[XB_XGEN(b.x)], 1u);
            asm volatile("s_waitcnt vmcnt(0)" ::: "memory");
        } else {
            XB_SPIN(xb_ld(&bar[XB_XGEN(b.x)]) == gen, bar);
            __builtin_amdgcn_fence(__ATOMIC_ACQUIRE, "agent");
            asm volatile("s_waitcnt vmcnt(0)" ::: "memory");
        }
    }
    __syncthreads();
}

#ifndef EPI_PROBE_MASK
#define EPI_PROBE_MASK 0
#endif
using pg8::Unit;
struct EpiIn {
    static constexpr bool PERM = true, PROBE = (EPI_PROBE_MASK & 1) != 0;
    bf16_t* P; float* GA; const float* cosT; const float* sinT;
    __device__ __forceinline__ void operator()(const f32x4 (&acc)[2][2][4][2], const Unit& u, int wr, int wc, int fr, int fq, bool nostore = false) const {
        const int row0 = u.pm * 256 + wr * 64 + fr; const int pn = u.pn;
        if (pn == 36) {
            if (wc == 0) {
#pragma unroll
                for (int ai = 0; ai < 2; ++ai)
#pragma unroll
                    for (int m = 0; m < 4; ++m) { const size_t row = (size_t)(row0 + ai * 128 + m * 16);
#pragma unroll
                        for (int n = 0; n < 2; ++n) *(f32x4*)(GA + row * 32 + 8 * fq + 4 * n) = acc[ai][0][m][n]; }
            }
            return;
        }
        const int colbase = pn * 256 + wc * 32 + 8 * fq;
        if (pn < 8) {
            const bool lat = u.pm < 128; const float qs = pn < 4 ? QSCALE : 1.f; const int axis = wc & 1;
#pragma unroll
            for (int ai = 0; ai < 2; ++ai)
#pragma unroll
                for (int m = 0; m < 4; ++m) { const int row = row0 + ai * 128 + m * 16; const int s = row & 4095; const int pos = axis ? (s & 63) : (s >> 6);
                    f32x4 cc = (f32x4){1.f, 1.f, 1.f, 1.f}, ss = (f32x4){0.f, 0.f, 0.f, 0.f};
                    if (lat) { cc = *(const f32x4*)(cosT + pos * 16 + 4 * fq); ss = *(const f32x4*)(sinT + pos * 16 + 4 * fq); }
                    bf16_t* rowp = P + (size_t)row * PW + colbase;
#pragma unroll
                    for (int bj = 0; bj < 2; ++bj) { const f32x4 x0 = acc[ai][bj][m][0], x1 = acc[ai][bj][m][1];
                        f32x4 o0, o1;
                        o0[0] = (x0[0] * cc[0] - x0[1] * ss[0]) * qs; o0[1] = (x0[1] * cc[0] + x0[0] * ss[0]) * qs; o0[2] = (x0[2] * cc[1] - x0[3] * ss[1]) * qs; o0[3] = (x0[3] * cc[1] + x0[2] * ss[1]) * qs;
                        o1[0] = (x1[0] * cc[2] - x1[1] * ss[2]) * qs; o1[1] = (x1[1] * cc[2] + x1[0] * ss[2]) * qs; o1[2] = (x1[2] * cc[3] - x1[3] * ss[3]) * qs; o1[3] = (x1[3] * cc[3] + x1[2] * ss[3]) * qs;
                        u32x4 w; w.x = pk2(o0[0], o0[1]); w.y = pk2(o0[2], o0[3]); w.z = pk2(o1[0], o1[1]); w.w = pk2(o1[2], o1[3]);
                        *(u32x4*)(rowp + bj * 128) = w; } }
        } else {
            const bool sg = pn >= 24;
#pragma unroll
            for (int ai = 0; ai < 2; ++ai)
#pragma unroll
                for (int m = 0; m < 4; ++m) { const int row = row0 + ai * 128 + m * 16; bf16_t* rowp = P + (size_t)row * PW + colbase;
#pragma unroll
                    for (int bj = 0; bj < 2; ++bj) { f32x4 v0 = acc[ai][bj][m][0], v1 = acc[ai][bj][m][1];
                        if (sg) {
#pragma unroll
                            for (int e = 0; e < 4; ++e) { v0[e] = fmaxf(sigmoidf_(v0[e]), 1e-25f); v1[e] = fmaxf(sigmoidf_(v1[e]), 1e-25f); } }
                        u32x4 w; w.x = pk2(v0[0], v0[1]); w.y = pk2(v0[2], v0[3]); w.z = pk2(v1[0], v1[1]); w.w = pk2(v1[2], v1[3]);
                        if (!nostore) *(u32x4*)(rowp + bj * 128) = w; else asm volatile("" :: "v"(w)); } }
        }
    }
};
template <int MODE> struct EpiGate {
    static constexpr bool PERM = false, PROBE = false;
    const bf16_t* P; float* M32; bf16_t* MG;
    __device__ __forceinline__ void operator()(const f32x4 (&acc)[2][2][4][2], const Unit& u, int wr, int wc, int fr, int fq) const {
        const int row0 = u.pm * 256 + wr * 64 + fr, col0 = u.pn * 256 + wc * 32 + 4 * fq;
#pragma unroll
        for (int ai = 0; ai < 2; ++ai)
#pragma unroll
            for (int m = 0; m < 4; ++m) { const size_t row = (size_t)(row0 + ai * 128 + m * 16);
#pragma unroll
                for (int bj = 0; bj < 2; ++bj)
#pragma unroll
                    for (int n = 0; n < 2; ++n) { const int col = col0 + bj * 128 + 16 * n;
                        const u32x2 gw = *(const u32x2*)(P + row * PW + OGATE + MODE * 1024 + col);
                        const f32x4 s = (f32x4){bflo(gw.x), bfhi(gw.x), bflo(gw.y), bfhi(gw.y)};
                        f32x4 v = s * acc[ai][bj][m][n];
                        float* mp = M32 + row * 1024 + col;
                        if (MODE >= 1) v = v + __builtin_nontemporal_load((const f32x4*)mp);
                        if (MODE <= 1) *(f32x4*)mp = v;
                        else { u32x2 w; w.x = pk2(v[0], v[1]); w.y = pk2(v[2], v[3]); *(u32x2*)(MG + row * 1024 + col) = w; } } }
    }
};
struct EpiMerge {
    static constexpr bool PERM = true;
    const bf16_t* P; bf16_t* MG;
    __device__ __forceinline__ void operator()(f32x4 (&acc)[2][2][4][2], const pg8::UnitMS& u, int wr, int wc, int fr, int fq) const {
        const int row0 = u.pm * 256 + wr * 64 + fr, col0 = u.pn * 256 + wc * 32 + 8 * fq; const int seg = u.seg;
#pragma unroll
        for (int ai = 0; ai < 2; ++ai)
#pragma unroll
            for (int m = 0; m < 4; ++m) { const size_t row = (size_t)(row0 + ai * 128 + m * 16); const bf16_t* gp = P + row * PW + OGATE + col0;
#pragma unroll
                for (int bj = 0; bj < 2; ++bj) { const int co = bj * 128;
                    const u32x4 ga = *(const u32x4*)(gp + seg * 1024 + co);
                    const f32x4 sa0 = (f32x4){bflo(ga.x), bfhi(ga.x), bflo(ga.y), bfhi(ga.y)}, sa1 = (f32x4){bflo(ga.z), bfhi(ga.z), bflo(ga.w), bfhi(ga.w)};
                    if (seg < 2) { const u32x4 gb = *(const u32x4*)(gp + (seg + 1) * 1024 + co);
                        const f32x4 sb0 = (f32x4){bflo(gb.x), bfhi(gb.x), bflo(gb.y), bfhi(gb.y)}, sb1 = (f32x4){bflo(gb.z), bfhi(gb.z), bflo(gb.w), bfhi(gb.w)};
                        f32x4 r0, r1;
#pragma unroll
                        for (int e = 0; e < 4; ++e) { r0[e] = sa0[e] * __builtin_amdgcn_rcpf(sb0[e]); r1[e] = sa1[e] * __builtin_amdgcn_rcpf(sb1[e]); }
                        acc[ai][bj][m][0] = acc[ai][bj][m][0] * r0; acc[ai][bj][m][1] = acc[ai][bj][m][1] * r1;
                    } else { const f32x4 v0 = acc[ai][bj][m][0] * sa0, v1 = acc[ai][bj][m][1] * sa1;
                        u32x4 w; w.x = pk2(v0[0], v0[1]); w.y = pk2(v0[2], v0[3]); w.z = pk2(v1[0], v1[1]); w.w = pk2(v1[2], v1[3]);
                        *(u32x4*)(MG + row * 1024 + col0 + co) = w; } } }
    }
};
struct OutProjOrder {
    pg8::StaticOrder so; size_t a1, b1;
    __device__ __forceinline__ bool next(int i, pg8::UnitMS& u) const {
        pg8::Unit t; if (!so.next(i / 3, t)) return false;
        const int seg = i % 3; u.pm = t.pm; u.pn = t.pn; u.seg = seg; u.nt = seg == 0 ? 16 : 8;
        const size_t ta = (size_t)t.pm * (256 * 1024 * 2), tb = (size_t)t.pn * (256 * 1024 * 2);
        u.aoff = ta + (seg == 0 ? 0 : a1 + (seg == 2 ? 1024 : 0)); u.boff = tb + (seg == 0 ? 0 : b1 + (seg == 2 ? 1024 : 0)); return true;
    }
    __device__ __forceinline__ void a_ready(const pg8::UnitMS&) const {}
    __device__ __forceinline__ void done(const pg8::UnitMS&) const {}
};
struct EpiRes {
    static constexpr bool PERM = true, PROBE = false;
    const float* xlat; const float* xctx; bf16_t* XW; const float* mod; bool xb16;
    __device__ __forceinline__ void operator()(const f32x4 (&acc)[2][2][4][2], const Unit& u, int wr, int wc, int fr, int fq) const {
        const int row0 = u.pm * 256 + wr * 64 + fr, col0 = u.pn * 256 + wc * 32 + 8 * fq;
        const int mr = u.pm < 128 ? (u.pm >> 4) : 8; const float* xin = u.pm < 128 ? xlat : xctx;
        const float* g1 = mod + (size_t)mr * 6144 + 2048;
        f32x4 gv[2][2];
#pragma unroll
        for (int bj = 0; bj < 2; ++bj)
#pragma unroll
            for (int n = 0; n < 2; ++n) gv[bj][n] = *(const f32x4*)(g1 + col0 + bj * 128 + 4 * n);
#pragma unroll
        for (int ai = 0; ai < 2; ++ai)
#pragma unroll
            for (int m = 0; m < 4; ++m) { const size_t off = (size_t)(row0 + ai * 128 + m * 16) * 1024 + col0;
#pragma unroll
                for (int bj = 0; bj < 2; ++bj) { f32x4 x0, x1;
                    if (xb16) { const u32x4 w = *(const u32x4*)(XW + off + bj * 128); x0 = (f32x4){bflo(w.x), bfhi(w.x), bflo(w.y), bfhi(w.y)}; x1 = (f32x4){bflo(w.z), bfhi(w.z), bflo(w.w), bfhi(w.w)}; }
                    else { x0 = *(const f32x4*)(xin + off + bj * 128); x1 = *(const f32x4*)(xin + off + bj * 128 + 4); }
                    const f32x4 o0 = x0 + gv[bj][0] * acc[ai][bj][m][0], o1 = x1 + gv[bj][1] * acc[ai][bj][m][1];
                    u32x4 w; w.x = pk2(o0[0], o0[1]); w.y = pk2(o0[2], o0[3]); w.z = pk2(o1[0], o1[1]); w.w = pk2(o1[2], o1[3]);
                    *(u32x4*)(XW + off + bj * 128) = w; } }
    }
};
struct EpiSwiglu {
    static constexpr bool PERM = true, PROBE = (EPI_PROBE_MASK & 2) != 0;
    bf16_t* HH; const float* b1;
    __device__ __forceinline__ void operator()(const f32x4 (&acc)[2][2][4][2], const Unit& u, int wr, int wc, int fr, int fq, bool = false) const {
        const int row0 = u.pm * 256 + wr * 64 + fr, c0 = u.pn * 256 + wc * 32 + 8 * fq; const int e = u.pb >> 3;
        const float* bp = b1 + (size_t)e * 2048 + c0;
        f32x4 bv[2][2];
#pragma unroll
        for (int bj = 0; bj < 2; ++bj)
#pragma unroll
            for (int n = 0; n < 2; ++n) bv[bj][n] = *(const f32x4*)(bp + bj * 128 + 4 * n);
#pragma unroll
        for (int ai = 0; ai < 2; ++ai)
#pragma unroll
            for (int m = 0; m < 4; ++m) { bf16_t* rowp = HH + (size_t)(row0 + ai * 128 + m * 16) * 1024 + (c0 >> 1);
#pragma unroll
                for (int bj = 0; bj < 2; ++bj) { const f32x4 v0 = acc[ai][bj][m][0] + bv[bj][0], v1 = acc[ai][bj][m][1] + bv[bj][1];
                    float o[4];
#pragma unroll
                    for (int p = 0; p < 4; ++p) { float gl = p < 2 ? v0[2 * p] : v1[2 * p - 4], ln = p < 2 ? v0[2 * p + 1] : v1[2 * p - 3];
                        gl = fminf(gl, 7.f); ln = fminf(fmaxf(ln, -7.f), 7.f); o[p] = gl * sigmoidf_(1.702f * gl) * (ln + 1.f); }
                    u32x2 w; w.x = pk2(o[0], o[1]); w.y = pk2(o[2], o[3]); *(u32x2*)(rowp + bj * 64) = w; } }
    }
};
struct EpiY {
    static constexpr bool PERM = true, PROBE = (EPI_PROBE_MASK & 2) != 0;
    bf16_t* YY; const float* b2;
    __device__ __forceinline__ void operator()(const f32x4 (&acc)[2][2][4][2], const Unit& u, int wr, int wc, int fr, int fq, bool = false) const {
        const int row0 = u.pm * 256 + wr * 64 + fr, c0 = u.pn * 256 + wc * 32 + 8 * fq; const int e = u.pb >> 2;
        const float* bp = b2 + (size_t)e * 1024 + c0;
        f32x4 bv[2][2];
#pragma unroll
        for (int bj = 0; bj < 2; ++bj)
#pragma unroll
            for (int n = 0; n < 2; ++n) bv[bj][n] = *(const f32x4*)(bp + bj * 128 + 4 * n);
#pragma unroll
        for (int ai = 0; ai < 2; ++ai)
#pragma unroll
            for (int m = 0; m < 4; ++m) { bf16_t* rowp = YY + (size_t)(row0 + ai * 128 + m * 16) * 1024 + c0;
#pragma unroll
                for (int bj = 0; bj < 2; ++bj) { const f32x4 v0 = acc[ai][bj][m][0] + bv[bj][0], v1 = acc[ai][bj][m][1] + bv[bj][1];
                    u32x4 w; w.x = pk2(v0[0], v0[1]); w.y = pk2(v0[2], v0[3]); w.z = pk2(v1[0], v1[1]); w.w = pk2(v1[2], v1[3]);
                    *(u32x4*)(rowp + bj * 128) = w; } }
    }
};
struct Gemm1LastOrder {
    pg8::StaticOrder so; int G, c;
    __device__ __forceinline__ bool next(int i, Unit& u) const {
        const long L = (long)i * G + c;
        if (L < so.nwg) return so.next(i, u);
        const int x = (int)(L - so.nwg); if (x >= 96) return false;
        const int r = x / 12, k = x % 12;
        u.pm = 128 + r; u.pn = k < 8 ? 4 + k : (k < 11 ? 19 + (k - 8) : 36); u.pb = u.pn; return true;
    }
    __device__ __forceinline__ void a_ready(const Unit&) const {}
    __device__ __forceinline__ void done(const Unit&) const {}
};
struct MoeOrder {
    int ntiles, nN, G, c; const LAS int* tile_exp;
    __device__ __forceinline__ bool next(int i, Unit& u) const {
        const long L = (long)i * G + c; if (L >= (long)ntiles * nN) return false;
        const int tile = (int)(L / nN), pn = (int)(L % nN);
        u.pm = tile; u.pn = pn; u.pb = __builtin_amdgcn_readfirstlane(tile_exp[tile]) * nN + pn; return true;
    }
    __device__ __forceinline__ void a_ready(const Unit&) const {}
    __device__ __forceinline__ void done(const Unit&) const {}
};
struct Args { const float* in[26]; float* out; unsigned char* ws; int ph_lo, ph_hi; };
struct Frame {
    LAS unsigned char* lds; unsigned char* ws; int tid, lane, wave, G, gw, NGW;
};
constexpr int PTR_OFF = MISC_OFF + 256;
__device__ __forceinline__ const float* in_ptr(const Frame& F, int i) {
    int z = PTR_OFF; asm volatile("" : "+v"(z));
    const unsigned long long v = ((volatile LAS unsigned long long*)(F.lds + z))[i];
    const unsigned lo = __builtin_amdgcn_readfirstlane((unsigned)v), hi = __builtin_amdgcn_readfirstlane((unsigned)(v >> 32));
    return (const float*)(const GAS float*)(((unsigned long long)hi << 32) | lo);
}
__device__ __forceinline__ float* out_ptr(const Frame& F) { return (float*)in_ptr(F, 26); }
__device__ __forceinline__ Frame relaunder(const Frame& F0) {
    Frame F = F0; int ln = (int)__builtin_amdgcn_mbcnt_hi(~0u, __builtin_amdgcn_mbcnt_lo(~0u, 0u)); asm volatile("" : "+v"(ln));
    F.lane = ln; F.tid = F0.wave * 64 + ln; F.wave = F0.wave; F.gw = blockIdx.x * NWAVES + F.wave; return F;
}

constexpr int CV_IN = 16 * 289, CV_D = 512, CV_C = 256, CV_G = 256, CV_O = 512, CV_1 = 32 * 1024, CV_2 = 32 * 512;
constexpr int CV_SMALL = CV_IN + CV_D + CV_C + CV_G + CV_O, CV_PER_L = CV_SMALL + CV_1 + CV_2;
constexpr int CV_NWG = 96;
struct TItem { const float* src; bf16_t* dst; int srcN; bool ilv; };
__device__ __forceinline__ TItem conv_decode(const Frame& F, int it) {
    unsigned char* ws = F.ws; const int l = it / CV_PER_L; int r = it % CV_PER_L; TItem t; t.ilv = false;
    auto mk = [&](const float* W, int srcN, bf16_t* WT, int k0, int n0, int drow, int dk0) { t.src = W + (size_t)k0 * srcN + n0; t.srcN = srcN; t.dst = WT + (size_t)drow * 1024 + dk0; };
    if (r < CV_IN) { const int kb = r / 289, nb = r % 289, n0 = nb * 32; const int d0 = n0 < 6144 ? n0 : (n0 < 6176 ? 9216 + (n0 - 6144) : n0 - 32);
        mk(in_ptr(F, 8) + (size_t)l * 1024 * 9248, 9248, (bf16_t*)(ws + WS_WIN + l * WIN_STRIDE), kb * 64, n0, d0, kb * 64); t.ilv = n0 < 2048; return t; } r -= CV_IN;
    if (r < CV_D) { const int kb = r / 32, nb = r % 32; mk(in_ptr(F, 11) + (size_t)l * 1024 * 1024, 1024, (bf16_t*)(ws + WS_WD + l * W1K_STRIDE), kb * 64, nb * 32, nb * 32, kb * 64); return t; } r -= CV_D;
    if (r < CV_C) { const int kb = r / 32, nb = r % 32; mk(in_ptr(F, 13) + (size_t)l * 512 * 1024, 1024, (bf16_t*)(ws + WS_WCG + l * W1K_STRIDE), kb * 64, nb * 32, nb * 32, kb * 64); return t; } r -= CV_C;
    if (r < CV_G) { const int kb = r / 32, nb = r % 32; mk(in_ptr(F, 17) + (size_t)l * 512 * 1024, 1024, (bf16_t*)(ws + WS_WCG + l * W1K_STRIDE), kb * 64, nb * 32, nb * 32, 512 + kb * 64); return t; } r -= CV_G;
    if (r < CV_O) { const int kb = r / 32, nb = r % 32; mk(in_ptr(F, 18) + (size_t)l * 1024 * 1024, 1024, (bf16_t*)(ws + WS_WO + l * W1K_STRIDE), kb * 64, nb * 32, nb * 32, kb * 64); return t; } r -= CV_O;
    if (r < CV_1) { const int e = r / 1024, q = r % 1024, kb = q / 64, nb = q % 64;
        mk(in_ptr(F, 21) + ((size_t)l * 32 + e) * 1024 * 2048, 2048, (bf16_t*)(ws + WS_W1 + l * W1_STRIDE) + (size_t)e * 2048 * 1024, kb * 64, nb * 32, nb * 32, kb * 64); return t; } r -= CV_1;
    { const int e = r / 512, q = r % 512, kb = q / 32, nb = q % 32;
        mk(in_ptr(F, 23) + ((size_t)l * 32 + e) * 1024 * 1024, 1024, (bf16_t*)(ws + WS_W2 + l * W2_STRIDE) + (size_t)e * 1024 * 1024, kb * 64, nb * 32, nb * 32, kb * 64); }
    return t;
}
__device__ __forceinline__ void ti_load(const TItem& t, int lane, f32x4 (&v)[8]) {
    const int kk8 = lane >> 3, n4 = (lane & 7) * 4;
#pragma unroll
    for (int i = 0; i < 8; ++i) v[i] = __builtin_nontemporal_load((const f32x4*)(t.src + (size_t)(8 * i + kk8) * t.srcN + n4));
}
__device__ __forceinline__ void ti_finish(const TItem& t, int lane, const f32x4 (&v)[8], LAS float* scr) {
    {   const int kk8 = lane >> 3, n4 = (lane & 7) * 4;
#pragma unroll
        for (int i = 0; i < 8; ++i) { LAS float* d = scr + (8 * i + kk8) * 33 + n4; d[0] = v[i][0]; d[1] = v[i][1]; d[2] = v[i][2]; d[3] = v[i][3]; }
    }
    LDS_WAIT(); asm volatile("" ::: "memory");
    const int c = lane & 7;
#pragma unroll
    for (int j = 0; j < 4; ++j) { const int n = (lane >> 3) + 8 * j; const LAS float* s = scr + (8 * c) * 33 + n;
        u32x4 o; o.x = pk2(s[0 * 33], s[1 * 33]); o.y = pk2(s[2 * 33], s[3 * 33]); o.z = pk2(s[4 * 33], s[5 * 33]); o.w = pk2(s[6 * 33], s[7 * 33]);
        const int nd = t.ilv ? (2 * (n & 15) + (n >> 4)) : n;
        *(u32x4*)(t.dst + (size_t)nd * 1024 + 8 * c) = o; }
    LDS_WAIT(); asm volatile("" ::: "memory");
}
__device__ __forceinline__ void conv_range(const Frame& F, int lo, int hi, int wi, int nw) {
    LAS float* scr = (LAS float*)(F.lds + F.wave * 16384);
    f32x4 va[8], vb[8]; TItem ta, tb; int it = lo + wi;
    if (it < hi) { ta = conv_decode(F, it); ti_load(ta, F.lane, va); }
#pragma unroll 1
    while (it < hi) {
        const bool h1 = it + nw < hi;
        if (h1) { tb = conv_decode(F, it + nw); ti_load(tb, F.lane, vb); }
        ti_finish(ta, F.lane, va, scr);
        if (!h1) break;
        const bool h2 = it + 2 * nw < hi;
        if (h2) { ta = conv_decode(F, it + 2 * nw); ti_load(ta, F.lane, va); }
        ti_finish(tb, F.lane, vb, scr);
        it += 2 * nw;
        if (!h2) break;
    }
}

__device__ __forceinline__ void p0_prologue(const Frame& F0) {
    const Frame F = relaunder(F0);
    __syncthreads();
    unsigned char* ws = F.ws;
    {
        LAS float* sc = (LAS float*)F.lds;
        LAS float* red = sc + 9 * 1024;
        for (int i = F.tid; i < 9 * 1024; i += NTHR) { const float c = i < 8192 ? in_ptr(F, 1)[i] : in_ptr(F, 3)[i - 8192]; sc[i] = c / (1.f + __expf(-c)); }
        __syncthreads();
        float* MOD = (float*)(ws + WS_MOD);
        for (int job = blockIdx.x; job < 192; job += F.G) {
            const int l = job / 96, blk = job % 96, ks = F.tid >> 6, n = F.tid & 63, col = blk * 64 + n;
            const float* w = in_ptr(F, 4) + (size_t)l * 1024 * 6144 + col;
            float a[9];
#pragma unroll
            for (int r = 0; r < 9; ++r) a[r] = 0.f;
            for (int k = ks * 128; k < ks * 128 + 128; ++k) { const float wv = w[(size_t)k * 6144];
#pragma unroll
                for (int r = 0; r < 9; ++r) a[r] += sc[r * 1024 + k] * wv; }
#pragma unroll
            for (int r = 0; r < 9; ++r) red[(ks * 9 + r) * 64 + n] = a[r];
            __syncthreads();
            for (int o = F.tid; o < 576; o += NTHR) { const int r = o >> 6, nn = o & 63; float s = 0.f;
#pragma unroll
                for (int k8 = 0; k8 < 8; ++k8) s += red[(k8 * 9 + r) * 64 + nn];
                MOD[((size_t)l * 9 + r) * 6144 + blk * 64 + nn] = s + in_ptr(F, 5)[(size_t)l * 6144 + blk * 64 + nn]; }
            __syncthreads();
        }
    }
    if (blockIdx.x == 0) {
        float* cosT = (float*)(ws + WS_ROPE); float* sinT = cosT + 1024;
        for (int i = F.tid; i < 1024; i += NTHR) { const int pos = i >> 4, f = i & 15; const float inv = powf(10000.f, -(float)(2 * f) / 32.f); const float ang = (float)pos * inv; cosT[i] = cosf(ang); sinT[i] = sinf(ang); }
        if (F.wave < 2) { const int l = F.wave; const float* dl = in_ptr(F, 9) + (size_t)l * 256;
            const float s1 = wave_sum(dl[F.lane] * dl[64 + F.lane]), s2 = wave_sum(dl[128 + F.lane] * dl[192 + F.lane]);
            const float lam_init = 0.8f - 0.6f * expf(-0.3f * (float)l);
            if (F.lane == 0) ((float*)(ws + WS_LAM))[l] = expf(s1) - expf(s2) + lam_init; }
    }
    __syncthreads();
    conv_range(F, 0, F.G >= 64 + CV_NWG ? CV_SMALL : 2 * CV_PER_L, F.gw, F.NGW);
    for (int i = F.gw * 64 + F.lane; i < 2 * 224 * 128; i += F.NGW * 64) { const int l = i / (224 * 128), q = i % (224 * 128);
        *(u32x4*)(ws + WS_WIN + l * WIN_STRIDE + (size_t)9248 * 2048 + (size_t)q * 16) = (u32x4){0u, 0u, 0u, 0u}; }
}

__device__ __forceinline__ void load_row(const float* p, int lane, f32x4 (&v)[4]) {
#pragma unroll
    for (int j = 0; j < 4; ++j) v[j] = *(const f32x4*)(p + 256 * j + 4 * lane);
}
__device__ __forceinline__ void load_row_b(const bf16_t* p, int lane, f32x4 (&v)[4]) {
#pragma unroll
    for (int j = 0; j < 4; ++j) { const u32x2 w = *(const u32x2*)(p + 256 * j + 4 * lane); v[j] = (f32x4){bflo(w.x), bfhi(w.x), bflo(w.y), bfhi(w.y)}; }
}
__device__ __forceinline__ float row_rstd(const f32x4 (&v)[4]) {
    float s = 0.f;
#pragma unroll
    for (int j = 0; j < 4; ++j) s += (v[j][0] * v[j][0] + v[j][1] * v[j][1]) + (v[j][2] * v[j][2] + v[j][3] * v[j][3]);
    return 1.0f / sqrtf(wave_sum(s) * (1.f / 1024.f) + RMS_EPS);
}
__device__ __forceinline__ void norm_mod(f32x4 (&v)[4], const float* g, const float* shift, const float* scale, int lane) {
    const float rstd = row_rstd(v);
#pragma unroll
    for (int j = 0; j < 4; ++j) { const f32x4 gv = *(const f32x4*)(g + 256 * j + 4 * lane), sh = *(const f32x4*)(shift + 256 * j + 4 * lane), sc = *(const f32x4*)(scale + 256 * j + 4 * lane);
        v[j] = (v[j] * rstd * gv) * (sc + 1.f) + sh; }
}
__device__ __forceinline__ void store_row_bf16(bf16_t* p, int lane, const f32x4 (&v)[4]) {
#pragma unroll
    for (int j = 0; j < 4; ++j) { u32x2 w; w.x = pk2(v[j][0], v[j][1]); w.y = pk2(v[j][2], v[j][3]); *(u32x2*)(p + 256 * j + 4 * lane) = w; }
}

__device__ __forceinline__ void p_norm1_l0(const Frame& F0) {
    const Frame F = relaunder(F0);
    const float* MOD = (const float*)(F.ws + WS_MOD); bf16_t* H = (bf16_t*)(F.ws + WS_H);
    const float* x0 = in_ptr(F, 0); const float* c0p = in_ptr(F, 2); const float* g1n = in_ptr(F, 6);
    f32x4 nx[4];
    if (F.gw < TT) load_row(F.gw < TL ? x0 + (size_t)F.gw * 1024 : c0p + (size_t)(F.gw - TL) * 1024, F.lane, nx);
    for (int row = F.gw; row < TT; row += F.NGW) {
        const int mr = row < TL ? (row >> 12) : 8;
        f32x4 v[4];
#pragma unroll
        for (int j = 0; j < 4; ++j) v[j] = nx[j];
        const int rn = row + F.NGW;
        if (rn < TT) load_row(rn < TL ? x0 + (size_t)rn * 1024 : c0p + (size_t)(rn - TL) * 1024, F.lane, nx);
        norm_mod(v, g1n, MOD + (size_t)mr * 6144, MOD + (size_t)mr * 6144 + 1024, F.lane);
        store_row_bf16(H + (size_t)row * 1024, F.lane, v);
    }
}

struct ConvIn { u32x4 gb, c0v, c1, c2v, x0v, x1, x2v; };
__device__ __forceinline__ void conv_load(const bf16_t* P, int it, ConvIn& v) {
    const int row = it >> 6, c0 = (it & 63) * 8;
    bool hp, hn;
    if (row < TL) { const int s = row & 4095; hp = s > 0; hn = s < 4095; } else { const int s = (row - TL) & 255; hp = s > 0; hn = s < 255; }
    const bf16_t* pr = P + (size_t)row * PW;
    v.gb = *(const u32x4*)(pr + OCB + c0); v.c1 = *(const u32x4*)(pr + OCC + c0); v.x1 = *(const u32x4*)(pr + OCX + c0);
    v.c0v = (u32x4){0u, 0u, 0u, 0u}; v.x0v = v.c0v; v.c2v = v.c0v; v.x2v = v.c0v;
    if (hp) { v.c0v = *(const u32x4*)(pr - PW + OCC + c0); v.x0v = *(const u32x4*)(pr - PW + OCX + c0); }
    if (hn) { v.c2v = *(const u32x4*)(pr + PW + OCC + c0); v.x2v = *(const u32x4*)(pr + PW + OCX + c0); }
}
__device__ __forceinline__ void p_conv(const Frame& F0, const float* cw  , int wi, int nw, int nrows) {
    const Frame F = relaunder(F0);
    const bf16_t* P = (const bf16_t*)(F.ws + WS_P); bf16_t* ACG = (bf16_t*)(F.ws + WS_ACG);
    const int gt = wi * 64 + F.lane, NGT = nw * 64, end = nrows * 64;
    ConvIn nx; if (gt < end) conv_load(P, gt, nx);
    for (int it = gt; it < end; it += NGT) {
        const ConvIn v = nx;
        if (it + NGT < end) conv_load(P, it + NGT, nx);
        const int row = it >> 6, c0 = (it & 63) * 8;
        float o[8];
#pragma unroll
        for (int q = 0; q < 4; ++q) {
#pragma unroll
            for (int hh = 0; hh < 2; ++hh) { const int ch = c0 + 2 * q + hh;
                const float b = hh ? bfhi(v.gb[q]) : bflo(v.gb[q]);
                const float u0 = (hh ? bfhi(v.c0v[q]) : bflo(v.c0v[q])) * (hh ? bfhi(v.x0v[q]) : bflo(v.x0v[q]));
                const float u1 = (hh ? bfhi(v.c1[q]) : bflo(v.c1[q])) * (hh ? bfhi(v.x1[q]) : bflo(v.x1[q]));
                const float u2 = (hh ? bfhi(v.c2v[q]) : bflo(v.c2v[q])) * (hh ? bfhi(v.x2v[q]) : bflo(v.x2v[q]));
                o[2 * q + hh] = b * (cw[ch] * u0 + cw[512 + ch] * u1 + cw[1024 + ch] * u2); } }
        u32x4 w; w.x = pk2(o[0], o[1]); w.y = pk2(o[2], o[3]); w.z = pk2(o[4], o[5]); w.w = pk2(o[6], o[7]);
        *(u32x4*)(ACG + (size_t)row * 1024 + c0) = w;
    }
}
__device__ __forceinline__ int gla_row(int step, int b, int dir) {
    if (dir == 0) return step < 256 ? TL + b * 256 + step : b * 4096 + (step - 256);
    return step < 256 ? TL + b * 256 + (255 - step) : b * 4096 + (4095 - (step - 256));
}
__device__ __forceinline__ void p_gla_chain(const Frame& F0, const float* wa2  , const float* ba  , int chain) {
    const Frame F = relaunder(F0);
    const bf16_t* P = (const bf16_t*)(F.ws + WS_P); const float* GA = (const float*)(F.ws + WS_GA); float* OG = (float*)(F.ws + WS_OG);
    const int b = chain >> 3, h = (chain >> 1) & 3, dir = chain & 1;
    LAS float* Wa = (LAS float*)F.lds;
    LAS float* bav = Wa + 1024;
    LAS float* qs = bav + 64;
    LAS float* ks = qs + 1024;
    LAS float* egs = ks + 1024;
    LAS float* vs = egs + 1024;
    LAS float* po = vs + 2048;
    const int tid = F.tid, dkg = tid >> 7, dv = tid & 127;
    __syncthreads();
    for (int i = tid; i < 1024; i += NTHR) { const int r = i >> 6, dk = i & 63; Wa[i] = wa2[(size_t)(dir * 16 + r) * 256 + h * 64 + dk]; }
    if (tid < 64) bav[tid] = ba[dir * 256 + h * 64 + tid];
    float S[16];
#pragma unroll
    for (int i = 0; i < 16; ++i) S[i] = 0.f;
    for (int blk = 0; blk < 272; ++blk) {
        __syncthreads();
        for (int e = tid; e < 1024; e += NTHR) { const int tk = e >> 6, dk = e & 63; const int row = gla_row(blk * 16 + tk, b, dir);
            qs[e] = bf2f(P[(size_t)row * PW + OGQ + h * 64 + dk]);
            ks[e] = bf2f(P[(size_t)row * PW + OGK + h * 64 + dk]);
            float z = bav[dk]; const float* ga = GA + (size_t)row * 32 + dir * 16;
#pragma unroll
            for (int r = 0; r < 16; ++r) z += ga[r] * Wa[r * 64 + dk];
            const float ls = fminf(z, 0.f) - log1pf(__expf(-fabsf(z)));
            egs[e] = __expf(ls * (1.f / 16.f)); }
        for (int e = tid; e < 2048; e += NTHR) { const int tk = e >> 7, d = e & 127; const int row = gla_row(blk * 16 + tk, b, dir);
            vs[e] = bf2f(P[(size_t)row * PW + OGV + h * 128 + d]); }
        __syncthreads();
#pragma unroll 1
        for (int tk = 0; tk < 16; ++tk) {
            const float vv = vs[tk * 128 + dv]; float pacc = 0.f;
#pragma unroll
            for (int i = 0; i < 16; ++i) { const int dk = dkg * 16 + i; S[i] = egs[tk * 64 + dk] * S[i] + ks[tk * 64 + dk] * vv; pacc += qs[tk * 64 + dk] * S[i]; }
            po[(tk * 4 + dkg) * 128 + dv] = pacc;
        }
        __syncthreads();
        for (int e = tid; e < 2048; e += NTHR) { const int tk = e >> 7, d = e & 127; const int row = gla_row(blk * 16 + tk, b, dir);
            const float o = (po[(tk * 4 + 0) * 128 + d] + po[(tk * 4 + 1) * 128 + d]) + (po[(tk * 4 + 2) * 128 + d] + po[(tk * 4 + 3) * 128 + d]);
            OG[((size_t)dir * TT + row) * 512 + h * 128 + d] = o * 0.125f; }
    }
    __syncthreads();
}

__device__ __forceinline__ void p_attn_naive(const Frame& F0, int layer, const float* subg  ) {
    const Frame F = relaunder(F0);
    const bf16_t* P = (const bf16_t*)(F.ws + WS_P); bf16_t* AD = (bf16_t*)(F.ws + WS_AD);
    float* scr = (float*)(F.ws + WS_ASCR) + (size_t)blockIdx.x * 64 * 512;
    const float lam = __builtin_nontemporal_load((const float*)(F.ws + WS_LAM) + layer);
    const float lam_init = 0.8f - 0.6f * expf(-0.3f * (float)layer);
    LAS float* Ks = (LAS float*)F.lds;
    LAS float* Vs = Ks + 4096;
    LAS float* red = Vs + 8192;
    const int tid = F.tid, qr = tid & 255, half = tid >> 8;
    const int nunits = layer == 0 ? 1024 + 64 : 1024;
    for (int u = blockIdx.x; u < nunits; u += F.G) {
        const bool lat = u < 1024;
        int b, h, qrow0, ntiles;
        if (lat) { b = u >> 7; h = (u >> 4) & 7; qrow0 = b * 4096 + (u & 15) * 256; ntiles = 68; }
        else { const int v = u - 1024; b = v >> 3; h = v & 7; qrow0 = TL + b * 256; ntiles = 4; }
        const int qrow = qrow0 + qr;
        float O[64];
#pragma unroll 1
        for (int map = 1; map >= 0; --map) {
            float q[64];
            { const bf16_t* qp = P + (size_t)qrow * PW + OQ + h * 128 + map * 64;
#pragma unroll
              for (int c = 0; c < 8; ++c) { const u32x4 w = *(const u32x4*)(qp + 8 * c);
#pragma unroll
                  for (int e = 0; e < 4; ++e) { q[8 * c + 2 * e] = bflo(w[e]); q[8 * c + 2 * e + 1] = bfhi(w[e]); } asm volatile("" ::: "memory"); } }
            float mx = -1e30f, l = 0.f;
#pragma unroll
            for (int i = 0; i < 64; ++i) O[i] = 0.f;
#pragma unroll 1
            for (int t = 0; t < ntiles; ++t) {
                const int krow0 = (lat && t < 64) ? b * 4096 + t * 64 : TL + b * 256 + (t - (lat ? 64 : 0)) * 64;
                __syncthreads();
                { const int key = tid >> 3, ch = tid & 7; const u32x4 w = *(const u32x4*)(P + (size_t)(krow0 + key) * PW + OKK + h * 128 + map * 64 + ch * 8);
                  *(LAS f32x4*)(Ks + key * 64 + ch * 8) = (f32x4){bflo(w.x), bfhi(w.x), bflo(w.y), bfhi(w.y)};
                  *(LAS f32x4*)(Ks + key * 64 + ch * 8 + 4) = (f32x4){bflo(w.z), bfhi(w.z), bflo(w.w), bfhi(w.w)}; }
#pragma unroll
                for (int i2 = 0; i2 < 2; ++i2) { const int e = tid + i2 * 512, key = e >> 4, ch = e & 15; const u32x4 w = *(const u32x4*)(P + (size_t)(krow0 + key) * PW + OV + h * 128 + ch * 8);
                  *(LAS f32x4*)(Vs + key * 128 + ch * 8) = (f32x4){bflo(w.x), bfhi(w.x), bflo(w.y), bfhi(w.y)};
                  *(LAS f32x4*)(Vs + key * 128 + ch * 8 + 4) = (f32x4){bflo(w.z), bfhi(w.z), bflo(w.w), bfhi(w.w)}; }
                __syncthreads();
#pragma unroll 1
                for (int key = 0; key < 64; ++key) {
                    float s = 0.f;
#pragma unroll
                    for (int c = 0; c < 16; ++c) { const f32x4 kv = *(const LAS f32x4*)(Ks + key * 64 + 4 * c); s += (q[4 * c] * kv[0] + q[4 * c + 1] * kv[1]) + (q[4 * c + 2] * kv[2] + q[4 * c + 3] * kv[3]);
                        if ((c & 3) == 3) asm volatile("" ::: "memory"); }
                    const float mn = fmaxf(mx, s); const float alpha = __builtin_amdgcn_exp2f(mx - mn), p = __builtin_amdgcn_exp2f(s - mn);
                    l = l * alpha + p; mx = mn;
#pragma unroll
                    for (int c = 0; c < 16; ++c) { const f32x4 vv = *(const LAS f32x4*)(Vs + key * 128 + half * 64 + 4 * c);
                        O[4 * c] = O[4 * c] * alpha + p * vv[0]; O[4 * c + 1] = O[4 * c + 1] * alpha + p * vv[1]; O[4 * c + 2] = O[4 * c + 2] * alpha + p * vv[2]; O[4 * c + 3] = O[4 * c + 3] * alpha + p * vv[3];
                        if ((c & 3) == 3) asm volatile("" ::: "memory"); }
                }
            }
            const float inv = 1.f / l;
            if (map == 1) {
#pragma unroll
                for (int i = 0; i < 16; ++i) { *(f32x4*)(scr + tid * 64 + 4 * i) = (f32x4){O[4 * i] * inv, O[4 * i + 1] * inv, O[4 * i + 2] * inv, O[4 * i + 3] * inv}; if ((i & 3) == 3) asm volatile("" ::: "memory"); }
            } else {
#pragma unroll
                for (int i = 0; i < 16; ++i) { const f32x4 t = __builtin_nontemporal_load((const f32x4*)(scr + tid * 64 + 4 * i));
                    O[4 * i] = O[4 * i] * inv - lam * t[0]; O[4 * i + 1] = O[4 * i + 1] * inv - lam * t[1]; O[4 * i + 2] = O[4 * i + 2] * inv - lam * t[2]; O[4 * i + 3] = O[4 * i + 3] * inv - lam * t[3];
                    if ((i & 3) == 3) asm volatile("" ::: "memory"); }
            }
        }
        float ss = 0.f;
#pragma unroll
        for (int i = 0; i < 64; ++i) ss += O[i] * O[i];
        __syncthreads();
        red[tid] = ss;
        __syncthreads();
        const float tot = red[qr] + red[qr + 256];
        const float r = (1.f - lam_init) / sqrtf(tot * (1.f / 128.f) + RMS_EPS);
        bf16_t* op = AD + (size_t)qrow * 1024 + h * 128 + half * 64;
#pragma unroll
        for (int c = 0; c < 8; ++c) { u32x4 w;
            w.x = pk2(O[8 * c] * r * subg[half * 64 + 8 * c], O[8 * c + 1] * r * subg[half * 64 + 8 * c + 1]);
            w.y = pk2(O[8 * c + 2] * r * subg[half * 64 + 8 * c + 2], O[8 * c + 3] * r * subg[half * 64 + 8 * c + 3]);
            w.z = pk2(O[8 * c + 4] * r * subg[half * 64 + 8 * c + 4], O[8 * c + 5] * r * subg[half * 64 + 8 * c + 5]);
            w.w = pk2(O[8 * c + 6] * r * subg[half * 64 + 8 * c + 6], O[8 * c + 7] * r * subg[half * 64 + 8 * c + 7]);
            *(u32x4*)(op + 8 * c) = w; asm volatile("" ::: "memory"); }
    }
    __syncthreads();
}

__device__ __forceinline__ void p_gla_tail(const Frame& F0, const float* gng  , int row_lo, int nrows) {
    const Frame F = relaunder(F0);
    const bf16_t* P = (const bf16_t*)(F.ws + WS_P); const float* OG = (const float*)(F.ws + WS_OG); bf16_t* ACG = (bf16_t*)(F.ws + WS_ACG);
    const int c0 = F.lane * 8; const bf16_t* OGB = (const bf16_t*)OG;
    const f32x4 g0 = *(const f32x4*)(gng + (c0 & 127)), g1 = *(const f32x4*)(gng + (c0 & 127) + 4);
    u32x4 n0 = (u32x4){0u, 0u, 0u, 0u}, n1 = n0, nr = n0;
    const int r0 = row_lo + F.wave;
    if (r0 < nrows) { n0 = *(const u32x4*)(OGB + (size_t)r0 * 512 + c0); n1 = *(const u32x4*)(OGB + ((size_t)TT + r0) * 512 + c0); nr = *(const u32x4*)(P + (size_t)r0 * PW + OGR + c0); }
    for (int row = r0; row < nrows; row += NWAVES) {
        const u32x4 w0 = n0, w1 = n1, rw = nr; const int rn = row + NWAVES;
        if (rn < nrows) { n0 = *(const u32x4*)(OGB + (size_t)rn * 512 + c0); n1 = *(const u32x4*)(OGB + ((size_t)TT + rn) * 512 + c0); nr = *(const u32x4*)(P + (size_t)rn * PW + OGR + c0); }
        f32x4 a = (f32x4){bflo(w0.x) + bflo(w1.x), bfhi(w0.x) + bfhi(w1.x), bflo(w0.y) + bflo(w1.y), bfhi(w0.y) + bfhi(w1.y)};
        f32x4 b = (f32x4){bflo(w0.z) + bflo(w1.z), bfhi(w0.z) + bfhi(w1.z), bflo(w0.w) + bflo(w1.w), bfhi(w0.w) + bfhi(w1.w)};
        float ss = (a[0] * a[0] + a[1] * a[1]) + (a[2] * a[2] + a[3] * a[3]) + (b[0] * b[0] + b[1] * b[1]) + (b[2] * b[2] + b[3] * b[3]);
        ss += __shfl_xor(ss, 1); ss += __shfl_xor(ss, 2); ss += __shfl_xor(ss, 4); ss += __shfl_xor(ss, 8);
        const float rstd = 1.f / sqrtf(ss * (1.f / 128.f) + RMS_EPS);
        float rr[8] = {bflo(rw.x), bfhi(rw.x), bflo(rw.y), bfhi(rw.y), bflo(rw.z), bfhi(rw.z), bflo(rw.w), bfhi(rw.w)};
        float o[8];
#pragma unroll
        for (int i = 0; i < 4; ++i) { const float y0 = a[i] * rstd * g0[i], y1 = b[i] * rstd * g1[i];
            o[i] = y0 * (rr[i] * sigmoidf_(rr[i])); o[4 + i] = y1 * (rr[4 + i] * sigmoidf_(rr[4 + i])); }
        u32x4 w; w.x = pk2(o[0], o[1]); w.y = pk2(o[2], o[3]); w.z = pk2(o[4], o[5]); w.w = pk2(o[6], o[7]);
        *(u32x4*)(ACG + (size_t)row * 1024 + 512 + c0) = w;
    }
}

__device__ __forceinline__ void p_gla_tail_bh(const Frame& F0, const float* gng  , int b, int h, bool with_ctx) {
    const Frame F = relaunder(F0);
    const bf16_t* P = (const bf16_t*)(F.ws + WS_P); const bf16_t* OGB = (const bf16_t*)(F.ws + WS_OG); bf16_t* ACG = (bf16_t*)(F.ws + WS_ACG);
    const int sub = F.lane >> 4, c0 = h * 128 + (F.lane & 15) * 8;
    const f32x4 g0 = *(const f32x4*)(gng + (c0 & 127)), g1 = *(const f32x4*)(gng + (c0 & 127) + 4);
    const int n = with_ctx ? 4352 : 4096;
#define TBH_ROW(i_) ((i_) < 4096 ? b * 4096 + (i_) : TL + b * 256 + ((i_) - 4096))
    u32x4 n0 = (u32x4){0u, 0u, 0u, 0u}, n1 = n0, nr = n0;
    int i = F.wave * 4 + sub;
    if (i < n) { const int r_ = TBH_ROW(i); n0 = *(const u32x4*)(OGB + (size_t)r_ * 512 + c0); n1 = *(const u32x4*)(OGB + ((size_t)TT + r_) * 512 + c0); nr = *(const u32x4*)(P + (size_t)r_ * PW + OGR + c0); }
    for (; i < n; i += NWAVES * 4) {
        const u32x4 w0 = n0, w1 = n1, rw = nr; const int row = TBH_ROW(i), in = i + NWAVES * 4;
        if (in < n) { const int r_ = TBH_ROW(in); n0 = *(const u32x4*)(OGB + (size_t)r_ * 512 + c0); n1 = *(const u32x4*)(OGB + ((size_t)TT + r_) * 512 + c0); nr = *(const u32x4*)(P + (size_t)r_ * PW + OGR + c0); }
        f32x4 a = (f32x4){bflo(w0.x) + bflo(w1.x), bfhi(w0.x) + bfhi(w1.x), bflo(w0.y) + bflo(w1.y), bfhi(w0.y) + bfhi(w1.y)};
        f32x4 bq = (f32x4){bflo(w0.z) + bflo(w1.z), bfhi(w0.z) + bfhi(w1.z), bflo(w0.w) + bflo(w1.w), bfhi(w0.w) + bfhi(w1.w)};
        float ss = (a[0] * a[0] + a[1] * a[1]) + (a[2] * a[2] + a[3] * a[3]) + (bq[0] * bq[0] + bq[1] * bq[1]) + (bq[2] * bq[2] + bq[3] * bq[3]);
        ss += __shfl_xor(ss, 1); ss += __shfl_xor(ss, 2); ss += __shfl_xor(ss, 4); ss += __shfl_xor(ss, 8);
        const float rstd = 1.f / sqrtf(ss * (1.f / 128.f) + RMS_EPS);
        float rr[8] = {bflo(rw.x), bfhi(rw.x), bflo(rw.y), bfhi(rw.y), bflo(rw.z), bfhi(rw.z), bflo(rw.w), bfhi(rw.w)};
        float o[8];
#pragma unroll
        for (int k = 0; k < 4; ++k) { const float y0 = a[k] * rstd * g0[k], y1 = bq[k] * rstd * g1[k];
            o[k] = y0 * (rr[k] * sigmoidf_(rr[k])); o[4 + k] = y1 * (rr[4 + k] * sigmoidf_(rr[4 + k])); }
        u32x4 w; w.x = pk2(o[0], o[1]); w.y = pk2(o[2], o[3]); w.z = pk2(o[4], o[5]); w.w = pk2(o[6], o[7]);
        *(u32x4*)(ACG + (size_t)row * 1024 + 512 + c0) = w;
    }
#undef TBH_ROW
}

typedef float rf2_t __attribute__((ext_vector_type(2)));
__device__ __forceinline__ float router_reduce(float (&p)[32], int lane) {
#pragma unroll
    for (int i = 0; i < 16; ++i) { const bool up = (lane & 32) != 0; const float send = up ? p[i] : p[i + 16], keep = up ? p[i + 16] : p[i]; p[i] = keep + __shfl_xor(send, 32); }
#pragma unroll
    for (int i = 0; i < 8; ++i) { const bool up = (lane & 16) != 0; const float send = up ? p[i] : p[i + 8], keep = up ? p[i + 8] : p[i]; p[i] = keep + __shfl_xor(send, 16); }
#pragma unroll
    for (int i = 0; i < 4; ++i) { const bool up = (lane & 8) != 0; const float send = up ? p[i] : p[i + 4], keep = up ? p[i + 4] : p[i]; p[i] = keep + __shfl_xor(send, 8); }
#pragma unroll
    for (int i = 0; i < 2; ++i) { const bool up = (lane & 4) != 0; const float send = up ? p[i] : p[i + 2], keep = up ? p[i + 2] : p[i]; p[i] = keep + __shfl_xor(send, 4); }
    { const bool up = (lane & 2) != 0; const float send = up ? p[0] : p[1], keep = up ? p[1] : p[0]; p[0] = keep + __shfl_xor(send, 2); }
    return p[0] + __shfl_xor(p[0], 1);
}
__device__ __forceinline__ void router_topk(float logit, int row, bool valid, int lane, LAS float* lg, LAS float* selv, LAS int* hist, int* TOPI, float* TOPG) {
    const int ex = lane >> 1;
    if ((lane & 1) == 0) lg[ex] = logit;
    LDS_WAIT(); asm volatile("" ::: "memory");
    int rank = 0;
#pragma unroll
    for (int e = 0; e < 32; ++e) { const float o = lg[e]; rank += (o > logit || (o == logit && e < ex)) ? 1 : 0; }
    if ((lane & 1) == 0 && rank < 4) { selv[rank * 2] = logit; selv[rank * 2 + 1] = __builtin_bit_cast(float, ex); }
    LDS_WAIT(); asm volatile("" ::: "memory");
    const float v0 = selv[0], v1 = selv[2], v2 = selv[4], v3 = selv[6];
    const float e0 = 1.f, e1 = __expf(v1 - v0), e2 = __expf(v2 - v0), e3 = __expf(v3 - v0); const float inv = 1.f / (e0 + e1 + e2 + e3);
    if (valid && lane < 4) { const int ej = __builtin_bit_cast(int, selv[lane * 2 + 1]); const float gj = (lane == 0 ? e0 : lane == 1 ? e1 : lane == 2 ? e2 : e3) * inv;
        TOPI[(size_t)row * 4 + lane] = ej; TOPG[(size_t)row * 4 + lane] = gj; __hip_atomic_fetch_add(hist + ej, 1, __ATOMIC_RELAXED, __HIP_MEMORY_SCOPE_WORKGROUP); }
    LDS_WAIT(); asm volatile("" ::: "memory");
}
__device__ __forceinline__ void p_norm2_router(const Frame& F0, int layer, int Tm) {
    const Frame F = relaunder(F0);
    const float* MOD = (const float*)(F.ws + WS_MOD) + (size_t)layer * 9 * 6144; bf16_t* H = (bf16_t*)(F.ws + WS_H); const bf16_t* XW = (const bf16_t*)(F.ws + WS_XW);
    unsigned char* rt = F.ws + WS_ROUTE + layer * ROUTE_STRIDE;
    int* TOPI = (int*)(rt + R_TOPI); float* TOPG = (float*)(rt + R_TOPG); int* CNT = (int*)(rt + R_CNT);
    const float* rw = in_ptr(F, 19) + (size_t)layer * 1024 * 32; const float* rb = in_ptr(F, 20) + layer * 32; const float* g2n = in_ptr(F, 7) + layer * 1024;
    LAS float* WT = (LAS float*)F.lds;
    LAS float* lg = (LAS float*)(F.lds + 132096) + F.wave * 32;
    LAS float* selv = (LAS float*)(F.lds + 132096 + 1024) + F.wave * 8;
    LAS int* hist = (LAS int*)(F.lds + 132096 + 2048);
    __syncthreads();
    {
        f32x4 wv[16];
#pragma unroll
        for (int i = 0; i < 16; ++i) wv[i] = *(const f32x4*)(rw + 4 * (F.tid + NTHR * i));
#pragma unroll
        for (int i = 0; i < 16; ++i) { const int i4 = F.tid + NTHR * i, k = i4 >> 3, e0 = (i4 & 7) * 4;
            WT[(e0 + 0) * 1028 + k] = wv[i][0]; WT[(e0 + 1) * 1028 + k] = wv[i][1]; WT[(e0 + 2) * 1028 + k] = wv[i][2]; WT[(e0 + 3) * 1028 + k] = wv[i][3]; }
    }
    if (F.tid < 32) hist[F.tid] = 0;
    __syncthreads();
    const int RPW = Tm / F.G;
    const int nk = RPW / NWAVES;
    f32x4 shv[4], scv[4]; int mrc = -1;
    const int row0w = blockIdx.x * RPW + F.wave;
    f32x4 nA[4], nB[4];
    load_row_b(XW + (size_t)row0w * 1024, F.lane, nA); load_row_b(XW + (size_t)(nk > 1 ? row0w + NWAVES : row0w) * 1024, F.lane, nB);
#pragma unroll 1
    for (int k = 0; k < nk; k += 2) {
        const bool hasB = k + 1 < nk;
        const int rowA = row0w + NWAVES * k, rowB = hasB ? rowA + NWAVES : rowA;
        f32x4 vA[4], vB[4];
#pragma unroll
        for (int j = 0; j < 4; ++j) { vA[j] = nA[j]; vB[j] = nB[j]; }
        if (k + 2 < nk) { const int rA2 = rowA + 2 * NWAVES, rB2 = (k + 3 < nk) ? rA2 + NWAVES : rA2; load_row_b(XW + (size_t)rA2 * 1024, F.lane, nA); load_row_b(XW + (size_t)rB2 * 1024, F.lane, nB); }
        const int mrA = rowA < TL ? (rowA >> 12) : 8, mrB = rowB < TL ? (rowB >> 12) : 8;
        if (mrA != mrc) { mrc = mrA;
#pragma unroll
            for (int j = 0; j < 4; ++j) { shv[j] = *(const f32x4*)(MOD + (size_t)mrA * 6144 + 3072 + 256 * j + 4 * F.lane); scv[j] = *(const f32x4*)(MOD + (size_t)mrA * 6144 + 4096 + 256 * j + 4 * F.lane) + 1.f; } }
        { const float rsA = row_rstd(vA);
#pragma unroll
          for (int j = 0; j < 4; ++j) vA[j] = (vA[j] * rsA * *(const f32x4*)(g2n + 256 * j + 4 * F.lane)) * scv[j] + shv[j]; }
        if (mrB != mrc) { mrc = mrB;
#pragma unroll
            for (int j = 0; j < 4; ++j) { shv[j] = *(const f32x4*)(MOD + (size_t)mrB * 6144 + 3072 + 256 * j + 4 * F.lane); scv[j] = *(const f32x4*)(MOD + (size_t)mrB * 6144 + 4096 + 256 * j + 4 * F.lane) + 1.f; } }
        { const float rsB = row_rstd(vB);
#pragma unroll
          for (int j = 0; j < 4; ++j) vB[j] = (vB[j] * rsB * *(const f32x4*)(g2n + 256 * j + 4 * F.lane)) * scv[j] + shv[j]; }
        store_row_bf16(H + (size_t)rowA * 1024, F.lane, vA);
        if (hasB) store_row_bf16(H + (size_t)rowB * 1024, F.lane, vB);
        float pA[32], pB[32];
#pragma unroll
        for (int e4 = 0; e4 < 32; e4 += 2) {
            f32x4 w[2][4];
#pragma unroll
            for (int x = 0; x < 2; ++x)
#pragma unroll
                for (int j = 0; j < 4; ++j) w[x][j] = *(const LAS f32x4*)(WT + (e4 + x) * 1028 + 256 * j + 4 * F.lane);
            asm volatile("" ::: "memory");
            rf2_t acc2[2][2];
#pragma unroll
            for (int x = 0; x < 2; ++x) { acc2[x][0] = (rf2_t){0.f, 0.f}; acc2[x][1] = (rf2_t){0.f, 0.f}; }
#pragma unroll
            for (int j = 0; j < 4; ++j)
#pragma unroll
                for (int i = 0; i < 4; ++i) { const rf2_t ab = (rf2_t){vA[j][i], vB[j][i]};
#pragma unroll
                    for (int x = 0; x < 2; ++x) acc2[x][i & 1] = __builtin_elementwise_fma(ab, (rf2_t){w[x][j][i], w[x][j][i]}, acc2[x][i & 1]); }
#pragma unroll
            for (int x = 0; x < 2; ++x) { const rf2_t t = acc2[x][0] + acc2[x][1]; pA[e4 + x] = t[0]; pB[e4 + x] = t[1]; } }
        const int ex = F.lane >> 1; const float bias = rb[ex];
        const float logitA = router_reduce(pA, F.lane) + bias, logitB = router_reduce(pB, F.lane) + bias;
        router_topk(logitA, rowA, true, F.lane, lg, selv, hist, TOPI, TOPG);
        router_topk(logitB, rowB, hasB, F.lane, lg, selv, hist, TOPI, TOPG);
    }
    __syncthreads();
    if (F.tid < 32) CNT[blockIdx.x * 32 + F.tid] = hist[F.tid];
}

__device__ __forceinline__ void p_route_gather(const Frame& F0, int layer, int Tm) {
    const Frame F = relaunder(F0);
    unsigned char* rt = F.ws + WS_ROUTE + layer * ROUTE_STRIDE;
    const int* TOPI = (const int*)(rt + R_TOPI); int* POSOF = (int*)(rt + R_POSOF); int* ROWTOK = (int*)(rt + R_ROWTOK); const int* CNT = (const int*)(rt + R_CNT);
    int* TILEEXP = (int*)(rt + R_TILEEXP); int* NT = (int*)(rt + R_NT);
    LAS int* tot = (LAS int*)F.lds;
    LAS int* mine = tot + 32;
    LAS int* pst = mine + 32;
    LAS int* es = pst + 64;
    LAS int* ps = es + 1024;
    const int RPW = Tm / F.G, NP = RPW * 4;
    __syncthreads();
    {
        LAS int* part = ps + 1024;
        const int e = F.tid & 31, sl = F.tid >> 5; int t = 0, m = 0;
        for (int w = sl; w < F.G; w += 16) { const int c = __builtin_nontemporal_load(CNT + w * 32 + e); t += c; if (w < (int)blockIdx.x) m += c; }
        part[sl * 32 + e] = t; part[512 + sl * 32 + e] = m;
        __syncthreads();
        if (F.tid < 32) { int tt = 0, mm = 0;
#pragma unroll
            for (int k = 0; k < 16; ++k) { tt += part[k * 32 + F.tid]; mm += part[512 + k * 32 + F.tid]; }
            tot[F.tid] = tt; mine[F.tid] = mm; } }
    for (int i = F.tid; i < NP; i += NTHR) es[i] = __builtin_nontemporal_load(TOPI + (size_t)blockIdx.x * NP + i);
    __syncthreads();
    if (F.tid == 0) { int s = 0; for (int e = 0; e < 32; ++e) { pst[e] = s; s += (tot[e] + 255) & ~255; } pst[32] = s; }
    __syncthreads();
    {
        LAS int* rk = ps + 2048;
        int base[4] = {0, 0, 0, 0};
        for (int c0 = 0; c0 < NP; c0 += 64) { const int i = c0 + F.lane; const int e = i < NP ? es[i] : -1;
#pragma unroll
            for (int x = 0; x < 4; ++x) { const unsigned long long b = __ballot(e == 4 * F.wave + x);
                if (e == 4 * F.wave + x) rk[i] = base[x] + __popcll(b & ((1ull << F.lane) - 1ull));
                base[x] += __popcll(b); } }
        __syncthreads();
    }
    for (int i = F.tid; i < NP; i += NTHR) { const int e = es[i]; const int r = (ps + 2048)[i];
        const int pos = pst[e] + mine[e] + r; ps[i] = pos; const int tok = blockIdx.x * RPW + (i >> 2);
        ROWTOK[pos] = tok; POSOF[(size_t)tok * 4 + (i & 3)] = pos; }
    const int ntiles = pst[32] >> 8;
    if (blockIdx.x == 0) { for (int t = F.tid; t < ntiles; t += NTHR) { int e = 0; for (int q = 0; q < 32; ++q) if (pst[q] <= t * 256) e = q; TILEEXP[t] = e; }
        if (F.tid == 0) NT[0] = ntiles; }
    __syncthreads();
    if (blockIdx.x < 32) { const int e = blockIdx.x; const int r0 = pst[e] + tot[e], r1 = pst[e + 1];
        for (int r = r0 + F.tid; r < r1; r += NTHR) ROWTOK[r] = 0; }
}

__device__ __forceinline__ void p_combine(const Frame& F0, int layer, int Tm) {
    const Frame F = relaunder(F0);
    const float* MODL = (const float*)(F.ws + WS_MOD) + (size_t)layer * 9 * 6144;
    const float* MODN = (const float*)(F.ws + WS_MOD) + (size_t)(layer + 1) * 9 * 6144;
    unsigned char* rt = F.ws + WS_ROUTE + layer * ROUTE_STRIDE;
    const int* POSOF = (const int*)(rt + R_POSOF); const float* TOPG = (const float*)(rt + R_TOPG);
    const bf16_t* YY = (const bf16_t*)(F.ws + WS_XS); bf16_t* XW = (bf16_t*)(F.ws + WS_XW); bf16_t* H = (bf16_t*)(F.ws + WS_H);
    const bool last = layer == 1;
    const float* fin_g = in_ptr(F, 25); const float* n1g = in_ptr(F, 6) + 1024; float* outp = out_ptr(F);
    u32x4 pos4 = (u32x4){0u, 0u, 0u, 0u}; f32x4 gt4 = (f32x4){0.f, 0.f, 0.f, 0.f};
    if (F.gw < Tm) { pos4 = __builtin_nontemporal_load((const u32x4*)(POSOF + (size_t)F.gw * 4)); gt4 = __builtin_nontemporal_load((const f32x4*)(TOPG + (size_t)F.gw * 4)); }
    for (int row = F.gw; row < Tm; row += F.NGW) {
        const int mr = row < TL ? (row >> 12) : 8;
        f32x4 v[4]; load_row_b(XW + (size_t)row * 1024, F.lane, v);
        u32x2 yw[4][4];
#pragma unroll
        for (int s = 0; s < 4; ++s) { const bf16_t* yp = YY + (size_t)pos4[s] * 1024;
#pragma unroll
            for (int j = 0; j < 4; ++j) yw[s][j] = *(const u32x2*)(yp + 256 * j + 4 * F.lane); }
        const f32x4 gcur = gt4;
        if (row + F.NGW < Tm) { pos4 = __builtin_nontemporal_load((const u32x4*)(POSOF + (size_t)(row + F.NGW) * 4)); gt4 = __builtin_nontemporal_load((const f32x4*)(TOPG + (size_t)(row + F.NGW) * 4)); }
        f32x4 y[4];
#pragma unroll
        for (int j = 0; j < 4; ++j) y[j] = (f32x4){0.f, 0.f, 0.f, 0.f};
#pragma unroll
        for (int s = 0; s < 4; ++s)
#pragma unroll
            for (int j = 0; j < 4; ++j) y[j] = y[j] + gcur[s] * (f32x4){bflo(yw[s][j].x), bfhi(yw[s][j].x), bflo(yw[s][j].y), bfhi(yw[s][j].y)};
        const float* g2 = MODL + (size_t)mr * 6144 + 5120;
#pragma unroll
        for (int j = 0; j < 4; ++j) v[j] = v[j] + *(const f32x4*)(g2 + 256 * j + 4 * F.lane) * y[j];
        if (!last) {
            store_row_bf16(XW + (size_t)row * 1024, F.lane, v);
            norm_mod(v, n1g, MODN + (size_t)mr * 6144, MODN + (size_t)mr * 6144 + 1024, F.lane);
            store_row_bf16(H + (size_t)row * 1024, F.lane, v);
        } else {
            const float rstd = row_rstd(v);
#pragma unroll
            for (int j = 0; j < 4; ++j) *(f32x4*)(outp + (size_t)row * 1024 + 256 * j + 4 * F.lane) = v[j] * rstd * *(const f32x4*)(fin_g + 256 * j + 4 * F.lane);
        }
    }
}
typedef float f32x16 __attribute__((ext_vector_type(16)));
typedef short bf16x8 __attribute__((ext_vector_type(8)));
typedef short v4i16_t __attribute__((ext_vector_type(4)));

typedef __bf16 abf2_t __attribute__((ext_vector_type(2)));
typedef float af2_t __attribute__((ext_vector_type(2)));
__device__ __forceinline__ unsigned cvt_pk(float lo, float hi) { const af2_t v = {lo, hi}; return __builtin_bit_cast(unsigned, __builtin_convertvector(v, abf2_t)); }

constexpr int AK_STRIDE = 272, AV_STRIDE = 320, AK_BYTES = 64 * AK_STRIDE, AV_BYTES = 64 * AV_STRIDE;
constexpr int AV_OFF = 2 * AK_BYTES;
constexpr int AQ_OFF = AV_OFF + 3 * AV_BYTES;
#ifndef ATT_PROBE
#define ATT_PROBE 0
#endif
struct AttnSt { f32x16 O[4]; f32x16 negm; float mrun, lrun; };
#define ASB() __builtin_amdgcn_sched_barrier(0)
#define APIN(x) asm volatile("" : "+v"(x))
#define AMF(a, b, c) __builtin_amdgcn_mfma_f32_32x32x16_bf16(a, b, c, 0, 0, 0)
#define AMX3(a, b, c) __builtin_fmaxf(__builtin_fmaxf((a), (b)), (c))
#define AGAPA(MF, A0, A1, A2, A3, W0, W1, PW) do { MF; sacc += A0; sacc += A1; sacc += A2; sacc += A3; APIN(sacc); W0; W1; APIN(PW); ASB(); } while (0)
#define AGAPB(MF, RD, X, i) do { MF; RD; X[i] = __builtin_amdgcn_exp2f(X[i]); X[i + 1] = __builtin_amdgcn_exp2f(X[i + 1]); APIN(X); ASB(); } while (0)
__device__ __forceinline__ float attn_rowmax(const f32x16& p0, const f32x16& p1) {
    float a = AMX3(p0[0], p0[1], p1[0]), b = AMX3(p0[2], p0[3], p1[1]); a = AMX3(a, p1[2], p1[3]);
#pragma unroll
    for (int r = 4; r < 16; r += 4) { a = AMX3(a, p0[r], p0[r + 1]); b = AMX3(b, p0[r + 2], p0[r + 3]); a = AMX3(a, p1[r], p1[r + 1]); b = AMX3(b, p1[r + 2], p1[r + 3]); }
    float m = __builtin_fmaxf(a, b);
    const auto rr = __builtin_amdgcn_permlane32_swap(__builtin_bit_cast(unsigned, m), __builtin_bit_cast(unsigned, m), false, false);
    return __builtin_fmaxf(__builtin_bit_cast(float, rr[0]), __builtin_bit_cast(float, rr[1]));
}
template <int PT, bool PRE>
__device__ __forceinline__ void attn_phA(const Frame& F, AttnSt& st, f32x16& C0, f32x16& C1, f32x16& P0, f32x16& P1, u32x4& pw0, u32x4& pw1, u32x4& pw2, u32x4& pw3,
                                         bf16x8 (&vf)[4], const bf16x8 (&qf)[4], const LAS unsigned char* vb, int q, int hi, int map) {
    const LAS unsigned char* kb = F.lds + PT * AK_BYTES + q * AK_STRIDE + map * 128 + hi * 16;
    bf16x8 ra[2], rb2[2];
#define AKQ(sl, ks) do { ra[sl] = *(const LAS bf16x8*)(kb + (ks) * 32); rb2[sl] = *(const LAS bf16x8*)(kb + 32 * AK_STRIDE + (ks) * 32); } while (0)
#define ATR(p) __builtin_amdgcn_ds_read_tr16_b64_v4i16((LAS v4i16_t*)(p))
#define AVR(sl, d, s) do { const v4i16_t lo_ = ATR(vb + (s) * 16 * AV_STRIDE + (d) * 64), hi_ = ATR(vb + (s) * 16 * AV_STRIDE + 8 * AV_STRIDE + (d) * 64); \
        vf[sl] = (bf16x8){lo_[0], lo_[1], lo_[2], lo_[3], hi_[0], hi_[1], hi_[2], hi_[3]}; } while (0)
#define AVRD(d, s) do { const v4i16_t lo_ = ATR(vb + (s) * 16 * AV_STRIDE + (d) * 64), hi_ = ATR(vb + (s) * 16 * AV_STRIDE + 8 * AV_STRIDE + (d) * 64); \
        vf[d] = (bf16x8){lo_[0], lo_[1], lo_[2], lo_[3], hi_[0], hi_[1], hi_[2], hi_[3]}; } while (0)
    ASB();
    AKQ(0, 0); AKQ(1, 1);
    float sacc = P0[0] + P0[1];
    ASB();
    AGAPA(C0 = AMF(ra[0], qf[0], st.negm),  P0[2], P0[3], P0[4], P0[5],     pw0[0] = cvt_pk(P0[0], P0[1]),   pw0[1] = cvt_pk(P0[2], P0[3]),   pw0);
    AGAPA(C1 = AMF(rb2[0], qf[0], st.negm), P0[6], P0[7], P0[8], P0[9],     pw0[2] = cvt_pk(P0[4], P0[5]),   pw0[3] = cvt_pk(P0[6], P0[7]),   pw0);
    AKQ(0, 2); ASB();
    AGAPA(C0 = AMF(ra[1], qf[1], C0),   P0[10], P0[11], P0[12], P0[13], pw1[0] = cvt_pk(P0[8], P0[9]),   pw1[1] = cvt_pk(P0[10], P0[11]), pw1);
    AGAPA(C1 = AMF(rb2[1], qf[1], C1),  P0[14], P0[15], P1[0], P1[1],   pw1[2] = cvt_pk(P0[12], P0[13]), pw1[3] = cvt_pk(P0[14], P0[15]), pw1);
    AKQ(1, 3); ASB();
    AGAPA(C0 = AMF(ra[0], qf[2], C0),   P1[2], P1[3], P1[4], P1[5],     pw2[0] = cvt_pk(P1[0], P1[1]),   pw2[1] = cvt_pk(P1[2], P1[3]),   pw2);
    AGAPA(C1 = AMF(rb2[0], qf[2], C1),  P1[6], P1[7], P1[8], P1[9],     pw2[2] = cvt_pk(P1[4], P1[5]),   pw2[3] = cvt_pk(P1[6], P1[7]),   pw2);
    if (PRE) { AVRD(0, 0); AVRD(1, 0); ASB(); }
    AGAPA(C0 = AMF(ra[1], qf[3], C0),   P1[10], P1[11], P1[12], P1[13], pw3[0] = cvt_pk(P1[8], P1[9]),   pw3[1] = cvt_pk(P1[10], P1[11]), pw3);
    if (PRE) { AVRD(2, 0); AVRD(3, 0); ASB(); }
    AGAPA(C1 = AMF(rb2[1], qf[3], C1),  P1[14], P1[15], 0.f, 0.f,       pw3[2] = cvt_pk(P1[12], P1[13]), pw3[3] = cvt_pk(P1[14], P1[15]), pw3);
    st.lrun += sacc;
#undef AKQ
}
__device__ __forceinline__ void attn_mid(AttnSt& st, f32x16& C0, f32x16& C1, float& alpha, bool& resc) {
    const float mx = attn_rowmax(C0, C1);
    alpha = 1.f; resc = false;
    if (!__builtin_expect(__all(mx <= 8.f), 1)) { const float dl = fmaxf(mx, 0.f); st.mrun += dl; alpha = __builtin_amdgcn_exp2f(-dl); st.lrun *= alpha; resc = true;
#pragma unroll
        for (int r = 0; r < 16; ++r) { C0[r] -= dl; C1[r] -= dl; st.negm[r] = -st.mrun; }
        APIN(st.negm); }
    ASB();
}
template <bool PRE>
__device__ __forceinline__ void attn_phB(AttnSt& st, f32x16& C0, f32x16& C1, const u32x4& pw0, const u32x4& pw1, const u32x4& pw2, const u32x4& pw3, bf16x8 (&vf)[4],
                                         const LAS unsigned char* vb, float alpha, bool resc) {
#define APF(k) __builtin_bit_cast(bf16x8, pw##k)
    if (!PRE) { ASB(); AVR(0, 0, 0); AVR(1, 1, 0); AVR(2, 2, 0); AVR(3, 3, 0); ASB(); }
    __builtin_amdgcn_s_setprio(1); ASB();
    AGAPB(st.O[0] = AMF(vf[0], APF(0), st.O[0]), AVR(0, 0, 1), C0, 0);
    AGAPB(st.O[1] = AMF(vf[1], APF(0), st.O[1]), AVR(1, 1, 1), C0, 2);
    AGAPB(st.O[2] = AMF(vf[2], APF(0), st.O[2]), AVR(2, 2, 1), C0, 4);
    AGAPB(st.O[3] = AMF(vf[3], APF(0), st.O[3]), AVR(3, 3, 1), C0, 6);
    AGAPB(st.O[0] = AMF(vf[0], APF(1), st.O[0]), AVR(0, 0, 2), C0, 8);
    AGAPB(st.O[1] = AMF(vf[1], APF(1), st.O[1]), AVR(1, 1, 2), C0, 10);
    AGAPB(st.O[2] = AMF(vf[2], APF(1), st.O[2]), AVR(2, 2, 2), C0, 12);
    AGAPB(st.O[3] = AMF(vf[3], APF(1), st.O[3]), AVR(3, 3, 2), C0, 14);
    AGAPB(st.O[0] = AMF(vf[0], APF(2), st.O[0]), AVR(0, 0, 3), C1, 0);
    AGAPB(st.O[1] = AMF(vf[1], APF(2), st.O[1]), AVR(1, 1, 3), C1, 2);
    AGAPB(st.O[2] = AMF(vf[2], APF(2), st.O[2]), AVR(2, 2, 3), C1, 4);
    AGAPB(st.O[3] = AMF(vf[3], APF(2), st.O[3]), AVR(3, 3, 3), C1, 6);
    AGAPB(st.O[0] = AMF(vf[0], APF(3), st.O[0]), (void)0, C1, 8);
    AGAPB(st.O[1] = AMF(vf[1], APF(3), st.O[1]), (void)0, C1, 10);
    AGAPB(st.O[2] = AMF(vf[2], APF(3), st.O[2]), (void)0, C1, 12);
    AGAPB(st.O[3] = AMF(vf[3], APF(3), st.O[3]), (void)0, C1, 14);
    __builtin_amdgcn_s_setprio(0); ASB();
    if (resc) {
#pragma unroll
        for (int d = 0; d < 4; ++d)
#pragma unroll
            for (int r = 0; r < 16; ++r) st.O[d][r] *= alpha;
    }
#undef APF
}
__device__ __forceinline__ void attn_drain(AttnSt& st, f32x16& P0, f32x16& P1, const LAS unsigned char* vb) {
    float sacc = 0.f;
#pragma unroll
    for (int r = 0; r < 16; ++r) sacc += P0[r] + P1[r];
    st.lrun += sacc;
#pragma unroll
    for (int s = 0; s < 4; ++s) { u32x4 w;
#pragma unroll
        for (int j = 0; j < 4; ++j) { const int r = 8 * (s & 1) + 2 * j; w[j] = (s < 2) ? cvt_pk(P0[r], P0[r + 1]) : cvt_pk(P1[r], P1[r + 1]); }
        const bf16x8 pf = __builtin_bit_cast(bf16x8, w);
#pragma unroll
        for (int d = 0; d < 4; ++d) { const v4i16_t lo_ = ATR(vb + s * 16 * AV_STRIDE + d * 64), hi_ = ATR(vb + s * 16 * AV_STRIDE + 8 * AV_STRIDE + d * 64);
            const bf16x8 v = (bf16x8){lo_[0], lo_[1], lo_[2], lo_[3], hi_[0], hi_[1], hi_[2], hi_[3]}; st.O[d] = AMF(v, pf, st.O[d]); }
    }
}
__device__ __forceinline__ void attn_unit(const Frame& F, int u, float lam, float osc, const float* subg, int tmask = -1) {
    const bf16_t* P = (const bf16_t*)(F.ws + WS_P); bf16_t* AD = (bf16_t*)(F.ws + WS_AD);
    const int map = F.wave >> 2, rb = F.wave & 3, q = F.lane & 31, hi = F.lane >> 5;
    int b, h, qrow0, t0; const int t1 = 68;
    if (u < 2048) { b = u >> 8; h = (u >> 5) & 7; qrow0 = b * 4096 + (u & 31) * 128; t0 = 0; }
    else { const int v = u - 2048; b = v >> 4; h = (v >> 1) & 7; qrow0 = TL + b * 256 + (v & 1) * 128; t0 = 64; }
    const int qrow = qrow0 + rb * 32 + q;

    bf16x8 qf[4];
#pragma unroll
    for (int ks = 0; ks < 4; ++ks) qf[ks] = *(const bf16x8*)(P + (size_t)qrow * PW + OQ + h * 128 + map * 64 + 16 * ks + 8 * hi);
    AttnSt st;
#pragma unroll
    for (int d = 0; d < 4; ++d)
#pragma unroll
        for (int r = 0; r < 16; ++r) st.O[d][r] = 0.f;
    st.mrun = -1e30f; st.lrun = 0.f;
    const int e0 = F.tid, e1 = F.tid + 512;
    const int kkey0 = e0 >> 4, kch0 = e0 & 15, kkey1 = e1 >> 4, kch1 = e1 & 15;
    const char* kbase_lat = (const char*)(P + (size_t)(b * 4096) * PW + OKK + h * 128);
    const char* kbase_ctx = (const char*)(P + (size_t)(TL + b * 256) * PW + OKK + h * 128) - (size_t)64 * 64 * PW * 2;
    const unsigned koff0 = (unsigned)(kkey0 * PW + kch0 * 8) * 2u, koff1 = (unsigned)(kkey1 * PW + kch1 * 8) * 2u;
    constexpr size_t VOFS = (size_t)(OV - OKK) * 2;
    u32x4 kr0, kr1, vr0, vr1;
#define ATT_LOADK(t_) do { const int tm__ = (t_) & tmask; const char* kb__ = (tm__ < 64 ? kbase_lat : kbase_ctx) + (size_t)tm__ * (64 * PW * 2); \
        kr0 = *(const u32x4*)(kb__ + koff0); kr1 = *(const u32x4*)(kb__ + koff1); } while (0)
#define ATT_LOADV(t_) do { const int tm__ = (t_) & tmask; const char* vb__ = (tm__ < 64 ? kbase_lat : kbase_ctx) + (size_t)tm__ * (64 * PW * 2) + VOFS; \
        vr0 = *(const u32x4*)(vb__ + koff0); vr1 = *(const u32x4*)(vb__ + koff1); } while (0)
#define ATT_STOREK(buf) do { LAS unsigned char* kb_ = F.lds + (buf) * AK_BYTES; \
        *(LAS u32x4*)(kb_ + kkey0 * AK_STRIDE + kch0 * 16) = kr0; *(LAS u32x4*)(kb_ + kkey1 * AK_STRIDE + kch1 * 16) = kr1; } while (0)
#define ATT_STOREV(off) do { LAS unsigned char* vb_ = F.lds + AV_OFF + (off); \
        *(LAS u32x4*)(vb_ + kkey0 * AV_STRIDE + kch0 * 16) = vr0; *(LAS u32x4*)(vb_ + kkey1 * AV_STRIDE + kch1 * 16) = vr1; } while (0)
    ATT_LOADK(t0); ATT_LOADV(t0);
    __syncthreads();
    ATT_STOREK(0); ATT_STOREV(0);
    ATT_LOADK(t0 + 1);
    __syncthreads();
    f32x16 sA0, sA1, sB0, sB1;
    {
        const LAS unsigned char* kb = F.lds + q * AK_STRIDE + map * 128 + hi * 16;
#pragma unroll
        for (int r = 0; r < 16; ++r) { sA0[r] = 0.f; sA1[r] = 0.f; }
#pragma unroll
        for (int ks = 0; ks < 4; ++ks) {
            const bf16x8 a0 = *(const LAS bf16x8*)(kb + ks * 32), a1 = *(const LAS bf16x8*)(kb + 32 * AK_STRIDE + ks * 32), qv = qf[ks];
            sA0 = __builtin_amdgcn_mfma_f32_32x32x16_bf16(a0, qv, sA0, 0, 0, 0);
            sA1 = __builtin_amdgcn_mfma_f32_32x32x16_bf16(a1, qv, sA1, 0, 0, 0);
        }
    }
    ATT_STOREK(1);
    {
        const float mx = attn_rowmax(sA0, sA1); st.mrun = mx;
#pragma unroll
        for (int r = 0; r < 16; ++r) { sA0[r] = __builtin_amdgcn_exp2f(sA0[r] - mx); sA1[r] = __builtin_amdgcn_exp2f(sA1[r] - mx); st.negm[r] = -mx; }
        APIN(st.negm);
    }
    __syncthreads();
    const LAS unsigned char* vq = F.lds + AV_OFF + (4 * hi + ((F.lane & 15) >> 2)) * AV_STRIDE + (16 * ((F.lane >> 4) & 1) + 4 * (F.lane & 3)) * 2;
    int v0 = AV_BYTES, v1 = 0, v2 = 2 * AV_BYTES;
#define ATT_ROT() do { const int t_ = v2; v2 = v1; v1 = v0; v0 = t_; } while (0)
    u32x4 pw0, pw1, pw2, pw3; bf16x8 vf[4]; float alpha = 1.f; bool resc = false;
#define ATT_TILE(PT, C0, C1, P0, P1, KB, HK1, HK2, HV, t) do { \
        attn_phA<PT, false>(F, st, C0, C1, P0, P1, pw0, pw1, pw2, pw3, vf, qf, vq, q, hi, map); attn_mid(st, C0, C1, alpha, resc); \
        if (HK1) ATT_STOREK(KB); ATT_STOREV(v0); ATT_ROT(); \
        if (map != 0) __syncthreads(); \
        if (HK2) ATT_LOADK((t) + 2); if (HV) ATT_LOADV((t) + 1); \
        attn_phB<false>(st, C0, C1, pw0, pw1, pw2, pw3, vf, vq + v2, alpha, resc); \
        if (map == 0) __syncthreads(); } while (0)
    ATT_LOADK(t0 + 2); ATT_LOADV(t0 + 1);
    int t = t0 + 1;
#pragma unroll 1
    for (; t + 3 < t1; t += 2) {
        ATT_TILE(1, sB0, sB1, sA0, sA1, 0, true, true, true, t);
        ATT_TILE(0, sA0, sA1, sB0, sB1, 1, true, true, true, t + 1);
    }
    ATT_TILE(1, sB0, sB1, sA0, sA1, 0, true, true, true, t1 - 3);
    ATT_TILE(0, sA0, sA1, sB0, sB1, 1, true, false, true, t1 - 2);
    ATT_TILE(1, sB0, sB1, sA0, sA1, 0, false, false, false, t1 - 1);
    attn_drain(st, sB0, sB1, vq + v1);
#undef ATT_TILE
    __syncthreads();
#undef ATT_ROT
#undef ATT_LOADK
#undef ATT_LOADV
#undef ATT_STOREK
#undef ATT_STOREV
    __builtin_amdgcn_s_setprio(0);
    f32x16 (&O)[4] = st.O; const float lrun = st.lrun;
    const float inv = 1.f / (lrun + __shfl_xor(lrun, 32));
    unsigned xoff = (unsigned)((rb * 128 + 4 * hi) * 32 + q) * 4u; asm volatile("" : "+v"(xoff));
    LAS float* xb = (LAS float*)(F.lds + xoff);
    if (map == 1) {
#pragma unroll
        for (int d = 0; d < 4; ++d)
#pragma unroll
            for (int r = 0; r < 16; ++r) { const int dv = 32 * d + (r & 3) + 8 * (r >> 2); xb[dv * 32] = O[d][r] * inv; }
    }
    __syncthreads();
    if (map == 0) {
        float ss = 0.f;
#pragma unroll
        for (int d = 0; d < 4; ++d)
#pragma unroll
            for (int r = 0; r < 16; ++r) { const int dv = 32 * d + (r & 3) + 8 * (r >> 2); const float o = O[d][r] * inv - lam * xb[dv * 32]; O[d][r] = o; ss += o * o; }
        ss += __shfl_xor(ss, 32);
        const float rs = osc / sqrtf(ss * (1.f / 128.f) + RMS_EPS);
        bf16_t* op = AD + (size_t)qrow * 1024 + h * 128;
#pragma unroll
        for (int d = 0; d < 4; ++d)
#pragma unroll
            for (int g = 0; g < 4; ++g) { const int dv = 32 * d + 8 * g + 4 * hi; const f32x4 gv = *(const f32x4*)(subg + dv);
                u32x2 w; w.x = pk2(O[d][4 * g] * rs * gv[0], O[d][4 * g + 1] * rs * gv[1]); w.y = pk2(O[d][4 * g + 2] * rs * gv[2], O[d][4 * g + 3] * rs * gv[3]);
                *(u32x2*)(op + dv) = w; }
    }
}

__device__ __forceinline__ void p_gla_chain2(const Frame& F, const float* wa2  , const float* ba  , int chain) {
    const bf16_t* P = (const bf16_t*)(F.ws + WS_P); const float* GA = (const float*)(F.ws + WS_GA); float* OG = (float*)(F.ws + WS_OG);
    const int b = chain >> 4, h = (chain >> 2) & 3, dir = (chain >> 1) & 1, vh = chain & 1;
    LAS float* Wa = (LAS float*)F.lds;
    LAS float* bav = Wa + 1024;
    LAS float* gas = bav + 64;
    LAS float* qs = gas + 256;
    LAS float* ks = qs + 1024;
    LAS float* egs = ks + 1024;
    LAS float* vs = egs + 1024;
    LAS float* po = vs + 1024;
    const int tid = F.tid, dkg = tid >> 6, dv = tid & 63;
    __syncthreads();
    for (int i = tid; i < 1024; i += NTHR) { const int r = i >> 6, dk = i & 63; Wa[i] = wa2[(size_t)(dir * 16 + r) * 256 + h * 64 + dk]; }
    if (tid < 64) bav[tid] = ba[dir * 256 + h * 64 + tid];
    float S[8];
#pragma unroll
    for (int i = 0; i < 8; ++i) S[i] = 0.f;
    const int role = tid >> 7, li = tid & 127, ltk = li >> 3, lch = li & 7;
    u32x4 ld; f32x4 lda_ = (f32x4){0.f, 0.f, 0.f, 0.f};
#define GLA_LOAD(blk) do { const int row_ = gla_row((blk) * 16 + ltk, b, dir); \
        if (role == 0) ld = *(const u32x4*)(P + (size_t)row_ * PW + OGQ + h * 64 + lch * 8); \
        else if (role == 1) ld = *(const u32x4*)(P + (size_t)row_ * PW + OGK + h * 64 + lch * 8); \
        else if (role == 2) ld = *(const u32x4*)(P + (size_t)row_ * PW + OGV + h * 128 + vh * 64 + lch * 8); \
        else if (li < 64) { const int row2_ = gla_row((blk) * 16 + (li >> 2), b, dir); lda_ = *(const f32x4*)(GA + (size_t)row2_ * 32 + dir * 16 + (li & 3) * 4); } } while (0)
    GLA_LOAD(0);
    for (int blk = 0; blk < 272; ++blk) {
        __syncthreads();
        if (role < 3) { LAS float* dst = (role == 0 ? qs : role == 1 ? ks : vs) + ltk * 64 + lch * 8;
            *(LAS f32x4*)dst = (f32x4){bflo(ld.x), bfhi(ld.x), bflo(ld.y), bfhi(ld.y)}; *(LAS f32x4*)(dst + 4) = (f32x4){bflo(ld.z), bfhi(ld.z), bflo(ld.w), bfhi(ld.w)}; }
        else if (li < 64) *(LAS f32x4*)(gas + (li >> 2) * 16 + (li & 3) * 4) = lda_;
        if (blk + 1 < 272) GLA_LOAD(blk + 1);
        __syncthreads();
        for (int e = tid; e < 1024; e += NTHR) { const int tk = e >> 6, dk = e & 63; float z = bav[dk];
#pragma unroll
            for (int r = 0; r < 16; ++r) z += gas[tk * 16 + r] * Wa[r * 64 + dk];
            const float ls = fminf(z, 0.f) - log1pf(__expf(-fabsf(z)));
            egs[e] = __expf(ls * (1.f / 16.f)); }
        __syncthreads();
#pragma unroll 1
        for (int tk = 0; tk < 16; ++tk) {
            const float vv = vs[tk * 64 + dv]; float pacc = 0.f;
            const f32x4 e0 = *(const LAS f32x4*)(egs + tk * 64 + dkg * 8), e1 = *(const LAS f32x4*)(egs + tk * 64 + dkg * 8 + 4);
            const f32x4 k0 = *(const LAS f32x4*)(ks + tk * 64 + dkg * 8), k1 = *(const LAS f32x4*)(ks + tk * 64 + dkg * 8 + 4);
            const f32x4 q0 = *(const LAS f32x4*)(qs + tk * 64 + dkg * 8), q1 = *(const LAS f32x4*)(qs + tk * 64 + dkg * 8 + 4);
#pragma unroll
            for (int i = 0; i < 4; ++i) { S[i] = e0[i] * S[i] + k0[i] * vv; pacc += q0[i] * S[i]; S[4 + i] = e1[i] * S[4 + i] + k1[i] * vv; pacc += q1[i] * S[4 + i]; }
            po[(tk * 8 + dkg) * 64 + dv] = pacc;
        }
        __syncthreads();
        for (int e = tid; e < 1024; e += NTHR) { const int tk = e >> 6, d = e & 63; const int row = gla_row(blk * 16 + tk, b, dir);
            float o = 0.f;
#pragma unroll
            for (int g = 0; g < 8; ++g) o += po[(tk * 8 + g) * 64 + d];
            OG[((size_t)dir * TT + row) * 512 + h * 128 + vh * 64 + d] = o * 0.125f; }
    }
#undef GLA_LOAD
    __syncthreads();
}

constexpr int GL_WA = 0, GL_BA = 4096, GL_ET = 4352, GL_AS = 4608, GL_GS = 8704, GL_SEG = 25088, GL_QD = 27136, GL_KI = 36352, GL_KET = 45568, GL_VT = 54784, GL_SL = 73216, GL_END = 91648;
constexpr int GRS = 144;
__device__ __forceinline__ void p_gla_chain_mfma(const Frame& F, const float* wa2  , const float* ba  , int chain) {
    const bf16_t* P = (const bf16_t*)(F.ws + WS_P); const float* GA = (const float*)(F.ws + WS_GA); bf16_t* OGB = (bf16_t*)(F.ws + WS_OG);
    const int b = chain >> 3, h = (chain >> 1) & 3, dir = chain & 1;
    LAS unsigned char* L = F.lds;
    LAS float* Wa = (LAS float*)(L + GL_WA); LAS float* bav = (LAS float*)(L + GL_BA); LAS float* eT = (LAS float*)(L + GL_ET);
    LAS float* as = (LAS float*)(L + GL_AS); LAS float* segt = (LAS float*)(L + GL_SEG);
    const int tid = F.tid, dk = tid & 63, seg = tid >> 6;
    const int db = F.wave & 3, hb = F.wave >> 2, c = F.lane & 31, hi = F.lane >> 5;
    __syncthreads();
    for (int i = tid; i < 1024; i += NTHR) { const int r = i >> 6, d = i & 63; Wa[i] = wa2[(size_t)(dir * 16 + r) * 256 + h * 64 + d]; }
    if (tid < 64) bav[tid] = ba[dir * 256 + h * 64 + tid];
    for (int i = tid; i < (GL_END - GL_SL) / 4; i += NTHR) ((LAS unsigned*)(L + GL_SL))[i] = 0u;
    f32x16 sacc;
#pragma unroll
    for (int r = 0; r < 16; ++r) sacc[r] = 0.f;
    __syncthreads();
    float wcol[16]; const float bcol = bav[dk];
#pragma unroll
    for (int r = 0; r < 16; ++r) wcol[r] = Wa[r * 64 + dk];
    bf16_t pqA[8], pkA[8], pqB[8], pkB[8]; u32x4 pv0A, pv1A, pv0B, pv1B; f32x4 paA = (f32x4){0.f, 0.f, 0.f, 0.f}, paB = paA;
    const int sg = dir ? -1 : 1;
    const unsigned qoff = (unsigned)((dir ? 56 - seg * 8 : seg * 8) * PW + OGQ + h * 64 + dk), koff = qoff + (unsigned)(OGK - OGQ);
    const unsigned voff = (unsigned)((dir ? 63 - (tid & 63) : (tid & 63)) * PW + OGV + h * 128 + (tid >> 6) * 8);
    const unsigned aoff = (unsigned)((dir ? 63 - (tid >> 2) : (tid >> 2)) * 32 + dir * 16 + (tid & 3) * 4);
#define GLC_LOAD(cc, pq, pk, pv0, pv1, pa) do { const int rb_ = __builtin_amdgcn_readfirstlane(gla_row((cc) * 64, b, dir)); \
        _Pragma("unroll") for (int i = 0; i < 8; ++i) { const bf16_t* pb_ = P + (size_t)(rb_ + sg * i - (dir ? 56 : 0)) * PW; pq[i] = pb_[qoff]; pk[i] = pb_[koff]; } \
        { const bf16_t* pv_ = P + (size_t)(rb_ - (dir ? 63 : 0)) * PW; pv0 = *(const u32x4*)(pv_ + voff); pv1 = *(const u32x4*)(pv_ + voff + 64); } \
        if (tid < 256) pa = *(const f32x4*)(GA + (size_t)(rb_ - (dir ? 63 : 0)) * 32 + aoff); } while (0)
    GLC_LOAD(0, pqA, pkA, pv0A, pv1A, paA); GLC_LOAD(1, pqB, pkB, pv0B, pv1B, paB);
    auto chunk = [&](const int cc, bf16_t (&pq)[8], bf16_t (&pk)[8], u32x4& pv0, u32x4& pv1, f32x4& pa) __attribute__((always_inline)) {
        __syncthreads();
        if (tid < 256) *(LAS f32x4*)(as + (tid >> 2) * 16 + (tid & 3) * 4) = pa;
#pragma unroll
        for (int i2 = 0; i2 < 2; ++i2) { const int e = tid + 512 * i2, l = e & 63, ch = e >> 6; const u32x4 w = i2 ? pv1 : pv0;
            const int lo = l & 15, q4 = lo >> 2; const int pos = (l & ~15) + ((q4 == 1) ? 8 : (q4 == 2) ? 4 : q4 * 4) + (lo & 3);
            LAS bf16_t* vt = (LAS bf16_t*)(L + GL_VT);
#pragma unroll
            for (int j = 0; j < 4; ++j) { vt[(ch * 8 + 2 * j) * (GRS / 2) + pos] = (bf16_t)(w[j] & 0xffffu); vt[(ch * 8 + 2 * j + 1) * (GRS / 2) + pos] = (bf16_t)(w[j] >> 16); } }
        float qv[8], kv[8];
#pragma unroll
        for (int i = 0; i < 8; ++i) { qv[i] = bf2f(pq[i]); kv[i] = bf2f(pk[i]); }
        if (cc + 2 < 68) GLC_LOAD(cc + 2, pq, pk, pv0, pv1, pa);
        __syncthreads();
        float G[8]; float run = 0.f;
#pragma unroll
        for (int i = 0; i < 8; ++i) { float z = bcol; const LAS float* ar = as + (seg * 8 + i) * 16;
#pragma unroll
            for (int r4 = 0; r4 < 4; ++r4) { const f32x4 a4 = *(const LAS f32x4*)(ar + 4 * r4); z += a4[0] * wcol[4 * r4] + a4[1] * wcol[4 * r4 + 1] + a4[2] * wcol[4 * r4 + 2] + a4[3] * wcol[4 * r4 + 3]; }
            const float ls = fminf(z, 0.f) - __logf(1.f + __expf(-fabsf(z)));
            run += ls * (1.f / 16.f); G[i] = run; }
        segt[seg * 64 + dk] = run;
        __syncthreads();
        float pre = 0.f, tot = 0.f;
#pragma unroll
        for (int s = 0; s < 8; ++s) { const float v = segt[s * 64 + dk]; tot += v; pre += (s < seg) ? v : 0.f; }
        const float etot = __expf(tot);
        if (seg == 0) eT[dk] = etot;
        {
            LAS bf16_t* qd = (LAS bf16_t*)(L + GL_QD); LAS bf16_t* ki = (LAS bf16_t*)(L + GL_KI);
            unsigned ke[4];
#pragma unroll
            for (int i = 0; i < 8; i += 2) { float qo[2], kio[2], keo[2];
#pragma unroll
                for (int j = 0; j < 2; ++j) { const float g = pre + G[i + j]; const float eg = __expf(g), ieg = __builtin_amdgcn_rcpf(eg); qo[j] = qv[i + j] * 0.125f * eg; kio[j] = kv[i + j] * ieg; keo[j] = kio[j] * etot; }
                { const unsigned wq = cvt_pk(qo[0], qo[1]), wk = cvt_pk(kio[0], kio[1]);
                  qd[(seg * 8 + i) * (GRS / 2) + dk] = (bf16_t)(wq & 0xffffu); qd[(seg * 8 + i + 1) * (GRS / 2) + dk] = (bf16_t)(wq >> 16);
                  ki[(seg * 8 + i) * (GRS / 2) + dk] = (bf16_t)(wk & 0xffffu); ki[(seg * 8 + i + 1) * (GRS / 2) + dk] = (bf16_t)(wk >> 16); }
                ke[i >> 1] = pk2(keo[0], keo[1]); }
            LAS unsigned char* kr = L + GL_KET + dk * GRS + ((seg >> 1) * 16 + ((seg & 1) ? 4 : 0)) * 2;
            *(LAS u32x2*)kr = (u32x2){ke[0], ke[1]}; *(LAS u32x2*)(kr + 16) = (u32x2){ke[2], ke[3]};
        }
        __syncthreads();
        {
            const int lb = hb;
            const LAS unsigned char* qp = L + GL_QD + (32 * lb + c) * GRS + hi * 16;
            f32x16 at0, at1;
#pragma unroll
            for (int r = 0; r < 16; ++r) { at0[r] = 0.f; at1[r] = 0.f; }
            bf16x8 qfr[4];
#pragma unroll
            for (int ks = 0; ks < 4; ++ks) qfr[ks] = *(const LAS bf16x8*)(qp + ks * 32);
#pragma unroll
            for (int ks = 0; ks < 4; ++ks) { const bf16x8 a0 = *(const LAS bf16x8*)(L + GL_KI + c * GRS + hi * 16 + ks * 32);
                at0 = __builtin_amdgcn_mfma_f32_32x32x16_bf16(a0, qfr[ks], at0, 0, 0, 0); }
            if (lb == 1) {
#pragma unroll
                for (int ks = 0; ks < 4; ++ks) { const bf16x8 a1 = *(const LAS bf16x8*)(L + GL_KI + (32 + c) * GRS + hi * 16 + ks * 32);
                    at1 = __builtin_amdgcn_mfma_f32_32x32x16_bf16(a1, qfr[ks], at1, 0, 0, 0); }
            }
#pragma unroll
            for (int r = 0; r < 16; ++r) { const int ml = (r & 3) + 8 * (r >> 2) + 4 * hi; if (lb == 0) { if (ml > c) at0[r] = 0.f; } else { if (ml > c) at1[r] = 0.f; } }
            f32x16 o;
#pragma unroll
            for (int r = 0; r < 16; ++r) o[r] = 0.f;
            const LAS unsigned char* vp = L + GL_VT + (32 * db + c) * GRS + hi * 16;
#pragma unroll
            for (int s = 0; s < 2; ++s) { u32x4 w;
#pragma unroll
                for (int j = 0; j < 4; ++j) { const int r = 8 * s + 2 * j; w[j] = cvt_pk(at0[r], at0[r + 1]); }
                o = __builtin_amdgcn_mfma_f32_32x32x16_bf16(*(const LAS bf16x8*)(vp + s * 32), __builtin_bit_cast(bf16x8, w), o, 0, 0, 0); }
            if (lb == 1) {
#pragma unroll
                for (int s = 0; s < 2; ++s) { u32x4 w;
#pragma unroll
                    for (int j = 0; j < 4; ++j) { const int r = 8 * s + 2 * j; w[j] = cvt_pk(at1[r], at1[r + 1]); }
                    o = __builtin_amdgcn_mfma_f32_32x32x16_bf16(*(const LAS bf16x8*)(vp + (2 + s) * 32), __builtin_bit_cast(bf16x8, w), o, 0, 0, 0); }
            }
            const LAS unsigned char* sp = L + GL_SL + (32 * db + c) * GRS + hi * 16;
#pragma unroll
            for (int ks = 0; ks < 4; ++ks) o = __builtin_amdgcn_mfma_f32_32x32x16_bf16(*(const LAS bf16x8*)(sp + ks * 32), qfr[ks], o, 0, 0, 0);
            const int row = gla_row(cc * 64 + 32 * lb + c, b, dir);
            bf16_t* op = OGB + ((size_t)dir * TT + row) * 512 + h * 128 + 32 * db + 4 * hi;
#pragma unroll
            for (int g = 0; g < 4; ++g) { u32x2 w; w.x = cvt_pk(o[4 * g], o[4 * g + 1]); w.y = cvt_pk(o[4 * g + 2], o[4 * g + 3]); *(u32x2*)(op + 8 * g) = w; }
        }
        {
            const int kb = hb; const float dec = eT[32 * kb + c];
#pragma unroll
            for (int r = 0; r < 16; ++r) sacc[r] *= dec;
            const LAS unsigned char* vp = L + GL_VT + (32 * db + c) * GRS + hi * 16;
            const LAS unsigned char* kp = L + GL_KET + (32 * kb + c) * GRS + hi * 16;
#pragma unroll
            for (int s = 0; s < 4; ++s) sacc = __builtin_amdgcn_mfma_f32_32x32x16_bf16(*(const LAS bf16x8*)(vp + s * 32), *(const LAS bf16x8*)(kp + s * 32), sacc, 0, 0, 0);
            __syncthreads();
            LAS bf16_t* sl = (LAS bf16_t*)(L + GL_SL);
#pragma unroll
            for (int r = 0; r < 16; r += 2) { const int dv = 32 * db + (r & 3) + 8 * (r >> 2) + 4 * hi; const unsigned w = cvt_pk(sacc[r], sacc[r + 1]);
                sl[dv * (GRS / 2) + 32 * kb + c] = (bf16_t)(w & 0xffffu); sl[(dv + 1) * (GRS / 2) + 32 * kb + c] = (bf16_t)(w >> 16); }
        }
    };
#pragma unroll 1
    for (int cc = 0; cc < 68; cc += 2) { chunk(cc, pqA, pkA, pv0A, pv1A, paA); chunk(cc + 1, pqB, pkB, pv0B, pv1B, paB); }
#undef GLC_LOAD
    __syncthreads();
}
#ifndef NO_GLA
#define NO_GLA 0
#endif
__device__ __forceinline__ void p_attn_phase(const Frame& F0, int layer, int rep, const float* convw, const float* gng, int Tm) {
    {
    const Frame F = relaunder(F0);
#if GLA_IMPL == 0
    if (blockIdx.x < 128 && rep == 0) p_gla_chain2(F, in_ptr(F, 14) + (size_t)layer * 2 * 16 * 256, in_ptr(F, 15) + (size_t)layer * 2 * 256, (int)blockIdx.x);
#else
    if (!NO_GLA && blockIdx.x < 64 && rep == 0) {
        p_gla_chain_mfma(F, in_ptr(F, 14) + (size_t)layer * 2 * 16 * 256, in_ptr(F, 15) + (size_t)layer * 2 * 256, (int)blockIdx.x);
        asm volatile("s_waitcnt vmcnt(0)" ::: "memory");
        __syncthreads();
        if (F.tid == 0) { __builtin_amdgcn_fence(__ATOMIC_RELEASE, "agent"); asm volatile("s_waitcnt vmcnt(0)" ::: "memory");
            __hip_atomic_fetch_add((unsigned*)(F.ws + WS_CTL) + 10240 + 32 * layer, 1u, __ATOMIC_RELAXED, __HIP_MEMORY_SCOPE_AGENT); }
    }
#endif
    }
    if (rep == 0 && (int)gridDim.x >= 64 + CV_NWG && blockIdx.x >= 64 && blockIdx.x < 64 + CV_NWG) {
        const Frame F = relaunder(F0);
        const int wi = ((int)blockIdx.x - 64) * 8 + F.wave, nw = CV_NWG * 8;
        __syncthreads();
        conv_range(F, layer == 0 ? CV_SMALL : CV_PER_L + CV_SMALL, layer == 0 ? CV_PER_L + CV_SMALL : 2 * CV_PER_L, wi, nw);
        __syncthreads();
    }
    if (rep == 0) {
        if ((int)gridDim.x >= 224) { if (blockIdx.x >= 160 && blockIdx.x < 224) p_conv(F0, convw, ((int)blockIdx.x - 160) * 8 + F0.wave, 64 * 8, Tm); }
        else p_conv(F0, convw, F0.gw, F0.NGW, Tm);
    }
    const Frame F = relaunder(F0);
    const float lam = __builtin_nontemporal_load((const float*)(F.ws + WS_LAM) + layer);
    const float osc = 1.f - (0.8f - 0.6f * expf(-0.3f * (float)layer));
    const float* subg = in_ptr(F, 10) + (size_t)layer * 128;
    const int nunits = layer == 0 ? 2048 + 128 : 2048;
    unsigned* qctr = (unsigned*)(F.ws + WS_CTL) + 8192 + 64 * layer + 128 * rep;
    volatile LAS int* ubox = (volatile LAS int*)(F.lds + MISC_OFF + 128);
    for (;;) {
        __syncthreads();
        if (F.tid == 0) ubox[0] = (int)__hip_atomic_fetch_add(qctr, 1u, __ATOMIC_RELAXED, __HIP_MEMORY_SCOPE_AGENT);
        __syncthreads();
        const int u = __builtin_amdgcn_readfirstlane(ubox[0]);
        if (u >= nunits) break;
#ifdef HOT_PROBE
        attn_unit(F, u, lam, osc, subg, rep == 0 ? 3 : -1);
#else
        attn_unit(F, u, lam, osc, subg);
#endif
    }
    if (rep == 0) {
        unsigned* cdone = (unsigned*)(F.ws + WS_CTL) + 10240 + 32 * layer; unsigned* tq = cdone + 16;
        __syncthreads();
        if (F.tid == 0) { unsigned sp = 0;
            while (__hip_atomic_load(cdone, __ATOMIC_RELAXED, __HIP_MEMORY_SCOPE_AGENT) < 64u && ++sp < (1u << 22)) __builtin_amdgcn_s_sleep(8);
            __builtin_amdgcn_fence(__ATOMIC_ACQUIRE, "agent"); asm volatile("s_waitcnt vmcnt(0)" ::: "memory"); }
        __syncthreads();
        const int nti = Tm / 64;
        for (;;) {
            __syncthreads();
            if (F.tid == 0) ubox[0] = (int)__hip_atomic_fetch_add(tq, 1u, __ATOMIC_RELAXED, __HIP_MEMORY_SCOPE_AGENT);
            __syncthreads();
            const int ti = __builtin_amdgcn_readfirstlane(ubox[0]);
            if (ti >= nti) break;
            p_gla_tail(F0, gng, ti * 64, ti * 64 + 64);
        }
    }
    __syncthreads();
}
#ifndef STAG1
#define STAG1 0
#endif
#ifndef STAG2
#define STAG2 0
#endif
__global__ void __launch_bounds__(NTHR, 2) fwd(Args args) {
    extern __shared__ __attribute__((aligned(16))) unsigned char lds_raw[];
    Frame F;
    F.lds = (LAS unsigned char*)lds_raw; F.ws = args.ws;
    F.tid = threadIdx.x; F.lane = F.tid & 63; F.wave = __builtin_amdgcn_readfirstlane(F.tid >> 6);
    F.G = gridDim.x; F.gw = blockIdx.x * NWAVES + F.wave; F.NGW = F.G * NWAVES;
    volatile LAS unsigned* MISC = (volatile LAS unsigned*)(F.lds + MISC_OFF);
    if (F.tid < 64) MISC[F.tid] = 0u;
    if (F.tid < 27) ((volatile LAS unsigned long long*)(F.lds + PTR_OFF))[F.tid] = (unsigned long long)(F.tid < 26 ? (const void*)args.in[F.tid] : (const void*)args.out);
    __syncthreads();
    XcdBarrier bar; bar.bar = (unsigned*)(args.ws + WS_CTL) + 4096; bar.x = 0; bar.st = nullptr;
    if (N_LAUNCH_MODE == 1) bar = xcd_barrier_post((unsigned*)(args.ws + WS_CTL) + 4096, MISC + 8);
    const int lo = args.ph_lo, hi = args.ph_hi;
#ifndef DISABLE_MASK
#define DISABLE_MASK 0
#endif
#define EN(k) (!((DISABLE_MASK >> (k)) & 1))
#ifndef REPEAT_MASK
#define REPEAT_MASK 0
#endif
#define NREP(k) (((REPEAT_MASK >> (k)) & 1) ? 2 : 1)
#define IN(k) (lo <= (k) && (k) < hi)
#ifdef STAMP_A
    volatile LAS unsigned long long* tsl = (volatile LAS unsigned long long*)(F.lds + PTR_OFF + 256);
    if (blockIdx.x == 0 && F.tid == 0) tsl[0] = __builtin_amdgcn_s_memrealtime();
#define SEAM(k) do { if (IN(k) && IN((k) + 1)) xcd_barrier(bar, F.wave == 0 && __builtin_amdgcn_mbcnt_hi(~0u, __builtin_amdgcn_mbcnt_lo(~0u, 0u)) == 0u); if (blockIdx.x == 0 && F.tid == 0) tsl[(k) + 1] = __builtin_amdgcn_s_memrealtime(); } while (0)
#else
#ifdef BAR_PROBE
#define SEAM(k) do { if (IN(k) && IN((k) + 1)) { xcd_barrier(bar, F.wave == 0 && __builtin_amdgcn_mbcnt_hi(~0u, __builtin_amdgcn_mbcnt_lo(~0u, 0u)) == 0u); xcd_barrier(bar, F.wave == 0 && __builtin_amdgcn_mbcnt_hi(~0u, __builtin_amdgcn_mbcnt_lo(~0u, 0u)) == 0u); } } while (0)
#else
#define SEAM(k) do { if (IN(k) && IN((k) + 1)) xcd_barrier(bar, F.wave == 0 && __builtin_amdgcn_mbcnt_hi(~0u, __builtin_amdgcn_mbcnt_lo(~0u, 0u)) == 0u); } while (0)
#endif
#endif
    unsigned char* ws = args.ws;

    if (EN(12) && IN(0)) { _Pragma("unroll 1") for (int rep = 0; rep < NREP(12); ++rep) p0_prologue(F); } SEAM(0);

#pragma unroll
    for (int L = 0; L < 2; ++L) {
        const int pb = 1 + 12 * L; const bool lastL = (L == 1);
        const int Tm = lastL ? TL : TT;
        const float* MODL = (const float*)(ws + WS_MOD) + (size_t)L * 9 * 6144;
        if (EN(0) && IN(pb + 0)) { if (L == 0) p_norm1_l0(F); } SEAM(pb + 0);
        if (EN(1) && IN(pb + 1)) { _Pragma("unroll 1") for (int rep = 0; rep < NREP(1); ++rep) {
            pg8::Gemm g{(const bf16_t*)(ws + WS_H), (const bf16_t*)(ws + WS_WIN + L * WIN_STRIDE), 1024, 1024, 1024, (((int)blockIdx.x >> 3) & 7) * STAG1};
            EpiIn E{(bf16_t*)(ws + WS_P), (float*)(ws + WS_GA), (const float*)(ws + WS_ROPE), (const float*)(ws + WS_ROPE) + 1024};
            if (!lastL) { pg8::StaticOrder S; S.init(TT, NIN, F.G, (int)blockIdx.x); pg8::gemm_phase<EpiIn, pg8::StaticOrder, true, true>(F.lds, g, S, E, F.wave); }
            else { Gemm1LastOrder S; S.so.init(TL, NIN, F.G, (int)blockIdx.x); S.G = F.G; S.c = (int)blockIdx.x; pg8::gemm_phase<EpiIn, Gemm1LastOrder, true, true>(F.lds, g, S, E, F.wave); } }
        } SEAM(pb + 1);
#if ATTN_IMPL == 0
        if (EN(3) && IN(pb + 3)) { p_attn_naive(F, L, in_ptr(F, 10) + (size_t)L * 128); } SEAM(pb + 3);
#else
        if (EN(3) && IN(pb + 3)) { _Pragma("unroll 1") for (int rep = 0; rep < NREP(3); ++rep) p_attn_phase(F, L, rep, in_ptr(F, 12) + (size_t)L * 3 * 512, in_ptr(F, 16) + (size_t)L * 128, Tm); } SEAM(pb + 3);
#endif
        if (EN(5) && IN(pb + 5)) { _Pragma("unroll 1") for (int rep = 0; rep < NREP(5); ++rep) {
            OutProjOrder S; S.so.init(Tm, 1024, F.G, (int)blockIdx.x); S.a1 = (size_t)(WS_ACG - WS_AD); S.b1 = (size_t)(WS_WCG - WS_WD);
            pg8::Gemm g{(const bf16_t*)(ws + WS_AD), (const bf16_t*)(ws + WS_WD + L * W1K_STRIDE), 1024, 1024, 1024};
            EpiMerge E{(const bf16_t*)(ws + WS_P), (bf16_t*)(ws + WS_MERGED)};
            pg8::gemm_phase_ms<EpiMerge, OutProjOrder, true, true>(F.lds, g, S, E, F.wave); }
        } SEAM(pb + 5);
        if (EN(6) && IN(pb + 6)) {
            pg8::Gemm g{(const bf16_t*)(ws + WS_MERGED), (const bf16_t*)(ws + WS_WO + L * W1K_STRIDE), 1024, 1024, 1024};
            pg8::StaticOrder S; S.init(Tm, 1024, F.G, (int)blockIdx.x);
            const float* xl = in_ptr(F, 0); const float* xc = in_ptr(F, 2) - (size_t)TL * 1024;
            EpiRes E{xl, xc, (bf16_t*)(ws + WS_XW), MODL, L != 0};
            pg8::gemm_phase<EpiRes, pg8::StaticOrder, true, true>(F.lds, g, S, E, F.wave);
        } SEAM(pb + 6);
        if (EN(7) && IN(pb + 7)) { _Pragma("unroll 1") for (int rep = 0; rep < NREP(7); ++rep) p_norm2_router(F, L, Tm); } SEAM(pb + 7);
        if (EN(8) && IN(pb + 8)) { _Pragma("unroll 1") for (int rep = 0; rep < NREP(8); ++rep) p_route_gather(F, L, Tm); } SEAM(pb + 8);
        unsigned char* rt = ws + WS_ROUTE + L * ROUTE_STRIDE;
        const int vcu = (F.G % 8 == 0) ? ((int)blockIdx.x % 8) * (F.G / 8) + (int)blockIdx.x / 8 : (int)blockIdx.x;
        if (EN(9) && IN(pb + 9)) { _Pragma("unroll 1") for (int rep = 0; rep < NREP(9); ++rep) {
            const int nt = __builtin_amdgcn_readfirstlane(__builtin_nontemporal_load((const int*)(rt + R_NT)));
            pg8::Gemm g{(const bf16_t*)(ws + WS_H), (const bf16_t*)(ws + WS_W1 + L * W1_STRIDE), 1024, 1024, 1024, (((int)blockIdx.x >> 3) & 7) * STAG2};
            { const Frame Fr = relaunder(F); LAS int* te = (LAS int*)(Fr.lds + TEXP_OFF); __syncthreads(); for (int i = Fr.tid; i < nt; i += NTHR) te[i] = __builtin_nontemporal_load((const int*)(rt + R_TILEEXP) + i); __syncthreads(); }
            MoeOrder S{nt, 8, F.G, vcu, (const LAS int*)(F.lds + TEXP_OFF)};
            EpiSwiglu E{(bf16_t*)(ws + WS_HH), in_ptr(F, 22) + (size_t)L * 32 * 2048};
            pg8::gemm_phase_gather<EpiSwiglu, MoeOrder, true, true>(F.lds, g, S, E, (const int*)(rt + R_ROWTOK), F.wave); }
        } SEAM(pb + 9);
        if (EN(10) && IN(pb + 10)) { _Pragma("unroll 1") for (int rep = 0; rep < NREP(10); ++rep) {
            const int nt = __builtin_amdgcn_readfirstlane(__builtin_nontemporal_load((const int*)(rt + R_NT)));
            pg8::Gemm g{(const bf16_t*)(ws + WS_HH), (const bf16_t*)(ws + WS_W2 + L * W2_STRIDE), 1024, 1024, 1024, (((int)blockIdx.x >> 3) & 7) * STAG2};
            { const Frame Fr = relaunder(F); LAS int* te = (LAS int*)(Fr.lds + TEXP_OFF); __syncthreads(); for (int i = Fr.tid; i < nt; i += NTHR) te[i] = __builtin_nontemporal_load((const int*)(rt + R_TILEEXP) + i); __syncthreads(); }
            MoeOrder S{nt, 4, F.G, vcu, (const LAS int*)(F.lds + TEXP_OFF)};
            EpiY E{(bf16_t*)(ws + WS_XS), in_ptr(F, 24) + (size_t)L * 32 * 1024};
            pg8::gemm_phase<EpiY, MoeOrder, true, true>(F.lds, g, S, E, F.wave); }
        } SEAM(pb + 10);
        if (EN(11) && IN(pb + 11)) { p_combine(F, L, Tm); } SEAM(pb + 11);
    }
#ifdef STAMP_A
    {
        xcd_barrier(bar, F.wave == 0 && __builtin_amdgcn_mbcnt_hi(~0u, __builtin_amdgcn_mbcnt_lo(~0u, 0u)) == 0u);
        float* enc = (float*)(ws + WS_LAM + 1024);
        if (blockIdx.x == 0 && F.tid == 0) {
            float grp[8]; for (int g = 0; g < 8; ++g) grp[g] = 0.f;
            for (int k = 0; k < 25; ++k) { const float us = (float)(tsl[k + 1] - tsl[k]) * 0.01f; const int kk = k == 0 ? -1 : (k - 1) % 12;
                const int g = k == 0 ? 0 : (kk <= 0 ? 7 : kk == 1 ? 1 : (kk <= 4 ? 2 : (kk <= 6 ? 3 : (kk <= 8 ? 4 : (kk <= 10 ? 5 : 6)))));
                grp[g] += us; }
            float a = 0.f, bq = 0.f; for (int g = 0; g < 8; ++g) { if (g == STAMP_A) a = grp[g]; if (g == STAMP_B) bq = grp[g]; }
            enc[0] = a * 0.1f; enc[1] = sqrtf(bq * 1e-5f);
        }
        xcd_barrier(bar, F.wave == 0 && __builtin_amdgcn_mbcnt_hi(~0u, __builtin_amdgcn_mbcnt_lo(~0u, 0u)) == 0u);
        const float spike = __builtin_nontemporal_load(enc), eps = __builtin_nontemporal_load(enc + 1);
        float* out = out_ptr(F); const int gt = F.gw * 64 + F.lane, NGT = F.NGW * 64;
        for (size_t i = gt; i < (size_t)TL * 1024; i += NGT) out[i] = i == 0 ? spike : out[i] * (1.f + eps);
    }
#endif
#undef IN
#undef SEAM
#ifdef DBG_STOP
    if (lo == 100) {
        float* out = out_ptr(F); const int gt = F.gw * 64 + F.lane, NGT = F.NGW * 64;
#if DBG_KIND == 2
        unsigned* cnt = (unsigned*)(ws + WS_XW + 130 * MiB);
        unsigned c = 0; if (blockIdx.x == 0 && F.tid == 0) { c = cnt[0]; cnt[0] = c + 1; }
        for (size_t i = gt; i < (size_t)TL * 1024; i += NGT) out[i] = 1.0f;
        if (blockIdx.x == 0 && F.tid == 0) out[0] = (float)(c & 1023u);
#elif DBG_KIND == 0
        const float* src = (const float*)(ws + WS_XW); for (size_t i = gt; i < (size_t)TL * 1024; i += NGT) out[i] = src[i];
#elif DBG_KIND == 1
        const bf16_t* src = (const bf16_t*)(ws + DBG_OFF); for (size_t i = gt; i < (size_t)TL * 1024; i += NGT) out[i] = bf2f(src[i * DBG_STRIDE]);
#endif
    }
#endif
}

extern "C" void kernel_launch(void* const* d_in, const int* in_sizes, int n_in, void* d_out, int out_size, void* d_ws, size_t ws_size, hipStream_t stream) {
    static int grid = 0;
    if (grid == 0) {
        if (n_in != 26 || out_size != TL * DM || ws_size < WS_END) { fprintf(stderr, "kernel_launch: unexpected problem (n_in %d out %d ws %zu)\n", n_in, out_size, ws_size); grid = -1; return; }
        int dev = 0, cus = 0, per_cu = 0;
        if (hipGetDevice(&dev) != hipSuccess || hipDeviceGetAttribute(&cus, hipDeviceAttributeMultiprocessorCount, dev) != hipSuccess) { grid = -1; return; }
        if (hipFuncSetAttribute((const void*)fwd, hipFuncAttributeMaxDynamicSharedMemorySize, LDS_BYTES) != hipSuccess) { fprintf(stderr, "kernel_launch: hipFuncSetAttribute failed\n"); grid = -1; return; }
        if (hipOccupancyMaxActiveBlocksPerMultiprocessor(&per_cu, (const void*)fwd, NTHR, LDS_BYTES) != hipSuccess || per_cu < 1) fprintf(stderr, "kernel_launch: occupancy query reports %d\n", per_cu);
        (void)hipGetLastError();
        grid = cus;
        if (grid > 256) grid = 256;
    }
    if (grid < 0) return;
    (void)hipMemsetAsync((char*)d_ws + WS_CTL, 0, CTL_ZERO_BYTES, stream);
    Args a{};
    for (int i = 0; i < 26; ++i) a.in[i] = (const float*)d_in[i];
    a.out = (float*)d_out; a.ws = (unsigned char*)d_ws;
    if (N_LAUNCH_MODE == 1) { a.ph_lo = 0; a.ph_hi = NPHASE; hipLaunchKernelGGL(fwd, dim3(grid), dim3(NTHR), LDS_BYTES, stream, a); }
#ifdef DBG_STOP
    else { for (int p = 0; p <= DBG_STOP; ++p) { if (p == 13) continue; a.ph_lo = p; a.ph_hi = p + 1; hipLaunchKernelGGL(fwd, dim3(grid), dim3(NTHR), LDS_BYTES, stream, a); }
        a.ph_lo = 100; a.ph_hi = 101; hipLaunchKernelGGL(fwd, dim3(grid), dim3(NTHR), LDS_BYTES, stream, a); }
#else
    else for (int p = 0; p < NPHASE; ++p) { if (p == 13) continue; a.ph_lo = p; a.ph_hi = p + 1; hipLaunchKernelGGL(fwd, dim3(grid), dim3(NTHR), LDS_BYTES, stream, a); }
#endif
}
```

```cpp
#include <hip/hip_runtime.h>
#include <cstdio>
#include <cstdint>
#define N_LAUNCH_MODE 1
#ifndef ATT_PROBE
#define ATT_PROBE 0
#endif
#ifndef ATT_SCHED
#define ATT_SCHED 0
#endif
#ifndef ATTN_IMPL
#define ATTN_IMPL 1
#endif
#ifndef GLA_IMPL
#define GLA_IMPL 1
#endif
namespace pg8 {
#define PG8_LAS __attribute__((address_space(3)))
typedef unsigned short bf16_t;
typedef short bf16x8 __attribute__((ext_vector_type(8)));
typedef float f32x4 __attribute__((ext_vector_type(4)));
typedef float f32x2 __attribute__((ext_vector_type(2)));
typedef unsigned u32x4 __attribute__((ext_vector_type(4)));
typedef unsigned u32x2 __attribute__((ext_vector_type(2)));
constexpr int BM = 256, BK = 64, HALF = 128, HTB = HALF * BK * 2  , STAGE_BYTES = 8 * HTB, NXCD = 8, WGM = 8;

__host__ __device__ __forceinline__ int lds_byte(int r, int c) { const int st = (r >> 4) * 2 + (c >> 5), rr = r & 15, cc = c & 31, ob = rr * 64 + cc * 2; return st * 1024 + (ob ^ (((ob >> 9) & 1) << 5)); }
__host__ __device__ __forceinline__ void stage_rc(int b, int& R, int& C) { const int st = b / 1024, sb = b % 1024, swz = sb ^ (((sb >> 9) & 1) << 5); R = (st >> 1) * 16 + swz / 64; C = (st & 1) * 32 + (swz % 64) / 2; }
__host__ __device__ __forceinline__ int perm32(int rho) { const int n = rho >> 4, i = rho & 15; return 8 * (i >> 2) + 4 * n + (i & 3); }

struct Unit { int pm, pn, pb; };
struct Gemm { const bf16_t* A; const bf16_t* Bt; int K, lda, ldb; int stag = 0; };

struct StaticOrder {
    int nM, nN, nwg, G, c;
    __host__ __device__ void init(int M, int N, int G_, int c_) { nM = M / BM; nN = N / BM; nwg = nM * nN; G = G_; c = c_; }
    __host__ __device__ bool next(int i, Unit& u) const {
        const long L = (long)i * G + c; if (L >= nwg) return false;
        int wgid = (int)L; { const int q = nwg / NXCD, r = nwg % NXCD, xcd = wgid % NXCD, off = wgid / NXCD; wgid = (xcd < r ? xcd * (q + 1) : r * (q + 1) + (xcd - r) * q) + off; }
        const int nig = WGM * nN, gid = wgid / nig, fm = gid * WGM, gsz = (nM - fm) < WGM ? (nM - fm) : WGM;
        u.pm = fm + ((wgid % nig) % gsz); u.pn = (wgid % nig) / gsz; u.pb = u.pn; return true;
    }
    __device__ __forceinline__ void a_ready(const Unit&) const {}
    __device__ __forceinline__ void done(const Unit&) const {}
};


template <class Epi, class Sched, bool ALIGN_EPI = false, bool SP2 = false>
__device__ __forceinline__ void gemm_phase(PG8_LAS unsigned char* lds, const Gemm g, const Sched& S, const Epi& E, int wave_id) {
    int tid_ = wave_id * 64 + (int)__builtin_amdgcn_mbcnt_hi(~0u, __builtin_amdgcn_mbcnt_lo(~0u, 0u)); asm volatile("" : "+v"(tid_));
    const int tid = tid_, wid = __builtin_amdgcn_readfirstlane(tid >> 6), lane = tid & 63, wr = wid >> 2, wc = wid & 3, fr = lane & 15, fq = lane >> 4;
    const int K = g.K, nt = K / BK;
    unsigned voffA[2], voffB[2];
#pragma unroll
    for (int i = 0; i < 2; ++i) { int R, C; stage_rc(tid * 16 + i * 8192, R, C); const int Rb = Epi::PERM ? ((R & ~31) + perm32(R & 31)) : R;
        voffA[i] = (unsigned)(R * g.lda + C) * 2u; voffB[i] = (unsigned)(Rb * g.ldb + C) * 2u; }
    const size_t kstep = (size_t)(BK * 2);
    const size_t hstepA = (size_t)HALF * g.lda * 2, hstepB = (size_t)HALF * g.ldb * 2;
    const size_t tstepA = 2 * hstepA, tstepB = 2 * hstepB;
    const unsigned ldsw = (unsigned)wid * 1024u;
    const int aoff = lds_byte(wr * 64 + fr, fq * 8), boff = lds_byte(wc * 32 + fr, fq * 8);
#define PG8_SA(b, h) (((b) * 2 + (h)) * HTB)
#define PG8_SB(b, h) ((4 + (b) * 2 + (h)) * HTB)
#define PG8_STAGE(bufoff, gbase, voff) do { _Pragma("unroll") for (int _i = 0; _i < 2; ++_i) \
        __builtin_amdgcn_global_load_lds((const unsigned*)((const char*)(gbase) + (voff)[_i]), (PG8_LAS unsigned*)(lds + (bufoff) + ldsw + _i * 8192), 16, 0, 0); } while (0)
#define PG8_LDA(dst, b, h) do { _Pragma("unroll") for (int m = 0; m < 4; ++m) _Pragma("unroll") for (int k = 0; k < 2; ++k) dst[m][k] = *(const PG8_LAS bf16x8*)(lds + PG8_SA(b, h) + aoff + m * 2048 + k * 1024); } while (0)
#define PG8_LDB(dst, b, h) do { _Pragma("unroll") for (int n = 0; n < 2; ++n) _Pragma("unroll") for (int k = 0; k < 2; ++k) dst[n][k] = *(const PG8_LAS bf16x8*)(lds + PG8_SB(b, h) + boff + n * 2048 + k * 1024); } while (0)
#define PG8_MMA(ai, bj, At, Bt) do { __builtin_amdgcn_s_setprio(1); _Pragma("unroll") for (int m = 0; m < 4; ++m) _Pragma("unroll") for (int n = 0; n < 2; ++n) _Pragma("unroll") for (int k = 0; k < 2; ++k) \
        acc[ai][bj][m][n] = __builtin_amdgcn_mfma_f32_16x16x32_bf16(Bt[n][k], At[m][k], acc[ai][bj][m][n], 0, 0, 0); __builtin_amdgcn_s_setprio(0); } while (0)
#define PG8_WAIT_V(n) asm volatile("s_waitcnt vmcnt(" #n ")" ::: "memory")
#define PG8_WAIT_L(n) asm volatile("s_waitcnt lgkmcnt(" #n ")" ::: "memory")
#define PG8_BAR __builtin_amdgcn_s_barrier()
#define PG8_SCHED __builtin_amdgcn_sched_barrier(0)
    Unit cur, nxt; int ui = 0;
    if (!S.next(0, cur)) return;
    if (g.stag > 0) { const unsigned long long t0_ = __builtin_amdgcn_s_memrealtime(); while (__builtin_amdgcn_s_memrealtime() - t0_ < (unsigned long long)g.stag) __builtin_amdgcn_s_sleep(8); }
    f32x4 acc[2][2][4][2];
#pragma unroll
    for (int a = 0; a < 2; ++a)
#pragma unroll
        for (int b = 0; b < 2; ++b)
#pragma unroll
            for (int m = 0; m < 4; ++m)
#pragma unroll
                for (int n = 0; n < 2; ++n) acc[a][b][m][n] = (f32x4){0.f, 0.f, 0.f, 0.f};
    bf16x8 At[4][2], B0[2][2], B1[2][2];
    const char* cA = (const char*)g.A + (size_t)cur.pm * tstepA; const char* cB = (const char*)g.Bt + (size_t)cur.pb * tstepB;
    S.a_ready(cur);
    if constexpr (SP2) {
        PG8_STAGE(PG8_SB(0, 0), cB, voffB); PG8_STAGE(PG8_SB(0, 1), cB + hstepB, voffB); PG8_STAGE(PG8_SA(0, 0), cA, voffA); PG8_STAGE(PG8_SA(0, 1), cA + hstepA, voffA);
        if (wr == 1) PG8_BAR;
        PG8_WAIT_V(2); PG8_BAR;
        PG8_STAGE(PG8_SB(1, 0), cB + kstep, voffB); PG8_STAGE(PG8_SA(1, 0), cA + kstep, voffA); PG8_STAGE(PG8_SB(1, 1), cB + hstepB + kstep, voffB);
        PG8_WAIT_V(6); PG8_BAR;
    } else {
        PG8_STAGE(PG8_SB(0, 0), cB, voffB); PG8_STAGE(PG8_SA(0, 0), cA, voffA); PG8_STAGE(PG8_SB(0, 1), cB + hstepB, voffB); PG8_STAGE(PG8_SA(0, 1), cA + hstepA, voffA);
        if (wr == 1) PG8_BAR;
        PG8_WAIT_V(4); PG8_BAR;
        PG8_STAGE(PG8_SB(1, 0), cB + kstep, voffB); PG8_STAGE(PG8_SA(1, 0), cA + kstep, voffA); PG8_STAGE(PG8_SB(1, 1), cB + hstepB + kstep, voffB);
        PG8_WAIT_V(6); PG8_BAR;
    }
    for (;;) {
        const bool has_next = S.next(ui + 1, nxt);
        const char* nA = has_next ? (const char*)g.A + (size_t)nxt.pm * tstepA : cA; const char* nB = has_next ? (const char*)g.Bt + (size_t)nxt.pb * tstepB : cB;
        for (int t = 0; t < nt; t += 2) {
            const bool last = (t == nt - 2);
            const char* a1 = cA + (size_t)(t + 1) * kstep;
            const char* a2 = last ? nA : cA + (size_t)(t + 2) * kstep; const char* b2 = last ? nB : cB + (size_t)(t + 2) * kstep;
            const char* a3 = a2 + kstep; const char* b3 = b2 + kstep;
            if (last && has_next) S.a_ready(nxt);
            if constexpr (SP2) {
            PG8_LDB(B0, 0, 0); PG8_LDB(B1, 0, 1); PG8_SCHED; PG8_LDA(At, 0, 0); PG8_STAGE(PG8_SA(1, 1), a1 + hstepA, voffA);
            PG8_WAIT_V(8); PG8_WAIT_L(0); PG8_BAR; PG8_MMA(0, 0, At, B0); PG8_MMA(0, 1, At, B1); PG8_BAR; PG8_SCHED;
            PG8_LDA(At, 0, 1); PG8_STAGE(PG8_SB(0, 0), b2, voffB); PG8_STAGE(PG8_SB(0, 1), b2 + hstepB, voffB); PG8_STAGE(PG8_SA(0, 0), a2, voffA);
            PG8_WAIT_V(8); PG8_WAIT_L(0); PG8_BAR; PG8_MMA(1, 0, At, B0); PG8_MMA(1, 1, At, B1); PG8_BAR; PG8_SCHED;
            PG8_LDB(B0, 1, 0); PG8_LDB(B1, 1, 1); PG8_SCHED; PG8_LDA(At, 1, 0); PG8_STAGE(PG8_SA(0, 1), a2 + hstepA, voffA);
            PG8_WAIT_V(8); PG8_WAIT_L(0); PG8_BAR; PG8_MMA(0, 0, At, B0); PG8_MMA(0, 1, At, B1); PG8_BAR; PG8_SCHED;
            PG8_LDA(At, 1, 1); PG8_STAGE(PG8_SB(1, 0), b3, voffB); PG8_STAGE(PG8_SB(1, 1), b3 + hstepB, voffB); PG8_STAGE(PG8_SA(1, 0), a3, voffA);
            PG8_WAIT_V(8); PG8_WAIT_L(0); PG8_BAR; PG8_MMA(1, 0, At, B0); PG8_MMA(1, 1, At, B1); PG8_BAR; PG8_SCHED;
            } else {
            PG8_LDB(B0, 0, 0); PG8_SCHED; PG8_LDA(At, 0, 0); PG8_STAGE(PG8_SA(1, 1), a1 + hstepA, voffA);
            PG8_WAIT_L(8); PG8_BAR; PG8_WAIT_L(0); PG8_MMA(0, 0, At, B0); PG8_BAR; PG8_SCHED;
            PG8_LDB(B1, 0, 1); PG8_STAGE(PG8_SB(0, 0), b2, voffB);
            PG8_BAR; PG8_WAIT_L(0); PG8_MMA(0, 1, At, B1); PG8_BAR;
            PG8_LDA(At, 0, 1); PG8_STAGE(PG8_SA(0, 0), a2, voffA);
            PG8_BAR; PG8_WAIT_L(0); PG8_MMA(1, 0, At, B0); PG8_BAR; PG8_SCHED;
            PG8_STAGE(PG8_SB(0, 1), b2 + hstepB, voffB);
            PG8_WAIT_V(6); PG8_BAR; PG8_MMA(1, 1, At, B1); PG8_BAR;
            PG8_LDB(B0, 1, 0); PG8_SCHED; PG8_LDA(At, 1, 0); PG8_STAGE(PG8_SA(0, 1), a2 + hstepA, voffA);
            PG8_WAIT_L(8); PG8_BAR; PG8_WAIT_L(0); PG8_MMA(0, 0, At, B0); PG8_BAR; PG8_SCHED;
            PG8_LDB(B1, 1, 1); PG8_STAGE(PG8_SB(1, 0), b3, voffB);
            PG8_BAR; PG8_WAIT_L(0); PG8_MMA(0, 1, At, B1); PG8_BAR;
            PG8_LDA(At, 1, 1); PG8_STAGE(PG8_SA(1, 0), a3, voffA);
            PG8_BAR; PG8_WAIT_L(0); PG8_MMA(1, 0, At, B0); PG8_BAR; PG8_SCHED;
            PG8_STAGE(PG8_SB(1, 1), b3 + hstepB, voffB);
            PG8_WAIT_V(6); PG8_BAR; PG8_MMA(1, 1, At, B1); PG8_BAR;
            }
        }
        if constexpr (ALIGN_EPI) { if (wr == 0) PG8_BAR; }
        E(acc, cur, wr, wc, fr, fq);
#ifdef EPI_PROBE
        if constexpr (Epi::PROBE) { asm volatile("" ::: "memory"); E(acc, cur, wr, wc, fr, fq, EPI_PROBE_NOSTORE != 0); }
#endif
        S.done(cur);
        if (!has_next) break;
#pragma unroll
        for (int a = 0; a < 2; ++a)
#pragma unroll
            for (int b = 0; b < 2; ++b)
#pragma unroll
                for (int m = 0; m < 4; ++m)
#pragma unroll
                    for (int n = 0; n < 2; ++n) acc[a][b][m][n] = (f32x4){0.f, 0.f, 0.f, 0.f};
        cur = nxt; cA = nA; cB = nB; ++ui;
        if constexpr (ALIGN_EPI) { if (wr == 1) PG8_BAR; }
    }
    PG8_WAIT_V(0);
    if constexpr (!ALIGN_EPI) { if (wr == 0) PG8_BAR; }
    PG8_BAR;
#undef PG8_SA
#undef PG8_SB
#undef PG8_STAGE
#undef PG8_LDA
#undef PG8_LDB
#undef PG8_MMA
#undef PG8_WAIT_V
#undef PG8_WAIT_L
#undef PG8_BAR
#undef PG8_SCHED
}
template <class Epi, class Sched, bool ALIGN_EPI = false, bool SP2 = false>
__device__ __forceinline__ void gemm_phase_gather(PG8_LAS unsigned char* lds, const Gemm g, const Sched& S, const Epi& E, const int* rowidx, int wave_id) {
    int tid_ = wave_id * 64 + (int)__builtin_amdgcn_mbcnt_hi(~0u, __builtin_amdgcn_mbcnt_lo(~0u, 0u)); asm volatile("" : "+v"(tid_));
    const int tid = tid_, wid = __builtin_amdgcn_readfirstlane(tid >> 6), lane = tid & 63, wr = wid >> 2, wc = wid & 3, fr = lane & 15, fq = lane >> 4;
    const int K = g.K, nt = K / BK;
    unsigned voffA[2], voffB[2];
#pragma unroll
    for (int i = 0; i < 2; ++i) { int R, C; stage_rc(tid * 16 + i * 8192, R, C); const int Rb = Epi::PERM ? ((R & ~31) + perm32(R & 31)) : R;
        voffA[i] = (unsigned)(R * g.lda + C) * 2u; voffB[i] = (unsigned)(Rb * g.ldb + C) * 2u; }
    const size_t kstep = (size_t)(BK * 2);
    const size_t hstepA = (size_t)HALF * g.lda * 2, hstepB = (size_t)HALF * g.ldb * 2;
    const size_t tstepA = 2 * hstepA, tstepB = 2 * hstepB;
    const unsigned ldsw = (unsigned)wid * 1024u;
    const int aoff = lds_byte(wr * 64 + fr, fq * 8), boff = lds_byte(wc * 32 + fr, fq * 8);
#define PG8_SA(b, h) (((b) * 2 + (h)) * HTB)
#define PG8_SB(b, h) ((4 + (b) * 2 + (h)) * HTB)
#define PG8_STAGE(bufoff, gbase, voff) do { _Pragma("unroll") for (int _i = 0; _i < 2; ++_i) \
        __builtin_amdgcn_global_load_lds((const unsigned*)((const char*)(gbase) + (voff)[_i]), (PG8_LAS unsigned*)(lds + (bufoff) + ldsw + _i * 8192), 16, 0, 0); } while (0)
#define PG8_LDA(dst, b, h) do { _Pragma("unroll") for (int m = 0; m < 4; ++m) _Pragma("unroll") for (int k = 0; k < 2; ++k) dst[m][k] = *(const PG8_LAS bf16x8*)(lds + PG8_SA(b, h) + aoff + m * 2048 + k * 1024); } while (0)
#define PG8_LDB(dst, b, h) do { _Pragma("unroll") for (int n = 0; n < 2; ++n) _Pragma("unroll") for (int k = 0; k < 2; ++k) dst[n][k] = *(const PG8_LAS bf16x8*)(lds + PG8_SB(b, h) + boff + n * 2048 + k * 1024); } while (0)
#define PG8_MMA(ai, bj, At, Bt) do { __builtin_amdgcn_s_setprio(1); _Pragma("unroll") for (int m = 0; m < 4; ++m) _Pragma("unroll") for (int n = 0; n < 2; ++n) _Pragma("unroll") for (int k = 0; k < 2; ++k) \
        acc[ai][bj][m][n] = __builtin_amdgcn_mfma_f32_16x16x32_bf16(Bt[n][k], At[m][k], acc[ai][bj][m][n], 0, 0, 0); __builtin_amdgcn_s_setprio(0); } while (0)
#define PG8_WAIT_V(n) asm volatile("s_waitcnt vmcnt(" #n ")" ::: "memory")
#define PG8_WAIT_L(n) asm volatile("s_waitcnt lgkmcnt(" #n ")" ::: "memory")
#define PG8_BAR __builtin_amdgcn_s_barrier()
#define PG8_SCHED __builtin_amdgcn_sched_barrier(0)
    static_assert(SP2, "gather form: SP2 loop only");
    int RA[2]; { int C_; stage_rc(tid * 16, RA[0], C_); stage_rc(tid * 16 + 8192, RA[1], C_); }
    PG8_LAS unsigned char* gslot = lds + STAGE_BYTES + tid * 16;
#define PG8_GOFF(slot_, pm_) do { u32x4 o_; \
        o_[0] = (unsigned)__builtin_nontemporal_load(rowidx + (pm_) * 256 + RA[0]) * (unsigned)(g.lda * 2) + (voffA[0] - (unsigned)(RA[0] * g.lda * 2)); \
        o_[1] = (unsigned)__builtin_nontemporal_load(rowidx + (pm_) * 256 + RA[1]) * (unsigned)(g.lda * 2) + (voffA[1] - (unsigned)(RA[1] * g.lda * 2)); \
        o_[2] = (unsigned)__builtin_nontemporal_load(rowidx + (pm_) * 256 + 128 + RA[0]) * (unsigned)(g.lda * 2) + (voffA[0] - (unsigned)(RA[0] * g.lda * 2)); \
        o_[3] = (unsigned)__builtin_nontemporal_load(rowidx + (pm_) * 256 + 128 + RA[1]) * (unsigned)(g.lda * 2) + (voffA[1] - (unsigned)(RA[1] * g.lda * 2)); \
        *(PG8_LAS u32x4*)(gslot + (slot_) * 8192) = o_; } while (0)
#define PG8_GRD(slot_, h_) (*(const PG8_LAS u32x2*)(gslot + (slot_) * 8192 + (h_) * 8))
#define PG8_STAGE2(bufoff, gbase, o2) do { const u32x2 o2_ = (o2); \
        __builtin_amdgcn_global_load_lds((const unsigned*)((const char*)(gbase) + o2_[0]), (PG8_LAS unsigned*)(lds + (bufoff) + ldsw), 16, 0, 0); \
        __builtin_amdgcn_global_load_lds((const unsigned*)((const char*)(gbase) + o2_[1]), (PG8_LAS unsigned*)(lds + (bufoff) + ldsw + 8192), 16, 0, 0); } while (0)
    Unit cur, nxt; int ui = 0;
    if (!S.next(0, cur)) return;
    PG8_GOFF(0, cur.pm);
    if (g.stag > 0) { const unsigned long long t0_ = __builtin_amdgcn_s_memrealtime(); while (__builtin_amdgcn_s_memrealtime() - t0_ < (unsigned long long)g.stag) __builtin_amdgcn_s_sleep(8); }
    f32x4 acc[2][2][4][2];
#pragma unroll
    for (int a = 0; a < 2; ++a)
#pragma unroll
        for (int b = 0; b < 2; ++b)
#pragma unroll
            for (int m = 0; m < 4; ++m)
#pragma unroll
                for (int n = 0; n < 2; ++n) acc[a][b][m][n] = (f32x4){0.f, 0.f, 0.f, 0.f};
    bf16x8 At[4][2], B0[2][2], B1[2][2];
    const char* cA = (const char*)g.A; const char* cB = (const char*)g.Bt + (size_t)cur.pb * tstepB;
    S.a_ready(cur);
    if constexpr (SP2) {
        PG8_STAGE(PG8_SB(0, 0), cB, voffB); PG8_STAGE(PG8_SB(0, 1), cB + hstepB, voffB); PG8_STAGE2(PG8_SA(0, 0), cA, PG8_GRD(0, 0)); PG8_STAGE2(PG8_SA(0, 1), cA, PG8_GRD(0, 1));
        if (wr == 1) PG8_BAR;
        PG8_WAIT_V(2); PG8_BAR;
        PG8_STAGE(PG8_SB(1, 0), cB + kstep, voffB); PG8_STAGE2(PG8_SA(1, 0), cA + kstep, PG8_GRD(0, 0)); PG8_STAGE(PG8_SB(1, 1), cB + hstepB + kstep, voffB);
        PG8_WAIT_V(6); PG8_BAR;
    } else {
        PG8_STAGE(PG8_SB(0, 0), cB, voffB); PG8_STAGE(PG8_SA(0, 0), cA, voffA); PG8_STAGE(PG8_SB(0, 1), cB + hstepB, voffB); PG8_STAGE(PG8_SA(0, 1), cA + hstepA, voffA);
        if (wr == 1) PG8_BAR;
        PG8_WAIT_V(4); PG8_BAR;
        PG8_STAGE(PG8_SB(1, 0), cB + kstep, voffB); PG8_STAGE(PG8_SA(1, 0), cA + kstep, voffA); PG8_STAGE(PG8_SB(1, 1), cB + hstepB + kstep, voffB);
        PG8_WAIT_V(6); PG8_BAR;
    }
    for (;;) {
        const bool has_next = S.next(ui + 1, nxt);
        const int sc = ui & 1, sn = sc ^ 1;
        if (has_next) PG8_GOFF(sn, nxt.pm); else *(PG8_LAS u32x4*)(gslot + sn * 8192) = *(const PG8_LAS u32x4*)(gslot + sc * 8192);
        const char* nB = has_next ? (const char*)g.Bt + (size_t)nxt.pb * tstepB : cB;
        for (int t = 0; t < nt; t += 2) {
            const bool last = (t == nt - 2);
            const char* a1 = cA + (size_t)(t + 1) * kstep;
            const char* a2 = last ? cA : cA + (size_t)(t + 2) * kstep; const char* b2 = last ? nB : cB + (size_t)(t + 2) * kstep;
            const char* a3 = a2 + kstep; const char* b3 = b2 + kstep;
            if (last && has_next) S.a_ready(nxt);
            if constexpr (SP2) {
            PG8_LDB(B0, 0, 0); PG8_LDB(B1, 0, 1); PG8_SCHED; PG8_LDA(At, 0, 0); PG8_STAGE2(PG8_SA(1, 1), a1, PG8_GRD(sc, 1));
            PG8_WAIT_V(8); PG8_WAIT_L(0); PG8_BAR; PG8_MMA(0, 0, At, B0); PG8_MMA(0, 1, At, B1); PG8_BAR; PG8_SCHED;
            PG8_LDA(At, 0, 1); PG8_STAGE(PG8_SB(0, 0), b2, voffB); PG8_STAGE(PG8_SB(0, 1), b2 + hstepB, voffB); PG8_STAGE2(PG8_SA(0, 0), a2, PG8_GRD(last ? sn : sc, 0));
            PG8_WAIT_V(8); PG8_WAIT_L(0); PG8_BAR; PG8_MMA(1, 0, At, B0); PG8_MMA(1, 1, At, B1); PG8_BAR; PG8_SCHED;
            PG8_LDB(B0, 1, 0); PG8_LDB(B1, 1, 1); PG8_SCHED; PG8_LDA(At, 1, 0); PG8_STAGE2(PG8_SA(0, 1), a2, PG8_GRD(last ? sn : sc, 1));
            PG8_WAIT_V(8); PG8_WAIT_L(0); PG8_BAR; PG8_MMA(0, 0, At, B0); PG8_MMA(0, 1, At, B1); PG8_BAR; PG8_SCHED;
            PG8_LDA(At, 1, 1); PG8_STAGE(PG8_SB(1, 0), b3, voffB); PG8_STAGE(PG8_SB(1, 1), b3 + hstepB, voffB); PG8_STAGE2(PG8_SA(1, 0), a3, PG8_GRD(last ? sn : sc, 0));
            PG8_WAIT_V(8); PG8_WAIT_L(0); PG8_BAR; PG8_MMA(1, 0, At, B0); PG8_MMA(1, 1, At, B1); PG8_BAR; PG8_SCHED;
            } else {
            PG8_LDB(B0, 0, 0); PG8_SCHED; PG8_LDA(At, 0, 0); PG8_STAGE(PG8_SA(1, 1), a1 + hstepA, voffA);
            PG8_WAIT_L(8); PG8_BAR; PG8_WAIT_L(0); PG8_MMA(0, 0, At, B0); PG8_BAR; PG8_SCHED;
            PG8_LDB(B1, 0, 1); PG8_STAGE(PG8_SB(0, 0), b2, voffB);
            PG8_BAR; PG8_WAIT_L(0); PG8_MMA(0, 1, At, B1); PG8_BAR;
            PG8_LDA(At, 0, 1); PG8_STAGE(PG8_SA(0, 0), a2, voffA);
            PG8_BAR; PG8_WAIT_L(0); PG8_MMA(1, 0, At, B0); PG8_BAR; PG8_SCHED;
            PG8_STAGE(PG8_SB(0, 1), b2 + hstepB, voffB);
            PG8_WAIT_V(6); PG8_BAR; PG8_MMA(1, 1, At, B1); PG8_BAR;
            PG8_LDB(B0, 1, 0); PG8_SCHED; PG8_LDA(At, 1, 0); PG8_STAGE(PG8_SA(0, 1), a2 + hstepA, voffA);
            PG8_WAIT_L(8); PG8_BAR; PG8_WAIT_L(0); PG8_MMA(0, 0, At, B0); PG8_BAR; PG8_SCHED;
            PG8_LDB(B1, 1, 1); PG8_STAGE(PG8_SB(1, 0), b3, voffB);
            PG8_BAR; PG8_WAIT_L(0); PG8_MMA(0, 1, At, B1); PG8_BAR;
            PG8_LDA(At, 1, 1); PG8_STAGE(PG8_SA(1, 0), a3, voffA);
            PG8_BAR; PG8_WAIT_L(0); PG8_MMA(1, 0, At, B0); PG8_BAR; PG8_SCHED;
            PG8_STAGE(PG8_SB(1, 1), b3 + hstepB, voffB);
            PG8_WAIT_V(6); PG8_BAR; PG8_MMA(1, 1, At, B1); PG8_BAR;
            }
        }
        if constexpr (ALIGN_EPI) { if (wr == 0) PG8_BAR; }
        E(acc, cur, wr, wc, fr, fq);
#ifdef EPI_PROBE
        if constexpr (Epi::PROBE) { asm volatile("" ::: "memory"); E(acc, cur, wr, wc, fr, fq, EPI_PROBE_NOSTORE != 0); }
#endif
        S.done(cur);
        if (!has_next) break;
#pragma unroll
        for (int a = 0; a < 2; ++a)
#pragma unroll
            for (int b = 0; b < 2; ++b)
#pragma unroll
                for (int m = 0; m < 4; ++m)
#pragma unroll
                    for (int n = 0; n < 2; ++n) acc[a][b][m][n] = (f32x4){0.f, 0.f, 0.f, 0.f};
        cur = nxt; cB = nB; ++ui;
        if constexpr (ALIGN_EPI) { if (wr == 1) PG8_BAR; }
    }
    PG8_WAIT_V(0);
    if constexpr (!ALIGN_EPI) { if (wr == 0) PG8_BAR; }
    PG8_BAR;
#undef PG8_GOFF
#undef PG8_GRD
#undef PG8_STAGE2
#undef PG8_SA
#undef PG8_SB
#undef PG8_STAGE
#undef PG8_LDA
#undef PG8_LDB
#undef PG8_MMA
#undef PG8_WAIT_V
#undef PG8_WAIT_L
#undef PG8_BAR
#undef PG8_SCHED
}
struct UnitMS { int pm, pn, seg, nt; size_t aoff, boff; int pub = 0; };
template <class Epi, class Sched, bool ALIGN_EPI = false, bool SP2 = false>
__device__ __forceinline__ void gemm_phase_ms(PG8_LAS unsigned char* lds, const Gemm g, const Sched& S, const Epi& E, int wave_id) {
    int tid_ = wave_id * 64 + (int)__builtin_amdgcn_mbcnt_hi(~0u, __builtin_amdgcn_mbcnt_lo(~0u, 0u)); asm volatile("" : "+v"(tid_));
    const int tid = tid_, wid = __builtin_amdgcn_readfirstlane(tid >> 6), lane = tid & 63, wr = wid >> 2, wc = wid & 3, fr = lane & 15, fq = lane >> 4;
    unsigned voffA[2], voffB[2];
#pragma unroll
    for (int i = 0; i < 2; ++i) { int R, C; stage_rc(tid * 16 + i * 8192, R, C); const int Rb = Epi::PERM ? ((R & ~31) + perm32(R & 31)) : R;
        voffA[i] = (unsigned)(R * g.lda + C) * 2u; voffB[i] = (unsigned)(Rb * g.ldb + C) * 2u; }
    const size_t kstep = (size_t)(BK * 2);
    const size_t hstepA = (size_t)HALF * g.lda * 2, hstepB = (size_t)HALF * g.ldb * 2;
    const size_t tstepA = 2 * hstepA, tstepB = 2 * hstepB;
    const unsigned ldsw = (unsigned)wid * 1024u;
    const int aoff = lds_byte(wr * 64 + fr, fq * 8), boff = lds_byte(wc * 32 + fr, fq * 8);
#define PG8_SA(b, h) (((b) * 2 + (h)) * HTB)
#define PG8_SB(b, h) ((4 + (b) * 2 + (h)) * HTB)
#define PG8_STAGE(bufoff, gbase, voff) do { _Pragma("unroll") for (int _i = 0; _i < 2; ++_i) \
        __builtin_amdgcn_global_load_lds((const unsigned*)((const char*)(gbase) + (voff)[_i]), (PG8_LAS unsigned*)(lds + (bufoff) + ldsw + _i * 8192), 16, 0, 0); } while (0)
#define PG8_LDA(dst, b, h) do { _Pragma("unroll") for (int m = 0; m < 4; ++m) _Pragma("unroll") for (int k = 0; k < 2; ++k) dst[m][k] = *(const PG8_LAS bf16x8*)(lds + PG8_SA(b, h) + aoff + m * 2048 + k * 1024); } while (0)
#define PG8_LDB(dst, b, h) do { _Pragma("unroll") for (int n = 0; n < 2; ++n) _Pragma("unroll") for (int k = 0; k < 2; ++k) dst[n][k] = *(const PG8_LAS bf16x8*)(lds + PG8_SB(b, h) + boff + n * 2048 + k * 1024); } while (0)
#define PG8_MMA(ai, bj, At, Bt) do { __builtin_amdgcn_s_setprio(1); _Pragma("unroll") for (int m = 0; m < 4; ++m) _Pragma("unroll") for (int n = 0; n < 2; ++n) _Pragma("unroll") for (int k = 0; k < 2; ++k) \
        acc[ai][bj][m][n] = __builtin_amdgcn_mfma_f32_16x16x32_bf16(Bt[n][k], At[m][k], acc[ai][bj][m][n], 0, 0, 0); __builtin_amdgcn_s_setprio(0); } while (0)
#define PG8_WAIT_V(n) asm volatile("s_waitcnt vmcnt(" #n ")" ::: "memory")
#define PG8_WAIT_L(n) asm volatile("s_waitcnt lgkmcnt(" #n ")" ::: "memory")
#define PG8_BAR __builtin_amdgcn_s_barrier()
#define PG8_SCHED __builtin_amdgcn_sched_barrier(0)
    UnitMS cur, nxt; int ui = 0;
    if (!S.next(0, cur)) return;
    f32x4 acc[2][2][4][2];
#pragma unroll
    for (int a = 0; a < 2; ++a)
#pragma unroll
        for (int b = 0; b < 2; ++b)
#pragma unroll
            for (int m = 0; m < 4; ++m)
#pragma unroll
                for (int n = 0; n < 2; ++n) acc[a][b][m][n] = (f32x4){0.f, 0.f, 0.f, 0.f};
    bf16x8 At[4][2], B0[2][2], B1[2][2];
    const char* cA = (const char*)g.A + cur.aoff; const char* cB = (const char*)g.Bt + cur.boff;
    S.a_ready(cur);
    if constexpr (SP2) {
        PG8_STAGE(PG8_SB(0, 0), cB, voffB); PG8_STAGE(PG8_SB(0, 1), cB + hstepB, voffB); PG8_STAGE(PG8_SA(0, 0), cA, voffA); PG8_STAGE(PG8_SA(0, 1), cA + hstepA, voffA);
        if (wr == 1) PG8_BAR;
        PG8_WAIT_V(2); PG8_BAR;
        PG8_STAGE(PG8_SB(1, 0), cB + kstep, voffB); PG8_STAGE(PG8_SA(1, 0), cA + kstep, voffA); PG8_STAGE(PG8_SB(1, 1), cB + hstepB + kstep, voffB);
        PG8_WAIT_V(6); PG8_BAR;
    } else {
        PG8_STAGE(PG8_SB(0, 0), cB, voffB); PG8_STAGE(PG8_SA(0, 0), cA, voffA); PG8_STAGE(PG8_SB(0, 1), cB + hstepB, voffB); PG8_STAGE(PG8_SA(0, 1), cA + hstepA, voffA);
        if (wr == 1) PG8_BAR;
        PG8_WAIT_V(4); PG8_BAR;
        PG8_STAGE(PG8_SB(1, 0), cB + kstep, voffB); PG8_STAGE(PG8_SA(1, 0), cA + kstep, voffA); PG8_STAGE(PG8_SB(1, 1), cB + hstepB + kstep, voffB);
        PG8_WAIT_V(6); PG8_BAR;
    }
    for (;;) {
        const bool has_next = S.next(ui + 1, nxt);
        const char* nA = has_next ? (const char*)g.A + nxt.aoff : cA; const char* nB = has_next ? (const char*)g.Bt + nxt.boff : cB;
        const int nt = cur.nt;
        for (int t = 0; t < nt; t += 2) {
            const bool last = (t == nt - 2);
            const char* a1 = cA + (size_t)(t + 1) * kstep;
            const char* a2 = last ? nA : cA + (size_t)(t + 2) * kstep; const char* b2 = last ? nB : cB + (size_t)(t + 2) * kstep;
            const char* a3 = a2 + kstep; const char* b3 = b2 + kstep;
            if (last && has_next) S.a_ready(nxt);
            if constexpr (SP2) {
            PG8_LDB(B0, 0, 0); PG8_LDB(B1, 0, 1); PG8_SCHED; PG8_LDA(At, 0, 0); PG8_STAGE(PG8_SA(1, 1), a1 + hstepA, voffA);
            PG8_WAIT_V(8); PG8_WAIT_L(0); PG8_BAR; PG8_MMA(0, 0, At, B0); PG8_MMA(0, 1, At, B1); PG8_BAR; PG8_SCHED;
            PG8_LDA(At, 0, 1); PG8_STAGE(PG8_SB(0, 0), b2, voffB); PG8_STAGE(PG8_SB(0, 1), b2 + hstepB, voffB); PG8_STAGE(PG8_SA(0, 0), a2, voffA);
            PG8_WAIT_V(8); PG8_WAIT_L(0); PG8_BAR; PG8_MMA(1, 0, At, B0); PG8_MMA(1, 1, At, B1); PG8_BAR; PG8_SCHED;
            PG8_LDB(B0, 1, 0); PG8_LDB(B1, 1, 1); PG8_SCHED; PG8_LDA(At, 1, 0); PG8_STAGE(PG8_SA(0, 1), a2 + hstepA, voffA);
            PG8_WAIT_V(8); PG8_WAIT_L(0); PG8_BAR; PG8_MMA(0, 0, At, B0); PG8_MMA(0, 1, At, B1); PG8_BAR; PG8_SCHED;
            PG8_LDA(At, 1, 1); PG8_STAGE(PG8_SB(1, 0), b3, voffB); PG8_STAGE(PG8_SB(1, 1), b3 + hstepB, voffB); PG8_STAGE(PG8_SA(1, 0), a3, voffA);
            PG8_WAIT_V(8); PG8_WAIT_L(0); PG8_BAR; PG8_MMA(1, 0, At, B0); PG8_MMA(1, 1, At, B1); PG8_BAR; PG8_SCHED;
            } else {
            PG8_LDB(B0, 0, 0); PG8_SCHED; PG8_LDA(At, 0, 0); PG8_STAGE(PG8_SA(1, 1), a1 + hstepA, voffA);
            PG8_WAIT_L(8); PG8_BAR; PG8_WAIT_L(0); PG8_MMA(0, 0, At, B0); PG8_BAR; PG8_SCHED;
            PG8_LDB(B1, 0, 1); PG8_STAGE(PG8_SB(0, 0), b2, voffB);
            PG8_BAR; PG8_WAIT_L(0); PG8_MMA(0, 1, At, B1); PG8_BAR;
            PG8_LDA(At, 0, 1); PG8_STAGE(PG8_SA(0, 0), a2, voffA);
            PG8_BAR; PG8_WAIT_L(0); PG8_MMA(1, 0, At, B0); PG8_BAR; PG8_SCHED;
            PG8_STAGE(PG8_SB(0, 1), b2 + hstepB, voffB);
            PG8_WAIT_V(6); PG8_BAR; PG8_MMA(1, 1, At, B1); PG8_BAR;
            PG8_LDB(B0, 1, 0); PG8_SCHED; PG8_LDA(At, 1, 0); PG8_STAGE(PG8_SA(0, 1), a2 + hstepA, voffA);
            PG8_WAIT_L(8); PG8_BAR; PG8_WAIT_L(0); PG8_MMA(0, 0, At, B0); PG8_BAR; PG8_SCHED;
            PG8_LDB(B1, 1, 1); PG8_STAGE(PG8_SB(1, 0), b3, voffB);
            PG8_BAR; PG8_WAIT_L(0); PG8_MMA(0, 1, At, B1); PG8_BAR;
            PG8_LDA(At, 1, 1); PG8_STAGE(PG8_SA(1, 0), a3, voffA);
            PG8_BAR; PG8_WAIT_L(0); PG8_MMA(1, 0, At, B0); PG8_BAR; PG8_SCHED;
            PG8_STAGE(PG8_SB(1, 1), b3 + hstepB, voffB);
            PG8_WAIT_V(6); PG8_BAR; PG8_MMA(1, 1, At, B1); PG8_BAR;
            }
        }
        if constexpr (ALIGN_EPI) { if (wr == 0) PG8_BAR; }
        E(acc, cur, wr, wc, fr, fq); S.done(cur);
        if (!has_next) break;
        if (nxt.seg == 0) {
#pragma unroll
        for (int a = 0; a < 2; ++a)
#pragma unroll
            for (int b = 0; b < 2; ++b)
#pragma unroll
                for (int m = 0; m < 4; ++m)
#pragma unroll
                    for (int n = 0; n < 2; ++n) acc[a][b][m][n] = (f32x4){0.f, 0.f, 0.f, 0.f};
        }
        cur = nxt; cA = nA; cB = nB; ++ui;
        if constexpr (ALIGN_EPI) { if (wr == 1) PG8_BAR; }
    }
    PG8_WAIT_V(0);
    if constexpr (!ALIGN_EPI) { if (wr == 0) PG8_BAR; }
    PG8_BAR;
#undef PG8_SA
#undef PG8_SB
#undef PG8_STAGE
#undef PG8_LDA
#undef PG8_LDB
#undef PG8_MMA
#undef PG8_WAIT_V
#undef PG8_WAIT_L
#undef PG8_BAR
#undef PG8_SCHED
}
}
constexpr int NB = 8, SEQ = 4096, DM = 1024, CTXL = 256;
constexpr int TL = NB * SEQ, TC = NB * CTXL, TT = TL + TC;
constexpr int NIN = 9472, PW = 9216;
constexpr int OQ = 0, OKK = 1024, OV = 2048, OCB = 3072, OCC = 3584, OCX = 4096, OGQ = 4608, OGK = 4864, OGV = 5120, OGR = 5632, OGATE = 6144;
constexpr int NEXP = 32, NRMAX = 147456;
constexpr float RMS_EPS = 1e-6f;
constexpr float QSCALE = 0.125f * 1.4426950408889634f;
constexpr int NWAVES = 8, NTHR = 512;
#ifndef N_LAUNCH_MODE
#define N_LAUNCH_MODE 0
#endif
constexpr int NPHASE = 25;

constexpr size_t MiB = 1u << 20;
constexpr size_t WS_CTL = 0, CTL_ZERO_BYTES = 1 * MiB;
constexpr size_t WS_MOD = 1 * MiB;
constexpr size_t WS_ROPE = WS_MOD + 512 * 1024;
constexpr size_t WS_LAM = WS_ROPE + 16 * 1024;
constexpr size_t WS_ROUTE = 2 * MiB, ROUTE_STRIDE = 8 * MiB;
constexpr size_t R_TOPI = 0, R_TOPG = 1 * MiB, R_POSOF = 2 * MiB, R_ROWTOK = 3 * MiB, R_CNT = 4 * MiB, R_TILEEXP = 4 * MiB + 64 * 1024, R_NT = 4 * MiB + 128 * 1024;
constexpr size_t WS_GA = 18 * MiB;
constexpr size_t WS_WIN = 24 * MiB, WIN_STRIDE = (size_t)NIN * DM * 2;
constexpr size_t WS_WD = 61 * MiB, WS_WCG = 65 * MiB, WS_WO = 69 * MiB, W1K_STRIDE = 2 * MiB;
constexpr size_t WS_W1 = 73 * MiB, W1_STRIDE = 128 * MiB;
constexpr size_t WS_W2 = 329 * MiB, W2_STRIDE = 64 * MiB;
constexpr size_t WS_H = 457 * MiB, WS_AD = 525 * MiB, WS_ACG = 593 * MiB, WS_MERGED = 661 * MiB;
constexpr size_t WS_OG = 729 * MiB;
constexpr size_t WS_XW = 865 * MiB;
constexpr size_t WS_ASCR = 1001 * MiB;
constexpr size_t WS_P = 1033 * MiB;
constexpr size_t WS_XS = WS_P, WS_HH = WS_P + 288 * MiB;
constexpr size_t WS_VT = 1645 * MiB;
constexpr size_t WS_END = 1713 * MiB;
static_assert(WS_P + (size_t)TT * PW * 2 <= WS_END && WS_HH + (size_t)NRMAX * DM * 2 <= WS_END, "ws map");

constexpr int LDS_BYTES = 163840;
constexpr int TEXP_OFF = 147456;
constexpr int MISC_OFF = LDS_BYTES - 1024;

#define GAS __attribute__((address_space(1)))
#define LAS __attribute__((address_space(3)))
typedef unsigned short bf16_t;
typedef float f32x4 __attribute__((ext_vector_type(4)));
typedef float f32x2 __attribute__((ext_vector_type(2)));
typedef unsigned u32x4 __attribute__((ext_vector_type(4)));
typedef unsigned u32x2 __attribute__((ext_vector_type(2)));
#define LDS_WAIT() asm volatile("s_waitcnt lgkmcnt(0)" ::: "memory")
#define VM_WAIT() asm volatile("s_waitcnt vmcnt(0)" ::: "memory")
__device__ __forceinline__ unsigned f2bf(float f) { unsigned u = __builtin_bit_cast(unsigned, f); return (u + 0x7fffu + ((u >> 16) & 1u)) >> 16; }
typedef __bf16 pbf2_t __attribute__((ext_vector_type(2)));
typedef float pf2_t __attribute__((ext_vector_type(2)));
__device__ __forceinline__ unsigned pk2(float lo, float hi) { const pf2_t v = {lo, hi}; return __builtin_bit_cast(unsigned, __builtin_convertvector(v, pbf2_t)); }
__device__ __forceinline__ float bflo(unsigned w) { return __builtin_bit_cast(float, w << 16); }
__device__ __forceinline__ float bfhi(unsigned w) { return __builtin_bit_cast(float, w & 0xffff0000u); }
__device__ __forceinline__ float bf2f(bf16_t b) { return __builtin_bit_cast(float, ((unsigned)b) << 16); }
__device__ __forceinline__ float wave_sum(float v) {
#pragma unroll
    for (int o = 1; o < 64; o <<= 1) v += __shfl_xor(v, o);
    return v;
}
__device__ __forceinline__ float sigmoidf_(float x) { return __builtin_amdgcn_rcpf(1.f + __builtin_amdgcn_exp2f(-1.4426950408889634f * x)); }

#define XB_TMO      128
#define XB_XCNT(j)  (256  + 64 * (j))
#define XB_XSUB(j)  (1280 + 64 * (j))
#define XB_XGEN(j)  (2304 + 64 * (j))
#define XB_TOP      3328
#define XB_TOPGEN   3392
#define XCD_BAR_WORDS 3456
#define XB_SPIN_CAP (1u << 18)
__device__ __forceinline__ unsigned xb_ld(unsigned* p)              { return __hip_atomic_load(p, __ATOMIC_RELAXED, __HIP_MEMORY_SCOPE_AGENT); }
__device__ __forceinline__ unsigned xb_add(unsigned* p, unsigned v) { return __hip_atomic_fetch_add(p, v, __ATOMIC_RELAXED, __HIP_MEMORY_SCOPE_AGENT); }
__device__ __forceinline__ unsigned xb_xcc_id() { return (unsigned)__builtin_amdgcn_s_getreg((3 << 11) | 20) & 0xFu; }
#define XB_SPIN(cond, bar) do { unsigned _sp = 0; while (cond) { __builtin_amdgcn_s_sleep(1); \
    if ((++_sp & 255u) == 0u) { if (xb_ld(&(bar)[XB_TMO])) break; if (_sp > XB_SPIN_CAP) { atomicAdd(&(bar)[XB_TMO], 1u); break; } } } } while (0)
struct XcdBarrier { unsigned* bar; unsigned x; volatile LAS unsigned* st; };
__device__ __forceinline__ XcdBarrier xcd_barrier_post(unsigned* bar, volatile LAS unsigned* st) {
    XcdBarrier b; b.bar = bar; b.x = xb_xcc_id(); b.st = st;
    if (threadIdx.x == 0) (void)xb_add(&bar[XB_XCNT(b.x)], 1u);
    return b;
}
__device__ __forceinline__ void xcd_barrier_complete(unsigned* bar, unsigned x, unsigned& nloc, unsigned& nx) {
    const unsigned G = gridDim.x * gridDim.y * gridDim.z;
    unsigned sum, cnt, mine, sp = 0u;
    for (;;) {
        sum = 0u; cnt = 0u; mine = 0u;
        unsigned cv[16];
        {
            const unsigned* cp = &bar[XB_XCNT(0)];
            asm volatile("global_load_dword %0, %16, off sc1\n\tglobal_load_dword %1, %16, off offset:256 sc1\n\tglobal_load_dword %2, %16, off offset:512 sc1\n\tglobal_load_dword %3, %16, off offset:768 sc1\n\t"
                         "global_load_dword %4, %16, off offset:1024 sc1\n\tglobal_load_dword %5, %16, off offset:1280 sc1\n\tglobal_load_dword %6, %16, off offset:1536 sc1\n\tglobal_load_dword %7, %16, off offset:1792 sc1\n\t"
                         "global_load_dword %8, %16, off offset:2048 sc1\n\tglobal_load_dword %9, %16, off offset:2304 sc1\n\tglobal_load_dword %10, %16, off offset:2560 sc1\n\tglobal_load_dword %11, %16, off offset:2816 sc1\n\t"
                         "global_load_dword %12, %16, off offset:3072 sc1\n\tglobal_load_dword %13, %16, off offset:3328 sc1\n\tglobal_load_dword %14, %16, off offset:3584 sc1\n\tglobal_load_dword %15, %16, off offset:3840 sc1\n\t"
                         "s_waitcnt vmcnt(0)"
                         : "=&v"(cv[0]), "=&v"(cv[1]), "=&v"(cv[2]), "=&v"(cv[3]), "=&v"(cv[4]), "=&v"(cv[5]), "=&v"(cv[6]), "=&v"(cv[7]),
                           "=&v"(cv[8]), "=&v"(cv[9]), "=&v"(cv[10]), "=&v"(cv[11]), "=&v"(cv[12]), "=&v"(cv[13]), "=&v"(cv[14]), "=&v"(cv[15])
                         : "v"(cp) : "memory");
        }
#pragma unroll
        for (unsigned j = 0; j < 16; ++j) { const unsigned c = cv[j]; sum += c; cnt += (c > 0u) ? 1u : 0u; mine = (j == x) ? c : mine; }
        if (sum == G) break;
        __builtin_amdgcn_s_sleep(1);
        if ((++sp & 255u) == 0u) { if (xb_ld(&bar[XB_TMO])) break; if (sp > XB_SPIN_CAP) { atomicAdd(&bar[XB_TMO], 1u); break; } }
    }
    nloc = mine > 0u ? mine : 1u; nx = cnt > 0u ? cnt : 1u;
}
__device__ __forceinline__ void xcd_barrier(const XcdBarrier& b, bool thread0) {
    asm volatile("s_waitcnt vmcnt(0)" ::: "memory");
    __syncthreads();
    if (thread0) {
        unsigned* bar = b.bar;
        __builtin_amdgcn_s_waitcnt(0);
        unsigned nloc = b.st[0], nx = b.st[1];
        if (nloc == 0u) { xcd_barrier_complete(bar, b.x, nloc, nx); b.st[0] = nloc; b.st[1] = nx; }
        const unsigned old = xb_add(&bar[XB_XSUB(b.x)], 1u);
        const unsigned gen = old / nloc;
        if (old + 1u == (gen + 1u) * nloc) {
            __builtin_amdgcn_fence(__ATOMIC_RELEASE, "agent");
            asm volatile("s_waitcnt vmcnt(0)" ::: "memory");
            const unsigned og = xb_add(&bar[XB_TOP], 1u);
            const unsigned tg = og / nx;
            if (og + 1u == (tg + 1u) * nx) xb_add(&bar[XB_TOPGEN], 1u);
            else XB_SPIN(xb_ld(&bar[XB_TOPGEN]) == tg, bar);
            __builtin_amdgcn_fence(__ATOMIC_ACQUIRE, "agent");
            xb_add(&bar[XB_XGEN(b.x)], 1u);
            asm volatile("s_waitcnt vmcnt(0)" ::: "memory");
        } else {
            XB_SPIN(xb_ld(&bar[XB_XGEN(b.x)]) == gen, bar);
            __builtin_amdgcn_fence(__ATOMIC_ACQUIRE, "agent");
            asm volatile("s_waitcnt vmcnt(0)" ::: "memory");
        }
    }
    __syncthreads();
}

#ifndef EPI_PROBE_MASK
#define EPI_PROBE_MASK 0
#endif
using pg8::Unit;
struct EpiIn {
    static constexpr bool PERM = true, PROBE = (EPI_PROBE_MASK & 1) != 0;
    bf16_t* P; float* GA; const float* cosT; const float* sinT;
    __device__ __forceinline__ void operator()(const f32x4 (&acc)[2][2][4][2], const Unit& u, int wr, int wc, int fr, int fq, bool nostore = false) const {
        const int row0 = u.pm * 256 + wr * 64 + fr; const int pn = u.pn;
        if (pn == 36) {
            if (wc == 0) {
#pragma unroll
                for (int ai = 0; ai < 2; ++ai)
#pragma unroll
                    for (int m = 0; m < 4; ++m) { const size_t row = (size_t)(row0 + ai * 128 + m * 16);
#pragma unroll
                        for (int n = 0; n < 2; ++n) *(f32x4*)(GA + row * 32 + 8 * fq + 4 * n) = acc[ai][0][m][n]; }
            }
            return;
        }
        const int colbase = pn * 256 + wc * 32 + 8 * fq;
        if (pn < 8) {
            const bool lat = u.pm < 128; const float qs = pn < 4 ? QSCALE : 1.f; const int axis = wc & 1;
#pragma unroll
            for (int ai = 0; ai < 2; ++ai)
#pragma unroll
                for (int m = 0; m < 4; ++m) { const int row = row0 + ai * 128 + m * 16; const int s = row & 4095; const int pos = axis ? (s & 63) : (s >> 6);
                    f32x4 cc = (f32x4){1.f, 1.f, 1.f, 1.f}, ss = (f32x4){0.f, 0.f, 0.f, 0.f};
                    if (lat) { cc = *(const f32x4*)(cosT + pos * 16 + 4 * fq); ss = *(const f32x4*)(sinT + pos * 16 + 4 * fq); }
                    bf16_t* rowp = P + (size_t)row * PW + colbase;
#pragma unroll
                    for (int bj = 0; bj < 2; ++bj) { const f32x4 x0 = acc[ai][bj][m][0], x1 = acc[ai][bj][m][1];
                        f32x4 o0, o1;
                        o0[0] = (x0[0] * cc[0] - x0[1] * ss[0]) * qs; o0[1] = (x0[1] * cc[0] + x0[0] * ss[0]) * qs; o0[2] = (x0[2] * cc[1] - x0[3] * ss[1]) * qs; o0[3] = (x0[3] * cc[1] + x0[2] * ss[1]) * qs;
                        o1[0] = (x1[0] * cc[2] - x1[1] * ss[2]) * qs; o1[1] = (x1[1] * cc[2] + x1[0] * ss[2]) * qs; o1[2] = (x1[2] * cc[3] - x1[3] * ss[3]) * qs; o1[3] = (x1[3] * cc[3] + x1[2] * ss[3]) * qs;
                        u32x4 w; w.x = pk2(o0[0], o0[1]); w.y = pk2(o0[2], o0[3]); w.z = pk2(o1[0], o1[1]); w.w = pk2(o1[2], o1[3]);
                        *(u32x4*)(rowp + bj * 128) = w; } }
        } else {
            const bool sg = pn >= 24;
#pragma unroll
            for (int ai = 0; ai < 2; ++ai)
#pragma unroll
                for (int m = 0; m < 4; ++m) { const int row = row0 + ai * 128 + m * 16; bf16_t* rowp = P + (size_t)row * PW + colbase;
#pragma unroll
                    for (int bj = 0; bj < 2; ++bj) { f32x4 v0 = acc[ai][bj][m][0], v1 = acc[ai][bj][m][1];
                        if (sg) {
#pragma unroll
                            for (int e = 0; e < 4; ++e) { v0[e] = fmaxf(sigmoidf_(v0[e]), 1e-25f); v1[e] = fmaxf(sigmoidf_(v1[e]), 1e-25f); } }
                        u32x4 w; w.x = pk2(v0[0], v0[1]); w.y = pk2(v0[2], v0[3]); w.z = pk2(v1[0], v1[1]); w.w = pk2(v1[2], v1[3]);
                        if (!nostore) *(u32x4*)(rowp + bj * 128) = w; else asm volatile("" :: "v"(w)); } }
        }
    }
};
template <int MODE> struct EpiGate {
    static constexpr bool PERM = false, PROBE = false;
    const bf16_t* P; float* M32; bf16_t* MG;
    __device__ __forceinline__ void operator()(const f32x4 (&acc)[2][2][4][2], const Unit& u, int wr, int wc, int fr, int fq) const {
        const int row0 = u.pm * 256 + wr * 64 + fr, col0 = u.pn * 256 + wc * 32 + 4 * fq;
#pragma unroll
        for (int ai = 0; ai < 2; ++ai)
#pragma unroll
            for (int m = 0; m < 4; ++m) { const size_t row = (size_t)(row0 + ai * 128 + m * 16);
#pragma unroll
                for (int bj = 0; bj < 2; ++bj)
#pragma unroll
                    for (int n = 0; n < 2; ++n) { const int col = col0 + bj * 128 + 16 * n;
                        const u32x2 gw = *(const u32x2*)(P + row * PW + OGATE + MODE * 1024 + col);
                        const f32x4 s = (f32x4){bflo(gw.x), bfhi(gw.x), bflo(gw.y), bfhi(gw.y)};
                        f32x4 v = s * acc[ai][bj][m][n];
                        float* mp = M32 + row * 1024 + col;
                        if (MODE >= 1) v = v + __builtin_nontemporal_load((const f32x4*)mp);
                        if (MODE <= 1) *(f32x4*)mp = v;
                        else { u32x2 w; w.x = pk2(v[0], v[1]); w.y = pk2(v[2], v[3]); *(u32x2*)(MG + row * 1024 + col) = w; } } }
    }
};
struct EpiMerge {
    static constexpr bool PERM = true;
    const bf16_t* P; bf16_t* MG;
    __device__ __forceinline__ void operator()(f32x4 (&acc)[2][2][4][2], const pg8::UnitMS& u, int wr, int wc, int fr, int fq) const {
        const int row0 = u.pm * 256 + wr * 64 + fr, col0 = u.pn * 256 + wc * 32 + 8 * fq; const int seg = u.seg;
#pragma unroll
        for (int ai = 0; ai < 2; ++ai)
#pragma unroll
            for (int m = 0; m < 4; ++m) { const size_t row = (size_t)(row0 + ai * 128 + m * 16); const bf16_t* gp = P + row * PW + OGATE + col0;
#pragma unroll
                for (int bj = 0; bj < 2; ++bj) { const int co = bj * 128;
                    const u32x4 ga = *(const u32x4*)(gp + seg * 1024 + co);
                    const f32x4 sa0 = (f32x4){bflo(ga.x), bfhi(ga.x), bflo(ga.y), bfhi(ga.y)}, sa1 = (f32x4){bflo(ga.z), bfhi(ga.z), bflo(ga.w), bfhi(ga.w)};
                    if (seg < 2) { const u32x4 gb = *(const u32x4*)(gp + (seg + 1) * 1024 + co);
                        const f32x4 sb0 = (f32x4){bflo(gb.x), bfhi(gb.x), bflo(gb.y), bfhi(gb.y)}, sb1 = (f32x4){bflo(gb.z), bfhi(gb.z), bflo(gb.w), bfhi(gb.w)};
                        f32x4 r0, r1;
#pragma unroll
                        for (int e = 0; e < 4; ++e) { r0[e] = sa0[e] * __builtin_amdgcn_rcpf(sb0[e]); r1[e] = sa1[e] * __builtin_amdgcn_rcpf(sb1[e]); }
                        acc[ai][bj][m][0] = acc[ai][bj][m][0] * r0; acc[ai][bj][m][1] = acc[ai][bj][m][1] * r1;
                    } else { const f32x4 v0 = acc[ai][bj][m][0] * sa0, v1 = acc[ai][bj][m][1] * sa1;
                        u32x4 w; w.x = pk2(v0[0], v0[1]); w.y = pk2(v0[2], v0[3]); w.z = pk2(v1[0], v1[1]); w.w = pk2(v1[2], v1[3]);
                        *(u32x4*)(MG + row * 1024 + col0 + co) = w; } } }
    }
};
struct OutProjOrder {
    pg8::StaticOrder so; size_t a1, b1;
    unsigned* cnt = nullptr; int c = 0, wave = 0;
    __device__ __forceinline__ bool next(int i, pg8::UnitMS& u) const {
        pg8::Unit t; const int iu = i / 3, seg = i % 3;
        if (!so.next(iu, t)) { if (cnt != nullptr && iu == 2 && c < 32) { t.pm = 128 + (c >> 2); t.pn = c & 3; } else return false; }
        u.pm = t.pm; u.pn = t.pn; u.seg = seg; u.nt = seg == 0 ? 16 : 8;
        u.pub = (cnt != nullptr && seg == 2) ? (iu == 1 ? 1 : iu == 2 ? 2 : 0) : 0;
        const size_t ta = (size_t)t.pm * (256 * 1024 * 2), tb = (size_t)t.pn * (256 * 1024 * 2);
        u.aoff = ta + (seg == 0 ? 0 : a1 + (seg == 2 ? 1024 : 0)); u.boff = tb + (seg == 0 ? 0 : b1 + (seg == 2 ? 1024 : 0)); return true;
    }
    __device__ __forceinline__ void a_ready(const pg8::UnitMS&) const {}
    __device__ __forceinline__ void done(const pg8::UnitMS& u) const {
        if (u.pub != 0) {
            asm volatile("s_waitcnt vmcnt(0)" ::: "memory");
            __syncthreads();
            if (wave == 0 && __builtin_amdgcn_mbcnt_hi(~0u, __builtin_amdgcn_mbcnt_lo(~0u, 0u)) == 0u) {
                __builtin_amdgcn_fence(__ATOMIC_RELEASE, "agent"); asm volatile("s_waitcnt vmcnt(0)" ::: "memory");
                __hip_atomic_fetch_add(cnt + (u.pub == 1 ? 0 : 16), u.pub == 1 ? 2u : 1u, __ATOMIC_RELAXED, __HIP_MEMORY_SCOPE_AGENT); }
        }
    }
};
struct WoL0Order {
    int c;
    __device__ __forceinline__ bool next(int i, Unit& u) const {
        if (c < 32) { if (i > 0) return false; u.pm = 128 + (c >> 2); u.pn = c & 3; }
        else { const int r = (c & 7) * 28 + ((c >> 3) - 4), j = r + 224 * i; if (j >= 512) return false; u.pm = j >> 2; u.pn = j & 3; }
        u.pb = u.pn; return true;
    }
    __device__ __forceinline__ void a_ready(const Unit&) const {}
    __device__ __forceinline__ void done(const Unit&) const {}
};
struct EpiRes {
    static constexpr bool PERM = true, PROBE = false;
    const float* xlat; const float* xctx; bf16_t* XW; const float* mod; bool xb16;
    __device__ __forceinline__ void operator()(const f32x4 (&acc)[2][2][4][2], const Unit& u, int wr, int wc, int fr, int fq) const {
        const int row0 = u.pm * 256 + wr * 64 + fr, col0 = u.pn * 256 + wc * 32 + 8 * fq;
        const int mr = u.pm < 128 ? (u.pm >> 4) : 8; const float* xin = u.pm < 128 ? xlat : xctx;
        const float* g1 = mod + (size_t)mr * 6144 + 2048;
        f32x4 gv[2][2];
#pragma unroll
        for (int bj = 0; bj < 2; ++bj)
#pragma unroll
            for (int n = 0; n < 2; ++n) gv[bj][n] = *(const f32x4*)(g1 + col0 + bj * 128 + 4 * n);
#pragma unroll
        for (int ai = 0; ai < 2; ++ai)
#pragma unroll
            for (int m = 0; m < 4; ++m) { const size_t off = (size_t)(row0 + ai * 128 + m * 16) * 1024 + col0;
#pragma unroll
                for (int bj = 0; bj < 2; ++bj) { f32x4 x0, x1;
                    if (xb16) { const u32x4 w = *(const u32x4*)(XW + off + bj * 128); x0 = (f32x4){bflo(w.x), bfhi(w.x), bflo(w.y), bfhi(w.y)}; x1 = (f32x4){bflo(w.z), bfhi(w.z), bflo(w.w), bfhi(w.w)}; }
                    else { x0 = *(const f32x4*)(xin + off + bj * 128); x1 = *(const f32x4*)(xin + off + bj * 128 + 4); }
                    const f32x4 o0 = x0 + gv[bj][0] * acc[ai][bj][m][0], o1 = x1 + gv[bj][1] * acc[ai][bj][m][1];
                    u32x4 w; w.x = pk2(o0[0], o0[1]); w.y = pk2(o0[2], o0[3]); w.z = pk2(o1[0], o1[1]); w.w = pk2(o1[2], o1[3]);
                    *(u32x4*)(XW + off + bj * 128) = w; } }
    }
};
struct EpiSwiglu {
    static constexpr bool PERM = true, PROBE = (EPI_PROBE_MASK & 2) != 0;
    bf16_t* HH; const float* b1;
    __device__ __forceinline__ void operator()(const f32x4 (&acc)[2][2][4][2], const Unit& u, int wr, int wc, int fr, int fq, bool = false) const {
        const int row0 = u.pm * 256 + wr * 64 + fr, c0 = u.pn * 256 + wc * 32 + 8 * fq; const int e = u.pb >> 3;
        const float* bp = b1 + (size_t)e * 2048 + c0;
        f32x4 bv[2][2];
#pragma unroll
        for (int bj = 0; bj < 2; ++bj)
#pragma unroll
            for (int n = 0; n < 2; ++n) { bv[bj][n] = *(const f32x4*)(bp + bj * 128 + 4 * n); bv[bj][n][1] += 1.f; bv[bj][n][3] += 1.f; }
#pragma unroll
        for (int ai = 0; ai < 2; ++ai)
#pragma unroll
            for (int m = 0; m < 4; ++m) { bf16_t* rowp = HH + (size_t)(row0 + ai * 128 + m * 16) * 1024 + (c0 >> 1);
#pragma unroll
                for (int bj = 0; bj < 2; ++bj) { const f32x4 v0 = acc[ai][bj][m][0] + bv[bj][0], v1 = acc[ai][bj][m][1] + bv[bj][1];
                    float o[4];
#pragma unroll
                    for (int p = 0; p < 4; ++p) { float gl = p < 2 ? v0[2 * p] : v1[2 * p - 4], ln1 = p < 2 ? v0[2 * p + 1] : v1[2 * p - 3];
                        gl = fminf(gl, 7.f); ln1 = fminf(fmaxf(ln1, -6.f), 8.f);
                        o[p] = gl * __builtin_amdgcn_rcpf(1.f + __builtin_amdgcn_exp2f(-2.4554669595930156f * gl)) * ln1; }
                    u32x2 w; w.x = pk2(o[0], o[1]); w.y = pk2(o[2], o[3]); *(u32x2*)(rowp + bj * 64) = w; } }
    }
};
struct EpiY {
    static constexpr bool PERM = true, PROBE = (EPI_PROBE_MASK & 2) != 0;
    bf16_t* YY; const float* b2;
    __device__ __forceinline__ void operator()(const f32x4 (&acc)[2][2][4][2], const Unit& u, int wr, int wc, int fr, int fq, bool = false) const {
        const int row0 = u.pm * 256 + wr * 64 + fr, c0 = u.pn * 256 + wc * 32 + 8 * fq; const int e = u.pb >> 2;
        const float* bp = b2 + (size_t)e * 1024 + c0;
        f32x4 bv[2][2];
#pragma unroll
        for (int bj = 0; bj < 2; ++bj)
#pragma unroll
            for (int n = 0; n < 2; ++n) bv[bj][n] = *(const f32x4*)(bp + bj * 128 + 4 * n);
#pragma unroll
        for (int ai = 0; ai < 2; ++ai)
#pragma unroll
            for (int m = 0; m < 4; ++m) { bf16_t* rowp = YY + (size_t)(row0 + ai * 128 + m * 16) * 1024 + c0;
#pragma unroll
                for (int bj = 0; bj < 2; ++bj) { const f32x4 v0 = acc[ai][bj][m][0] + bv[bj][0], v1 = acc[ai][bj][m][1] + bv[bj][1];
                    u32x4 w; w.x = pk2(v0[0], v0[1]); w.y = pk2(v0[2], v0[3]); w.z = pk2(v1[0], v1[1]); w.w = pk2(v1[2], v1[3]);
                    *(u32x4*)(rowp + bj * 128) = w; } }
    }
};
struct Gemm1LastOrder {
    pg8::StaticOrder so; int G, c;
    __device__ __forceinline__ bool next(int i, Unit& u) const {
        const long L = (long)i * G + c;
        if (L < so.nwg) return so.next(i, u);
        const int x = (int)(L - so.nwg); if (x >= 96) return false;
        const int r = x / 12, k = x % 12;
        u.pm = 128 + r; u.pn = k < 8 ? 4 + k : (k < 11 ? 19 + (k - 8) : 36); u.pb = u.pn; return true;
    }
    __device__ __forceinline__ void a_ready(const Unit&) const {}
    __device__ __forceinline__ void done(const Unit&) const {}
};
struct MoeOrder {
    int ntiles, nN, G, c; const LAS int* tile_exp;
    __device__ __forceinline__ bool next(int i, Unit& u) const {
        const long L = (long)i * G + c; if (L >= (long)ntiles * nN) return false;
        const int tile = (int)(L / nN), pn = (int)(L % nN);
        u.pm = tile; u.pn = pn; u.pb = __builtin_amdgcn_readfirstlane(tile_exp[tile]) * nN + pn; return true;
    }
    __device__ __forceinline__ void a_ready(const Unit&) const {}
    __device__ __forceinline__ void done(const Unit&) const {}
};
struct Args { const float* in[26]; float* out; unsigned char* ws; int ph_lo, ph_hi; };
struct Frame {
    LAS unsigned char* lds; unsigned char* ws; int tid, lane, wave, G, gw, NGW;
};
constexpr int PTR_OFF = MISC_OFF + 256;
__device__ __forceinline__ const float* in_ptr(const Frame& F, int i) {
    int z = PTR_OFF; asm volatile("" : "+v"(z));
    const unsigned long long v = ((volatile LAS unsigned long long*)(F.lds + z))[i];
    const unsigned lo = __builtin_amdgcn_readfirstlane((unsigned)v), hi = __builtin_amdgcn_readfirstlane((unsigned)(v >> 32));
    return (const float*)(const GAS float*)(((unsigned long long)hi << 32) | lo);
}
__device__ __forceinline__ float* out_ptr(const Frame& F) { return (float*)in_ptr(F, 26); }
__device__ __forceinline__ Frame relaunder(const Frame& F0) {
    Frame F = F0; int ln = (int)__builtin_amdgcn_mbcnt_hi(~0u, __builtin_amdgcn_mbcnt_lo(~0u, 0u)); asm volatile("" : "+v"(ln));
    F.lane = ln; F.tid = F0.wave * 64 + ln; F.wave = F0.wave; F.gw = blockIdx.x * NWAVES + F.wave; return F;
}

constexpr int CV_IN = 16 * 289, CV_D = 512, CV_C = 256, CV_G = 256, CV_O = 512, CV_1 = 32 * 1024, CV_2 = 32 * 512;
constexpr int CV_SMALL = CV_IN + CV_D + CV_C + CV_G + CV_O, CV_PER_L = CV_SMALL + CV_1 + CV_2;
constexpr int CV_NWG = 96;
struct TItem { const float* src; bf16_t* dst; int srcN; bool ilv; };
__device__ __forceinline__ TItem conv_decode(const Frame& F, int it) {
    unsigned char* ws = F.ws; const int l = it / CV_PER_L; int r = it % CV_PER_L; TItem t; t.ilv = false;
    auto mk = [&](const float* W, int srcN, bf16_t* WT, int k0, int n0, int drow, int dk0) { t.src = W + (size_t)k0 * srcN + n0; t.srcN = srcN; t.dst = WT + (size_t)drow * 1024 + dk0; };
    if (r < CV_IN) { const int kb = r / 289, nb = r % 289, n0 = nb * 32; const int d0 = n0 < 6144 ? n0 : (n0 < 6176 ? 9216 + (n0 - 6144) : n0 - 32);
        mk(in_ptr(F, 8) + (size_t)l * 1024 * 9248, 9248, (bf16_t*)(ws + WS_WIN + l * WIN_STRIDE), kb * 64, n0, d0, kb * 64); t.ilv = n0 < 2048; return t; } r -= CV_IN;
    if (r < CV_D) { const int kb = r / 32, nb = r % 32; mk(in_ptr(F, 11) + (size_t)l * 1024 * 1024, 1024, (bf16_t*)(ws + WS_WD + l * W1K_STRIDE), kb * 64, nb * 32, nb * 32, kb * 64); return t; } r -= CV_D;
    if (r < CV_C) { const int kb = r / 32, nb = r % 32; mk(in_ptr(F, 13) + (size_t)l * 512 * 1024, 1024, (bf16_t*)(ws + WS_WCG + l * W1K_STRIDE), kb * 64, nb * 32, nb * 32, kb * 64); return t; } r -= CV_C;
    if (r < CV_G) { const int kb = r / 32, nb = r % 32; mk(in_ptr(F, 17) + (size_t)l * 512 * 1024, 1024, (bf16_t*)(ws + WS_WCG + l * W1K_STRIDE), kb * 64, nb * 32, nb * 32, 512 + kb * 64); return t; } r -= CV_G;
    if (r < CV_O) { const int kb = r / 32, nb = r % 32; mk(in_ptr(F, 18) + (size_t)l * 1024 * 1024, 1024, (bf16_t*)(ws + WS_WO + l * W1K_STRIDE), kb * 64, nb * 32, nb * 32, kb * 64); return t; } r -= CV_O;
    if (r < CV_1) { const int e = r / 1024, q = r % 1024, kb = q / 64, nb = q % 64;
        mk(in_ptr(F, 21) + ((size_t)l * 32 + e) * 1024 * 2048, 2048, (bf16_t*)(ws + WS_W1 + l * W1_STRIDE) + (size_t)e * 2048 * 1024, kb * 64, nb * 32, nb * 32, kb * 64); return t; } r -= CV_1;
    { const int e = r / 512, q = r % 512, kb = q / 32, nb = q % 32;
        mk(in_ptr(F, 23) + ((size_t)l * 32 + e) * 1024 * 1024, 1024, (bf16_t*)(ws + WS_W2 + l * W2_STRIDE) + (size_t)e * 1024 * 1024, kb * 64, nb * 32, nb * 32, kb * 64); }
    return t;
}
__device__ __forceinline__ void ti_load(const TItem& t, int lane, f32x4 (&v)[8]) {
    const int kk8 = lane >> 3, n4 = (lane & 7) * 4;
#pragma unroll
    for (int i = 0; i < 8; ++i) v[i] = __builtin_nontemporal_load((const f32x4*)(t.src + (size_t)(8 * i + kk8) * t.srcN + n4));
}
__device__ __forceinline__ void ti_finish(const TItem& t, int lane, const f32x4 (&v)[8], LAS float* scr) {
    {   const int kk8 = lane >> 3, n4 = (lane & 7) * 4;
#pragma unroll
        for (int i = 0; i < 8; ++i) { LAS float* d = scr + (8 * i + kk8) * 33 + n4; d[0] = v[i][0]; d[1] = v[i][1]; d[2] = v[i][2]; d[3] = v[i][3]; }
    }
    LDS_WAIT(); asm volatile("" ::: "memory");
    const int c = lane & 7;
#pragma unroll
    for (int j = 0; j < 4; ++j) { const int n = (lane >> 3) + 8 * j; const LAS float* s = scr + (8 * c) * 33 + n;
        u32x4 o; o.x = pk2(s[0 * 33], s[1 * 33]); o.y = pk2(s[2 * 33], s[3 * 33]); o.z = pk2(s[4 * 33], s[5 * 33]); o.w = pk2(s[6 * 33], s[7 * 33]);
        const int nd = t.ilv ? (2 * (n & 15) + (n >> 4)) : n;
        *(u32x4*)(t.dst + (size_t)nd * 1024 + 8 * c) = o; }
    LDS_WAIT(); asm volatile("" ::: "memory");
}
__device__ __forceinline__ void conv_range(const Frame& F, int lo, int hi, int wi, int nw) {
    LAS float* scr = (LAS float*)(F.lds + F.wave * 16384);
    f32x4 va[8], vb[8]; TItem ta, tb; int it = lo + wi;
    if (it < hi) { ta = conv_decode(F, it); ti_load(ta, F.lane, va); }
#pragma unroll 1
    while (it < hi) {
        const bool h1 = it + nw < hi;
        if (h1) { tb = conv_decode(F, it + nw); ti_load(tb, F.lane, vb); }
        ti_finish(ta, F.lane, va, scr);
        if (!h1) break;
        const bool h2 = it + 2 * nw < hi;
        if (h2) { ta = conv_decode(F, it + 2 * nw); ti_load(ta, F.lane, va); }
        ti_finish(tb, F.lane, vb, scr);
        it += 2 * nw;
        if (!h2) break;
    }
}

__device__ __forceinline__ void p0_prologue(const Frame& F0) {
    const Frame F = relaunder(F0);
    __syncthreads();
    unsigned char* ws = F.ws;
    {
        LAS float* sc = (LAS float*)F.lds;
        LAS float* red = sc + 9 * 1024;
        {
            const float* c1 = in_ptr(F, 1); const float* c3 = in_ptr(F, 3); float cv[18];
#pragma unroll
            for (int q = 0; q < 16; ++q) cv[q] = c1[F.tid + NTHR * q];
#pragma unroll
            for (int q = 0; q < 2; ++q) cv[16 + q] = c3[F.tid + NTHR * q];
#pragma unroll
            for (int q = 0; q < 18; ++q) sc[F.tid + NTHR * q] = cv[q] / (1.f + __expf(-cv[q]));
        }
        __syncthreads();
        float* MOD = (float*)(ws + WS_MOD);
        for (int job = blockIdx.x; job < 192; job += F.G) {
            const int l = job / 96, blk = job % 96, ks = F.tid >> 6, n = F.tid & 63, col = blk * 64 + n;
            const float* w = in_ptr(F, 4) + (size_t)l * 1024 * 6144 + col;
            float a[9];
#pragma unroll
            for (int r = 0; r < 9; ++r) a[r] = 0.f;
            for (int k0 = ks * 128; k0 < ks * 128 + 128; k0 += 64) {
                float wv[64];
#pragma unroll
                for (int q = 0; q < 64; ++q) wv[q] = w[(size_t)(k0 + q) * 6144];
#pragma unroll
                for (int q = 0; q < 64; ++q)
#pragma unroll
                    for (int r = 0; r < 9; ++r) a[r] += sc[r * 1024 + k0 + q] * wv[q]; }
#pragma unroll
            for (int r = 0; r < 9; ++r) red[(ks * 9 + r) * 64 + n] = a[r];
            __syncthreads();
            for (int o = F.tid; o < 576; o += NTHR) { const int r = o >> 6, nn = o & 63; float s = 0.f;
#pragma unroll
                for (int k8 = 0; k8 < 8; ++k8) s += red[(k8 * 9 + r) * 64 + nn];
                MOD[((size_t)l * 9 + r) * 6144 + blk * 64 + nn] = s + in_ptr(F, 5)[(size_t)l * 6144 + blk * 64 + nn]; }
            __syncthreads();
        }
    }
    if (blockIdx.x == gridDim.x - 1) {
        float* cosT = (float*)(ws + WS_ROPE); float* sinT = cosT + 1024;
        for (int i = F.tid; i < 1024; i += NTHR) { const int pos = i >> 4, f = i & 15; const float inv = powf(10000.f, -(float)(2 * f) / 32.f); const float ang = (float)pos * inv; cosT[i] = cosf(ang); sinT[i] = sinf(ang); }
        if (F.wave < 2) { const int l = F.wave; const float* dl = in_ptr(F, 9) + (size_t)l * 256;
            const float s1 = wave_sum(dl[F.lane] * dl[64 + F.lane]), s2 = wave_sum(dl[128 + F.lane] * dl[192 + F.lane]);
            const float lam_init = 0.8f - 0.6f * expf(-0.3f * (float)l);
            if (F.lane == 0) ((float*)(ws + WS_LAM))[l] = expf(s1) - expf(s2) + lam_init; }
    }
    __syncthreads();
    conv_range(F, 0, F.G >= 64 + CV_NWG ? CV_SMALL : 2 * CV_PER_L, F.gw, F.NGW);
    for (int i = F.gw * 64 + F.lane; i < 2 * 224 * 128; i += F.NGW * 64) { const int l = i / (224 * 128), q = i % (224 * 128);
        *(u32x4*)(ws + WS_WIN + l * WIN_STRIDE + (size_t)9248 * 2048 + (size_t)q * 16) = (u32x4){0u, 0u, 0u, 0u}; }
}

__device__ __forceinline__ void load_row(const float* p, int lane, f32x4 (&v)[4]) {
#pragma unroll
    for (int j = 0; j < 4; ++j) v[j] = *(const f32x4*)(p + 256 * j + 4 * lane);
}
__device__ __forceinline__ void load_row_b(const bf16_t* p, int lane, f32x4 (&v)[4]) {
#pragma unroll
    for (int j = 0; j < 4; ++j) { const u32x2 w = *(const u32x2*)(p + 256 * j + 4 * lane); v[j] = (f32x4){bflo(w.x), bfhi(w.x), bflo(w.y), bfhi(w.y)}; }
}
__device__ __forceinline__ float row_rstd(const f32x4 (&v)[4]) {
    float s = 0.f;
#pragma unroll
    for (int j = 0; j < 4; ++j) s += (v[j][0] * v[j][0] + v[j][1] * v[j][1]) + (v[j][2] * v[j][2] + v[j][3] * v[j][3]);
    return 1.0f / sqrtf(wave_sum(s) * (1.f / 1024.f) + RMS_EPS);
}
__device__ __forceinline__ void norm_mod(f32x4 (&v)[4], const float* g, const float* shift, const float* scale, int lane) {
    const float rstd = row_rstd(v);
#pragma unroll
    for (int j = 0; j < 4; ++j) { const f32x4 gv = *(const f32x4*)(g + 256 * j + 4 * lane), sh = *(const f32x4*)(shift + 256 * j + 4 * lane), sc = *(const f32x4*)(scale + 256 * j + 4 * lane);
        v[j] = (v[j] * rstd * gv) * (sc + 1.f) + sh; }
}
__device__ __forceinline__ void store_row_bf16(bf16_t* p, int lane, const f32x4 (&v)[4]) {
#pragma unroll
    for (int j = 0; j < 4; ++j) { u32x2 w; w.x = pk2(v[j][0], v[j][1]); w.y = pk2(v[j][2], v[j][3]); *(u32x2*)(p + 256 * j + 4 * lane) = w; }
}

__device__ __forceinline__ void p_norm1_l0(const Frame& F0) {
    const Frame F = relaunder(F0);
    const float* MOD = (const float*)(F.ws + WS_MOD); bf16_t* H = (bf16_t*)(F.ws + WS_H);
    const float* x0 = in_ptr(F, 0); const float* c0p = in_ptr(F, 2); const float* g1n = in_ptr(F, 6);
    f32x4 nx[4];
    if (F.gw < TT) load_row(F.gw < TL ? x0 + (size_t)F.gw * 1024 : c0p + (size_t)(F.gw - TL) * 1024, F.lane, nx);
    for (int row = F.gw; row < TT; row += F.NGW) {
        const int mr = row < TL ? (row >> 12) : 8;
        f32x4 v[4];
#pragma unroll
        for (int j = 0; j < 4; ++j) v[j] = nx[j];
        const int rn = row + F.NGW;
        if (rn < TT) load_row(rn < TL ? x0 + (size_t)rn * 1024 : c0p + (size_t)(rn - TL) * 1024, F.lane, nx);
        norm_mod(v, g1n, MOD + (size_t)mr * 6144, MOD + (size_t)mr * 6144 + 1024, F.lane);
        store_row_bf16(H + (size_t)row * 1024, F.lane, v);
    }
}

struct ConvIn { u32x4 gb, c0v, c1, c2v, x0v, x1, x2v; };
__device__ __forceinline__ void conv_load(const bf16_t* P, int it, ConvIn& v) {
    const int row = it >> 6, c0 = (it & 63) * 8;
    bool hp, hn;
    if (row < TL) { const int s = row & 4095; hp = s > 0; hn = s < 4095; } else { const int s = (row - TL) & 255; hp = s > 0; hn = s < 255; }
    const bf16_t* pr = P + (size_t)row * PW;
    v.gb = *(const u32x4*)(pr + OCB + c0); v.c1 = *(const u32x4*)(pr + OCC + c0); v.x1 = *(const u32x4*)(pr + OCX + c0);
    v.c0v = (u32x4){0u, 0u, 0u, 0u}; v.x0v = v.c0v; v.c2v = v.c0v; v.x2v = v.c0v;
    if (hp) { v.c0v = *(const u32x4*)(pr - PW + OCC + c0); v.x0v = *(const u32x4*)(pr - PW + OCX + c0); }
    if (hn) { v.c2v = *(const u32x4*)(pr + PW + OCC + c0); v.x2v = *(const u32x4*)(pr + PW + OCX + c0); }
}
__device__ __forceinline__ void p_conv(const Frame& F0, const float* cw  , int wi, int nw, int nrows) {
    const Frame F = relaunder(F0);
    const bf16_t* P = (const bf16_t*)(F.ws + WS_P); bf16_t* ACG = (bf16_t*)(F.ws + WS_ACG);
    const int gt = wi * 64 + F.lane, NGT = nw * 64, end = nrows * 64;
    ConvIn nx; if (gt < end) conv_load(P, gt, nx);
    for (int it = gt; it < end; it += NGT) {
        const ConvIn v = nx;
        if (it + NGT < end) conv_load(P, it + NGT, nx);
        const int row = it >> 6, c0 = (it & 63) * 8;
        float o[8];
#pragma unroll
        for (int q = 0; q < 4; ++q) {
#pragma unroll
            for (int hh = 0; hh < 2; ++hh) { const int ch = c0 + 2 * q + hh;
                const float b = hh ? bfhi(v.gb[q]) : bflo(v.gb[q]);
                const float u0 = (hh ? bfhi(v.c0v[q]) : bflo(v.c0v[q])) * (hh ? bfhi(v.x0v[q]) : bflo(v.x0v[q]));
                const float u1 = (hh ? bfhi(v.c1[q]) : bflo(v.c1[q])) * (hh ? bfhi(v.x1[q]) : bflo(v.x1[q]));
                const float u2 = (hh ? bfhi(v.c2v[q]) : bflo(v.c2v[q])) * (hh ? bfhi(v.x2v[q]) : bflo(v.x2v[q]));
                o[2 * q + hh] = b * (cw[ch] * u0 + cw[512 + ch] * u1 + cw[1024 + ch] * u2); } }
        u32x4 w; w.x = pk2(o[0], o[1]); w.y = pk2(o[2], o[3]); w.z = pk2(o[4], o[5]); w.w = pk2(o[6], o[7]);
        *(u32x4*)(ACG + (size_t)row * 1024 + c0) = w;
    }
}
__device__ __forceinline__ int gla_row(int step, int b, int dir) {
    if (dir == 0) return step < 256 ? TL + b * 256 + step : b * 4096 + (step - 256);
    return step < 256 ? TL + b * 256 + (255 - step) : b * 4096 + (4095 - (step - 256));
}
__device__ __forceinline__ void p_gla_chain(const Frame& F0, const float* wa2  , const float* ba  , int chain) {
    const Frame F = relaunder(F0);
    const bf16_t* P = (const bf16_t*)(F.ws + WS_P); const float* GA = (const float*)(F.ws + WS_GA); float* OG = (float*)(F.ws + WS_OG);
    const int b = chain >> 3, h = (chain >> 1) & 3, dir = chain & 1;
    LAS float* Wa = (LAS float*)F.lds;
    LAS float* bav = Wa + 1024;
    LAS float* qs = bav + 64;
    LAS float* ks = qs + 1024;
    LAS float* egs = ks + 1024;
    LAS float* vs = egs + 1024;
    LAS float* po = vs + 2048;
    const int tid = F.tid, dkg = tid >> 7, dv = tid & 127;
    __syncthreads();
    for (int i = tid; i < 1024; i += NTHR) { const int r = i >> 6, dk = i & 63; Wa[i] = wa2[(size_t)(dir * 16 + r) * 256 + h * 64 + dk]; }
    if (tid < 64) bav[tid] = ba[dir * 256 + h * 64 + tid];
    float S[16];
#pragma unroll
    for (int i = 0; i < 16; ++i) S[i] = 0.f;
    for (int blk = 0; blk < 272; ++blk) {
        __syncthreads();
        for (int e = tid; e < 1024; e += NTHR) { const int tk = e >> 6, dk = e & 63; const int row = gla_row(blk * 16 + tk, b, dir);
            qs[e] = bf2f(P[(size_t)row * PW + OGQ + h * 64 + dk]);
            ks[e] = bf2f(P[(size_t)row * PW + OGK + h * 64 + dk]);
            float z = bav[dk]; const float* ga = GA + (size_t)row * 32 + dir * 16;
#pragma unroll
            for (int r = 0; r < 16; ++r) z += ga[r] * Wa[r * 64 + dk];
            const float ls = fminf(z, 0.f) - log1pf(__expf(-fabsf(z)));
            egs[e] = __expf(ls * (1.f / 16.f)); }
        for (int e = tid; e < 2048; e += NTHR) { const int tk = e >> 7, d = e & 127; const int row = gla_row(blk * 16 + tk, b, dir);
            vs[e] = bf2f(P[(size_t)row * PW + OGV + h * 128 + d]); }
        __syncthreads();
#pragma unroll 1
        for (int tk = 0; tk < 16; ++tk) {
            const float vv = vs[tk * 128 + dv]; float pacc = 0.f;
#pragma unroll
            for (int i = 0; i < 16; ++i) { const int dk = dkg * 16 + i; S[i] = egs[tk * 64 + dk] * S[i] + ks[tk * 64 + dk] * vv; pacc += qs[tk * 64 + dk] * S[i]; }
            po[(tk * 4 + dkg) * 128 + dv] = pacc;
        }
        __syncthreads();
        for (int e = tid; e < 2048; e += NTHR) { const int tk = e >> 7, d = e & 127; const int row = gla_row(blk * 16 + tk, b, dir);
            const float o = (po[(tk * 4 + 0) * 128 + d] + po[(tk * 4 + 1) * 128 + d]) + (po[(tk * 4 + 2) * 128 + d] + po[(tk * 4 + 3) * 128 + d]);
            OG[((size_t)dir * TT + row) * 512 + h * 128 + d] = o * 0.125f; }
    }
    __syncthreads();
}

__device__ __forceinline__ void p_attn_naive(const Frame& F0, int layer, const float* subg  ) {
    const Frame F = relaunder(F0);
    const bf16_t* P = (const bf16_t*)(F.ws + WS_P); bf16_t* AD = (bf16_t*)(F.ws + WS_AD);
    float* scr = (float*)(F.ws + WS_ASCR) + (size_t)blockIdx.x * 64 * 512;
    const float lam = __builtin_nontemporal_load((const float*)(F.ws + WS_LAM) + layer);
    const float lam_init = 0.8f - 0.6f * expf(-0.3f * (float)layer);
    LAS float* Ks = (LAS float*)F.lds;
    LAS float* Vs = Ks + 4096;
    LAS float* red = Vs + 8192;
    const int tid = F.tid, qr = tid & 255, half = tid >> 8;
    const int nunits = layer == 0 ? 1024 + 64 : 1024;
    for (int u = blockIdx.x; u < nunits; u += F.G) {
        const bool lat = u < 1024;
        int b, h, qrow0, ntiles;
        if (lat) { b = u >> 7; h = (u >> 4) & 7; qrow0 = b * 4096 + (u & 15) * 256; ntiles = 68; }
        else { const int v = u - 1024; b = v >> 3; h = v & 7; qrow0 = TL + b * 256; ntiles = 4; }
        const int qrow = qrow0 + qr;
        float O[64];
#pragma unroll 1
        for (int map = 1; map >= 0; --map) {
            float q[64];
            { const bf16_t* qp = P + (size_t)qrow * PW + OQ + h * 128 + map * 64;
#pragma unroll
              for (int c = 0; c < 8; ++c) { const u32x4 w = *(const u32x4*)(qp + 8 * c);
#pragma unroll
                  for (int e = 0; e < 4; ++e) { q[8 * c + 2 * e] = bflo(w[e]); q[8 * c + 2 * e + 1] = bfhi(w[e]); } asm volatile("" ::: "memory"); } }
            float mx = -1e30f, l = 0.f;
#pragma unroll
            for (int i = 0; i < 64; ++i) O[i] = 0.f;
#pragma unroll 1
            for (int t = 0; t < ntiles; ++t) {
                const int krow0 = (lat && t < 64) ? b * 4096 + t * 64 : TL + b * 256 + (t - (lat ? 64 : 0)) * 64;
                __syncthreads();
                { const int key = tid >> 3, ch = tid & 7; const u32x4 w = *(const u32x4*)(P + (size_t)(krow0 + key) * PW + OKK + h * 128 + map * 64 + ch * 8);
                  *(LAS f32x4*)(Ks + key * 64 + ch * 8) = (f32x4){bflo(w.x), bfhi(w.x), bflo(w.y), bfhi(w.y)};
                  *(LAS f32x4*)(Ks + key * 64 + ch * 8 + 4) = (f32x4){bflo(w.z), bfhi(w.z), bflo(w.w), bfhi(w.w)}; }
#pragma unroll
                for (int i2 = 0; i2 < 2; ++i2) { const int e = tid + i2 * 512, key = e >> 4, ch = e & 15; const u32x4 w = *(const u32x4*)(P + (size_t)(krow0 + key) * PW + OV + h * 128 + ch * 8);
                  *(LAS f32x4*)(Vs + key * 128 + ch * 8) = (f32x4){bflo(w.x), bfhi(w.x), bflo(w.y), bfhi(w.y)};
                  *(LAS f32x4*)(Vs + key * 128 + ch * 8 + 4) = (f32x4){bflo(w.z), bfhi(w.z), bflo(w.w), bfhi(w.w)}; }
                __syncthreads();
#pragma unroll 1
                for (int key = 0; key < 64; ++key) {
                    float s = 0.f;
#pragma unroll
                    for (int c = 0; c < 16; ++c) { const f32x4 kv = *(const LAS f32x4*)(Ks + key * 64 + 4 * c); s += (q[4 * c] * kv[0] + q[4 * c + 1] * kv[1]) + (q[4 * c + 2] * kv[2] + q[4 * c + 3] * kv[3]);
                        if ((c & 3) == 3) asm volatile("" ::: "memory"); }
                    const float mn = fmaxf(mx, s); const float alpha = __builtin_amdgcn_exp2f(mx - mn), p = __builtin_amdgcn_exp2f(s - mn);
                    l = l * alpha + p; mx = mn;
#pragma unroll
                    for (int c = 0; c < 16; ++c) { const f32x4 vv = *(const LAS f32x4*)(Vs + key * 128 + half * 64 + 4 * c);
                        O[4 * c] = O[4 * c] * alpha + p * vv[0]; O[4 * c + 1] = O[4 * c + 1] * alpha + p * vv[1]; O[4 * c + 2] = O[4 * c + 2] * alpha + p * vv[2]; O[4 * c + 3] = O[4 * c + 3] * alpha + p * vv[3];
                        if ((c & 3) == 3) asm volatile("" ::: "memory"); }
                }
            }
            const float inv = 1.f / l;
            if (map == 1) {
#pragma unroll
                for (int i = 0; i < 16; ++i) { *(f32x4*)(scr + tid * 64 + 4 * i) = (f32x4){O[4 * i] * inv, O[4 * i + 1] * inv, O[4 * i + 2] * inv, O[4 * i + 3] * inv}; if ((i & 3) == 3) asm volatile("" ::: "memory"); }
            } else {
#pragma unroll
                for (int i = 0; i < 16; ++i) { const f32x4 t = __builtin_nontemporal_load((const f32x4*)(scr + tid * 64 + 4 * i));
                    O[4 * i] = O[4 * i] * inv - lam * t[0]; O[4 * i + 1] = O[4 * i + 1] * inv - lam * t[1]; O[4 * i + 2] = O[4 * i + 2] * inv - lam * t[2]; O[4 * i + 3] = O[4 * i + 3] * inv - lam * t[3];
                    if ((i & 3) == 3) asm volatile("" ::: "memory"); }
            }
        }
        float ss = 0.f;
#pragma unroll
        for (int i = 0; i < 64; ++i) ss += O[i] * O[i];
        __syncthreads();
        red[tid] = ss;
        __syncthreads();
        const float tot = red[qr] + red[qr + 256];
        const float r = (1.f - lam_init) / sqrtf(tot * (1.f / 128.f) + RMS_EPS);
        bf16_t* op = AD + (size_t)qrow * 1024 + h * 128 + half * 64;
#pragma unroll
        for (int c = 0; c < 8; ++c) { u32x4 w;
            w.x = pk2(O[8 * c] * r * subg[half * 64 + 8 * c], O[8 * c + 1] * r * subg[half * 64 + 8 * c + 1]);
            w.y = pk2(O[8 * c + 2] * r * subg[half * 64 + 8 * c + 2], O[8 * c + 3] * r * subg[half * 64 + 8 * c + 3]);
            w.z = pk2(O[8 * c + 4] * r * subg[half * 64 + 8 * c + 4], O[8 * c + 5] * r * subg[half * 64 + 8 * c + 5]);
            w.w = pk2(O[8 * c + 6] * r * subg[half * 64 + 8 * c + 6], O[8 * c + 7] * r * subg[half * 64 + 8 * c + 7]);
            *(u32x4*)(op + 8 * c) = w; asm volatile("" ::: "memory"); }
    }
    __syncthreads();
}

__device__ __forceinline__ void p_gla_tail(const Frame& F0, const float* gng  , int row_lo, int nrows) {
    const Frame F = relaunder(F0);
    const bf16_t* P = (const bf16_t*)(F.ws + WS_P); const float* OG = (const float*)(F.ws + WS_OG); bf16_t* ACG = (bf16_t*)(F.ws + WS_ACG);
    const int c0 = F.lane * 8; const bf16_t* OGB = (const bf16_t*)OG;
    const f32x4 g0 = *(const f32x4*)(gng + (c0 & 127)), g1 = *(const f32x4*)(gng + (c0 & 127) + 4);
    u32x4 n0 = (u32x4){0u, 0u, 0u, 0u}, n1 = n0, nr = n0;
    const int r0 = row_lo + F.wave;
    if (r0 < nrows) { n0 = *(const u32x4*)(OGB + (size_t)r0 * 512 + c0); n1 = *(const u32x4*)(OGB + ((size_t)TT + r0) * 512 + c0); nr = *(const u32x4*)(P + (size_t)r0 * PW + OGR + c0); }
    for (int row = r0; row < nrows; row += NWAVES) {
        const u32x4 w0 = n0, w1 = n1, rw = nr; const int rn = row + NWAVES;
        if (rn < nrows) { n0 = *(const u32x4*)(OGB + (size_t)rn * 512 + c0); n1 = *(const u32x4*)(OGB + ((size_t)TT + rn) * 512 + c0); nr = *(const u32x4*)(P + (size_t)rn * PW + OGR + c0); }
        f32x4 a = (f32x4){bflo(w0.x) + bflo(w1.x), bfhi(w0.x) + bfhi(w1.x), bflo(w0.y) + bflo(w1.y), bfhi(w0.y) + bfhi(w1.y)};
        f32x4 b = (f32x4){bflo(w0.z) + bflo(w1.z), bfhi(w0.z) + bfhi(w1.z), bflo(w0.w) + bflo(w1.w), bfhi(w0.w) + bfhi(w1.w)};
        float ss = (a[0] * a[0] + a[1] * a[1]) + (a[2] * a[2] + a[3] * a[3]) + (b[0] * b[0] + b[1] * b[1]) + (b[2] * b[2] + b[3] * b[3]);
        ss += __shfl_xor(ss, 1); ss += __shfl_xor(ss, 2); ss += __shfl_xor(ss, 4); ss += __shfl_xor(ss, 8);
        const float rstd = 1.f / sqrtf(ss * (1.f / 128.f) + RMS_EPS);
        float rr[8] = {bflo(rw.x), bfhi(rw.x), bflo(rw.y), bfhi(rw.y), bflo(rw.z), bfhi(rw.z), bflo(rw.w), bfhi(rw.w)};
        float o[8];
#pragma unroll
        for (int i = 0; i < 4; ++i) { const float y0 = a[i] * rstd * g0[i], y1 = b[i] * rstd * g1[i];
            o[i] = y0 * (rr[i] * sigmoidf_(rr[i])); o[4 + i] = y1 * (rr[4 + i] * sigmoidf_(rr[4 + i])); }
        u32x4 w; w.x = pk2(o[0], o[1]); w.y = pk2(o[2], o[3]); w.z = pk2(o[4], o[5]); w.w = pk2(o[6], o[7]);
        *(u32x4*)(ACG + (size_t)row * 1024 + 512 + c0) = w;
    }
}

__device__ __forceinline__ void p_gla_tail_bh(const Frame& F0, const float* gng  , int b, int h, bool with_ctx) {
    const Frame F = relaunder(F0);
    const bf16_t* P = (const bf16_t*)(F.ws + WS_P); const bf16_t* OGB = (const bf16_t*)(F.ws + WS_OG); bf16_t* ACG = (bf16_t*)(F.ws + WS_ACG);
    const int sub = F.lane >> 4, c0 = h * 128 + (F.lane & 15) * 8;
    const f32x4 g0 = *(const f32x4*)(gng + (c0 & 127)), g1 = *(const f32x4*)(gng + (c0 & 127) + 4);
    const int n = with_ctx ? 4352 : 4096;
#define TBH_ROW(i_) ((i_) < 4096 ? b * 4096 + (i_) : TL + b * 256 + ((i_) - 4096))
    u32x4 n0 = (u32x4){0u, 0u, 0u, 0u}, n1 = n0, nr = n0;
    int i = F.wave * 4 + sub;
    if (i < n) { const int r_ = TBH_ROW(i); n0 = *(const u32x4*)(OGB + (size_t)r_ * 512 + c0); n1 = *(const u32x4*)(OGB + ((size_t)TT + r_) * 512 + c0); nr = *(const u32x4*)(P + (size_t)r_ * PW + OGR + c0); }
    for (; i < n; i += NWAVES * 4) {
        const u32x4 w0 = n0, w1 = n1, rw = nr; const int row = TBH_ROW(i), in = i + NWAVES * 4;
        if (in < n) { const int r_ = TBH_ROW(in); n0 = *(const u32x4*)(OGB + (size_t)r_ * 512 + c0); n1 = *(const u32x4*)(OGB + ((size_t)TT + r_) * 512 + c0); nr = *(const u32x4*)(P + (size_t)r_ * PW + OGR + c0); }
        f32x4 a = (f32x4){bflo(w0.x) + bflo(w1.x), bfhi(w0.x) + bfhi(w1.x), bflo(w0.y) + bflo(w1.y), bfhi(w0.y) + bfhi(w1.y)};
        f32x4 bq = (f32x4){bflo(w0.z) + bflo(w1.z), bfhi(w0.z) + bfhi(w1.z), bflo(w0.w) + bflo(w1.w), bfhi(w0.w) + bfhi(w1.w)};
        float ss = (a[0] * a[0] + a[1] * a[1]) + (a[2] * a[2] + a[3] * a[3]) + (bq[0] * bq[0] + bq[1] * bq[1]) + (bq[2] * bq[2] + bq[3] * bq[3]);
        ss += __shfl_xor(ss, 1); ss += __shfl_xor(ss, 2); ss += __shfl_xor(ss, 4); ss += __shfl_xor(ss, 8);
        const float rstd = 1.f / sqrtf(ss * (1.f / 128.f) + RMS_EPS);
        float rr[8] = {bflo(rw.x), bfhi(rw.x), bflo(rw.y), bfhi(rw.y), bflo(rw.z), bfhi(rw.z), bflo(rw.w), bfhi(rw.w)};
        float o[8];
#pragma unroll
        for (int k = 0; k < 4; ++k) { const float y0 = a[k] * rstd * g0[k], y1 = bq[k] * rstd * g1[k];
            o[k] = y0 * (rr[k] * sigmoidf_(rr[k])); o[4 + k] = y1 * (rr[4 + k] * sigmoidf_(rr[4 + k])); }
        u32x4 w; w.x = pk2(o[0], o[1]); w.y = pk2(o[2], o[3]); w.z = pk2(o[4], o[5]); w.w = pk2(o[6], o[7]);
        *(u32x4*)(ACG + (size_t)row * 1024 + 512 + c0) = w;
    }
#undef TBH_ROW
}

typedef float rf2_t __attribute__((ext_vector_type(2)));
__device__ __forceinline__ float router_reduce(float (&p)[32], int lane) {
#pragma unroll
    for (int i = 0; i < 16; ++i) { const bool up = (lane & 32) != 0; const float send = up ? p[i] : p[i + 16], keep = up ? p[i + 16] : p[i]; p[i] = keep + __shfl_xor(send, 32); }
#pragma unroll
    for (int i = 0; i < 8; ++i) { const bool up = (lane & 16) != 0; const float send = up ? p[i] : p[i + 8], keep = up ? p[i + 8] : p[i]; p[i] = keep + __shfl_xor(send, 16); }
#pragma unroll
    for (int i = 0; i < 4; ++i) { const bool up = (lane & 8) != 0; const float send = up ? p[i] : p[i + 4], keep = up ? p[i + 4] : p[i]; p[i] = keep + __shfl_xor(send, 8); }
#pragma unroll
    for (int i = 0; i < 2; ++i) { const bool up = (lane & 4) != 0; const float send = up ? p[i] : p[i + 2], keep = up ? p[i + 2] : p[i]; p[i] = keep + __shfl_xor(send, 4); }
    { const bool up = (lane & 2) != 0; const float send = up ? p[0] : p[1], keep = up ? p[1] : p[0]; p[0] = keep + __shfl_xor(send, 2); }
    return p[0] + __shfl_xor(p[0], 1);
}
__device__ __forceinline__ void router_topk(float logit, int row, bool valid, int lane, LAS float* lg, LAS float* selv, LAS int* hist, int* TOPI, float* TOPG) {
    const int ex = lane >> 1;
    if ((lane & 1) == 0) lg[ex] = logit;
    LDS_WAIT(); asm volatile("" ::: "memory");
    int rank = 0;
#pragma unroll
    for (int e = 0; e < 32; ++e) { const float o = lg[e]; rank += (o > logit || (o == logit && e < ex)) ? 1 : 0; }
    if ((lane & 1) == 0 && rank < 4) { selv[rank * 2] = logit; selv[rank * 2 + 1] = __builtin_bit_cast(float, ex); }
    LDS_WAIT(); asm volatile("" ::: "memory");
    const float v0 = selv[0], v1 = selv[2], v2 = selv[4], v3 = selv[6];
    const float e0 = 1.f, e1 = __expf(v1 - v0), e2 = __expf(v2 - v0), e3 = __expf(v3 - v0); const float inv = 1.f / (e0 + e1 + e2 + e3);
    if (valid && lane < 4) { const int ej = __builtin_bit_cast(int, selv[lane * 2 + 1]); const float gj = (lane == 0 ? e0 : lane == 1 ? e1 : lane == 2 ? e2 : e3) * inv;
        TOPI[(size_t)row * 4 + lane] = ej; TOPG[(size_t)row * 4 + lane] = gj; __hip_atomic_fetch_add(hist + ej, 1, __ATOMIC_RELAXED, __HIP_MEMORY_SCOPE_WORKGROUP); }
    LDS_WAIT(); asm volatile("" ::: "memory");
}
__device__ __forceinline__ void p_norm2_router(const Frame& F0, int layer, int Tm) {
    const Frame F = relaunder(F0);
    const float* MOD = (const float*)(F.ws + WS_MOD) + (size_t)layer * 9 * 6144; bf16_t* H = (bf16_t*)(F.ws + WS_H); const bf16_t* XW = (const bf16_t*)(F.ws + WS_XW);
    unsigned char* rt = F.ws + WS_ROUTE + layer * ROUTE_STRIDE;
    int* TOPI = (int*)(rt + R_TOPI); float* TOPG = (float*)(rt + R_TOPG); int* CNT = (int*)(rt + R_CNT);
    const float* rw = in_ptr(F, 19) + (size_t)layer * 1024 * 32; const float* rb = in_ptr(F, 20) + layer * 32; const float* g2n = in_ptr(F, 7) + layer * 1024;
    LAS float* WT = (LAS float*)F.lds;
    LAS float* lg = (LAS float*)(F.lds + 132096) + F.wave * 32;
    LAS float* selv = (LAS float*)(F.lds + 132096 + 1024) + F.wave * 8;
    LAS int* hist = (LAS int*)(F.lds + 132096 + 2048);
    __syncthreads();
    {
        f32x4 wv[16];
#pragma unroll
        for (int i = 0; i < 16; ++i) wv[i] = *(const f32x4*)(rw + 4 * (F.tid + NTHR * i));
#pragma unroll
        for (int i = 0; i < 16; ++i) { const int i4 = F.tid + NTHR * i, k = i4 >> 3, e0 = (i4 & 7) * 4;
            WT[(e0 + 0) * 1028 + k] = wv[i][0]; WT[(e0 + 1) * 1028 + k] = wv[i][1]; WT[(e0 + 2) * 1028 + k] = wv[i][2]; WT[(e0 + 3) * 1028 + k] = wv[i][3]; }
    }
    if (F.tid < 32) hist[F.tid] = 0;
    __syncthreads();
    const int RPW = Tm / F.G;
    const int nk = RPW / NWAVES;
    f32x4 shv[4], scv[4]; int mrc = -1;
    const int row0w = blockIdx.x * RPW + F.wave;
    f32x4 nA[4], nB[4];
    load_row_b(XW + (size_t)row0w * 1024, F.lane, nA); load_row_b(XW + (size_t)(nk > 1 ? row0w + NWAVES : row0w) * 1024, F.lane, nB);
#pragma unroll 1
    for (int k = 0; k < nk; k += 2) {
        const bool hasB = k + 1 < nk;
        const int rowA = row0w + NWAVES * k, rowB = hasB ? rowA + NWAVES : rowA;
        f32x4 vA[4], vB[4];
#pragma unroll
        for (int j = 0; j < 4; ++j) { vA[j] = nA[j]; vB[j] = nB[j]; }
        f32x4 gn[4];
#pragma unroll
        for (int j = 0; j < 4; ++j) gn[j] = *(const f32x4*)(g2n + 256 * j + 4 * F.lane);
        const int mrA = rowA < TL ? (rowA >> 12) : 8, mrB = rowB < TL ? (rowB >> 12) : 8;
        if (mrA != mrc) { mrc = mrA;
#pragma unroll
            for (int j = 0; j < 4; ++j) { shv[j] = *(const f32x4*)(MOD + (size_t)mrA * 6144 + 3072 + 256 * j + 4 * F.lane); scv[j] = *(const f32x4*)(MOD + (size_t)mrA * 6144 + 4096 + 256 * j + 4 * F.lane) + 1.f; }
            __builtin_amdgcn_s_waitcnt(0); }
        { const int rA2 = (k + 2 < nk) ? rowA + 2 * NWAVES : rowA, rB2 = (k + 3 < nk) ? rA2 + NWAVES : rA2; load_row_b(XW + (size_t)rA2 * 1024, F.lane, nA); load_row_b(XW + (size_t)rB2 * 1024, F.lane, nB); }
        { const float rsA = row_rstd(vA);
#pragma unroll
          for (int j = 0; j < 4; ++j) vA[j] = (vA[j] * rsA * gn[j]) * scv[j] + shv[j]; }
        if (mrB != mrc) { mrc = mrB;
#pragma unroll
            for (int j = 0; j < 4; ++j) { shv[j] = *(const f32x4*)(MOD + (size_t)mrB * 6144 + 3072 + 256 * j + 4 * F.lane); scv[j] = *(const f32x4*)(MOD + (size_t)mrB * 6144 + 4096 + 256 * j + 4 * F.lane) + 1.f; }
            __builtin_amdgcn_s_waitcnt(0); }
        { const float rsB = row_rstd(vB);
#pragma unroll
          for (int j = 0; j < 4; ++j) vB[j] = (vB[j] * rsB * gn[j]) * scv[j] + shv[j]; }
        store_row_bf16(H + (size_t)rowA * 1024, F.lane, vA);
        if (hasB) store_row_bf16(H + (size_t)rowB * 1024, F.lane, vB);
        float pA[32], pB[32];
#pragma unroll
        for (int e4 = 0; e4 < 32; e4 += 2) {
            f32x4 w[2][4];
#pragma unroll
            for (int x = 0; x < 2; ++x)
#pragma unroll
                for (int j = 0; j < 4; ++j) w[x][j] = *(const LAS f32x4*)(WT + (e4 + x) * 1028 + 256 * j + 4 * F.lane);
            asm volatile("" ::: "memory");
            rf2_t acc2[2][2];
#pragma unroll
            for (int x = 0; x < 2; ++x) { acc2[x][0] = (rf2_t){0.f, 0.f}; acc2[x][1] = (rf2_t){0.f, 0.f}; }
#pragma unroll
            for (int j = 0; j < 4; ++j)
#pragma unroll
                for (int i = 0; i < 4; ++i) { const rf2_t ab = (rf2_t){vA[j][i], vB[j][i]};
#pragma unroll
                    for (int x = 0; x < 2; ++x) acc2[x][i & 1] = __builtin_elementwise_fma(ab, (rf2_t){w[x][j][i], w[x][j][i]}, acc2[x][i & 1]); }
#pragma unroll
            for (int x = 0; x < 2; ++x) { const rf2_t t = acc2[x][0] + acc2[x][1]; pA[e4 + x] = t[0]; pB[e4 + x] = t[1]; } }
        const int ex = F.lane >> 1; const float bias = rb[ex];
        const float logitA = router_reduce(pA, F.lane) + bias, logitB = router_reduce(pB, F.lane) + bias;
        router_topk(logitA, rowA, true, F.lane, lg, selv, hist, TOPI, TOPG);
        router_topk(logitB, rowB, hasB, F.lane, lg, selv, hist, TOPI, TOPG);
    }
    __syncthreads();
    if (F.tid < 32) CNT[blockIdx.x * 32 + F.tid] = hist[F.tid];
}

__device__ __forceinline__ void p_route_gather(const Frame& F0, int layer, int Tm) {
    const Frame F = relaunder(F0);
    unsigned char* rt = F.ws + WS_ROUTE + layer * ROUTE_STRIDE;
    const int* TOPI = (const int*)(rt + R_TOPI); int* POSOF = (int*)(rt + R_POSOF); int* ROWTOK = (int*)(rt + R_ROWTOK); const int* CNT = (const int*)(rt + R_CNT);
    int* TILEEXP = (int*)(rt + R_TILEEXP); int* NT = (int*)(rt + R_NT);
    LAS int* tot = (LAS int*)F.lds;
    LAS int* mine = tot + 32;
    LAS int* pst = mine + 32;
    LAS int* es = pst + 64;
    LAS int* ps = es + 1024;
    const int RPW = Tm / F.G, NP = RPW * 4;
    __syncthreads();
    const int es0 = __builtin_nontemporal_load(TOPI + (size_t)blockIdx.x * NP + F.tid);
    const int es1 = F.tid + NTHR < NP ? __builtin_nontemporal_load(TOPI + (size_t)blockIdx.x * NP + F.tid + NTHR) : 0;
    {
        LAS int* part = ps + 1024;
        const int e = F.tid & 31, sl = F.tid >> 5; int t = 0, m = 0;
        if (F.G == 256) {
            int cv[16];
#pragma unroll
            for (int k = 0; k < 16; ++k) cv[k] = __builtin_nontemporal_load(CNT + (sl + 16 * k) * 32 + e);
#pragma unroll
            for (int k = 0; k < 16; ++k) { t += cv[k]; if (sl + 16 * k < (int)blockIdx.x) m += cv[k]; }
        } else
        for (int w = sl; w < F.G; w += 16) { const int c = __builtin_nontemporal_load(CNT + w * 32 + e); t += c; if (w < (int)blockIdx.x) m += c; }
        part[sl * 32 + e] = t; part[512 + sl * 32 + e] = m;
        __syncthreads();
        if (F.tid < 32) { int tt = 0, mm = 0;
#pragma unroll
            for (int k = 0; k < 16; ++k) { tt += part[k * 32 + F.tid]; mm += part[512 + k * 32 + F.tid]; }
            tot[F.tid] = tt; mine[F.tid] = mm; } }
    es[F.tid] = es0; if (F.tid + NTHR < NP) es[F.tid + NTHR] = es1;
    __syncthreads();
    if (F.tid == 0) { int s = 0; for (int e = 0; e < 32; ++e) { pst[e] = s; s += (tot[e] + 255) & ~255; } pst[32] = s; }
    __syncthreads();
    {
        LAS int* rk = ps + 2048;
        int base[4] = {0, 0, 0, 0};
        for (int c0 = 0; c0 < NP; c0 += 64) { const int i = c0 + F.lane; const int e = i < NP ? es[i] : -1;
#pragma unroll
            for (int x = 0; x < 4; ++x) { const unsigned long long b = __ballot(e == 4 * F.wave + x);
                if (e == 4 * F.wave + x) rk[i] = base[x] + __popcll(b & ((1ull << F.lane) - 1ull));
                base[x] += __popcll(b); } }
        __syncthreads();
    }
    for (int i = F.tid; i < NP; i += NTHR) { const int e = es[i]; const int r = (ps + 2048)[i];
        const int pos = pst[e] + mine[e] + r; ps[i] = pos; const int tok = blockIdx.x * RPW + (i >> 2);
        ROWTOK[pos] = tok; POSOF[(size_t)tok * 4 + (i & 3)] = pos; }
    const int ntiles = pst[32] >> 8;
    if (blockIdx.x == 0) { for (int t = F.tid; t < ntiles; t += NTHR) { int e = 0; for (int q = 0; q < 32; ++q) if (pst[q] <= t * 256) e = q; TILEEXP[t] = e; }
        if (F.tid == 0) NT[0] = ntiles; }
    __syncthreads();
    if (blockIdx.x < 32) { const int e = blockIdx.x; const int r0 = pst[e] + tot[e], r1 = pst[e + 1];
        for (int r = r0 + F.tid; r < r1; r += NTHR) ROWTOK[r] = 0; }
}

__device__ __forceinline__ void p_combine(const Frame& F0, int layer, int Tm) {
    const Frame F = relaunder(F0);
    const float* MODL = (const float*)(F.ws + WS_MOD) + (size_t)layer * 9 * 6144;
    const float* MODN = (const float*)(F.ws + WS_MOD) + (size_t)(layer + 1) * 9 * 6144;
    unsigned char* rt = F.ws + WS_ROUTE + layer * ROUTE_STRIDE;
    const int* POSOF = (const int*)(rt + R_POSOF); const float* TOPG = (const float*)(rt + R_TOPG);
    const bf16_t* YY = (const bf16_t*)(F.ws + WS_XS); bf16_t* XW = (bf16_t*)(F.ws + WS_XW); bf16_t* H = (bf16_t*)(F.ws + WS_H);
    const bool last = layer == 1;
    const float* fin_g = in_ptr(F, 25); const float* n1g = in_ptr(F, 6) + 1024; float* outp = out_ptr(F);
    u32x4 pos4 = (u32x4){0u, 0u, 0u, 0u}; f32x4 gt4 = (f32x4){0.f, 0.f, 0.f, 0.f};
    if (F.gw < Tm) { pos4 = __builtin_nontemporal_load((const u32x4*)(POSOF + (size_t)F.gw * 4)); gt4 = __builtin_nontemporal_load((const f32x4*)(TOPG + (size_t)F.gw * 4)); }
    for (int row = F.gw; row < Tm; row += F.NGW) {
        const int mr = row < TL ? (row >> 12) : 8;
        f32x4 v[4]; load_row_b(XW + (size_t)row * 1024, F.lane, v);
        u32x2 yw[4][4];
#pragma unroll
        for (int s = 0; s < 4; ++s) { const bf16_t* yp = YY + (size_t)pos4[s] * 1024;
#pragma unroll
            for (int j = 0; j < 4; ++j) yw[s][j] = *(const u32x2*)(yp + 256 * j + 4 * F.lane); }
        const f32x4 gcur = gt4;
        if (row + F.NGW < Tm) { pos4 = __builtin_nontemporal_load((const u32x4*)(POSOF + (size_t)(row + F.NGW) * 4)); gt4 = __builtin_nontemporal_load((const f32x4*)(TOPG + (size_t)(row + F.NGW) * 4)); }
        f32x4 y[4];
#pragma unroll
        for (int j = 0; j < 4; ++j) y[j] = (f32x4){0.f, 0.f, 0.f, 0.f};
#pragma unroll
        for (int s = 0; s < 4; ++s)
#pragma unroll
            for (int j = 0; j < 4; ++j) y[j] = y[j] + gcur[s] * (f32x4){bflo(yw[s][j].x), bfhi(yw[s][j].x), bflo(yw[s][j].y), bfhi(yw[s][j].y)};
        const float* g2 = MODL + (size_t)mr * 6144 + 5120;
#pragma unroll
        for (int j = 0; j < 4; ++j) v[j] = v[j] + *(const f32x4*)(g2 + 256 * j + 4 * F.lane) * y[j];
        if (!last) {
            store_row_bf16(XW + (size_t)row * 1024, F.lane, v);
            norm_mod(v, n1g, MODN + (size_t)mr * 6144, MODN + (size_t)mr * 6144 + 1024, F.lane);
            store_row_bf16(H + (size_t)row * 1024, F.lane, v);
        } else {
            const float rstd = row_rstd(v);
#pragma unroll
            for (int j = 0; j < 4; ++j) *(f32x4*)(outp + (size_t)row * 1024 + 256 * j + 4 * F.lane) = v[j] * rstd * *(const f32x4*)(fin_g + 256 * j + 4 * F.lane);
        }
    }
}
typedef float f32x16 __attribute__((ext_vector_type(16)));
typedef short bf16x8 __attribute__((ext_vector_type(8)));
typedef short v4i16_t __attribute__((ext_vector_type(4)));

typedef __bf16 abf2_t __attribute__((ext_vector_type(2)));
typedef float af2_t __attribute__((ext_vector_type(2)));
__device__ __forceinline__ unsigned cvt_pk(float lo, float hi) { const af2_t v = {lo, hi}; return __builtin_bit_cast(unsigned, __builtin_convertvector(v, abf2_t)); }

constexpr int AK_STRIDE = 272, AV_STRIDE = 320, AK_BYTES = 64 * AK_STRIDE, AV_BYTES = 64 * AV_STRIDE;
constexpr int AV_OFF = 2 * AK_BYTES;
constexpr int AQ_OFF = AV_OFF + 3 * AV_BYTES;
#ifndef ATT_PROBE
#define ATT_PROBE 0
#endif
struct AttnSt { f32x16 O[4]; f32x16 negm; float mrun, lrun; };
#define ASB() __builtin_amdgcn_sched_barrier(0)
#define APIN(x) asm volatile("" : "+v"(x))
#define AMF(a, b, c) __builtin_amdgcn_mfma_f32_32x32x16_bf16(a, b, c, 0, 0, 0)
#define AMX3(a, b, c) __builtin_fmaxf(__builtin_fmaxf((a), (b)), (c))
#define AGAPA(MF, A0, A1, A2, A3, W0, W1, PW) do { MF; sacc += A0; sacc += A1; sacc += A2; sacc += A3; APIN(sacc); W0; W1; APIN(PW); ASB(); } while (0)
#define AGAPB(MF, RD, X, i) do { MF; RD; X[i] = __builtin_amdgcn_exp2f(X[i]); X[i + 1] = __builtin_amdgcn_exp2f(X[i + 1]); APIN(X); ASB(); } while (0)
__device__ __forceinline__ float attn_rowmax(const f32x16& p0, const f32x16& p1) {
    float a = AMX3(p0[0], p0[1], p1[0]), b = AMX3(p0[2], p0[3], p1[1]); a = AMX3(a, p1[2], p1[3]);
#pragma unroll
    for (int r = 4; r < 16; r += 4) { a = AMX3(a, p0[r], p0[r + 1]); b = AMX3(b, p0[r + 2], p0[r + 3]); a = AMX3(a, p1[r], p1[r + 1]); b = AMX3(b, p1[r + 2], p1[r + 3]); }
    float m = __builtin_fmaxf(a, b);
    const auto rr = __builtin_amdgcn_permlane32_swap(__builtin_bit_cast(unsigned, m), __builtin_bit_cast(unsigned, m), false, false);
    return __builtin_fmaxf(__builtin_bit_cast(float, rr[0]), __builtin_bit_cast(float, rr[1]));
}
template <int PT, bool PRE>
__device__ __forceinline__ void attn_phA(const Frame& F, AttnSt& st, f32x16& C0, f32x16& C1, f32x16& P0, f32x16& P1, u32x4& pw0, u32x4& pw1, u32x4& pw2, u32x4& pw3,
                                         bf16x8 (&vf)[4], const bf16x8 (&qf)[4], const LAS unsigned char* vb, int q, int hi, int map) {
    const LAS unsigned char* kb = F.lds + PT * AK_BYTES + q * AK_STRIDE + map * 128 + hi * 16;
    bf16x8 ra[2], rb2[2];
#define AKQ(sl, ks) do { ra[sl] = *(const LAS bf16x8*)(kb + (ks) * 32); rb2[sl] = *(const LAS bf16x8*)(kb + 32 * AK_STRIDE + (ks) * 32); } while (0)
#define ATR(p) __builtin_amdgcn_ds_read_tr16_b64_v4i16((LAS v4i16_t*)(p))
#define AVR(sl, d, s) do { const v4i16_t lo_ = ATR(vb + (s) * 16 * AV_STRIDE + (d) * 64), hi_ = ATR(vb + (s) * 16 * AV_STRIDE + 8 * AV_STRIDE + (d) * 64); \
        vf[sl] = (bf16x8){lo_[0], lo_[1], lo_[2], lo_[3], hi_[0], hi_[1], hi_[2], hi_[3]}; } while (0)
#define AVRD(d, s) do { const v4i16_t lo_ = ATR(vb + (s) * 16 * AV_STRIDE + (d) * 64), hi_ = ATR(vb + (s) * 16 * AV_STRIDE + 8 * AV_STRIDE + (d) * 64); \
        vf[d] = (bf16x8){lo_[0], lo_[1], lo_[2], lo_[3], hi_[0], hi_[1], hi_[2], hi_[3]}; } while (0)
    ASB();
    AKQ(0, 0); AKQ(1, 1);
    float sacc = P0[0] + P0[1];
    ASB();
    AGAPA(C0 = AMF(ra[0], qf[0], st.negm),  P0[2], P0[3], P0[4], P0[5],     pw0[0] = cvt_pk(P0[0], P0[1]),   pw0[1] = cvt_pk(P0[2], P0[3]),   pw0);
    AGAPA(C1 = AMF(rb2[0], qf[0], st.negm), P0[6], P0[7], P0[8], P0[9],     pw0[2] = cvt_pk(P0[4], P0[5]),   pw0[3] = cvt_pk(P0[6], P0[7]),   pw0);
    AKQ(0, 2); ASB();
    AGAPA(C0 = AMF(ra[1], qf[1], C0),   P0[10], P0[11], P0[12], P0[13], pw1[0] = cvt_pk(P0[8], P0[9]),   pw1[1] = cvt_pk(P0[10], P0[11]), pw1);
    AGAPA(C1 = AMF(rb2[1], qf[1], C1),  P0[14], P0[15], P1[0], P1[1],   pw1[2] = cvt_pk(P0[12], P0[13]), pw1[3] = cvt_pk(P0[14], P0[15]), pw1);
    AKQ(1, 3); ASB();
    AGAPA(C0 = AMF(ra[0], qf[2], C0),   P1[2], P1[3], P1[4], P1[5],     pw2[0] = cvt_pk(P1[0], P1[1]),   pw2[1] = cvt_pk(P1[2], P1[3]),   pw2);
    AGAPA(C1 = AMF(rb2[0], qf[2], C1),  P1[6], P1[7], P1[8], P1[9],     pw2[2] = cvt_pk(P1[4], P1[5]),   pw2[3] = cvt_pk(P1[6], P1[7]),   pw2);
    if (PRE) { AVRD(0, 0); AVRD(1, 0); ASB(); }
    AGAPA(C0 = AMF(ra[1], qf[3], C0),   P1[10], P1[11], P1[12], P1[13], pw3[0] = cvt_pk(P1[8], P1[9]),   pw3[1] = cvt_pk(P1[10], P1[11]), pw3);
    if (PRE) { AVRD(2, 0); AVRD(3, 0); ASB(); }
    AGAPA(C1 = AMF(rb2[1], qf[3], C1),  P1[14], P1[15], 0.f, 0.f,       pw3[2] = cvt_pk(P1[12], P1[13]), pw3[3] = cvt_pk(P1[14], P1[15]), pw3);
    st.lrun += sacc;
#undef AKQ
}
__device__ __forceinline__ void attn_mid(AttnSt& st, f32x16& C0, f32x16& C1, float& alpha, bool& resc) {
    const float mx = attn_rowmax(C0, C1);
    alpha = 1.f; resc = false;
    if (!__builtin_expect(__all(mx <= 8.f), 1)) { const float dl = fmaxf(mx, 0.f); st.mrun += dl; alpha = __builtin_amdgcn_exp2f(-dl); st.lrun *= alpha; resc = true;
#pragma unroll
        for (int r = 0; r < 16; ++r) { C0[r] -= dl; C1[r] -= dl; st.negm[r] = -st.mrun; }
        APIN(st.negm); }
    ASB();
}
template <bool PRE>
__device__ __forceinline__ void attn_phB(AttnSt& st, f32x16& C0, f32x16& C1, const u32x4& pw0, const u32x4& pw1, const u32x4& pw2, const u32x4& pw3, bf16x8 (&vf)[4],
                                         const LAS unsigned char* vb, float alpha, bool resc) {
#define APF(k) __builtin_bit_cast(bf16x8, pw##k)
    if (!PRE) { ASB(); AVR(0, 0, 0); AVR(1, 1, 0); AVR(2, 2, 0); AVR(3, 3, 0); ASB(); }
    __builtin_amdgcn_s_setprio(1); ASB();
    AGAPB(st.O[0] = AMF(vf[0], APF(0), st.O[0]), AVR(0, 0, 1), C0, 0);
    AGAPB(st.O[1] = AMF(vf[1], APF(0), st.O[1]), AVR(1, 1, 1), C0, 2);
    AGAPB(st.O[2] = AMF(vf[2], APF(0), st.O[2]), AVR(2, 2, 1), C0, 4);
    AGAPB(st.O[3] = AMF(vf[3], APF(0), st.O[3]), AVR(3, 3, 1), C0, 6);
    AGAPB(st.O[0] = AMF(vf[0], APF(1), st.O[0]), AVR(0, 0, 2), C0, 8);
    AGAPB(st.O[1] = AMF(vf[1], APF(1), st.O[1]), AVR(1, 1, 2), C0, 10);
    AGAPB(st.O[2] = AMF(vf[2], APF(1), st.O[2]), AVR(2, 2, 2), C0, 12);
    AGAPB(st.O[3] = AMF(vf[3], APF(1), st.O[3]), AVR(3, 3, 2), C0, 14);
    AGAPB(st.O[0] = AMF(vf[0], APF(2), st.O[0]), AVR(0, 0, 3), C1, 0);
    AGAPB(st.O[1] = AMF(vf[1], APF(2), st.O[1]), AVR(1, 1, 3), C1, 2);
    AGAPB(st.O[2] = AMF(vf[2], APF(2), st.O[2]), AVR(2, 2, 3), C1, 4);
    AGAPB(st.O[3] = AMF(vf[3], APF(2), st.O[3]), AVR(3, 3, 3), C1, 6);
    AGAPB(st.O[0] = AMF(vf[0], APF(3), st.O[0]), (void)0, C1, 8);
    AGAPB(st.O[1] = AMF(vf[1], APF(3), st.O[1]), (void)0, C1, 10);
    AGAPB(st.O[2] = AMF(vf[2], APF(3), st.O[2]), (void)0, C1, 12);
    AGAPB(st.O[3] = AMF(vf[3], APF(3), st.O[3]), (void)0, C1, 14);
    __builtin_amdgcn_s_setprio(0); ASB();
    if (resc) {
#pragma unroll
        for (int d = 0; d < 4; ++d)
#pragma unroll
            for (int r = 0; r < 16; ++r) st.O[d][r] *= alpha;
    }
#undef APF
}
__device__ __forceinline__ void attn_drain(AttnSt& st, f32x16& P0, f32x16& P1, const LAS unsigned char* vb) {
    float sacc = 0.f;
#pragma unroll
    for (int r = 0; r < 16; ++r) sacc += P0[r] + P1[r];
    st.lrun += sacc;
#pragma unroll
    for (int s = 0; s < 4; ++s) { u32x4 w;
#pragma unroll
        for (int j = 0; j < 4; ++j) { const int r = 8 * (s & 1) + 2 * j; w[j] = (s < 2) ? cvt_pk(P0[r], P0[r + 1]) : cvt_pk(P1[r], P1[r + 1]); }
        const bf16x8 pf = __builtin_bit_cast(bf16x8, w);
#pragma unroll
        for (int d = 0; d < 4; ++d) { const v4i16_t lo_ = ATR(vb + s * 16 * AV_STRIDE + d * 64), hi_ = ATR(vb + s * 16 * AV_STRIDE + 8 * AV_STRIDE + d * 64);
            const bf16x8 v = (bf16x8){lo_[0], lo_[1], lo_[2], lo_[3], hi_[0], hi_[1], hi_[2], hi_[3]}; st.O[d] = AMF(v, pf, st.O[d]); }
    }
}
__device__ __forceinline__ void attn_unit(const Frame& F, int u, float lam, float osc, const float* subg, int tmask = -1) {
    const bf16_t* P = (const bf16_t*)(F.ws + WS_P); bf16_t* AD = (bf16_t*)(F.ws + WS_AD);
    const int map = F.wave >> 2, rb = F.wave & 3, q = F.lane & 31, hi = F.lane >> 5;
    int b, h, qrow0, t0; const int t1 = 68;
    if (u < 2048) { b = u >> 8; h = (u >> 5) & 7; qrow0 = b * 4096 + (u & 31) * 128; t0 = 0; }
    else { const int v = u - 2048; b = v >> 4; h = (v >> 1) & 7; qrow0 = TL + b * 256 + (v & 1) * 128; t0 = 64; }
    const int qrow = qrow0 + rb * 32 + q;

    bf16x8 qf[4];
#pragma unroll
    for (int ks = 0; ks < 4; ++ks) qf[ks] = *(const bf16x8*)(P + (size_t)qrow * PW + OQ + h * 128 + map * 64 + 16 * ks + 8 * hi);
    AttnSt st;
#pragma unroll
    for (int d = 0; d < 4; ++d)
#pragma unroll
        for (int r = 0; r < 16; ++r) st.O[d][r] = 0.f;
    st.mrun = -1e30f; st.lrun = 0.f;
    const int e0 = F.tid, e1 = F.tid + 512;
    const int kkey0 = e0 >> 4, kch0 = e0 & 15, kkey1 = e1 >> 4, kch1 = e1 & 15;
    const char* kbase_lat = (const char*)(P + (size_t)(b * 4096) * PW + OKK + h * 128);
    const char* kbase_ctx = (const char*)(P + (size_t)(TL + b * 256) * PW + OKK + h * 128) - (size_t)64 * 64 * PW * 2;
    const unsigned koff0 = (unsigned)(kkey0 * PW + kch0 * 8) * 2u, koff1 = (unsigned)(kkey1 * PW + kch1 * 8) * 2u;
    constexpr size_t VOFS = (size_t)(OV - OKK) * 2;
    u32x4 kr0, kr1, vr0, vr1;
#define ATT_LOADK(t_) do { const int tm__ = (t_) & tmask; const char* kb__ = (tm__ < 64 ? kbase_lat : kbase_ctx) + (size_t)tm__ * (64 * PW * 2); \
        kr0 = *(const u32x4*)(kb__ + koff0); kr1 = *(const u32x4*)(kb__ + koff1); } while (0)
#define ATT_LOADV(t_) do { const int tm__ = (t_) & tmask; const char* vb__ = (tm__ < 64 ? kbase_lat : kbase_ctx) + (size_t)tm__ * (64 * PW * 2) + VOFS; \
        vr0 = *(const u32x4*)(vb__ + koff0); vr1 = *(const u32x4*)(vb__ + koff1); } while (0)
#define ATT_STOREK(buf) do { LAS unsigned char* kb_ = F.lds + (buf) * AK_BYTES; \
        *(LAS u32x4*)(kb_ + kkey0 * AK_STRIDE + kch0 * 16) = kr0; *(LAS u32x4*)(kb_ + kkey1 * AK_STRIDE + kch1 * 16) = kr1; } while (0)
#define ATT_STOREV(off) do { LAS unsigned char* vb_ = F.lds + AV_OFF + (off); \
        *(LAS u32x4*)(vb_ + kkey0 * AV_STRIDE + kch0 * 16) = vr0; *(LAS u32x4*)(vb_ + kkey1 * AV_STRIDE + kch1 * 16) = vr1; } while (0)
    ATT_LOADK(t0); ATT_LOADV(t0);
    __syncthreads();
    ATT_STOREK(0); ATT_STOREV(0);
    ATT_LOADK(t0 + 1);
    __syncthreads();
    f32x16 sA0, sA1, sB0, sB1;
    {
        const LAS unsigned char* kb = F.lds + q * AK_STRIDE + map * 128 + hi * 16;
#pragma unroll
        for (int r = 0; r < 16; ++r) { sA0[r] = 0.f; sA1[r] = 0.f; }
#pragma unroll
        for (int ks = 0; ks < 4; ++ks) {
            const bf16x8 a0 = *(const LAS bf16x8*)(kb + ks * 32), a1 = *(const LAS bf16x8*)(kb + 32 * AK_STRIDE + ks * 32), qv = qf[ks];
            sA0 = __builtin_amdgcn_mfma_f32_32x32x16_bf16(a0, qv, sA0, 0, 0, 0);
            sA1 = __builtin_amdgcn_mfma_f32_32x32x16_bf16(a1, qv, sA1, 0, 0, 0);
        }
    }
    ATT_STOREK(1);
    {
        const float mx = attn_rowmax(sA0, sA1); st.mrun = mx;
#pragma unroll
        for (int r = 0; r < 16; ++r) { sA0[r] = __builtin_amdgcn_exp2f(sA0[r] - mx); sA1[r] = __builtin_amdgcn_exp2f(sA1[r] - mx); st.negm[r] = -mx; }
        APIN(st.negm);
    }
    __syncthreads();
    const LAS unsigned char* vq = F.lds + AV_OFF + (4 * hi + ((F.lane & 15) >> 2)) * AV_STRIDE + (16 * ((F.lane >> 4) & 1) + 4 * (F.lane & 3)) * 2;
    int v0 = AV_BYTES, v1 = 0, v2 = 2 * AV_BYTES;
#define ATT_ROT() do { const int t_ = v2; v2 = v1; v1 = v0; v0 = t_; } while (0)
    u32x4 pw0, pw1, pw2, pw3; bf16x8 vf[4]; float alpha = 1.f; bool resc = false;
#define ATT_TILE(PT, C0, C1, P0, P1, KB, HK1, HK2, HV, t) do { \
        attn_phA<PT, false>(F, st, C0, C1, P0, P1, pw0, pw1, pw2, pw3, vf, qf, vq, q, hi, map); attn_mid(st, C0, C1, alpha, resc); \
        if (HK1) ATT_STOREK(KB); ATT_STOREV(v0); ATT_ROT(); \
        if (map != 0) __syncthreads(); \
        if (HK2) ATT_LOADK((t) + 2); if (HV) ATT_LOADV((t) + 1); \
        attn_phB<false>(st, C0, C1, pw0, pw1, pw2, pw3, vf, vq + v2, alpha, resc); \
        if (map == 0) __syncthreads(); } while (0)
    ATT_LOADK(t0 + 2); ATT_LOADV(t0 + 1);
    int t = t0 + 1;
#pragma unroll 1
    for (; t + 3 < t1; t += 2) {
        ATT_TILE(1, sB0, sB1, sA0, sA1, 0, true, true, true, t);
        ATT_TILE(0, sA0, sA1, sB0, sB1, 1, true, true, true, t + 1);
    }
    ATT_TILE(1, sB0, sB1, sA0, sA1, 0, true, true, true, t1 - 3);
    ATT_TILE(0, sA0, sA1, sB0, sB1, 1, true, false, true, t1 - 2);
    ATT_TILE(1, sB0, sB1, sA0, sA1, 0, false, false, false, t1 - 1);
    attn_drain(st, sB0, sB1, vq + v1);
#undef ATT_TILE
    __syncthreads();
#undef ATT_ROT
#undef ATT_LOADK
#undef ATT_LOADV
#undef ATT_STOREK
#undef ATT_STOREV
    __builtin_amdgcn_s_setprio(0);
    f32x16 (&O)[4] = st.O; const float lrun = st.lrun;
    const float inv = 1.f / (lrun + __shfl_xor(lrun, 32));
    unsigned xoff = (unsigned)((rb * 128 + 4 * hi) * 32 + q) * 4u; asm volatile("" : "+v"(xoff));
    LAS float* xb = (LAS float*)(F.lds + xoff);
    if (map == 1) {
#pragma unroll
        for (int d = 0; d < 4; ++d)
#pragma unroll
            for (int r = 0; r < 16; ++r) { const int dv = 32 * d + (r & 3) + 8 * (r >> 2); xb[dv * 32] = O[d][r] * inv; }
    }
    __syncthreads();
    if (map == 0) {
        float ss = 0.f;
#pragma unroll
        for (int d = 0; d < 4; ++d)
#pragma unroll
            for (int r = 0; r < 16; ++r) { const int dv = 32 * d + (r & 3) + 8 * (r >> 2); const float o = O[d][r] * inv - lam * xb[dv * 32]; O[d][r] = o; ss += o * o; }
        ss += __shfl_xor(ss, 32);
        const float rs = osc / sqrtf(ss * (1.f / 128.f) + RMS_EPS);
        bf16_t* op = AD + (size_t)qrow * 1024 + h * 128;
#pragma unroll
        for (int d = 0; d < 4; ++d)
#pragma unroll
            for (int g = 0; g < 4; ++g) { const int dv = 32 * d + 8 * g + 4 * hi; const f32x4 gv = *(const f32x4*)(subg + dv);
                u32x2 w; w.x = pk2(O[d][4 * g] * rs * gv[0], O[d][4 * g + 1] * rs * gv[1]); w.y = pk2(O[d][4 * g + 2] * rs * gv[2], O[d][4 * g + 3] * rs * gv[3]);
                *(u32x2*)(op + dv) = w; }
    }
}

__device__ __forceinline__ void p_gla_chain2(const Frame& F, const float* wa2  , const float* ba  , int chain) {
    const bf16_t* P = (const bf16_t*)(F.ws + WS_P); const float* GA = (const float*)(F.ws + WS_GA); float* OG = (float*)(F.ws + WS_OG);
    const int b = chain >> 4, h = (chain >> 2) & 3, dir = (chain >> 1) & 1, vh = chain & 1;
    LAS float* Wa = (LAS float*)F.lds;
    LAS float* bav = Wa + 1024;
    LAS float* gas = bav + 64;
    LAS float* qs = gas + 256;
    LAS float* ks = qs + 1024;
    LAS float* egs = ks + 1024;
    LAS float* vs = egs + 1024;
    LAS float* po = vs + 1024;
    const int tid = F.tid, dkg = tid >> 6, dv = tid & 63;
    __syncthreads();
    for (int i = tid; i < 1024; i += NTHR) { const int r = i >> 6, dk = i & 63; Wa[i] = wa2[(size_t)(dir * 16 + r) * 256 + h * 64 + dk]; }
    if (tid < 64) bav[tid] = ba[dir * 256 + h * 64 + tid];
    float S[8];
#pragma unroll
    for (int i = 0; i < 8; ++i) S[i] = 0.f;
    const int role = tid >> 7, li = tid & 127, ltk = li >> 3, lch = li & 7;
    u32x4 ld; f32x4 lda_ = (f32x4){0.f, 0.f, 0.f, 0.f};
#define GLA_LOAD(blk) do { const int row_ = gla_row((blk) * 16 + ltk, b, dir); \
        if (role == 0) ld = *(const u32x4*)(P + (size_t)row_ * PW + OGQ + h * 64 + lch * 8); \
        else if (role == 1) ld = *(const u32x4*)(P + (size_t)row_ * PW + OGK + h * 64 + lch * 8); \
        else if (role == 2) ld = *(const u32x4*)(P + (size_t)row_ * PW + OGV + h * 128 + vh * 64 + lch * 8); \
        else if (li < 64) { const int row2_ = gla_row((blk) * 16 + (li >> 2), b, dir); lda_ = *(const f32x4*)(GA + (size_t)row2_ * 32 + dir * 16 + (li & 3) * 4); } } while (0)
    GLA_LOAD(0);
    for (int blk = 0; blk < 272; ++blk) {
        __syncthreads();
        if (role < 3) { LAS float* dst = (role == 0 ? qs : role == 1 ? ks : vs) + ltk * 64 + lch * 8;
            *(LAS f32x4*)dst = (f32x4){bflo(ld.x), bfhi(ld.x), bflo(ld.y), bfhi(ld.y)}; *(LAS f32x4*)(dst + 4) = (f32x4){bflo(ld.z), bfhi(ld.z), bflo(ld.w), bfhi(ld.w)}; }
        else if (li < 64) *(LAS f32x4*)(gas + (li >> 2) * 16 + (li & 3) * 4) = lda_;
        if (blk + 1 < 272) GLA_LOAD(blk + 1);
        __syncthreads();
        for (int e = tid; e < 1024; e += NTHR) { const int tk = e >> 6, dk = e & 63; float z = bav[dk];
#pragma unroll
            for (int r = 0; r < 16; ++r) z += gas[tk * 16 + r] * Wa[r * 64 + dk];
            const float ls = fminf(z, 0.f) - log1pf(__expf(-fabsf(z)));
            egs[e] = __expf(ls * (1.f / 16.f)); }
        __syncthreads();
#pragma unroll 1
        for (int tk = 0; tk < 16; ++tk) {
            const float vv = vs[tk * 64 + dv]; float pacc = 0.f;
            const f32x4 e0 = *(const LAS f32x4*)(egs + tk * 64 + dkg * 8), e1 = *(const LAS f32x4*)(egs + tk * 64 + dkg * 8 + 4);
            const f32x4 k0 = *(const LAS f32x4*)(ks + tk * 64 + dkg * 8), k1 = *(const LAS f32x4*)(ks + tk * 64 + dkg * 8 + 4);
            const f32x4 q0 = *(const LAS f32x4*)(qs + tk * 64 + dkg * 8), q1 = *(const LAS f32x4*)(qs + tk * 64 + dkg * 8 + 4);
#pragma unroll
            for (int i = 0; i < 4; ++i) { S[i] = e0[i] * S[i] + k0[i] * vv; pacc += q0[i] * S[i]; S[4 + i] = e1[i] * S[4 + i] + k1[i] * vv; pacc += q1[i] * S[4 + i]; }
            po[(tk * 8 + dkg) * 64 + dv] = pacc;
        }
        __syncthreads();
        for (int e = tid; e < 1024; e += NTHR) { const int tk = e >> 6, d = e & 63; const int row = gla_row(blk * 16 + tk, b, dir);
            float o = 0.f;
#pragma unroll
            for (int g = 0; g < 8; ++g) o += po[(tk * 8 + g) * 64 + d];
            OG[((size_t)dir * TT + row) * 512 + h * 128 + vh * 64 + d] = o * 0.125f; }
    }
#undef GLA_LOAD
    __syncthreads();
}

constexpr int GL_WA = 0, GL_BA = 4096, GL_ET = 4352, GL_AS = 4608, GL_GS = 8704, GL_SEG = 25088, GL_QD = 27136, GL_KI = 36352, GL_KET = 45568, GL_VT = 54784, GL_SL = 73216, GL_END = 91648;
constexpr int GRS = 144;
__device__ __forceinline__ void p_gla_chain_mfma(const Frame& F, const float* wa2  , const float* ba  , int chain) {
    const bf16_t* P = (const bf16_t*)(F.ws + WS_P); const float* GA = (const float*)(F.ws + WS_GA); bf16_t* OGB = (bf16_t*)(F.ws + WS_OG);
    const int b = chain >> 3, h = (chain >> 1) & 3, dir = chain & 1;
    LAS unsigned char* L = F.lds;
    LAS float* Wa = (LAS float*)(L + GL_WA); LAS float* bav = (LAS float*)(L + GL_BA); LAS float* eT = (LAS float*)(L + GL_ET);
    LAS float* as = (LAS float*)(L + GL_AS); LAS float* segt = (LAS float*)(L + GL_SEG);
    const int tid = F.tid, dk = tid & 63, seg = tid >> 6;
    const int db = F.wave & 3, hb = F.wave >> 2, c = F.lane & 31, hi = F.lane >> 5;
    __syncthreads();
    for (int i = tid; i < 1024; i += NTHR) { const int r = i >> 6, d = i & 63; Wa[i] = wa2[(size_t)(dir * 16 + r) * 256 + h * 64 + d]; }
    if (tid < 64) bav[tid] = ba[dir * 256 + h * 64 + tid];
    for (int i = tid; i < (GL_END - GL_SL) / 4; i += NTHR) ((LAS unsigned*)(L + GL_SL))[i] = 0u;
    f32x16 sacc;
#pragma unroll
    for (int r = 0; r < 16; ++r) sacc[r] = 0.f;
    __syncthreads();
    float wcol[16]; const float bcol = bav[dk];
#pragma unroll
    for (int r = 0; r < 16; ++r) wcol[r] = Wa[r * 64 + dk];
    bf16_t pqA[8], pkA[8], pqB[8], pkB[8]; u32x4 pv0A, pv1A, pv0B, pv1B; f32x4 paA = (f32x4){0.f, 0.f, 0.f, 0.f}, paB = paA;
    const int sg = dir ? -1 : 1;
    const unsigned qoff = (unsigned)((dir ? 56 - seg * 8 : seg * 8) * PW + OGQ + h * 64 + dk), koff = qoff + (unsigned)(OGK - OGQ);
    const unsigned voff = (unsigned)((dir ? 63 - (tid & 63) : (tid & 63)) * PW + OGV + h * 128 + (tid >> 6) * 8);
    const unsigned aoff = (unsigned)((dir ? 63 - (tid >> 2) : (tid >> 2)) * 32 + dir * 16 + (tid & 3) * 4);
#define GLC_LOAD(cc, pq, pk, pv0, pv1, pa) do { const int rb_ = __builtin_amdgcn_readfirstlane(gla_row((cc) * 64, b, dir)); \
        _Pragma("unroll") for (int i = 0; i < 8; ++i) { const bf16_t* pb_ = P + (size_t)(rb_ + sg * i - (dir ? 56 : 0)) * PW; pq[i] = pb_[qoff]; pk[i] = pb_[koff]; } \
        { const bf16_t* pv_ = P + (size_t)(rb_ - (dir ? 63 : 0)) * PW; pv0 = *(const u32x4*)(pv_ + voff); pv1 = *(const u32x4*)(pv_ + voff + 64); } \
        if (tid < 256) pa = *(const f32x4*)(GA + (size_t)(rb_ - (dir ? 63 : 0)) * 32 + aoff); } while (0)
    GLC_LOAD(0, pqA, pkA, pv0A, pv1A, paA); GLC_LOAD(1, pqB, pkB, pv0B, pv1B, paB);
    auto chunk = [&](const int cc, bf16_t (&pq)[8], bf16_t (&pk)[8], u32x4& pv0, u32x4& pv1, f32x4& pa) __attribute__((always_inline)) {
        __syncthreads();
        if (tid < 256) *(LAS f32x4*)(as + (tid >> 2) * 16 + (tid & 3) * 4) = pa;
#pragma unroll
        for (int i2 = 0; i2 < 2; ++i2) { const int e = tid + 512 * i2, l = e & 63, ch = e >> 6; const u32x4 w = i2 ? pv1 : pv0;
            const int lo = l & 15, q4 = lo >> 2; const int pos = (l & ~15) + ((q4 == 1) ? 8 : (q4 == 2) ? 4 : q4 * 4) + (lo & 3);
            LAS bf16_t* vt = (LAS bf16_t*)(L + GL_VT);
#pragma unroll
            for (int j = 0; j < 4; ++j) { vt[(ch * 8 + 2 * j) * (GRS / 2) + pos] = (bf16_t)(w[j] & 0xffffu); vt[(ch * 8 + 2 * j + 1) * (GRS / 2) + pos] = (bf16_t)(w[j] >> 16); } }
        float qv[8], kv[8];
#pragma unroll
        for (int i = 0; i < 8; ++i) { qv[i] = bf2f(pq[i]); kv[i] = bf2f(pk[i]); }
        if (cc + 2 < 68) GLC_LOAD(cc + 2, pq, pk, pv0, pv1, pa);
        __syncthreads();
        float G[8]; float run = 0.f;
#pragma unroll
        for (int i = 0; i < 8; ++i) { float z = bcol; const LAS float* ar = as + (seg * 8 + i) * 16;
#pragma unroll
            for (int r4 = 0; r4 < 4; ++r4) { const f32x4 a4 = *(const LAS f32x4*)(ar + 4 * r4); z += a4[0] * wcol[4 * r4] + a4[1] * wcol[4 * r4 + 1] + a4[2] * wcol[4 * r4 + 2] + a4[3] * wcol[4 * r4 + 3]; }
            const float ls = fminf(z, 0.f) - __logf(1.f + __expf(-fabsf(z)));
            run += ls * (1.f / 16.f); G[i] = run; }
        segt[seg * 64 + dk] = run;
        __syncthreads();
        float pre = 0.f, tot = 0.f;
#pragma unroll
        for (int s = 0; s < 8; ++s) { const float v = segt[s * 64 + dk]; tot += v; pre += (s < seg) ? v : 0.f; }
        const float etot = __expf(tot);
        if (seg == 0) eT[dk] = etot;
        {
            LAS bf16_t* qd = (LAS bf16_t*)(L + GL_QD); LAS bf16_t* ki = (LAS bf16_t*)(L + GL_KI);
            unsigned ke[4];
#pragma unroll
            for (int i = 0; i < 8; i += 2) { float qo[2], kio[2], keo[2];
#pragma unroll
                for (int j = 0; j < 2; ++j) { const float g = pre + G[i + j]; const float eg = __expf(g), ieg = __builtin_amdgcn_rcpf(eg); qo[j] = qv[i + j] * 0.125f * eg; kio[j] = kv[i + j] * ieg; keo[j] = kio[j] * etot; }
                { const unsigned wq = cvt_pk(qo[0], qo[1]), wk = cvt_pk(kio[0], kio[1]);
                  qd[(seg * 8 + i) * (GRS / 2) + dk] = (bf16_t)(wq & 0xffffu); qd[(seg * 8 + i + 1) * (GRS / 2) + dk] = (bf16_t)(wq >> 16);
                  ki[(seg * 8 + i) * (GRS / 2) + dk] = (bf16_t)(wk & 0xffffu); ki[(seg * 8 + i + 1) * (GRS / 2) + dk] = (bf16_t)(wk >> 16); }
                ke[i >> 1] = pk2(keo[0], keo[1]); }
            LAS unsigned char* kr = L + GL_KET + dk * GRS + ((seg >> 1) * 16 + ((seg & 1) ? 4 : 0)) * 2;
            *(LAS u32x2*)kr = (u32x2){ke[0], ke[1]}; *(LAS u32x2*)(kr + 16) = (u32x2){ke[2], ke[3]};
        }
        __syncthreads();
        {
            const int lb = hb;
            const LAS unsigned char* qp = L + GL_QD + (32 * lb + c) * GRS + hi * 16;
            f32x16 at0, at1;
#pragma unroll
            for (int r = 0; r < 16; ++r) { at0[r] = 0.f; at1[r] = 0.f; }
            bf16x8 qfr[4];
#pragma unroll
            for (int ks = 0; ks < 4; ++ks) qfr[ks] = *(const LAS bf16x8*)(qp + ks * 32);
#pragma unroll
            for (int ks = 0; ks < 4; ++ks) { const bf16x8 a0 = *(const LAS bf16x8*)(L + GL_KI + c * GRS + hi * 16 + ks * 32);
                at0 = __builtin_amdgcn_mfma_f32_32x32x16_bf16(a0, qfr[ks], at0, 0, 0, 0); }
            if (lb == 1) {
#pragma unroll
                for (int ks = 0; ks < 4; ++ks) { const bf16x8 a1 = *(const LAS bf16x8*)(L + GL_KI + (32 + c) * GRS + hi * 16 + ks * 32);
                    at1 = __builtin_amdgcn_mfma_f32_32x32x16_bf16(a1, qfr[ks], at1, 0, 0, 0); }
            }
#pragma unroll
            for (int r = 0; r < 16; ++r) { const int ml = (r & 3) + 8 * (r >> 2) + 4 * hi; if (lb == 0) { if (ml > c) at0[r] = 0.f; } else { if (ml > c) at1[r] = 0.f; } }
            f32x16 o;
#pragma unroll
            for (int r = 0; r < 16; ++r) o[r] = 0.f;
            const LAS unsigned char* vp = L + GL_VT + (32 * db + c) * GRS + hi * 16;
#pragma unroll
            for (int s = 0; s < 2; ++s) { u32x4 w;
#pragma unroll
                for (int j = 0; j < 4; ++j) { const int r = 8 * s + 2 * j; w[j] = cvt_pk(at0[r], at0[r + 1]); }
                o = __builtin_amdgcn_mfma_f32_32x32x16_bf16(*(const LAS bf16x8*)(vp + s * 32), __builtin_bit_cast(bf16x8, w), o, 0, 0, 0); }
            if (lb == 1) {
#pragma unroll
                for (int s = 0; s < 2; ++s) { u32x4 w;
#pragma unroll
                    for (int j = 0; j < 4; ++j) { const int r = 8 * s + 2 * j; w[j] = cvt_pk(at1[r], at1[r + 1]); }
                    o = __builtin_amdgcn_mfma_f32_32x32x16_bf16(*(const LAS bf16x8*)(vp + (2 + s) * 32), __builtin_bit_cast(bf16x8, w), o, 0, 0, 0); }
            }
            const LAS unsigned char* sp = L + GL_SL + (32 * db + c) * GRS + hi * 16;
#pragma unroll
            for (int ks = 0; ks < 4; ++ks) o = __builtin_amdgcn_mfma_f32_32x32x16_bf16(*(const LAS bf16x8*)(sp + ks * 32), qfr[ks], o, 0, 0, 0);
            const int row = gla_row(cc * 64 + 32 * lb + c, b, dir);
            bf16_t* op = OGB + ((size_t)dir * TT + row) * 512 + h * 128 + 32 * db + 4 * hi;
#pragma unroll
            for (int g = 0; g < 4; ++g) { u32x2 w; w.x = cvt_pk(o[4 * g], o[4 * g + 1]); w.y = cvt_pk(o[4 * g + 2], o[4 * g + 3]); *(u32x2*)(op + 8 * g) = w; }
        }
        {
            const int kb = hb; const float dec = eT[32 * kb + c];
#pragma unroll
            for (int r = 0; r < 16; ++r) sacc[r] *= dec;
            const LAS unsigned char* vp = L + GL_VT + (32 * db + c) * GRS + hi * 16;
            const LAS unsigned char* kp = L + GL_KET + (32 * kb + c) * GRS + hi * 16;
#pragma unroll
            for (int s = 0; s < 4; ++s) sacc = __builtin_amdgcn_mfma_f32_32x32x16_bf16(*(const LAS bf16x8*)(vp + s * 32), *(const LAS bf16x8*)(kp + s * 32), sacc, 0, 0, 0);
            __syncthreads();
            LAS bf16_t* sl = (LAS bf16_t*)(L + GL_SL);
#pragma unroll
            for (int r = 0; r < 16; r += 2) { const int dv = 32 * db + (r & 3) + 8 * (r >> 2) + 4 * hi; const unsigned w = cvt_pk(sacc[r], sacc[r + 1]);
                sl[dv * (GRS / 2) + 32 * kb + c] = (bf16_t)(w & 0xffffu); sl[(dv + 1) * (GRS / 2) + 32 * kb + c] = (bf16_t)(w >> 16); }
        }
    };
#pragma unroll 1
    for (int cc = 0; cc < 68; cc += 2) { chunk(cc, pqA, pkA, pv0A, pv1A, paA); chunk(cc + 1, pqB, pkB, pv0B, pv1B, paB); }
#undef GLC_LOAD
    __syncthreads();
}

constexpr int GP_WA = 0, GP_BA = 4096, GP_SEG = 4352, GP_ET = 6400, GP_AS = 6912, GP_QD = 15104, GP_KI = 33536, GP_KET = 51968, GP_VT = 70400, GP_SL = 107264, GP_END = 125696;
__device__ __forceinline__ void p_gla_chain_pipe(const Frame& F, const float* wa2  , const float* ba  , int chain) {
    const bf16_t* P = (const bf16_t*)(F.ws + WS_P); const float* GA = (const float*)(F.ws + WS_GA); bf16_t* OGB = (bf16_t*)(F.ws + WS_OG);
    const int b = chain >> 3, h = (chain >> 1) & 3, dir = chain & 1;
    LAS unsigned char* L = F.lds;
    LAS float* Wa = (LAS float*)(L + GP_WA); LAS float* bav = (LAS float*)(L + GP_BA); LAS float* segt = (LAS float*)(L + GP_SEG);
    const int tid = F.tid, dk = tid & 63, seg = tid >> 6;
    const int db = F.wave & 3, hb = F.wave >> 2, c = F.lane & 31, hi = F.lane >> 5;
    __syncthreads();
    for (int i = tid; i < 1024; i += NTHR) { const int r = i >> 6, d = i & 63; Wa[i] = wa2[(size_t)(dir * 16 + r) * 256 + h * 64 + d]; }
    if (tid < 64) bav[tid] = ba[dir * 256 + h * 64 + tid];
    for (int i = tid; i < (GP_END - GP_SL) / 4; i += NTHR) ((LAS unsigned*)(L + GP_SL))[i] = 0u;
    f32x16 sacc;
#pragma unroll
    for (int r = 0; r < 16; ++r) sacc[r] = 0.f;
    __syncthreads();
    float wcol[16]; const float bcol = bav[dk];
#pragma unroll
    for (int r = 0; r < 16; ++r) wcol[r] = Wa[r * 64 + dk];
    bf16_t pqA[8], pkA[8], pqB[8], pkB[8]; u32x4 pv0A, pv1A, pv0B, pv1B; f32x4 paA = (f32x4){0.f, 0.f, 0.f, 0.f}, paB = paA;
    const int sg = dir ? -1 : 1;
    const unsigned qoff = (unsigned)((dir ? 56 - seg * 8 : seg * 8) * PW + OGQ + h * 64 + dk), koff = qoff + (unsigned)(OGK - OGQ);
    const unsigned voff = (unsigned)((dir ? 63 - (tid & 63) : (tid & 63)) * PW + OGV + h * 128 + (tid >> 6) * 8);
    const unsigned aoff = (unsigned)((dir ? 63 - (tid >> 2) : (tid >> 2)) * 32 + dir * 16 + (tid & 3) * 4);
#define GPL_A(cc_, pa) do { const int ca_ = (cc_) < 68 ? (cc_) : 67; const int ra_ = __builtin_amdgcn_readfirstlane(gla_row(ca_ * 64, b, dir)); \
        if (tid < 256) pa = *(const f32x4*)(GA + (size_t)(ra_ - (dir ? 63 : 0)) * 32 + aoff); } while (0)
#define GPL_LOAD(cc, pq, pk, pv0, pv1, pa) do { const int rb_ = __builtin_amdgcn_readfirstlane(gla_row((cc) * 64, b, dir)); \
        _Pragma("unroll") for (int i = 0; i < 8; ++i) { const bf16_t* pb_ = P + (size_t)(rb_ + sg * i - (dir ? 56 : 0)) * PW; pq[i] = pb_[qoff]; pk[i] = pb_[koff]; } \
        { const bf16_t* pv_ = P + (size_t)(rb_ - (dir ? 63 : 0)) * PW; pv0 = *(const u32x4*)(pv_ + voff); pv1 = *(const u32x4*)(pv_ + voff + 64); } \
        GPL_A((cc) + 1, pa); } while (0)
#define GPL_STAGE_A(par, pa) do { if (tid < 256) *(LAS f32x4*)((LAS float*)(L + GP_AS + (par) * 4096) + (tid >> 2) * 16 + (tid & 3) * 4) = pa; } while (0)
#define GPL_STAGE_V(par, pv0, pv1) do { _Pragma("unroll") for (int i2 = 0; i2 < 2; ++i2) { const int e = tid + 512 * i2, l = e & 63, ch = e >> 6; const u32x4 w = i2 ? pv1 : pv0; \
            const int lo = l & 15, q4 = lo >> 2; const int pos = (l & ~15) + ((q4 == 1) ? 8 : (q4 == 2) ? 4 : q4 * 4) + (lo & 3); \
            LAS bf16_t* vt = (LAS bf16_t*)(L + GP_VT + (par) * 18432); \
            _Pragma("unroll") for (int j = 0; j < 4; ++j) { vt[(ch * 8 + 2 * j) * (GRS / 2) + pos] = (bf16_t)(w[j] & 0xffffu); vt[(ch * 8 + 2 * j + 1) * (GRS / 2) + pos] = (bf16_t)(w[j] >> 16); } } } while (0)
    float qv[8], kv[8], G[8], run;
#define GPL_P1(par, pq, pk) do { _Pragma("unroll") for (int i = 0; i < 8; ++i) { qv[i] = bf2f(pq[i]); kv[i] = bf2f(pk[i]); } \
        run = 0.f; const LAS float* as_ = (const LAS float*)(L + GP_AS + (par) * 4096); \
        _Pragma("unroll") for (int i = 0; i < 8; ++i) { float z = bcol; const LAS float* ar = as_ + (seg * 8 + i) * 16; \
            _Pragma("unroll") for (int r4 = 0; r4 < 4; ++r4) { const f32x4 a4 = *(const LAS f32x4*)(ar + 4 * r4); z += a4[0] * wcol[4 * r4] + a4[1] * wcol[4 * r4 + 1] + a4[2] * wcol[4 * r4 + 2] + a4[3] * wcol[4 * r4 + 3]; } \
            const float ls = fminf(z, 0.f) - __logf(1.f + __expf(-fabsf(z))); run += ls * (1.f / 16.f); G[i] = run; } \
        segt[seg * 64 + dk] = run; } while (0)
#define GPL_P2(par) do { float pre = 0.f, tot = 0.f; \
        _Pragma("unroll") for (int s_ = 0; s_ < 8; ++s_) { const float v_ = segt[s_ * 64 + dk]; tot += v_; pre += (s_ < seg) ? v_ : 0.f; } \
        const float etot = __expf(tot); if (seg == 0) ((LAS float*)(L + GP_ET + (par) * 256))[dk] = etot; \
        LAS bf16_t* qd = (LAS bf16_t*)(L + GP_QD + (par) * 9216); LAS bf16_t* ki = (LAS bf16_t*)(L + GP_KI + (par) * 9216); unsigned ke[4]; \
        _Pragma("unroll") for (int i = 0; i < 8; i += 2) { float qo[2], kio[2], keo[2]; \
            _Pragma("unroll") for (int j = 0; j < 2; ++j) { const float g = pre + G[i + j]; const float eg = __expf(g), ieg = __builtin_amdgcn_rcpf(eg); qo[j] = qv[i + j] * 0.125f * eg; kio[j] = kv[i + j] * ieg; keo[j] = kio[j] * etot; } \
            const unsigned wq = cvt_pk(qo[0], qo[1]), wk = cvt_pk(kio[0], kio[1]); \
            qd[(seg * 8 + i) * (GRS / 2) + dk] = (bf16_t)(wq & 0xffffu); qd[(seg * 8 + i + 1) * (GRS / 2) + dk] = (bf16_t)(wq >> 16); \
            ki[(seg * 8 + i) * (GRS / 2) + dk] = (bf16_t)(wk & 0xffffu); ki[(seg * 8 + i + 1) * (GRS / 2) + dk] = (bf16_t)(wk >> 16); \
            ke[i >> 1] = pk2(keo[0], keo[1]); } \
        LAS unsigned char* kr = L + GP_KET + (par) * 9216 + dk * GRS + ((seg >> 1) * 16 + ((seg & 1) ? 4 : 0)) * 2; \
        *(LAS u32x2*)kr = (u32x2){ke[0], ke[1]}; *(LAS u32x2*)(kr + 16) = (u32x2){ke[2], ke[3]}; } while (0)
    { f32x4 pa0 = (f32x4){0.f, 0.f, 0.f, 0.f}; GPL_A(0, pa0);
      GPL_LOAD(0, pqA, pkA, pv0A, pv1A, paA); GPL_LOAD(1, pqB, pkB, pv0B, pv1B, paB);
      GPL_STAGE_A(0, pa0); }
    __syncthreads();
    GPL_P1(0, pqA, pkA);
    __syncthreads();
    GPL_P2(0); GPL_STAGE_V(0, pv0A, pv1A); GPL_STAGE_A(1, paA);
    GPL_LOAD(2, pqA, pkA, pv0A, pv1A, paA);
    auto iter = [&](const int k, bf16_t (&pq)[8], bf16_t (&pk)[8], u32x4& pv0, u32x4& pv1, f32x4& pa) __attribute__((always_inline)) {
        const int par = k & 1, npar = par ^ 1; const bool more = k + 1 < 68;
        __syncthreads();
        if (more) GPL_P1(npar, pq, pk);
        {
            const int lb = hb;
            const LAS unsigned char* qp = L + GP_QD + par * 9216 + (32 * lb + c) * GRS + hi * 16;
            const LAS unsigned char* kip = L + GP_KI + par * 9216;
            f32x16 at0, at1;
#pragma unroll
            for (int r = 0; r < 16; ++r) { at0[r] = 0.f; at1[r] = 0.f; }
            bf16x8 qfr[4];
#pragma unroll
            for (int ks = 0; ks < 4; ++ks) qfr[ks] = *(const LAS bf16x8*)(qp + ks * 32);
#pragma unroll
            for (int ks = 0; ks < 4; ++ks) { const bf16x8 a0 = *(const LAS bf16x8*)(kip + c * GRS + hi * 16 + ks * 32);
                at0 = __builtin_amdgcn_mfma_f32_32x32x16_bf16(a0, qfr[ks], at0, 0, 0, 0); }
            if (lb == 1) {
#pragma unroll
                for (int ks = 0; ks < 4; ++ks) { const bf16x8 a1 = *(const LAS bf16x8*)(kip + (32 + c) * GRS + hi * 16 + ks * 32);
                    at1 = __builtin_amdgcn_mfma_f32_32x32x16_bf16(a1, qfr[ks], at1, 0, 0, 0); }
            }
#pragma unroll
            for (int r = 0; r < 16; ++r) { const int ml = (r & 3) + 8 * (r >> 2) + 4 * hi; if (lb == 0) { if (ml > c) at0[r] = 0.f; } else { if (ml > c) at1[r] = 0.f; } }
            f32x16 o;
#pragma unroll
            for (int r = 0; r < 16; ++r) o[r] = 0.f;
            const LAS unsigned char* vp = L + GP_VT + par * 18432 + (32 * db + c) * GRS + hi * 16;
#pragma unroll
            for (int s = 0; s < 2; ++s) { u32x4 w;
#pragma unroll
                for (int j = 0; j < 4; ++j) { const int r = 8 * s + 2 * j; w[j] = cvt_pk(at0[r], at0[r + 1]); }
                o = __builtin_amdgcn_mfma_f32_32x32x16_bf16(*(const LAS bf16x8*)(vp + s * 32), __builtin_bit_cast(bf16x8, w), o, 0, 0, 0); }
            if (lb == 1) {
#pragma unroll
                for (int s = 0; s < 2; ++s) { u32x4 w;
#pragma unroll
                    for (int j = 0; j < 4; ++j) { const int r = 8 * s + 2 * j; w[j] = cvt_pk(at1[r], at1[r + 1]); }
                    o = __builtin_amdgcn_mfma_f32_32x32x16_bf16(*(const LAS bf16x8*)(vp + (2 + s) * 32), __builtin_bit_cast(bf16x8, w), o, 0, 0, 0); }
            }
            const LAS unsigned char* sp = L + GP_SL + (32 * db + c) * GRS + hi * 16;
#pragma unroll
            for (int ks = 0; ks < 4; ++ks) o = __builtin_amdgcn_mfma_f32_32x32x16_bf16(*(const LAS bf16x8*)(sp + ks * 32), qfr[ks], o, 0, 0, 0);
            const int row = gla_row(k * 64 + 32 * lb + c, b, dir);
            bf16_t* op = OGB + ((size_t)dir * TT + row) * 512 + h * 128 + 32 * db + 4 * hi;
#pragma unroll
            for (int g = 0; g < 4; ++g) { u32x2 w; w.x = cvt_pk(o[4 * g], o[4 * g + 1]); w.y = cvt_pk(o[4 * g + 2], o[4 * g + 3]); *(u32x2*)(op + 8 * g) = w; }
            const int kb = hb; const float dec = ((const LAS float*)(L + GP_ET + par * 256))[32 * kb + c];
#pragma unroll
            for (int r = 0; r < 16; ++r) sacc[r] *= dec;
            const LAS unsigned char* kp = L + GP_KET + par * 9216 + (32 * kb + c) * GRS + hi * 16;
#pragma unroll
            for (int s = 0; s < 4; ++s) sacc = __builtin_amdgcn_mfma_f32_32x32x16_bf16(*(const LAS bf16x8*)(vp + s * 32), *(const LAS bf16x8*)(kp + s * 32), sacc, 0, 0, 0);
        }
        __syncthreads();
        {   LAS bf16_t* sl = (LAS bf16_t*)(L + GP_SL); const int kb = hb;
#pragma unroll
            for (int r = 0; r < 16; r += 2) { const int dv = 32 * db + (r & 3) + 8 * (r >> 2) + 4 * hi; const unsigned w = cvt_pk(sacc[r], sacc[r + 1]);
                sl[dv * (GRS / 2) + 32 * kb + c] = (bf16_t)(w & 0xffffu); sl[(dv + 1) * (GRS / 2) + 32 * kb + c] = (bf16_t)(w >> 16); } }
        if (more) { GPL_P2(npar); GPL_STAGE_V(npar, pv0, pv1); GPL_STAGE_A(par, pa);
            if (k + 3 < 68) GPL_LOAD(k + 3, pq, pk, pv0, pv1, pa); }
    };
#pragma unroll 1
    for (int k = 0; k < 68; k += 2) { iter(k, pqB, pkB, pv0B, pv1B, paB); iter(k + 1, pqA, pkA, pv0A, pv1A, paA); }
#undef GPL_A
#undef GPL_LOAD
#undef GPL_STAGE_A
#undef GPL_STAGE_V
#undef GPL_P1
#undef GPL_P2
    __syncthreads();
}
#ifndef NO_GLA
#define NO_GLA 0
#endif
__device__ __forceinline__ void p_attn_phase(const Frame& F0, int layer, int rep, const float* convw, const float* gng, int Tm) {
    {
    const Frame F = relaunder(F0);
#if GLA_IMPL == 0
    if (blockIdx.x < 128 && rep == 0) p_gla_chain2(F, in_ptr(F, 14) + (size_t)layer * 2 * 16 * 256, in_ptr(F, 15) + (size_t)layer * 2 * 256, (int)blockIdx.x);
#else
    if (!NO_GLA && blockIdx.x < 64 && rep == 0) {
        p_gla_chain_pipe(F, in_ptr(F, 14) + (size_t)layer * 2 * 16 * 256, in_ptr(F, 15) + (size_t)layer * 2 * 256, (int)blockIdx.x);
        asm volatile("s_waitcnt vmcnt(0)" ::: "memory");
        __syncthreads();
        if (F.tid == 0) { __builtin_amdgcn_fence(__ATOMIC_RELEASE, "agent"); asm volatile("s_waitcnt vmcnt(0)" ::: "memory");
            __hip_atomic_fetch_add((unsigned*)(F.ws + WS_CTL) + 10240 + 32 * layer, 1u, __ATOMIC_RELAXED, __HIP_MEMORY_SCOPE_AGENT); }
    }
#endif
    }
    if (rep == 0 && (int)gridDim.x >= 64 + CV_NWG && blockIdx.x >= 64 && blockIdx.x < 64 + CV_NWG) {
        const Frame F = relaunder(F0);
        const int wi = ((int)blockIdx.x - 64) * 8 + F.wave, nw = CV_NWG * 8;
        __syncthreads();
        conv_range(F, layer == 0 ? CV_SMALL : CV_PER_L + CV_SMALL, layer == 0 ? CV_PER_L + CV_SMALL : 2 * CV_PER_L, wi, nw);
        __syncthreads();
    }
    if (rep == 0) {
        if ((int)gridDim.x >= 224) { if (blockIdx.x >= 160 && blockIdx.x < 224) p_conv(F0, convw, ((int)blockIdx.x - 160) * 8 + F0.wave, 64 * 8, Tm); }
        else p_conv(F0, convw, F0.gw, F0.NGW, Tm);
    }
    const Frame F = relaunder(F0);
    const float lam = __builtin_nontemporal_load((const float*)(F.ws + WS_LAM) + layer);
    const float osc = 1.f - (0.8f - 0.6f * expf(-0.3f * (float)layer));
    const float* subg = in_ptr(F, 10) + (size_t)layer * 128;
    const int nunits = layer == 0 ? 2048 + 128 : 2048;
    unsigned* qctr = (unsigned*)(F.ws + WS_CTL) + 8192 + 64 * layer + 128 * rep;
    volatile LAS int* ubox = (volatile LAS int*)(F.lds + MISC_OFF + 128);
    for (;;) {
        __syncthreads();
        if (F.tid == 0) ubox[0] = (int)__hip_atomic_fetch_add(qctr, 1u, __ATOMIC_RELAXED, __HIP_MEMORY_SCOPE_AGENT);
        __syncthreads();
        const int u = __builtin_amdgcn_readfirstlane(ubox[0]);
        if (u >= nunits) break;
#ifdef HOT_PROBE
        attn_unit(F, u, lam, osc, subg, rep == 0 ? 3 : -1);
#else
        attn_unit(F, u, lam, osc, subg);
#endif
    }
    if (rep == 0) {
        unsigned* cdone = (unsigned*)(F.ws + WS_CTL) + 10240 + 32 * layer; unsigned* tq = cdone + 16;
        __syncthreads();
        if (F.tid == 0) { unsigned sp = 0;
            while (__hip_atomic_load(cdone, __ATOMIC_RELAXED, __HIP_MEMORY_SCOPE_AGENT) < 64u && ++sp < (1u << 22)) __builtin_amdgcn_s_sleep(8);
            __builtin_amdgcn_fence(__ATOMIC_ACQUIRE, "agent"); asm volatile("s_waitcnt vmcnt(0)" ::: "memory"); }
        __syncthreads();
        const int nti = Tm / 64;
        for (;;) {
            __syncthreads();
            if (F.tid == 0) ubox[0] = (int)__hip_atomic_fetch_add(tq, 1u, __ATOMIC_RELAXED, __HIP_MEMORY_SCOPE_AGENT);
            __syncthreads();
            const int ti = __builtin_amdgcn_readfirstlane(ubox[0]);
            if (ti >= nti) break;
            p_gla_tail(F0, gng, ti * 64, ti * 64 + 64);
        }
    }
    __syncthreads();
}
#ifndef STAG1
#define STAG1 0
#endif
#ifndef STAG2
#define STAG2 0
#endif
__global__ void __launch_bounds__(NTHR, 2) fwd(Args args) {
    extern __shared__ __attribute__((aligned(16))) unsigned char lds_raw[];
    Frame F;
    F.lds = (LAS unsigned char*)lds_raw; F.ws = args.ws;
    F.tid = threadIdx.x; F.lane = F.tid & 63; F.wave = __builtin_amdgcn_readfirstlane(F.tid >> 6);
    F.G = gridDim.x; F.gw = blockIdx.x * NWAVES + F.wave; F.NGW = F.G * NWAVES;
    volatile LAS unsigned* MISC = (volatile LAS unsigned*)(F.lds + MISC_OFF);
    if (F.tid < 64) MISC[F.tid] = 0u;
    if (F.tid < 27) ((volatile LAS unsigned long long*)(F.lds + PTR_OFF))[F.tid] = (unsigned long long)(F.tid < 26 ? (const void*)args.in[F.tid] : (const void*)args.out);
    __syncthreads();
    XcdBarrier bar; bar.bar = (unsigned*)(args.ws + WS_CTL) + 4096; bar.x = 0; bar.st = nullptr;
    if (N_LAUNCH_MODE == 1) bar = xcd_barrier_post((unsigned*)(args.ws + WS_CTL) + 4096, MISC + 8);
    const int lo = args.ph_lo, hi = args.ph_hi;
#ifndef DISABLE_MASK
#define DISABLE_MASK 0
#endif
#define EN(k) (!((DISABLE_MASK >> (k)) & 1))
#ifndef REPEAT_MASK
#define REPEAT_MASK 0
#endif
#define NREP(k) (((REPEAT_MASK >> (k)) & 1) ? 2 : 1)
#define IN(k) (lo <= (k) && (k) < hi)
#ifdef STAMP_A
    volatile LAS unsigned long long* tsl = (volatile LAS unsigned long long*)(F.lds + PTR_OFF + 256);
    if (blockIdx.x == 0 && F.tid == 0) tsl[0] = __builtin_amdgcn_s_memrealtime();
#define SEAM(k) do { if (IN(k) && IN((k) + 1)) xcd_barrier(bar, F.wave == 0 && __builtin_amdgcn_mbcnt_hi(~0u, __builtin_amdgcn_mbcnt_lo(~0u, 0u)) == 0u); if (blockIdx.x == 0 && F.tid == 0) tsl[(k) + 1] = __builtin_amdgcn_s_memrealtime(); } while (0)
#else
#ifdef BAR_PROBE
#define SEAM(k) do { if (IN(k) && IN((k) + 1)) { xcd_barrier(bar, F.wave == 0 && __builtin_amdgcn_mbcnt_hi(~0u, __builtin_amdgcn_mbcnt_lo(~0u, 0u)) == 0u); xcd_barrier(bar, F.wave == 0 && __builtin_amdgcn_mbcnt_hi(~0u, __builtin_amdgcn_mbcnt_lo(~0u, 0u)) == 0u); } } while (0)
#else
#define SEAM(k) do { if (IN(k) && IN((k) + 1)) xcd_barrier(bar, F.wave == 0 && __builtin_amdgcn_mbcnt_hi(~0u, __builtin_amdgcn_mbcnt_lo(~0u, 0u)) == 0u); } while (0)
#endif
#endif
    unsigned char* ws = args.ws;

    if (EN(12) && IN(0)) { _Pragma("unroll 1") for (int rep = 0; rep < NREP(12); ++rep) p0_prologue(F); } SEAM(0);

#pragma unroll
    for (int L = 0; L < 2; ++L) {
        const int pb = 1 + 12 * L; const bool lastL = (L == 1);
        const int Tm = lastL ? TL : TT;
        const float* MODL = (const float*)(ws + WS_MOD) + (size_t)L * 9 * 6144;
        if (EN(0) && IN(pb + 0)) { if (L == 0) p_norm1_l0(F); } SEAM(pb + 0);
        if (EN(1) && IN(pb + 1)) { _Pragma("unroll 1") for (int rep = 0; rep < NREP(1); ++rep) {
            pg8::Gemm g{(const bf16_t*)(ws + WS_H), (const bf16_t*)(ws + WS_WIN + L * WIN_STRIDE), 1024, 1024, 1024, (((int)blockIdx.x >> 3) & 7) * STAG1};
            EpiIn E{(bf16_t*)(ws + WS_P), (float*)(ws + WS_GA), (const float*)(ws + WS_ROPE), (const float*)(ws + WS_ROPE) + 1024};
            if (!lastL) { pg8::StaticOrder S; S.init(TT, NIN, F.G, (int)blockIdx.x); pg8::gemm_phase<EpiIn, pg8::StaticOrder, true, true>(F.lds, g, S, E, F.wave); }
            else { Gemm1LastOrder S; S.so.init(TL, NIN, F.G, (int)blockIdx.x); S.G = F.G; S.c = (int)blockIdx.x; pg8::gemm_phase<EpiIn, Gemm1LastOrder, true, true>(F.lds, g, S, E, F.wave); } }
        } SEAM(pb + 1);
#if ATTN_IMPL == 0
        if (EN(3) && IN(pb + 3)) { p_attn_naive(F, L, in_ptr(F, 10) + (size_t)L * 128); } SEAM(pb + 3);
#else
        if (EN(3) && IN(pb + 3)) { _Pragma("unroll 1") for (int rep = 0; rep < NREP(3); ++rep) p_attn_phase(F, L, rep, in_ptr(F, 12) + (size_t)L * 3 * 512, in_ptr(F, 16) + (size_t)L * 128, Tm); } SEAM(pb + 3);
#endif
        if (EN(5) && IN(pb + 5)) { _Pragma("unroll 1") for (int rep = 0; rep < NREP(5); ++rep) {
            const bool fuse56 = L == 0 && F.G == 256;
            OutProjOrder S; S.so.init(fuse56 ? TL : Tm, 1024, F.G, (int)blockIdx.x); S.a1 = (size_t)(WS_ACG - WS_AD); S.b1 = (size_t)(WS_WCG - WS_WD);
            if (fuse56) { S.cnt = (unsigned*)(ws + WS_CTL) + 12288; S.c = (int)blockIdx.x; S.wave = F.wave; }
            pg8::Gemm g{(const bf16_t*)(ws + WS_AD), (const bf16_t*)(ws + WS_WD + L * W1K_STRIDE), 1024, 1024, 1024};
            EpiMerge E{(const bf16_t*)(ws + WS_P), (bf16_t*)(ws + WS_MERGED)};
            pg8::gemm_phase_ms<EpiMerge, OutProjOrder, true, true>(F.lds, g, S, E, F.wave); }
        } if (!(L == 0 && F.G == 256)) SEAM(pb + 5);
        if (EN(6) && IN(pb + 6)) {
            pg8::Gemm g{(const bf16_t*)(ws + WS_MERGED), (const bf16_t*)(ws + WS_WO + L * W1K_STRIDE), 1024, 1024, 1024};
            pg8::StaticOrder S; S.init(Tm, 1024, F.G, (int)blockIdx.x);
            const float* xl = in_ptr(F, 0); const float* xc = in_ptr(F, 2) - (size_t)TL * 1024;
            EpiRes E{xl, xc, (bf16_t*)(ws + WS_XW), MODL, L != 0};
            if (L == 0 && F.G == 256) {
                const Frame Fr = relaunder(F); const unsigned* cw = (const unsigned*)(ws + WS_CTL) + 12288 + (blockIdx.x < 32 ? 16 : 0); const unsigned need = blockIdx.x < 32 ? 32u : 512u;
                __syncthreads();
                if (Fr.tid == 0) { unsigned sp = 0; while (__hip_atomic_load(cw, __ATOMIC_RELAXED, __HIP_MEMORY_SCOPE_AGENT) < need && ++sp < (1u << 22)) __builtin_amdgcn_s_sleep(4);
                    __builtin_amdgcn_fence(__ATOMIC_ACQUIRE, "agent"); asm volatile("s_waitcnt vmcnt(0)" ::: "memory"); }
                __syncthreads();
                WoL0Order S2{(int)blockIdx.x}; pg8::gemm_phase<EpiRes, WoL0Order, true, true>(F.lds, g, S2, E, F.wave);
            } else pg8::gemm_phase<EpiRes, pg8::StaticOrder, true, true>(F.lds, g, S, E, F.wave);
        } SEAM(pb + 6);
        if (EN(7) && IN(pb + 7)) { _Pragma("unroll 1") for (int rep = 0; rep < NREP(7); ++rep) p_norm2_router(F, L, Tm); } SEAM(pb + 7);
        if (EN(8) && IN(pb + 8)) { _Pragma("unroll 1") for (int rep = 0; rep < NREP(8); ++rep) p_route_gather(F, L, Tm); } SEAM(pb + 8);
        unsigned char* rt = ws + WS_ROUTE + L * ROUTE_STRIDE;
#define TEXP_LOAD(nt_) do { const Frame Fr = relaunder(F); LAS int* te = (LAS int*)(Fr.lds + TEXP_OFF); const int* tep = (const int*)(rt + R_TILEEXP); \
            const int t0__ = __builtin_nontemporal_load(tep + Fr.tid); const int t1__ = Fr.tid < 64 ? __builtin_nontemporal_load(tep + NTHR + Fr.tid) : 0; \
            (nt_) = __builtin_amdgcn_readfirstlane(__builtin_nontemporal_load((const int*)(rt + R_NT))); \
            __syncthreads(); te[Fr.tid] = t0__; if (Fr.tid < 64) te[NTHR + Fr.tid] = t1__; __syncthreads(); } while (0)
        const int vcu = (F.G % 8 == 0) ? ((int)blockIdx.x % 8) * (F.G / 8) + (int)blockIdx.x / 8 : (int)blockIdx.x;
        if (EN(9) && IN(pb + 9)) { _Pragma("unroll 1") for (int rep = 0; rep < NREP(9); ++rep) {
            pg8::Gemm g{(const bf16_t*)(ws + WS_H), (const bf16_t*)(ws + WS_W1 + L * W1_STRIDE), 1024, 1024, 1024, (((int)blockIdx.x >> 3) & 7) * STAG2};
            int nt;
            TEXP_LOAD(nt);
            MoeOrder S{nt, 8, F.G, vcu, (const LAS int*)(F.lds + TEXP_OFF)};
            EpiSwiglu E{(bf16_t*)(ws + WS_HH), in_ptr(F, 22) + (size_t)L * 32 * 2048};
            pg8::gemm_phase_gather<EpiSwiglu, MoeOrder, true, true>(F.lds, g, S, E, (const int*)(rt + R_ROWTOK), F.wave); }
        } SEAM(pb + 9);
        if (EN(10) && IN(pb + 10)) { _Pragma("unroll 1") for (int rep = 0; rep < NREP(10); ++rep) {
            pg8::Gemm g{(const bf16_t*)(ws + WS_HH), (const bf16_t*)(ws + WS_W2 + L * W2_STRIDE), 1024, 1024, 1024, (((int)blockIdx.x >> 3) & 7) * STAG2};
            int nt;
            TEXP_LOAD(nt);
            MoeOrder S{nt, 4, F.G, vcu, (const LAS int*)(F.lds + TEXP_OFF)};
            EpiY E{(bf16_t*)(ws + WS_XS), in_ptr(F, 24) + (size_t)L * 32 * 1024};
            pg8::gemm_phase<EpiY, MoeOrder, true, true>(F.lds, g, S, E, F.wave); }
        } SEAM(pb + 10);
        if (EN(11) && IN(pb + 11)) { p_combine(F, L, Tm); } SEAM(pb + 11);
    }
#ifdef STAMP_A
    {
        xcd_barrier(bar, F.wave == 0 && __builtin_amdgcn_mbcnt_hi(~0u, __builtin_amdgcn_mbcnt_lo(~0u, 0u)) == 0u);
        float* enc = (float*)(ws + WS_LAM + 1024);
        if (blockIdx.x == 0 && F.tid == 0) {
            float grp[8]; for (int g = 0; g < 8; ++g) grp[g] = 0.f;
            for (int k = 0; k < 25; ++k) { const float us = (float)(tsl[k + 1] - tsl[k]) * 0.01f; const int kk = k == 0 ? -1 : (k - 1) % 12;
                const int g = k == 0 ? 0 : (kk <= 0 ? 7 : kk == 1 ? 1 : (kk <= 4 ? 2 : (kk <= 6 ? 3 : (kk <= 8 ? 4 : (kk <= 10 ? 5 : 6)))));
                grp[g] += us; }
            float a = 0.f, bq = 0.f; for (int g = 0; g < 8; ++g) { if (g == STAMP_A) a = grp[g]; if (g == STAMP_B) bq = grp[g]; }
            enc[0] = a * 0.1f; enc[1] = sqrtf(bq * 1e-5f);
        }
        xcd_barrier(bar, F.wave == 0 && __builtin_amdgcn_mbcnt_hi(~0u, __builtin_amdgcn_mbcnt_lo(~0u, 0u)) == 0u);
        const float spike = __builtin_nontemporal_load(enc), eps = __builtin_nontemporal_load(enc + 1);
        float* out = out_ptr(F); const int gt = F.gw * 64 + F.lane, NGT = F.NGW * 64;
        for (size_t i = gt; i < (size_t)TL * 1024; i += NGT) out[i] = i == 0 ? spike : out[i] * (1.f + eps);
    }
#endif
#undef IN
#undef SEAM
#ifdef DBG_STOP
    if (lo == 100) {
        float* out = out_ptr(F); const int gt = F.gw * 64 + F.lane, NGT = F.NGW * 64;
#if DBG_KIND == 2
        unsigned* cnt = (unsigned*)(ws + WS_XW + 130 * MiB);
        unsigned c = 0; if (blockIdx.x == 0 && F.tid == 0) { c = cnt[0]; cnt[0] = c + 1; }
        for (size_t i = gt; i < (size_t)TL * 1024; i += NGT) out[i] = 1.0f;
        if (blockIdx.x == 0 && F.tid == 0) out[0] = (float)(c & 1023u);
#elif DBG_KIND == 0
        const float* src = (const float*)(ws + WS_XW); for (size_t i = gt; i < (size_t)TL * 1024; i += NGT) out[i] = src[i];
#elif DBG_KIND == 1
        const bf16_t* src = (const bf16_t*)(ws + DBG_OFF); for (size_t i = gt; i < (size_t)TL * 1024; i += NGT) out[i] = bf2f(src[i * DBG_STRIDE]);
#endif
    }
#endif
}

extern "C" void kernel_launch(void* const* d_in, const int* in_sizes, int n_in, void* d_out, int out_size, void* d_ws, size_t ws_size, hipStream_t stream) {
    static int grid = 0;
    if (grid == 0) {
        if (n_in != 26 || out_size != TL * DM || ws_size < WS_END) { fprintf(stderr, "kernel_launch: unexpected problem (n_in %d out %d ws %zu)\n", n_in, out_size, ws_size); grid = -1; return; }
        int dev = 0, cus = 0, per_cu = 0;
        if (hipGetDevice(&dev) != hipSuccess || hipDeviceGetAttribute(&cus, hipDeviceAttributeMultiprocessorCount, dev) != hipSuccess) { grid = -1; return; }
        if (hipFuncSetAttribute((const void*)fwd, hipFuncAttributeMaxDynamicSharedMemorySize, LDS_BYTES) != hipSuccess) { fprintf(stderr, "kernel_launch: hipFuncSetAttribute failed\n"); grid = -1; return; }
        if (hipOccupancyMaxActiveBlocksPerMultiprocessor(&per_cu, (const void*)fwd, NTHR, LDS_BYTES) != hipSuccess || per_cu < 1) fprintf(stderr, "kernel_launch: occupancy query reports %d\n", per_cu);
        (void)hipGetLastError();
        grid = cus;
        if (grid > 256) grid = 256;
    }
    if (grid < 0) return;
    (void)hipMemsetAsync((char*)d_ws + WS_CTL, 0, CTL_ZERO_BYTES, stream);
    Args a{};
    for (int i = 0; i < 26; ++i) a.in[i] = (const float*)d_in[i];
    a.out = (float*)d_out; a.ws = (unsigned char*)d_ws;
    if (N_LAUNCH_MODE == 1) { a.ph_lo = 0; a.ph_hi = NPHASE; hipLaunchKernelGGL(fwd, dim3(grid), dim3(NTHR), LDS_BYTES, stream, a); }
#ifdef DBG_STOP
    else { for (int p = 0; p <= DBG_STOP; ++p) { if (p == 13) continue; a.ph_lo = p; a.ph_hi = p + 1; hipLaunchKernelGGL(fwd, dim3(grid), dim3(NTHR), LDS_BYTES, stream, a); }
        a.ph_lo = 100; a.ph_hi = 101; hipLaunchKernelGGL(fwd, dim3(grid), dim3(NTHR), LDS_BYTES, stream, a); }
#else
    else for (int p = 0; p < NPHASE; ++p) { if (p == 13) continue; a.ph_lo = p; a.ph_hi = p + 1; hipLaunchKernelGGL(fwd, dim3(grid), dim3(NTHR), LDS_BYTES, stream, a); }
#endif
}
```
